# Optimizing an MI355X kernel written in HIP

```python
import math
import jax
import jax.numpy as jnp
from jax import lax
import numpy as np

D_MODEL = 1024
BATCH = 8
SEQ = 4096
DEPTH = 1

CHUNK = 64
PLE_DIM = 256
EPS = 1e-6

SSM_WIDTH = D_MODEL // 2
SSM_GROUP = 16
SSM_GROUPS = SSM_WIDTH // SSM_GROUP
SSM_STATE = 64
DT_MIN = 1e-3
DT_MAX = 1e-1

N_HEADS = 8
HEAD_DIM = 64
ATTN_WIDTH = N_HEADS * HEAD_DIM
IDX_HEADS = 8
IDX_DIM = 32
TOPK_MAX = 256
Q_BLOCK = 128
ROPE_THETA = 10000.0

IN_SIZES = (SSM_WIDTH, ATTN_WIDTH, ATTN_WIDTH, ATTN_WIDTH, IDX_HEADS * IDX_DIM, IDX_DIM, IDX_HEADS, D_MODEL, D_MODEL)
IN_COLS = sum(IN_SIZES)

N_EXPERTS = 32
TOP_K = 4
D_FF = D_MODEL
SWIGLU_LIMIT = 7.0
SWIGLU_ALPHA = 1.702

kernel_name = 'hybrid_s5_dsa_moe_ple_block'


def rmsnorm(x, g):
    xf = x.astype(jnp.float32)
    y = xf * lax.rsqrt(jnp.mean(xf * xf, axis=-1, keepdims=True) + EPS)
    return (y * g.astype(jnp.float32)).astype(x.dtype)


def rope(x, pos):
    d = x.shape[-1]
    half = d // 2
    inv = ROPE_THETA ** (-jnp.arange(half, dtype=jnp.float32) * 2.0 / d)
    ang = pos.astype(jnp.float32)[:, None] * inv[None, :]
    cos = jnp.cos(ang)[:, None, :]
    sin = jnp.sin(ang)[:, None, :]
    x1 = x[..., :half].astype(jnp.float32)
    x2 = x[..., half:].astype(jnp.float32)
    out = jnp.concatenate([x1 * cos - x2 * sin, x2 * cos + x1 * sin], axis=-1)
    return out.astype(x.dtype)


def split_in(z):
    pts = np.cumsum(IN_SIZES)[:-1].tolist()
    return jnp.split(z, pts, axis=-1)


def s5_scan(u, lam_re, lam_im, log_dt, b_re, b_im, c_re, c_im, d_skip):
    f32 = jnp.float32
    lam = lax.complex(lam_re.astype(f32), lam_im.astype(f32))
    dt = jnp.exp(log_dt.astype(f32))[:, None]
    lam_bar = jnp.exp(lam * dt)
    b = lax.complex(b_re.astype(f32), b_im.astype(f32))
    b_bar = ((lam_bar - 1.0) / lam)[..., None] * b
    c = lax.complex(c_re.astype(f32), c_im.astype(f32))

    def combine(e1, e2):
        a1, s1 = e1
        a2, s2 = e2
        return a1 * a2, a2 * s1 + s2

    def per_seq(u_seq):
        bu = jnp.einsum('gph,lgh->lgp', b_bar, u_seq.astype(f32))
        a = jnp.broadcast_to(lam_bar, bu.shape)
        _, states = lax.associative_scan(combine, (a, bu), axis=0)
        return jnp.einsum('ghp,lgp->lgh', c, states).real

    y = lax.map(per_seq, u)
    y = y + d_skip.astype(f32) * u.astype(f32)
    return y.astype(u.dtype)


def dsa_attention(q, k, v, q_idx, k_idx, w_idx):
    f32 = jnp.float32
    bsz, seq = q.shape[0], q.shape[1]
    topk = min(TOPK_MAX, seq // 4)
    key_chunk = jnp.arange(seq) // CHUNK
    scale = HEAD_DIM ** -0.5
    idx_scale = (IDX_HEADS * IDX_DIM) ** -0.5
    kf = k_idx.astype(f32)
    gather = jax.vmap(lambda t, i: t[i])

    def block(start):
        q_chunk = (start + jnp.arange(Q_BLOCK)) // CHUNK
        qb = lax.dynamic_slice_in_dim(q, start, Q_BLOCK, axis=1)
        qib = lax.dynamic_slice_in_dim(q_idx, start, Q_BLOCK, axis=1).astype(f32)
        wb = lax.dynamic_slice_in_dim(w_idx, start, Q_BLOCK, axis=1).astype(f32) * idx_scale
        dots = jnp.einsum('bthd,bsd->bths', qib, kf)
        score = jnp.einsum('bth,bths->bts', wb, jax.nn.relu(dots))
        allowed = key_chunk[None, :] <= q_chunk[:, None]
        score = jnp.where(allowed[None], score, -jnp.inf)
        _, sel = lax.top_k(score, topk)
        valid = key_chunk[sel] <= q_chunk[None, :, None]
        kg = gather(k, sel)
        vg = gather(v, sel)
        logits = jnp.einsum('bthd,btjhd->bthj', qb, kg).astype(f32) * scale
        logits = jnp.where(valid[:, :, None, :], logits, -jnp.inf)
        probs = jax.nn.softmax(logits, axis=-1).astype(v.dtype)
        return jnp.einsum('bthj,btjhd->bthd', probs, vg)

    starts = jnp.arange(seq // Q_BLOCK) * Q_BLOCK
    out = lax.map(block, starts)
    return jnp.moveaxis(out, 0, 1).reshape(bsz, seq, N_HEADS * HEAD_DIM)


def moe(h, w_router, b_router, w_gate, b_gate, w_up, b_up, w_down, b_down):
    bsz, seq, d = h.shape
    t = h.reshape(-1, d)
    logits = (t @ w_router + b_router).astype(jnp.float32)
    top_val, top_idx = lax.top_k(logits, TOP_K)
    weights = jax.nn.softmax(top_val, axis=-1)
    flat_e = top_idx.reshape(-1)
    order = jnp.argsort(flat_e)
    e_sorted = flat_e[order]
    xs = t[order // TOP_K]
    sizes = jnp.bincount(flat_e, length=N_EXPERTS).astype(jnp.int32)
    g = lax.ragged_dot(xs, w_gate, sizes) + b_gate[e_sorted]
    u = lax.ragged_dot(xs, w_up, sizes) + b_up[e_sorted]
    g = jnp.minimum(g, SWIGLU_LIMIT)
    u = jnp.clip(u, -SWIGLU_LIMIT, SWIGLU_LIMIT)
    a = (u + 1.0) * (g * jax.nn.sigmoid(SWIGLU_ALPHA * g))
    ys = lax.ragged_dot(a, w_down, sizes) + b_down[e_sorted]
    inv = jnp.argsort(order)
    y = ys[inv].reshape(-1, TOP_K, d)
    out = jnp.einsum('tk,tkd->td', weights.astype(y.dtype), y)
    return out.reshape(bsz, seq, d)


def setup_inputs(seed: int = 0) -> dict:
    key = jax.random.key(seed)
    ks = iter(jax.random.split(key, 40))
    f32 = jnp.float32

    def nrm(shape, scale):
        return jax.random.normal(next(ks), shape, f32) * scale

    def gain(shape):
        return 1.0 + nrm(shape, 0.05)

    nl, G, P, H, D, E = DEPTH, SSM_GROUPS, SSM_STATE, SSM_GROUP, D_MODEL, N_EXPERTS
    x = nrm((BATCH, SEQ, D), 1.0)
    p = nrm((DEPTH, BATCH, SEQ, PLE_DIM), 1.0)
    w_in = nrm((nl, D, IN_COLS), D ** -0.5)
    b_gates = nrm((nl, 2 * D), 0.01)
    n_idx = jnp.arange(P, dtype=f32)
    lam_re = -0.5 + nrm((nl, G, P), 0.01)
    lam_im = jnp.pi * n_idx + nrm((nl, G, P), 0.01)
    log_dt = jax.random.uniform(next(ks), (nl, G), f32, math.log(DT_MIN), math.log(DT_MAX))
    b_re = nrm((nl, G, P, H), (2 * H) ** -0.5)
    b_im = nrm((nl, G, P, H), (2 * H) ** -0.5)
    c_re = nrm((nl, G, H, P), (2 * P) ** -0.5)
    c_im = nrm((nl, G, H, P), (2 * P) ** -0.5)
    d_skip = nrm((nl, G, H), 1.0)
    w_glu = nrm((nl, SSM_WIDTH, SSM_WIDTH), SSM_WIDTH ** -0.5)
    b_glu = nrm((nl, SSM_WIDTH), 0.01)
    w_ssm_br = nrm((nl, SSM_WIDTH, D), SSM_WIDTH ** -0.5)
    w_attn_br = nrm((nl, ATTN_WIDTH, D), ATTN_WIDTH ** -0.5)
    w_o = nrm((nl, D, D), D ** -0.5)
    norm_mix = gain((nl, D))
    norm_ffn = gain((nl, D))
    w_router = nrm((nl, D, E), D ** -0.5)
    b_router = nrm((nl, E), 0.01)
    w_gate = nrm((nl, E, D, D_FF), D ** -0.5)
    b_gate = nrm((nl, E, D_FF), 0.01)
    w_up = nrm((nl, E, D, D_FF), D ** -0.5)
    b_up = nrm((nl, E, D_FF), 0.01)
    w_down = nrm((nl, E, D_FF, D), D_FF ** -0.5)
    b_down = nrm((nl, E, D), 0.01)
    w_ple_gate = nrm((nl, D, D), D ** -0.5)
    w_ple_proj = nrm((nl, PLE_DIM, D), PLE_DIM ** -0.5)
    norm_final = gain((D,))
    return {'x': x, 'p': p, 'w_in': w_in, 'b_gates': b_gates, 'lam_re': lam_re, 'lam_im': lam_im,
            'log_dt': log_dt, 'b_re': b_re, 'b_im': b_im, 'c_re': c_re, 'c_im': c_im, 'd_skip': d_skip,
            'w_glu': w_glu, 'b_glu': b_glu, 'w_ssm_br': w_ssm_br, 'w_attn_br': w_attn_br, 'w_o': w_o,
            'norm_mix': norm_mix, 'norm_ffn': norm_ffn, 'w_router': w_router, 'b_router': b_router,
            'w_gate': w_gate, 'b_gate': b_gate, 'w_up': w_up, 'b_up': b_up, 'w_down': w_down,
            'b_down': b_down, 'w_ple_gate': w_ple_gate, 'w_ple_proj': w_ple_proj, 'norm_final': norm_final}


def reference(x, p, w_in, b_gates, lam_re, lam_im, log_dt, b_re, b_im, c_re, c_im, d_skip,
              w_glu, b_glu, w_ssm_br, w_attn_br, w_o, norm_mix, norm_ffn, w_router, b_router,
              w_gate, b_gate, w_up, b_up, w_down, b_down, w_ple_gate, w_ple_proj, norm_final):
    bsz, seq, _ = x.shape
    pos = jnp.arange(seq)
    r = x
    for i in range(DEPTH):
        h = rmsnorm(r, norm_mix[i])
        z = h @ w_in[i]
        u_ssm, q, k, v, q_idx, k_idx, w_idx, z_gs, z_ga = split_in(z)

        u_ssm = u_ssm.reshape(bsz, seq, SSM_GROUPS, SSM_GROUP)
        y_ssm = s5_scan(u_ssm, lam_re[i], lam_im[i], log_dt[i], b_re[i], b_im[i],
                        c_re[i], c_im[i], d_skip[i]).reshape(bsz, seq, SSM_WIDTH)
        y_ssm = jax.nn.gelu(y_ssm)
        y_ssm = y_ssm * jax.nn.sigmoid(y_ssm @ w_glu[i] + b_glu[i])
        br_ssm = y_ssm @ w_ssm_br[i]

        q = rope(q.reshape(bsz, seq, N_HEADS, HEAD_DIM), pos)
        k = rope(k.reshape(bsz, seq, N_HEADS, HEAD_DIM), pos)
        v = v.reshape(bsz, seq, N_HEADS, HEAD_DIM)
        q_idx = rope(q_idx.reshape(bsz, seq, IDX_HEADS, IDX_DIM), pos)
        k_idx = rope(k_idx[:, :, None, :], pos)[:, :, 0, :]
        y_attn = dsa_attention(q, k, v, q_idx, k_idx, w_idx)
        br_attn = y_attn @ w_attn_br[i]

        g_ssm = jax.nn.sigmoid(z_gs + b_gates[i, :D_MODEL])
        g_attn = jax.nn.sigmoid(z_ga + b_gates[i, D_MODEL:])
        r = r + (g_ssm * br_ssm + g_attn * br_attn) @ w_o[i]

        h2 = rmsnorm(r, norm_ffn[i])
        r = r + moe(h2, w_router[i], b_router[i], w_gate[i], b_gate[i], w_up[i], b_up[i],
                    w_down[i], b_down[i])

        r = r + jax.nn.sigmoid(r @ w_ple_gate[i]) * (p[i] @ w_ple_proj[i])
    return rmsnorm(r, norm_final)
```

```cpp
#include <hip/hip_runtime.h>
#include <hip/hip_cooperative_groups.h>
#include <cstdio>
#include <cstdint>
#include <cmath>
namespace cg = cooperative_groups;

#define LAS __attribute__((address_space(3)))
#define GAS __attribute__((address_space(1)))
typedef unsigned short bf16_t;
typedef short bf16x8 __attribute__((ext_vector_type(8)));
typedef short s16x4 __attribute__((ext_vector_type(4)));
typedef float f32x4 __attribute__((ext_vector_type(4)));
typedef float f32x16 __attribute__((ext_vector_type(16)));
typedef unsigned u32x4 __attribute__((ext_vector_type(4)));
typedef unsigned u32x2 __attribute__((ext_vector_type(2)));

constexpr int LDS_BYTES_C = 147456;
constexpr int NB = 8, SEQ = 4096, DM = 1024, T = NB * SEQ;
constexpr int PLE = 256, NE = 32, TOPK = 4, NSLOT = T * TOPK;
constexpr int INC = 4392, INP = 4608;
constexpr int NGRP = 32, SST = 64;
constexpr float EPS = 1e-6f;
constexpr float C2 = 0.125f * 1.4426950408889634f;
constexpr int NTHR = 512;

constexpr size_t MB = 1000000;
constexpr size_t WS_CTL   = 0;
constexpr size_t WS_COS64 = 1 * MB;
constexpr size_t WS_SIN64 = WS_COS64 + 4096 * 32 * 4;
constexpr size_t WS_COS32 = WS_SIN64 + 4096 * 32 * 4;
constexpr size_t WS_SIN32 = WS_COS32 + 4096 * 16 * 4;
constexpr size_t WS_KG    = 3 * MB;
constexpr size_t WS_L64   = WS_KG + 32 * 64 * 256 * 4;
constexpr size_t WS_KIDX  = 6 * MB;
constexpr size_t WS_WIDX  = 9 * MB;
constexpr size_t WS_EF32  = 11 * MB;
constexpr size_t WS_WG    = 20 * MB;
constexpr size_t WS_LTOK  = 29 * MB;
constexpr size_t WS_LSLOT = 34 * MB;
constexpr size_t WS_LWT   = 39 * MB;
constexpr size_t WS_SMALL_END = 44 * MB;
constexpr size_t WS_W2T   = WS_SMALL_END;
constexpr size_t SZ_W2T   = (size_t)32 * 1024 * 1024 * 2;
constexpr size_t WS_W1T   = WS_W2T + SZ_W2T;
constexpr size_t SZ_W1T   = (size_t)32 * 2048 * 1024 * 2;
constexpr size_t WS_E     = WS_W1T + SZ_W1T;
constexpr size_t SZ_E     = (size_t)T * 1024 * 2;
constexpr size_t WS_A     = WS_E + SZ_E;
constexpr size_t SZ_A     = (size_t)NSLOT * 1024 * 2;
constexpr size_t WS_TAIL  = WS_A + SZ_A;
constexpr size_t WS_WINT  = WS_TAIL;
constexpr size_t WS_WIN8  = WS_WINT + (size_t)512 * 1024 * 2;
constexpr size_t WS_WGLUT = WS_WIN8 + (size_t)INP * 1024;
constexpr size_t WS_WSB8  = WS_WGLUT + 512 * 512 * 2;
constexpr size_t WS_WAB8  = WS_WSB8 + 1024 * 512;
constexpr size_t WS_WO8   = WS_WAB8 + 1024 * 512;
constexpr size_t WS_WPG8  = WS_WO8 + 1024 * 1024;
constexpr size_t WS_WPPT  = WS_WPG8 + 1024 * 1024;
constexpr size_t WS_END   = WS_WPPT + 1024 * 256 * 2;
static_assert(WS_END <= 604000000ull, "workspace map must fit sum(inputs) bytes");
constexpr size_t WS_U     = WS_A;
constexpr size_t SZ_U     = (size_t)32 * 512 * 1152 * 2;
constexpr size_t WS_Q     = WS_U + SZ_U;
constexpr size_t SZ_QKV   = (size_t)T * 512 * 2;
constexpr size_t WS_K     = WS_Q + SZ_QKV;
constexpr size_t WS_V     = WS_K + SZ_QKV;
constexpr size_t WS_QIDX  = WS_V + SZ_QKV;
constexpr size_t WS_MASK  = WS_QIDX + (size_t)T * 256 * 2;
constexpr size_t WS_TV    = WS_MASK + (size_t)8 * 128 * 4096 * 4;
constexpr size_t SZ_TV    = (size_t)32 * 1024 * 1152 * 2;
static_assert(WS_TV + SZ_TV <= WS_TAIL, "early temporaries fit the A region");
constexpr size_t WS_R2    = WS_A;
constexpr size_t WS_R2BF  = WS_A + (size_t)T * 1024 * 4;
constexpr size_t WS_PBF   = WS_R2BF + (size_t)T * 1024;
constexpr size_t WS_PROJ  = WS_PBF + (size_t)T * 256 * 2;
static_assert(WS_PROJ + (size_t)T * 1024 * 2 <= WS_TAIL, "late users fit the A region");
constexpr size_t WS_H8    = WS_W2T + (size_t)32 * 1024 * 1024;
constexpr size_t WS_YA8   = WS_E + 40 * MB;
constexpr size_t WS_Y28   = WS_K;
constexpr size_t WS_MIX8  = WS_TV;
constexpr int CW_CNT = 64;
constexpr int CW_QIDX = 192, CW_QATT = 256;
constexpr int CW_SSQ = 1024;
constexpr int CTL_WORDS = CW_SSQ + T;

__device__ __forceinline__ unsigned f2bf(float f) { unsigned u = __builtin_bit_cast(unsigned, f); return (u + 0x7fffu + ((u >> 16) & 1u)) >> 16; }
typedef float f32x2_t __attribute__((ext_vector_type(2))); typedef __bf16 bf16x2_t __attribute__((ext_vector_type(2)));
__device__ __forceinline__ unsigned pk2(float lo, float hi) { f32x2_t v = {lo, hi}; bf16x2_t b = __builtin_convertvector(v, bf16x2_t); return __builtin_bit_cast(unsigned, b); }
__device__ __forceinline__ float bf2f(unsigned short b) { return __builtin_bit_cast(float, (unsigned)b << 16); }
__device__ __forceinline__ float bflo(unsigned w) { return __builtin_bit_cast(float, w << 16); }
__device__ __forceinline__ float bfhi(unsigned w) { return __builtin_bit_cast(float, w & 0xffff0000u); }
__device__ __forceinline__ float wave_sum(float v) {
#pragma unroll
    for (int o = 1; o < 64; o <<= 1) v += __shfl_xor(v, o);
    return v;
}
__device__ __forceinline__ float sigmoidf_(float x) { return __builtin_amdgcn_rcpf(1.0f + __builtin_amdgcn_exp2f(-1.4426950408889634f * x)); }
__device__ __forceinline__ float gelu_tanh(float x) {
    const float u = 0.7978845608028654f * (x + 0.044715f * x * x * x);
    const float e = __expf(-2.0f * fabsf(u));
    float t = (1.0f - e) / (1.0f + e); t = u < 0.f ? -t : t;
    return 0.5f * x * (1.0f + t);
}


typedef int v8i_t __attribute__((ext_vector_type(8)));
typedef int v4i_t __attribute__((ext_vector_type(4)));
__device__ __forceinline__ unsigned pk4_fp8(float a, float b, float c, float d) { int w = __builtin_amdgcn_cvt_pk_fp8_f32(a, b, 0, false); w = __builtin_amdgcn_cvt_pk_fp8_f32(c, d, w, true); return (unsigned)w; }
#ifdef FP8_SELFTEST
__device__ __forceinline__ bool fp8_selftest(int lane) {
    const int rc = lane & 15, g = lane >> 4; v8i_t a, b;
#pragma unroll
    for (int w = 0; w < 8; ++w) { float av[4], bv[4];
#pragma unroll
        for (int q = 0; q < 4; ++q) { const int bb = w * 4 + q; const int k = bb < 16 ? 16 * g + bb : 64 + 16 * g + (bb - 16);
            av[q] = (float)((rc * 7 + k * 3) % 9 - 4) * 0.5f; bv[q] = (float)((k * 5 + rc * 11) % 7 - 3) * 0.25f; }
        a[w] = (int)pk4_fp8(av[0], av[1], av[2], av[3]); b[w] = (int)pk4_fp8(bv[0], bv[1], bv[2], bv[3]); }
    f32x4 c = {0.f, 0.f, 0.f, 0.f};
    c = __builtin_amdgcn_mfma_scale_f32_16x16x128_f8f6f4(a, b, c, 0, 0, 0, 0x7f7f7f7f, 0, 0x7f7f7f7f);
    bool ok = true;
#pragma unroll
    for (int r = 0; r < 4; ++r) { const int i = 4 * g + r, j = rc; float ref = 0.f;
        for (int k = 0; k < 128; ++k) ref += ((float)((i * 7 + k * 3) % 9 - 4) * 0.5f) * ((float)((k * 5 + j * 11) % 7 - 3) * 0.25f);
        ok = ok && (c[r] == ref); }
    return __all(ok);
}
#endif

namespace pg {
constexpr int BM = 256, BK = 64, HALF = 128, HTB = HALF * BK * 2, STAGE_BYTES = 8 * HTB;
__device__ __forceinline__ int lds_byte(int r, int c) { const int st = (r >> 4) * 2 + (c >> 5), rr = r & 15, cc = c & 31, ob = rr * 64 + cc * 2; return st * 1024 + (ob ^ (((ob >> 9) & 1) << 5)); }
__device__ __forceinline__ void stage_rc(int b, int& R, int& C) { const int st = b / 1024, sb = b % 1024, swz = sb ^ (((sb >> 9) & 1) << 5); R = (st >> 1) * 16 + swz / 64; C = (st & 1) * 32 + (swz % 64) / 2; }
struct Unit { int pm, pn, g, li; };

template <bool FP8 = false, class Prob, class Epi>
__device__ __forceinline__ void gemm_phase(LAS unsigned char* lds, const Prob& P, const Epi& E) {
    const int tid = threadIdx.x, wid = __builtin_amdgcn_readfirstlane(tid >> 6), lane = tid & 63, wr = wid >> 2, wc = wid & 3, fr = lane & 15, fq = lane >> 4;
    const int nt = P.nt;
    int R[2], C[2];
#pragma unroll
    for (int i = 0; i < 2; ++i) stage_rc(tid * 16 + i * 8192, R[i], C[i]);
    unsigned offB[2][2];
#pragma unroll
    for (int h = 0; h < 2; ++h)
#pragma unroll
        for (int i = 0; i < 2; ++i) offB[h][i] = (unsigned)(h * HALF + R[i]) * P.ldb_bytes + (unsigned)C[i] * 2u;
    const unsigned ldsw = (unsigned)wid * 1024u;
    const int aoff = lds_byte(wr * 64 + fr, fq * 8), boff = lds_byte(wc * 32 + fr, fq * 8);
#define PG_SA(b, h) (((b) * 2 + (h)) * HTB)
#define PG_SB(b, h) ((4 + (b) * 2 + (h)) * HTB)
#define PG_STAGE(bufoff, gbase, voff, kbytes) do { _Pragma("unroll") for (int _i = 0; _i < 2; ++_i) \
        __builtin_amdgcn_global_load_lds((const unsigned*)((const char*)(gbase) + (voff)[_i] + (kbytes)), (LAS unsigned*)(lds + (bufoff) + ldsw + _i * 8192), 16, 0, 0); } while (0)
#define PG_CAT8(x0, x1) __builtin_shufflevector(x0, x1, 0, 1, 2, 3, 4, 5, 6, 7)
#define PG_LDA(dst, b, h) do { if constexpr (FP8) { _Pragma("unroll") for (int m = 0; m < 4; ++m) dst##8[m] = PG_CAT8(*(const LAS v4i_t*)(lds + PG_SA(b, h) + aoff + m * 2048), *(const LAS v4i_t*)(lds + PG_SA(b, h) + aoff + m * 2048 + 1024)); } \
        else { _Pragma("unroll") for (int m = 0; m < 4; ++m) _Pragma("unroll") for (int k = 0; k < 2; ++k) dst[m][k] = *(const LAS bf16x8*)(lds + PG_SA(b, h) + aoff + m * 2048 + k * 1024); } } while (0)
#define PG_LDB(dst, b, h) do { if constexpr (FP8) { _Pragma("unroll") for (int n = 0; n < 2; ++n) dst##8[n] = PG_CAT8(*(const LAS v4i_t*)(lds + PG_SB(b, h) + boff + n * 2048), *(const LAS v4i_t*)(lds + PG_SB(b, h) + boff + n * 2048 + 1024)); } \
        else { _Pragma("unroll") for (int n = 0; n < 2; ++n) _Pragma("unroll") for (int k = 0; k < 2; ++k) dst[n][k] = *(const LAS bf16x8*)(lds + PG_SB(b, h) + boff + n * 2048 + k * 1024); } } while (0)
#define PG_MMA(ai, bj, At, Bt) do { __builtin_amdgcn_s_setprio(1); \
        if constexpr (FP8) { _Pragma("unroll") for (int m = 0; m < 4; ++m) _Pragma("unroll") for (int n = 0; n < 2; ++n) \
            asm volatile("v_mfma_scale_f32_16x16x128_f8f6f4 %0, %1, %2, %0, %3, %3 op_sel_hi:[0,0,0]" : "+v"(acc[ai][bj][m][n]) : "v"(Bt##8[n]), "v"(At##8[m]), "v"(sc1)); } \
        else { _Pragma("unroll") for (int m = 0; m < 4; ++m) _Pragma("unroll") for (int n = 0; n < 2; ++n) _Pragma("unroll") for (int k = 0; k < 2; ++k) \
            acc[ai][bj][m][n] = __builtin_amdgcn_mfma_f32_16x16x32_bf16(Bt[n][k], At[m][k], acc[ai][bj][m][n], 0, 0, 0); } \
        __builtin_amdgcn_s_setprio(0); } while (0)
#define PG_WAIT_V(n) asm volatile("s_waitcnt vmcnt(" #n ")" ::: "memory")
#define PG_WAIT_L(n) asm volatile("s_waitcnt lgkmcnt(" #n ")" ::: "memory")
#define PG_BAR __builtin_amdgcn_s_barrier()
#define PG_SCHED __builtin_amdgcn_sched_barrier(0)
    Unit cur, nxt; int ui = 0;
    if (!P.next(0, cur)) return;
    f32x4 acc[2][2][4][2];
#pragma unroll
    for (int a = 0; a < 2; ++a)
#pragma unroll
        for (int b = 0; b < 2; ++b)
#pragma unroll
            for (int m = 0; m < 4; ++m)
#pragma unroll
                for (int n = 0; n < 2; ++n) acc[a][b][m][n] = (f32x4){0.f, 0.f, 0.f, 0.f};
    bf16x8 At[4][2], B0[2][2], B1[2][2]; v8i_t At8[4], B08[2], B18[2]; int sc1 = 0x7f7f7f7f; asm volatile("" : "+v"(sc1));
    const char* cA = P.a_base(cur); const char* cB = P.b_base(cur);
    unsigned cOA[2][2], nOA[2][2];
#pragma unroll
    for (int h = 0; h < 2; ++h)
#pragma unroll
        for (int i = 0; i < 2; ++i) cOA[h][i] = P.a_off(cur, h * HALF + R[i], C[i]);
    PG_STAGE(PG_SB(0, 0), cB, offB[0], 0); PG_STAGE(PG_SB(0, 1), cB, offB[1], 0); PG_STAGE(PG_SA(0, 0), cA, cOA[0], 0); PG_STAGE(PG_SA(0, 1), cA, cOA[1], 0);
    if (wr == 1) PG_BAR;
    PG_WAIT_V(2); PG_BAR;
    PG_STAGE(PG_SB(1, 0), cB, offB[0], 128); PG_STAGE(PG_SA(1, 0), cA, cOA[0], 128); PG_STAGE(PG_SB(1, 1), cB, offB[1], 128);
    PG_WAIT_V(6); PG_BAR;
    for (;;) {
        const bool has_next = P.next(ui + 1, nxt);
        const char* nA = has_next ? P.a_base(nxt) : cA; const char* nB = has_next ? P.b_base(nxt) : cB;
#pragma unroll
        for (int h = 0; h < 2; ++h)
#pragma unroll
            for (int i = 0; i < 2; ++i) nOA[h][i] = has_next ? P.a_off(nxt, h * HALF + R[i], C[i]) : cOA[h][i];
        for (int t = 0; t < nt; t += 2) {
            const bool last = (t == nt - 2);
            const unsigned k1 = (unsigned)(t + 1) * 128u;
            const unsigned k2 = last ? 0u : (unsigned)(t + 2) * 128u, k3 = k2 + 128u;
            const char* a2 = last ? nA : cA; const char* b2 = last ? nB : cB;
            unsigned o2[2][2];
#pragma unroll
            for (int h = 0; h < 2; ++h)
#pragma unroll
                for (int i = 0; i < 2; ++i) o2[h][i] = last ? nOA[h][i] : cOA[h][i];
            PG_LDB(B0, 0, 0); PG_LDB(B1, 0, 1); PG_SCHED; PG_LDA(At, 0, 0); PG_STAGE(PG_SA(1, 1), cA, cOA[1], k1);
            PG_WAIT_V(8); PG_WAIT_L(0); PG_BAR; PG_MMA(0, 0, At, B0); PG_MMA(0, 1, At, B1); PG_BAR; PG_SCHED;
            PG_LDA(At, 0, 1); PG_STAGE(PG_SB(0, 0), b2, offB[0], k2); PG_STAGE(PG_SB(0, 1), b2, offB[1], k2); PG_STAGE(PG_SA(0, 0), a2, o2[0], k2);
            PG_WAIT_V(8); PG_WAIT_L(0); PG_BAR; PG_MMA(1, 0, At, B0); PG_MMA(1, 1, At, B1); PG_BAR; PG_SCHED;
            PG_LDB(B0, 1, 0); PG_LDB(B1, 1, 1); PG_SCHED; PG_LDA(At, 1, 0); PG_STAGE(PG_SA(0, 1), a2, o2[1], k2);
            PG_WAIT_V(8); PG_WAIT_L(0); PG_BAR; PG_MMA(0, 0, At, B0); PG_MMA(0, 1, At, B1); PG_BAR; PG_SCHED;
            PG_LDA(At, 1, 1); PG_STAGE(PG_SB(1, 0), b2, offB[0], k3); PG_STAGE(PG_SB(1, 1), b2, offB[1], k3); PG_STAGE(PG_SA(1, 0), a2, o2[0], k3);
            PG_WAIT_V(8); PG_WAIT_L(0); PG_BAR; PG_MMA(1, 0, At, B0); PG_MMA(1, 1, At, B1); PG_BAR; PG_SCHED;
        }
        if (wr == 0) PG_BAR;
        if constexpr (FP8) asm volatile("s_nop 15\n\ts_nop 15" ::: "memory");
        { int fr_ = fr, fq_ = fq; asm volatile("" : "+v"(fr_), "+v"(fq_));
          E(acc, cur, wr, wc, fr_, fq_);
#ifdef PROBE_EPI2
          asm volatile("" : "+v"(fr_), "+v"(fq_)); E(acc, cur, wr, wc, fr_, fq_);
#endif
        }
        if (!has_next) break;
#pragma unroll
        for (int a = 0; a < 2; ++a)
#pragma unroll
            for (int b = 0; b < 2; ++b)
#pragma unroll
                for (int m = 0; m < 4; ++m)
#pragma unroll
                    for (int n = 0; n < 2; ++n) acc[a][b][m][n] = (f32x4){0.f, 0.f, 0.f, 0.f};
        cur = nxt; cA = nA; cB = nB; ++ui;
#pragma unroll
        for (int h = 0; h < 2; ++h)
#pragma unroll
            for (int i = 0; i < 2; ++i) cOA[h][i] = nOA[h][i];
        if (wr == 1) PG_BAR;
    }
    PG_WAIT_V(0);
    PG_BAR;
#undef PG_SA
#undef PG_SB
#undef PG_STAGE
#undef PG_LDA
#undef PG_LDB
#undef PG_MMA
#undef PG_CAT8
#undef PG_WAIT_V
#undef PG_WAIT_L
#undef PG_BAR
#undef PG_SCHED
}

struct Order {
    int nM, nN, nwg, G, c;
    __device__ void init(int nM_, int nN_, int G_, int c_) { nM = nM_; nN = nN_; nwg = nM * nN; G = G_; c = c_; }
    __device__ bool get(int i, int& pm, int& pn) const {
        const long L = (long)i * G + c; if (L >= nwg) return false;
        int wgid = (int)L; { const int q = nwg / 8, r = nwg % 8, xcd = wgid % 8, off = wgid / 8; wgid = (xcd < r ? xcd * (q + 1) : r * (q + 1) + (xcd - r) * q) + off; }
        const int nig = 8 * nN, gid = wgid / nig, fm = gid * 8, gsz = (nM - fm) < 8 ? (nM - fm) : 8;
        pm = fm + ((wgid % nig) % gsz); pn = (wgid % nig) / gsz; return true;
    }
};
struct Dense {
    const char* A; const char* B; unsigned lda_bytes, ldb_bytes; int nt; Order ord; int pn_base = 0, pn_split = 1 << 30, pn_skip = 0, b_tile0 = 0;
    __device__ bool next(int i, Unit& u) const { u.g = 0; int pp; const bool ok = ord.get(i, u.pm, pp); u.pn = pn_base + pp + (pp >= pn_split ? pn_skip : 0); return ok; }
    __device__ const char* a_base(const Unit& u) const { return A + (size_t)u.pm * 256 * lda_bytes; }
    __device__ unsigned a_off(const Unit&, int row, int col) const { return (unsigned)row * lda_bytes + (unsigned)col * 2u; }
    __device__ const char* b_base(const Unit& u) const { return B + (size_t)(u.pn - b_tile0) * 256 * ldb_bytes; }
};
}

struct Frame {
    LAS unsigned char* lds;
    int tid, lane, wave, G, bid, dry;
    const float* in[30]; float* out; unsigned char* ws;
};
#define WSP(T_, off) ((T_*)(F.ws + (off)))
#define LDS_WAIT() asm volatile("s_waitcnt lgkmcnt(0)" ::: "memory")

template <class DstRow>
__device__ __forceinline__ void transpose_item(const float* W, int K, int N, bf16_t* WT, LAS float* scr, int item, int lane, const DstRow& dstrow) {
    const int nblk = (N + 63) / 64, kb = item / nblk, nb = item % nblk, k0 = 64 * kb, n0 = 64 * nb;
    const int kk = lane >> 4, n4 = (lane & 15) * 4;
    f32x4 v[16];
#pragma unroll
    for (int i = 0; i < 16; ++i) v[i] = *(const f32x4*)(W + (size_t)(k0 + 4 * i + kk) * N + n0 + n4);
#pragma unroll
    for (int i = 0; i < 16; ++i) { LAS float* d = scr + (4 * i + kk) * 65 + n4; d[0] = v[i].x; d[1] = v[i].y; d[2] = v[i].z; d[3] = v[i].w; }
    LDS_WAIT(); asm volatile("" ::: "memory");
    const int c = lane & 7;
#pragma unroll
    for (int j = 0; j < 8; ++j) { const int n = (lane >> 3) + 8 * j; const LAS float* p = scr + (8 * c) * 65 + n; const int dr = dstrow(n0 + n);
        if (dr >= 0) { u32x4 o; o.x = pk2(p[0], p[65]); o.y = pk2(p[130], p[195]); o.z = pk2(p[260], p[325]); o.w = pk2(p[390], p[455]);
            *(u32x4*)(WT + (size_t)dr * K + k0 + 8 * c) = o; } }
    LDS_WAIT(); asm volatile("" ::: "memory");
}
__device__ __forceinline__ void tr8_load(f32x4 (&v)[16], const float* W, int K, int N, int item, int lane) {
    const int nblk = (N + 63) / 64, kb = item / nblk, nb = item % nblk, k0 = 64 * kb, n0 = 64 * nb; const int kk = lane >> 4, n4 = (lane & 15) * 4;
#pragma unroll
    for (int i = 0; i < 16; ++i) v[i] = *(const f32x4*)(W + (size_t)(k0 + 4 * i + kk) * N + n0 + n4);
}
template <class DstRow>
__device__ __forceinline__ void tr8_process(const f32x4 (&v)[16], int K, int N, unsigned char* WT, LAS float* scr, int item, int lane, float scale, const DstRow& dstrow) {
    const int nblk = (N + 63) / 64, kb = item / nblk, nb = item % nblk, k0 = 64 * kb, n0 = 64 * nb; const int kk = lane >> 4, n4 = (lane & 15) * 4;
#pragma unroll
    for (int i = 0; i < 16; ++i) { LAS float* d = scr + (4 * i + kk) * 65 + n4; d[0] = v[i].x * scale; d[1] = v[i].y * scale; d[2] = v[i].z * scale; d[3] = v[i].w * scale; }
    LDS_WAIT(); asm volatile("" ::: "memory");
    const int c = lane & 3;
#pragma unroll
    for (int j = 0; j < 4; ++j) { const int n = (lane >> 2) + 16 * j; const LAS float* p = scr + (16 * c) * 65 + n; const int dr = dstrow(n0 + n);
        u32x4 o; o.x = pk4_fp8(p[0], p[65], p[130], p[195]); o.y = pk4_fp8(p[260], p[325], p[390], p[455]); o.z = pk4_fp8(p[520], p[585], p[650], p[715]); o.w = pk4_fp8(p[780], p[845], p[910], p[975]);
        *(u32x4*)(WT + (size_t)dr * K + k0 + 16 * c) = o; }
    LDS_WAIT(); asm volatile("" ::: "memory");
}
template <class DstRow>
__device__ __forceinline__ void transpose_item_fp8(const float* W, int K, int N, unsigned char* WT, LAS float* scr, int item, int lane, float scale, const DstRow& dstrow) {
    f32x4 v[16]; tr8_load(v, W, K, N, item, lane); tr8_process(v, K, N, WT, scr, item, lane, scale, dstrow);
}
__device__ __forceinline__ int win_dst_row(int c) {
    if (c < 512) return c;
    if (c < 1536) { const int isk = c >= 1024, cc = c - (isk ? 1024 : 512), t = cc >> 8, w = cc & 255, hl = w >> 6, half = (w >> 5) & 1, dd = w & 31; return ((isk ? 4 : 2) + t) * 256 + half * 128 + hl * 32 + dd; }
    if (c < 2048) return 6 * 256 + (c - 1536);
    if (c < 2304) { const int cc = c - 2048, head = cc >> 5, half = (cc >> 4) & 1, dd = cc & 15; return 8 * 256 + half * 128 + head * 16 + dd; }
    if (c < 2336) { const int cc = c - 2304, half = cc >> 4, w = cc & 15; return 9 * 256 + half * 128 + w; }
    if (c < 2344) return 9 * 256 + 16 + (c - 2336);
    if (c < INC) return 2560 + (c - 2344);
    return -1;
}
__device__ __forceinline__ void rms_row_to_bf16(const float* xrow, const float* gain, bf16_t* orow, unsigned char* orow8, int lane) {
    const f32x4* xr = (const f32x4*)xrow + lane; const f32x4* gr = (const f32x4*)gain + lane;
    f32x4 v[4]; float s = 0.f;
#pragma unroll
    for (int j = 0; j < 4; ++j) { v[j] = xr[64 * j]; s += (v[j].x * v[j].x + v[j].y * v[j].y) + (v[j].z * v[j].z + v[j].w * v[j].w); }
    const float rstd = 1.0f / sqrtf(wave_sum(s) * (1.f / 1024.f) + EPS);
    u32x2* o8 = (u32x2*)orow + lane;
#pragma unroll
    for (int j = 0; j < 4; ++j) { const f32x4 g = gr[64 * j]; const float a0 = v[j].x * rstd * g.x, a1 = v[j].y * rstd * g.y, a2 = v[j].z * rstd * g.z, a3 = v[j].w * rstd * g.w;
        u32x2 w; w.x = pk2(a0, a1); w.y = pk2(a2, a3); o8[64 * j] = w; ((unsigned*)orow8)[lane + 64 * j] = pk4_fp8(a0, a1, a2, a3); }
}

__device__ __forceinline__ void p0_prologue(Frame& F) {
    LAS float* scr = (LAS float*)(F.lds + F.wave * 16640);
    const int gw = F.bid * 8 + F.wave, NGW = F.G * 8;
    { unsigned* ctl = WSP(unsigned, WS_CTL); for (int i = F.bid * NTHR + F.tid; i < CTL_WORDS; i += F.G * NTHR) ctl[i] = 0u; }
    { float* c64 = WSP(float, WS_COS64); float* s64 = WSP(float, WS_SIN64); float* c32 = WSP(float, WS_COS32); float* s32 = WSP(float, WS_SIN32);
      for (int i = F.bid * NTHR + F.tid; i < 4096 * 48; i += F.G * NTHR) {
          if (i < 4096 * 32) { const int pos = i >> 5, k = i & 31; const float inv = powf(10000.0f, -(float)k * (2.0f / 64.0f)); const float a = (float)pos * inv; c64[i] = cosf(a); s64[i] = sinf(a); }
          else { const int j = i - 4096 * 32, pos = j >> 4, k = j & 15; const float inv = powf(10000.0f, -(float)k * (2.0f / 32.0f)); const float a = (float)pos * inv; c32[j] = cosf(a); s32[j] = sinf(a); } } }
    { bf16_t* WT = WSP(bf16_t, WS_WINT) + (size_t)256 * 1024; unsigned char* W8 = WSP(unsigned char, WS_WIN8) + (size_t)9 * 256 * 1024;
      for (int i = F.bid * NTHR + F.tid; i < 256 * 128; i += F.G * NTHR) { const int row = i >> 7, ch = i & 127; const int w = row & 127, half = row >> 7;
          const bool used = (w < 16) || (half == 0 && w < 24); if (!used) { *(u32x4*)(WT + (size_t)row * 1024 + ch * 8) = (u32x4){0u, 0u, 0u, 0u}; if (ch < 64) *(u32x4*)(W8 + (size_t)row * 1024 + ch * 16) = (u32x4){0u, 0u, 0u, 0u}; } } }
    constexpr int I_WIN = ((INC + 63) / 64) * (1024 / 64), I_GLU = (512 / 64) * (512 / 64), I_SB = (1024 / 64) * (512 / 64), I_AB = I_SB, I_O = (1024 / 64) * (1024 / 64), I_PG = I_O, I_PP = (1024 / 64) * (256 / 64);
    constexpr int I_E = (1024 / 64) * (1024 / 64);
    constexpr int NDENSE = I_WIN + I_GLU + I_SB + I_AB + I_O + I_PG + I_PP;
    auto ident = [](int n) { return n; };
    for (int it = gw; it < NDENSE; it += NGW) {
        int r = it;
        if (r < I_WIN) {
            const int nblk = (INC + 63) / 64, nb = r % nblk;
            if (nb * 64 + 64 <= INC) { transpose_item_fp8(F.in[2], 1024, INC, WSP(unsigned char, WS_WIN8), scr, r, F.lane, 32.0f, [](int n) { return win_dst_row(n); });
                if (nb * 64 + 64 > 2048 && nb * 64 < 2344) transpose_item(F.in[2], 1024, INC, WSP(bf16_t, WS_WINT), scr, r, F.lane, [](int n) { const int d = win_dst_row(n); return (d >= 2048 && d < 2560) ? d - 2048 : -1; }); }
            else { const int kb = r / nblk, k0 = 64 * kb, n0 = 64 * nb; const int n = n0 + F.lane; const int dr = n < INC ? win_dst_row(n) : -1;
                if (dr >= 0) { unsigned char* o = WSP(unsigned char, WS_WIN8) + (size_t)dr * 1024 + k0;
                    for (int k = 0; k < 64; k += 4) *(unsigned*)(o + k) = pk4_fp8(32.0f * F.in[2][(size_t)(k0 + k) * INC + n], 32.0f * F.in[2][(size_t)(k0 + k + 1) * INC + n], 32.0f * F.in[2][(size_t)(k0 + k + 2) * INC + n], 32.0f * F.in[2][(size_t)(k0 + k + 3) * INC + n]); } }
            continue; } r -= I_WIN;
        if (r < I_GLU) { transpose_item(F.in[12], 512, 512, WSP(bf16_t, WS_WGLUT), scr, r, F.lane, ident); continue; } r -= I_GLU;
        if (r < I_SB) { transpose_item_fp8(F.in[14], 512, 1024, WSP(unsigned char, WS_WSB8), scr, r, F.lane, 32.0f, ident); continue; } r -= I_SB;
        if (r < I_AB) { transpose_item_fp8(F.in[15], 512, 1024, WSP(unsigned char, WS_WAB8), scr, r, F.lane, 32.0f, ident); continue; } r -= I_AB;
        if (r < I_O) { transpose_item_fp8(F.in[16], 1024, 1024, WSP(unsigned char, WS_WO8), scr, r, F.lane, 32.0f, ident); continue; } r -= I_O;
        if (r < I_PG) { transpose_item_fp8(F.in[27], 1024, 1024, WSP(unsigned char, WS_WPG8), scr, r, F.lane, 32.0f, ident); continue; } r -= I_PG;
        transpose_item(F.in[28], 256, 1024, WSP(bf16_t, WS_WPPT), scr, r, F.lane, ident);
    }
    for (int m = gw; m < T; m += NGW) rms_row_to_bf16(F.in[0] + (size_t)m * 1024, F.in[17], WSP(bf16_t, WS_E) + (size_t)m * 1024, WSP(unsigned char, WS_H8) + (size_t)m * 1024, F.lane);
}

__device__ __forceinline__ void p0_s5_tables(Frame& F) {
    LAS float* zr = (LAS float*)F.lds; LAS float* zi = zr + 64; LAS float* bbr = zi + 64; LAS float* bbi = bbr + 1024; LAS float* Lr = bbi + 1024; LAS float* Li = Lr + 512;
    const float* lam_re = F.in[4]; const float* lam_im = F.in[5]; const float* log_dt = F.in[6]; const float* b_re = F.in[7]; const float* b_im = F.in[8];
    const float* c_re = F.in[9]; const float* c_im = F.in[10]; const float* d_skip = F.in[11];
    float* Kg = WSP(float, WS_KG); float* L64 = WSP(float, WS_L64); bf16_t* Wg = WSP(bf16_t, WS_WG); bf16_t* TV = WSP(bf16_t, WS_TV);
    for (int it = F.bid; it < 256; it += F.G) {
        const int g = it >> 3, sub = it & 7, tid = F.tid;
        __syncthreads();
        const float dt = expf(log_dt[g]);
        if (tid < 64) { zr[tid] = lam_re[g * 64 + tid] * dt; zi[tid] = lam_im[g * 64 + tid] * dt; }
        __syncthreads();
        for (int idx = tid; idx < 1024; idx += NTHR) { const int p = idx >> 4, hp = idx & 15;
            const float lr = lam_re[g * 64 + p], li = lam_im[g * 64 + p];
            const float er = expf(zr[p]), cr = er * cosf(zi[p]), ci = er * sinf(zi[p]);
            const float nr = cr - 1.0f, ni = ci, den = lr * lr + li * li;
            const float fr_ = (nr * lr + ni * li) / den, fi_ = (ni * lr - nr * li) / den;
            const float br = b_re[(g * 64 + p) * 16 + hp], bi = b_im[(g * 64 + p) * 16 + hp];
            bbr[idx] = fr_ * br - fi_ * bi; bbi[idx] = fr_ * bi + fi_ * br; }
        { const int lagl = tid >> 6, p = tid & 63; const float n = (float)(8 * sub + lagl); const float mag = expf(n * zr[p]), a = n * zi[p]; Lr[tid] = mag * cosf(a); Li[tid] = mag * sinf(a); }
        __syncthreads();
#pragma unroll 1
        for (int j = 0; j < 4; ++j) { const int o = tid + 512 * j, lagl = o >> 8, h = (o >> 4) & 15, hp = o & 15; float s = 0.f;
            for (int p = 0; p < 64; ++p) { const float cr = c_re[(g * 16 + h) * 64 + p], ci = c_im[(g * 16 + h) * 64 + p], lr = Lr[lagl * 64 + p], li = Li[lagl * 64 + p];
                const float tr = cr * lr - ci * li, ti = cr * li + ci * lr; s += tr * bbr[p * 16 + hp] - ti * bbi[p * 16 + hp]; }
            const int lag = 8 * sub + lagl; if (lag == 0 && h == hp) s += d_skip[g * 16 + h];
            Kg[((g * 64 + lag) * 16 + h) * 16 + hp] = s; }
        { const int pl = tid >> 6, j = tid & 63, p = 8 * sub + pl;
          { const float n = (float)(63 - j); const float mag = expf(n * zr[p]), a = n * zi[p]; const float er = mag * cosf(a), ei = mag * sinf(a);
            unsigned wre[8], wim[8];
#pragma unroll
            for (int q = 0; q < 8; ++q) { const float b0r = bbr[p * 16 + 2 * q], b0i = bbi[p * 16 + 2 * q], b1r = bbr[p * 16 + 2 * q + 1], b1i = bbi[p * 16 + 2 * q + 1];
                wre[q] = pk2(er * b0r - ei * b0i, er * b1r - ei * b1i); wim[q] = pk2(er * b0i + ei * b0r, er * b1i + ei * b1r); }
            u32x4* dre = (u32x4*)(Wg + (size_t)(g * 128 + p) * 1024 + j * 16); u32x4* dim = (u32x4*)(Wg + (size_t)(g * 128 + 64 + p) * 1024 + j * 16);
            dre[0] = (u32x4){wre[0], wre[1], wre[2], wre[3]}; dre[1] = (u32x4){wre[4], wre[5], wre[6], wre[7]};
            dim[0] = (u32x4){wim[0], wim[1], wim[2], wim[3]}; dim[1] = (u32x4){wim[4], wim[5], wim[6], wim[7]}; }
          { const int t = j; const float n = (float)(t + 1); const float mag = expf(n * zr[p]), a = n * zi[p]; const float er = mag * cosf(a), ei = mag * sinf(a);
#pragma unroll 4
            for (int h = 0; h < 16; ++h) { const float cr = c_re[(g * 16 + h) * 64 + p], ci = c_im[(g * 16 + h) * 64 + p];
                bf16_t* d = TV + (size_t)(g * 1024 + t * 16 + h) * 1152 + 1024 + p;
                d[0] = (bf16_t)f2bf(cr * er - ci * ei); d[64] = (bf16_t)f2bf(-(cr * ei + ci * er)); } }
          if (sub == 0 && tid < 64) { const float mag = expf(64.0f * zr[tid]), a = 64.0f * zi[tid]; L64[(g * 64 + tid) * 2] = mag * cosf(a); L64[(g * 64 + tid) * 2 + 1] = mag * sinf(a); }
        }
    }
    __syncthreads();
}
__device__ __forceinline__ void fill_tv_item(unsigned char* wsb, int tid, int item) {
    const float* Kg = (const float*)(wsb + WS_KG); bf16_t* TV = (bf16_t*)(wsb + WS_TV);
#pragma unroll 4
    for (int it = 0; it < 16; ++it) { const int ci = (item * 16 + it) * NTHR + tid;
        const int g = ci >> 17, row = (ci >> 7) & 1023, ch = ci & 127, t = row >> 4, h = row & 15, j = ch >> 1, h0 = (ch & 1) * 8, lag = t - j;
        u32x4 o = (u32x4){0u, 0u, 0u, 0u};
        if (lag >= 0) { const f32x4* sp = (const f32x4*)(Kg + ((g * 64 + lag) * 16 + h) * 16 + h0); const f32x4 a = sp[0], b = sp[1];
            o.x = pk2(a.x, a.y); o.y = pk2(a.z, a.w); o.z = pk2(b.x, b.y); o.w = pk2(b.z, b.w); }
        *(u32x4*)(TV + (size_t)(g * 1024 + row) * 1152 + ch * 8) = o; }
}

struct EpiInProj {
    bf16_t *U, *Q, *K, *V, *QI, *KI, *GS, *GA; float* WI; const float *bg, *c64, *s64, *c32, *s32; float ascale;
    __device__ __forceinline__ void operator()(f32x4 (&acc)[2][2][4][2], const pg::Unit& u, int wr, int wc, int fr, int fq) const {
        const int pn = u.pn, row0 = u.pm * 256 + wr * 64 + fr;
        if (ascale != 1.0f) {
#pragma unroll
            for (int a_ = 0; a_ < 2; ++a_)
#pragma unroll
                for (int b_ = 0; b_ < 2; ++b_)
#pragma unroll
                    for (int m_ = 0; m_ < 4; ++m_)
#pragma unroll
                        for (int n_ = 0; n_ < 2; ++n_) acc[a_][b_][m_][n_] *= ascale; }
        if (pn < 2) {
#pragma unroll
            for (int ai = 0; ai < 2; ++ai)
#pragma unroll
                for (int m = 0; m < 4; ++m) { const int r = row0 + ai * 128 + m * 16;
#pragma unroll
                    for (int bj = 0; bj < 2; ++bj)
#pragma unroll
                        for (int n = 0; n < 2; ++n) { const int c = pn * 256 + bj * 128 + wc * 32 + n * 16 + fq * 4; const int g = c >> 4, hp = c & 15; const f32x4 v = acc[ai][bj][m][n];
                            u32x2 w; w.x = pk2(v.x, v.y); w.y = pk2(v.z, v.w);
                            *(u32x2*)(U + ((size_t)(g * 512 + (r >> 6)) * 1152 + (r & 63) * 16 + hp)) = w; } }
        } else if (pn < 6) {
            bf16_t* O = pn < 4 ? Q : K; const float sc = pn < 4 ? C2 : 1.0f; const int head = (pn & 1) * 4 + wc;
#pragma unroll
            for (int ai = 0; ai < 2; ++ai)
#pragma unroll
                for (int m = 0; m < 4; ++m) { const int r = row0 + ai * 128 + m * 16, l = r & 4095;
#pragma unroll
                    for (int n = 0; n < 2; ++n) { const int dd = n * 16 + fq * 4; const f32x4 cs = *(const f32x4*)(c64 + l * 32 + dd), sn = *(const f32x4*)(s64 + l * 32 + dd);
                        const f32x4 x1 = acc[ai][0][m][n], x2 = acc[ai][1][m][n]; const f32x4 o1 = (x1 * cs - x2 * sn) * sc, o2 = (x2 * cs + x1 * sn) * sc;
                        bf16_t* d = O + (size_t)r * 512 + head * 64 + dd; u32x2 w;
                        w.x = pk2(o1.x, o1.y); w.y = pk2(o1.z, o1.w); *(u32x2*)d = w;
                        w.x = pk2(o2.x, o2.y); w.y = pk2(o2.z, o2.w); *(u32x2*)(d + 32) = w; } }
        } else if (pn < 8) {
#pragma unroll
            for (int ai = 0; ai < 2; ++ai)
#pragma unroll
                for (int m = 0; m < 4; ++m) { const int r = row0 + ai * 128 + m * 16;
#pragma unroll
                    for (int bj = 0; bj < 2; ++bj)
#pragma unroll
                        for (int n = 0; n < 2; ++n) { const int c = (pn - 6) * 256 + bj * 128 + wc * 32 + n * 16 + fq * 4; const f32x4 v = acc[ai][bj][m][n];
                            u32x2 w; w.x = pk2(v.x, v.y); w.y = pk2(v.z, v.w); *(u32x2*)(V + (size_t)r * 512 + c) = w; } }
        } else if (pn == 8) {
#pragma unroll
            for (int ai = 0; ai < 2; ++ai)
#pragma unroll
                for (int m = 0; m < 4; ++m) { const int r = row0 + ai * 128 + m * 16, l = r & 4095;
                    const f32x4 cs = *(const f32x4*)(c32 + l * 16 + fq * 4), sn = *(const f32x4*)(s32 + l * 16 + fq * 4);
#pragma unroll
                    for (int n = 0; n < 2; ++n) { const int head = 2 * wc + n; const f32x4 x1 = acc[ai][0][m][n], x2 = acc[ai][1][m][n]; const f32x4 o1 = x1 * cs - x2 * sn, o2 = x2 * cs + x1 * sn;
                        bf16_t* d = QI + (size_t)r * 256 + head * 32 + fq * 4; u32x2 w;
                        w.x = pk2(o1.x, o1.y); w.y = pk2(o1.z, o1.w); *(u32x2*)d = w;
                        w.x = pk2(o2.x, o2.y); w.y = pk2(o2.z, o2.w); *(u32x2*)(d + 16) = w; } }
        } else if (pn == 9) {
            if (wc == 0) {
#pragma unroll
                for (int ai = 0; ai < 2; ++ai)
#pragma unroll
                    for (int m = 0; m < 4; ++m) { const int r = row0 + ai * 128 + m * 16, l = r & 4095;
                        const f32x4 cs = *(const f32x4*)(c32 + l * 16 + fq * 4), sn = *(const f32x4*)(s32 + l * 16 + fq * 4);
                        const f32x4 x1 = acc[ai][0][m][0], x2 = acc[ai][1][m][0]; const f32x4 o1 = x1 * cs - x2 * sn, o2 = x2 * cs + x1 * sn;
                        bf16_t* d = KI + (size_t)r * 32 + fq * 4; u32x2 w;
                        w.x = pk2(o1.x, o1.y); w.y = pk2(o1.z, o1.w); *(u32x2*)d = w;
                        w.x = pk2(o2.x, o2.y); w.y = pk2(o2.z, o2.w); *(u32x2*)(d + 16) = w;
                        if (fq < 2) *(f32x4*)(WI + (size_t)r * 8 + fq * 4) = acc[ai][0][m][1]; } }
        } else {
#pragma unroll
            for (int bj = 0; bj < 2; ++bj)
#pragma unroll
                for (int n = 0; n < 2; ++n) { const int c = (pn - 10) * 256 + bj * 128 + wc * 32 + n * 16 + fq * 4; const f32x4 b = *(const f32x4*)(bg + c);
                    unsigned char* O = c < 1024 ? (unsigned char*)GS + c : (unsigned char*)GS + (size_t)T * 1024 + (c - 1024);
#pragma unroll
                    for (int ai = 0; ai < 2; ++ai)
#pragma unroll
                        for (int m = 0; m < 4; ++m) { const int r = row0 + ai * 128 + m * 16; const f32x4 v = acc[ai][bj][m][n] + b;
                            *(unsigned*)(O + (size_t)r * 1024) = pk4_fp8(sigmoidf_(v.x), sigmoidf_(v.y), sigmoidf_(v.z), sigmoidf_(v.w)); } }
        }
    }
};

__device__ __forceinline__ void idx_score_tile(bf16x8 k0, bf16x8 k1, const bf16x8 (&qp)[2], const bf16x8 (&qf)[8][2], const float (&w)[8], float (&sc)[16]) {
    const f32x16 z = (f32x16){0.f, 0.f, 0.f, 0.f, 0.f, 0.f, 0.f, 0.f, 0.f, 0.f, 0.f, 0.f, 0.f, 0.f, 0.f, 0.f};
    f32x16 lin = __builtin_amdgcn_mfma_f32_32x32x16_bf16(k0, qp[0], z, 0, 0, 0); lin = __builtin_amdgcn_mfma_f32_32x32x16_bf16(k1, qp[1], lin, 0, 0, 0);
    f32x16 dA = __builtin_amdgcn_mfma_f32_32x32x16_bf16(k0, qf[0][0], z, 0, 0, 0); dA = __builtin_amdgcn_mfma_f32_32x32x16_bf16(k1, qf[0][1], dA, 0, 0, 0);
#pragma unroll
    for (int r = 0; r < 16; ++r) sc[r] = lin[r];
#pragma unroll
    for (int h = 0; h < 8; ++h) {
        f32x16 dB = z;
        if (h < 7) { dB = __builtin_amdgcn_mfma_f32_32x32x16_bf16(k0, qf[h + 1][0], z, 0, 0, 0); dB = __builtin_amdgcn_mfma_f32_32x32x16_bf16(k1, qf[h + 1][1], dB, 0, 0, 0); }
#pragma unroll
        for (int r = 0; r < 16; ++r) sc[r] = __builtin_fmaf(w[h], __builtin_fabsf(dA[r]), sc[r]);
        asm volatile("" : "+v"(sc[0]), "+v"(sc[1]), "+v"(sc[2]), "+v"(sc[3]), "+v"(sc[4]), "+v"(sc[5]), "+v"(sc[6]), "+v"(sc[7]), "+v"(k0));
        asm volatile("" : "+v"(sc[8]), "+v"(sc[9]), "+v"(sc[10]), "+v"(sc[11]), "+v"(sc[12]), "+v"(sc[13]), "+v"(sc[14]), "+v"(sc[15]), "+v"(k1));
        dA = dB;
    }
}
__device__ __forceinline__ unsigned h16_of(float s) { const _Float16 hf = (_Float16)s; return (unsigned)__builtin_bit_cast(unsigned short, hf); }
__device__ __forceinline__ void idx_scan(const LAS unsigned* hq, unsigned need, int mode, unsigned& fb, unsigned& frem) {
    unsigned cum = 0; fb = 0; frem = 1; bool found = false;
    for (int k = 0; k < 256; ++k) { const int bin = mode == 0 ? (k < 128 ? 127 - k : k) : mode == 1 ? 255 - k : k; const unsigned c = hq[bin * 32];
        if (!found && cum + c >= need) { fb = (unsigned)bin; frem = need - cum; found = true; } cum += c; }
}
__device__ __forceinline__ void idx_phase(Frame& F) {
    LAS unsigned* hist = (LAS unsigned*)F.lds;
    LAS unsigned* b1s = hist + 16384; LAS unsigned* r1s = b1s + 64; LAS unsigned* ths = r1s + 64;
    const bf16_t* QI = WSP(bf16_t, WS_QIDX); const bf16_t* KI = WSP(bf16_t, WS_KIDX); const float* WI = WSP(float, WS_WIDX); unsigned* MASK = WSP(unsigned, WS_MASK);
    const int lane = F.lane, r32 = lane & 31, hi = lane >> 5, gq = F.wave & 1, ks = F.wave >> 1;
    LAS int* qslot = (LAS int*)(F.lds + 68 * 1024);
    unsigned* qhead = WSP(unsigned, WS_CTL) + CW_QIDX + (F.dry ? 16 : 0);
    for (;;) {
            __syncthreads();
            if (F.tid == 0) *qslot = (int)__hip_atomic_fetch_add(qhead, 1u, __ATOMIC_RELAXED, __HIP_MEMORY_SCOPE_AGENT);
            __syncthreads();
            const int qpos = *qslot; if (qpos >= 1024) break;
            if (qpos & 1) { if (!F.dry) fill_tv_item(F.ws, F.tid, qpos >> 1); continue; }
            const int un = qpos >> 1;
            const int qb = 63 - (un >> 3), b = un & 7;
            const int q0 = qb * 64 + gq * 32, tok = b * 4096 + q0 + r32, ntile = (qb + 1) * 2;
            bf16x8 qf[8][2], qp[2]; float w[8];
#pragma unroll
            for (int h = 0; h < 8; ++h)
#pragma unroll
                for (int k = 0; k < 2; ++k) qf[h][k] = *(const bf16x8*)(QI + (size_t)tok * 256 + h * 32 + k * 16 + hi * 8);
            { const f32x4 wa = *(const f32x4*)(WI + (size_t)tok * 8), wb = *(const f32x4*)(WI + (size_t)tok * 8 + 4); w[0] = wa.x; w[1] = wa.y; w[2] = wa.z; w[3] = wa.w; w[4] = wb.x; w[5] = wb.y; w[6] = wb.z; w[7] = wb.w; }
#pragma unroll
            for (int k = 0; k < 2; ++k) { float a[8];
#pragma unroll
                for (int j = 0; j < 8; ++j) a[j] = 0.f;
#pragma unroll
                for (int h = 0; h < 8; ++h)
#pragma unroll
                    for (int j = 0; j < 8; ++j) a[j] = __builtin_fmaf(w[h], bf2f((unsigned short)qf[h][k][j]), a[j]);
                u32x4 pkd; pkd.x = pk2(a[0], a[1]); pkd.y = pk2(a[2], a[3]); pkd.z = pk2(a[4], a[5]); pkd.w = pk2(a[6], a[7]); qp[k] = __builtin_bit_cast(bf16x8, pkd); }
            const bf16_t* kbase = KI + (size_t)(b * 4096 + r32) * 32 + hi * 8;
            LAS unsigned* hq = hist + gq * 8192 + r32;
            _Float16 theta = (_Float16)(-INFINITY); float sc[16]; bf16x8 kn0, kn1;
#define IDX_TILES(BODY) do { kn0 = *(const bf16x8*)(kbase + (size_t)ks * 1024); kn1 = *(const bf16x8*)(kbase + (size_t)ks * 1024 + 16); \
            for (int kt = ks; kt < ntile; kt += 4) { const bf16x8 kc0 = kn0, kc1 = kn1; \
                if (kt + 4 < ntile) { kn0 = *(const bf16x8*)(kbase + (size_t)(kt + 4) * 1024); kn1 = *(const bf16x8*)(kbase + (size_t)(kt + 4) * 1024 + 16); } \
                idx_score_tile(kc0, kc1, qp, qf, w, sc); BODY } } while (0)
            if (qb >= 4) {
                for (int i = F.tid; i < 16384; i += NTHR) hist[i] = 0u;
                __syncthreads();
                IDX_TILES({
                    _Pragma("unroll") for (int r = 0; r < 16; ++r) __hip_atomic_fetch_add(hq + (h16_of(sc[r]) >> 8) * 32, 1u, __ATOMIC_RELAXED, __HIP_MEMORY_SCOPE_WORKGROUP); });
                __syncthreads();
                if (ks == 0 && hi == 0) { unsigned fb, fr_; idx_scan(hq, 256u, 0, fb, fr_); b1s[gq * 32 + r32] = fb; r1s[gq * 32 + r32] = fr_; }
                __syncthreads();
                for (int i = F.tid; i < 16384; i += NTHR) hist[i] = 0u;
                __syncthreads();
                const unsigned b1 = b1s[gq * 32 + r32];
                IDX_TILES({
                    _Pragma("unroll") for (int r = 0; r < 16; ++r) { const unsigned hv = h16_of(sc[r]); if ((hv >> 8) == b1) __hip_atomic_fetch_add(hq + (hv & 255u) * 32, 1u, __ATOMIC_RELAXED, __HIP_MEMORY_SCOPE_WORKGROUP); } });
                __syncthreads();
                if (ks == 0 && hi == 0) { unsigned fb, fr_; const unsigned bb = b1s[gq * 32 + r32]; idx_scan(hq, r1s[gq * 32 + r32], bb < 128u ? 1 : 2, fb, fr_); ths[gq * 32 + r32] = (bb << 8) | fb; }
                __syncthreads();
                theta = __builtin_bit_cast(_Float16, (unsigned short)ths[gq * 32 + r32]);
            }
            IDX_TILES({
                unsigned bits = 0u;
                _Pragma("unroll") for (int r = 0; r < 16; ++r) bits |= ((_Float16)sc[r] >= theta ? 1u : 0u) << ((r & 3) + 8 * (r >> 2));
                bits <<= 4 * hi;
                bits |= (unsigned)__shfl_xor((int)bits, 32);
                if (hi == 0) MASK[(size_t)(b * 128 + kt) * 4096 + q0 + r32] = bits; });
#undef IDX_TILES
    }
}

constexpr int CV_IE = (1024 / 64) * (1024 / 64), CV_NITEMS = 3 * 32 * CV_IE, CV_NBLK = CV_NITEMS / 8;
__device__ __forceinline__ void expert_conv_item(LAS unsigned char* lds, unsigned char* ws, int wave, int lane, const float* wg_, const float* wu_, const float* wd_, int bitem) {
    LAS float* scr = (LAS float*)(lds + wave * 16640);
    const int r = bitem * 8 + wave, which = r / (32 * CV_IE), e = (r % (32 * CV_IE)) / CV_IE, item = r % CV_IE;
    auto w1row = [](int c) { const int pn = c >> 7, w = c & 127; return pn * 256 + (w & 96) + ((w >> 2) & 1) * 16 + ((w >> 3) & 3) * 4 + (w & 3); };
    const float* src = (which == 0 ? wg_ : which == 1 ? wu_ : wd_) + (size_t)e * 1024 * 1024;
    if (which == 0) transpose_item_fp8(src, 1024, 1024, ws + WS_W1T + (size_t)e * 2048 * 1024, scr, item, lane, 32.0f, w1row);
    else if (which == 1) transpose_item_fp8(src, 1024, 1024, ws + WS_W1T + (size_t)e * 2048 * 1024, scr, item, lane, 32.0f, [=](int c) { return w1row(c) + 128; });
    else transpose_item_fp8(src, 1024, 1024, ws + WS_W2T + (size_t)e * 1024 * 1024, scr, item, lane, 32.0f, [](int n) { return n; });
}
__device__ __forceinline__ s16x4 vtr(const LAS char* p) { typedef short v4i16_t __attribute__((ext_vector_type(4))); return __builtin_bit_cast(s16x4, __builtin_amdgcn_ds_read_tr16_b64_v4i16((LAS v4i16_t*)p)); }
__device__ __forceinline__ void glds16(const void* gsrc, unsigned lds_dst) {
    unsigned keep; asm volatile("s_mov_b32 %0, m0\n\ts_mov_b32 m0, %2\n\ts_nop 0\n\tglobal_load_lds_dwordx4 %1, off\n\ts_mov_b32 m0, %0" : "=&s"(keep) : "v"(gsrc), "s"(lds_dst) : "memory"); }
__device__ __forceinline__ void attn_phase(Frame& F) {
    const bf16_t* Q = WSP(bf16_t, WS_Q); const bf16_t* K = WSP(bf16_t, WS_K); const bf16_t* V = WSP(bf16_t, WS_V); unsigned char* O = F.dry ? WSP(unsigned char, WS_E) : WSP(unsigned char, WS_YA8); const unsigned* MASK = WSP(unsigned, WS_MASK);
    const int lane = F.lane, r32 = lane & 31, hi = lane >> 5, wv = F.wave;
    const LAS char* ldsc = (const LAS char*)F.lds;
    const unsigned lds0 = (unsigned)(uintptr_t)F.lds;
    constexpr int KOFF = 0, VOFF = 32768, MOFF = 65536;
    const float* const wg_ = F.in[21]; const float* const wu_ = F.in[23]; const float* const wd_ = F.in[25];
    LAS int* qslot = (LAS int*)(F.lds + LDS_BYTES_C - 128);
    unsigned* qhead = WSP(unsigned, WS_CTL) + CW_QATT + (F.dry ? 16 : 0);
    for (;;) {
            __syncthreads();
            if (F.tid == 0) *qslot = (int)__hip_atomic_fetch_add(qhead, 1u, __ATOMIC_RELAXED, __HIP_MEMORY_SCOPE_AGENT);
            __syncthreads();
            const int qp = *qslot; if (qp >= 1024 + CV_NBLK) break;
            if ((qp & 3) != 0 || qp >= 4096) { const int ci = qp < 4096 ? qp - (qp >> 2) - 1 : qp - 1024; if (!F.dry) expert_conv_item(F.lds, F.ws, F.wave, F.lane, wg_, wu_, wd_, ci); continue; }
            const int un = qp >> 2;
            const int qb = 15 - (un >> 6), b = (un >> 3) & 7, h = un & 7;
            const int q0 = qb * 256, NT = 4 * qb + 4, ntw = 4 * qb + (wv >> 1) + 1;
            const size_t tokq = (size_t)b * 4096 + q0 + wv * 32 + r32;
            const bf16_t* ksrc = K + ((size_t)b * 4096 + lane) * 512 + h * 64 + wv * 8;
            const bf16_t* vsrc = V + ((size_t)b * 4096 + 16 * (wv & 3) + (lane >> 2)) * 512 + h * 64 + (wv >> 2) * 32 + (lane & 3) * 8;
            const unsigned* msrc = MASK + ((size_t)b * 128 + (wv & 1)) * 4096 + q0 + lane * 4;
            const unsigned kdst = lds0 + KOFF + wv * 1024, vdst = lds0 + VOFF + wv * 1024, mdst = lds0 + MOFF + (wv & 1) * 1024;
#define ATT_DMA(t_) do { const int tt_ = (t_) < NT ? (t_) : NT - 1; const unsigned sl_ = (unsigned)((t_) & 3); \
        glds16(ksrc + (size_t)tt_ * 64 * 512, (unsigned)__builtin_amdgcn_readfirstlane(kdst + sl_ * 8192u)); \
        glds16(vsrc + (size_t)tt_ * 64 * 512, (unsigned)__builtin_amdgcn_readfirstlane(vdst + sl_ * 8192u)); \
        glds16(msrc + (size_t)tt_ * 2 * 4096, (unsigned)__builtin_amdgcn_readfirstlane(mdst + sl_ * 2048u)); } while (0)
            ATT_DMA(0); ATT_DMA(1); ATT_DMA(2);
            bf16x8 qr[4];
#pragma unroll
            for (int d0 = 0; d0 < 4; ++d0) qr[d0] = *(const bf16x8*)(Q + tokq * 512 + h * 64 + d0 * 16 + hi * 8);
            asm volatile("" : "+v"(qr[0]), "+v"(qr[1]), "+v"(qr[2]), "+v"(qr[3]));
            float m = 0.f; f32x16 o[2], o2, negm;
#pragma unroll
            for (int r = 0; r < 16; ++r) { o[0][r] = 0.f; o[1][r] = 0.f; o2[r] = 0.f; negm[r] = 0.f; }
            const unsigned onew = r32 == 0 ? 0x3f803f80u : 0u; const bf16x8 ones = __builtin_bit_cast(bf16x8, (u32x4){onew, onew, onew, onew});
            const int vlane = ((lane >> 4) & 1) * 32 + (lane & 3) * 8 + (4 * hi + ((lane & 15) >> 2)) * 64;
            for (int t = 0; t < NT; ++t) {
                asm volatile("s_waitcnt vmcnt(6)\n\ts_barrier" ::: "memory");
                ATT_DMA(t + 3);
                if (t < ntw) {
                    const int sl = t & 3;
                    const LAS char* Kb = ldsc + KOFF + sl * 8192; const LAS char* Vb = ldsc + VOFF + sl * 8192 + vlane; const LAS unsigned* Mb = (const LAS unsigned*)(ldsc + MOFF + sl * 2048) + wv * 32 + r32;
                    const int w0 = (int)(Mb[0] >> (4 * hi)), w1 = (int)(Mb[256] >> (4 * hi));
                    f32x16 p0, p1;
                    { const bf16x8 k0 = *(const LAS bf16x8*)(Kb + hi * 1024 + r32 * 16), k1 = *(const LAS bf16x8*)(Kb + hi * 1024 + r32 * 16 + 512);
                      p0 = __builtin_amdgcn_mfma_f32_32x32x16_bf16(k0, qr[0], negm, 0, 0, 0); p1 = __builtin_amdgcn_mfma_f32_32x32x16_bf16(k1, qr[0], negm, 0, 0, 0); }
#pragma unroll
                    for (int d0 = 1; d0 < 4; ++d0) { const bf16x8 k0 = *(const LAS bf16x8*)(Kb + d0 * 2048 + hi * 1024 + r32 * 16), k1 = *(const LAS bf16x8*)(Kb + d0 * 2048 + hi * 1024 + r32 * 16 + 512);
                        p0 = __builtin_amdgcn_mfma_f32_32x32x16_bf16(k0, qr[d0], p0, 0, 0, 0); p1 = __builtin_amdgcn_mfma_f32_32x32x16_bf16(k1, qr[d0], p1, 0, 0, 0); }
                    float rm = __builtin_fmaxf(p0[0], p1[0]);
#pragma unroll
                    for (int r = 1; r < 16; ++r) rm = __builtin_fmaxf(rm, __builtin_fmaxf(p0[r], p1[r]));
                    rm = __builtin_fmaxf(rm, __shfl_xor(rm, 32));
                    if (t == 0 || __any(rm > 0.f)) {
                        const float dl = t == 0 ? rm : __builtin_fmaxf(rm, 0.f), f = __builtin_amdgcn_exp2f(-dl);
                        m += dl;
#pragma unroll
                        for (int r = 0; r < 16; ++r) { negm[r] = -m; o[0][r] *= f; o[1][r] *= f; o2[r] *= f; p0[r] -= dl; p1[r] -= dl; }
                    }
#pragma unroll
                    for (int r = 0; r < 16; ++r) { const int bp = (r & 3) + 8 * (r >> 2);
                        p0[r] = __uint_as_float(__float_as_uint(__builtin_amdgcn_exp2f(p0[r])) & (unsigned)__builtin_amdgcn_sbfe(w0, bp, 1));
                        p1[r] = __uint_as_float(__float_as_uint(__builtin_amdgcn_exp2f(p1[r])) & (unsigned)__builtin_amdgcn_sbfe(w1, bp, 1)); }
                    u32x4 pw[4];
#pragma unroll
                    for (int q = 0; q < 4; ++q) { pw[0][q] = pk2(p0[2 * q], p0[2 * q + 1]); pw[1][q] = pk2(p0[8 + 2 * q], p0[8 + 2 * q + 1]); pw[2][q] = pk2(p1[2 * q], p1[2 * q + 1]); pw[3][q] = pk2(p1[8 + 2 * q], p1[8 + 2 * q + 1]); }
#pragma unroll
                    for (int d0 = 0; d0 < 2; ++d0)
#pragma unroll
                        for (int kk = 0; kk < 4; ++kk) { const s16x4 lo = vtr(Vb + d0 * 4096 + kk * 1024), hh = vtr(Vb + d0 * 4096 + kk * 1024 + 512);
                            const bf16x8 vf = (bf16x8){lo[0], lo[1], lo[2], lo[3], hh[0], hh[1], hh[2], hh[3]};
                            o[d0] = __builtin_amdgcn_mfma_f32_32x32x16_bf16(vf, __builtin_bit_cast(bf16x8, pw[kk]), o[d0], 0, 0, 0); }
#pragma unroll
                    for (int kk = 0; kk < 4; ++kk) o2 = __builtin_amdgcn_mfma_f32_32x32x16_bf16(ones, __builtin_bit_cast(bf16x8, pw[kk]), o2, 0, 0, 0);
                }
            }
            asm volatile("s_waitcnt vmcnt(0) lgkmcnt(0)\n\ts_barrier" ::: "memory");
#undef ATT_DMA
            const float lt = __shfl(o2[0], r32), inv = 1.0f / lt;
#pragma unroll
            for (int d0 = 0; d0 < 2; ++d0)
#pragma unroll
                for (int g4 = 0; g4 < 4; ++g4) { unsigned w = pk4_fp8(o[d0][4 * g4] * inv, o[d0][4 * g4 + 1] * inv, o[d0][4 * g4 + 2] * inv, o[d0][4 * g4 + 3] * inv);
#ifdef ABL_ATTN
                    w = 0u;
#endif
                    *(unsigned*)(O + tokq * 512 + h * 64 + d0 * 32 + g4 * 8 + hi * 4) = w; }
        }
}

struct ProbS5E {
    const char* U; const char* Wg; unsigned ldb_bytes; int nt, G, c;
    __device__ bool next(int i, pg::Unit& u) const { const int L = i * G + c; if (L >= 64) return false; u.g = L >> 1; u.pm = L & 1; u.pn = 0; return true; }
    __device__ const char* a_base(const pg::Unit& u) const { return U + ((size_t)u.g * 512 + u.pm * 256) * 2304; }
    __device__ unsigned a_off(const pg::Unit&, int row, int col) const { return (unsigned)row * 2304u + (unsigned)col * 2u; }
    __device__ const char* b_base(const pg::Unit& u) const { return Wg + (size_t)u.g * 128 * 2048; }
};
struct EpiS5E { float* E;
    __device__ __forceinline__ void operator()(f32x4 (&acc)[2][2][4][2], const pg::Unit& u, int wr, int wc, int fr, int fq) const {
#pragma unroll
        for (int ai = 0; ai < 2; ++ai)
#pragma unroll
            for (int m = 0; m < 4; ++m) { const int r = u.pm * 256 + ai * 128 + wr * 64 + m * 16 + fr;
#pragma unroll
                for (int n = 0; n < 2; ++n) *(f32x4*)(E + ((size_t)u.g * 512 + r) * 128 + wc * 32 + n * 16 + fq * 4) = acc[ai][0][m][n]; }
    }
};
__device__ __forceinline__ void s5_scan(Frame& F) {
    if (F.wave != 0) return;
    const float* E = WSP(float, WS_EF32); const float* L64 = WSP(float, WS_L64); bf16_t* U = WSP(bf16_t, WS_U);
    for (int gid = F.bid * 64 + F.lane; gid < 32 * 8 * 64; gid += F.G * 64) {
        const int p = gid & 63, b = (gid >> 6) & 7, g = gid >> 9;
        const float lr = L64[(g * 64 + p) * 2], li = L64[(g * 64 + p) * 2 + 1]; float sr = 0.f, si = 0.f;
        const size_t m0 = (size_t)g * 512 + b * 64;
#pragma unroll 1
        for (int c0 = 0; c0 < 64; c0 += 16) { float er[16], ei[16];
#pragma unroll
            for (int c = 0; c < 16; ++c) { er[c] = E[(m0 + c0 + c) * 128 + p]; ei[c] = E[(m0 + c0 + c) * 128 + 64 + p]; }
#pragma unroll
            for (int c = 0; c < 16; ++c) { const size_t m = m0 + c0 + c;
                U[m * 1152 + 1024 + p] = (bf16_t)f2bf(sr); U[m * 1152 + 1088 + p] = (bf16_t)f2bf(si);
                const float nr = lr * sr - li * si + er[c], ni = lr * si + li * sr + ei[c]; sr = nr; si = ni; } }
    }
}
struct ProbS5Y {
    const char* U; const char* TV; unsigned ldb_bytes; int nt, G, c;
    __device__ bool next(int i, pg::Unit& u) const { const int L = i * G + c; if (L >= 256) return false; u.g = L >> 3; u.pm = (L >> 2) & 1; u.pn = L & 3; return true; }
    __device__ const char* a_base(const pg::Unit& u) const { return U + ((size_t)u.g * 512 + u.pm * 256) * 2304; }
    __device__ unsigned a_off(const pg::Unit&, int row, int col) const { return (unsigned)row * 2304u + (unsigned)col * 2u; }
    __device__ const char* b_base(const pg::Unit& u) const { return TV + ((size_t)u.g * 1024 + u.pn * 256) * 2304; }
};
struct EpiS5Y { bf16_t* Y;
    __device__ __forceinline__ void operator()(f32x4 (&acc)[2][2][4][2], const pg::Unit& u, int wr, int wc, int fr, int fq) const {
#pragma unroll
        for (int ai = 0; ai < 2; ++ai)
#pragma unroll
            for (int m = 0; m < 4; ++m) { const int mm = u.pm * 256 + ai * 128 + wr * 64 + m * 16 + fr, b = mm >> 6, c = mm & 63;
#pragma unroll
                for (int bj = 0; bj < 2; ++bj)
#pragma unroll
                    for (int n = 0; n < 2; ++n) { const int nn = u.pn * 256 + bj * 128 + wc * 32 + n * 16 + fq * 4, t = nn >> 4, h = nn & 15; const f32x4 v = acc[ai][bj][m][n];
                        u32x2 w; w.x = pk2(gelu_tanh(v.x), gelu_tanh(v.y)); w.y = pk2(gelu_tanh(v.z), gelu_tanh(v.w));
#ifdef ABL_SSM
                        w.x = 0u; w.y = 0u;
#endif
                        *(u32x2*)(Y + ((size_t)b * 4096 + c * 64 + t) * 512 + u.g * 16 + h) = w; } }
    }
};

template <class Fn> __device__ __forceinline__ void epi_each(f32x4 (&acc)[2][2][4][2], const pg::Unit& u, int wr, int wc, int fr, int fq, const Fn& fn) {
#pragma unroll
    for (int ai = 0; ai < 2; ++ai)
#pragma unroll
        for (int m = 0; m < 4; ++m) { const int r = u.pm * 256 + ai * 128 + wr * 64 + m * 16 + fr;
#pragma unroll
            for (int bj = 0; bj < 2; ++bj)
#pragma unroll
                for (int n = 0; n < 2; ++n) fn(r, u.pn * 256 + bj * 128 + wc * 32 + n * 16 + fq * 4, acc[ai][bj][m][n]); }
}
struct EpiGlu { const bf16_t* YS; unsigned char* Y2; const float* b;
    __device__ __forceinline__ void operator()(f32x4 (&acc)[2][2][4][2], const pg::Unit& u, int wr, int wc, int fr, int fq) const {
        epi_each(acc, u, wr, wc, fr, fq, [&](int r, int c, const f32x4& v) { const f32x4 bb = *(const f32x4*)(b + c); const u32x2 y = *(const u32x2*)(YS + (size_t)r * 512 + c);
            *(unsigned*)(Y2 + (size_t)r * 512 + c) = pk4_fp8(bflo(y.x) * sigmoidf_(v.x + bb.x), bfhi(y.x) * sigmoidf_(v.y + bb.y), bflo(y.y) * sigmoidf_(v.z + bb.z), bfhi(y.y) * sigmoidf_(v.w + bb.w)); }); }
};
template <bool ADD> struct EpiMix { const unsigned char* Gt; bf16_t* MIX; unsigned char* MIX8;
    __device__ __forceinline__ void operator()(f32x4 (&acc)[2][2][4][2], const pg::Unit& u, int wr, int wc, int fr, int fq) const {
        epi_each(acc, u, wr, wc, fr, fq, [&](int r, int c, const f32x4& v) { const int g = *(const int*)(Gt + (size_t)r * 1024 + c);
            const f32x2_t glo = __builtin_amdgcn_cvt_pk_f32_fp8(g, false), ghi = __builtin_amdgcn_cvt_pk_f32_fp8(g, true);
            f32x4 o = (f32x4){glo[0] * v.x, glo[1] * v.y, ghi[0] * v.z, ghi[1] * v.w} * 0.03125f;
            if (ADD) { const u32x2 mo = *(const u32x2*)(MIX + (size_t)r * 1024 + c); o.x += bflo(mo.x); o.y += bfhi(mo.x); o.z += bflo(mo.y); o.w += bfhi(mo.y);
                *(unsigned*)(MIX8 + (size_t)r * 1024 + c) = pk4_fp8(o.x, o.y, o.z, o.w); }
            else { u32x2 w; w.x = pk2(o.x, o.y); w.y = pk2(o.z, o.w); *(u32x2*)(MIX + (size_t)r * 1024 + c) = w; } }); }
};
struct EpiStoreBf { bf16_t* O; int ldo; float sc;
    __device__ __forceinline__ void operator()(f32x4 (&acc)[2][2][4][2], const pg::Unit& u, int wr, int wc, int fr, int fq) const {
        epi_each(acc, u, wr, wc, fr, fq, [&](int r, int c, const f32x4& v) { u32x2 w; w.x = pk2(v.x * sc, v.y * sc); w.y = pk2(v.z * sc, v.w * sc); *(u32x2*)(O + (size_t)r * ldo + c) = w; }); }
};
struct EpiPle { const bf16_t* R2; const bf16_t* PROJ; bf16_t* R3;
    __device__ __forceinline__ void operator()(f32x4 (&acc)[2][2][4][2], const pg::Unit& u, int wr, int wc, int fr, int fq) const {
        epi_each(acc, u, wr, wc, fr, fq, [&](int r, int c, const f32x4& v) { const u32x2 r2 = *(const u32x2*)(R2 + (size_t)r * 1024 + c); const u32x2 pj = *(const u32x2*)(PROJ + (size_t)r * 1024 + c);
            u32x2 w; w.x = pk2(bflo(r2.x) + sigmoidf_(v.x * 0.03125f) * bflo(pj.x), bfhi(r2.x) + sigmoidf_(v.y * 0.03125f) * bfhi(pj.x));
            w.y = pk2(bflo(r2.y) + sigmoidf_(v.z * 0.03125f) * bflo(pj.y), bfhi(r2.y) + sigmoidf_(v.w * 0.03125f) * bfhi(pj.y));
            *(u32x2*)(R3 + (size_t)r * 1024 + c) = w; }); }
};

__device__ __forceinline__ void router_phase(Frame& F) {
    constexpr int WST = 1032;
    LAS bf16_t* whi = (LAS bf16_t*)F.lds; LAS bf16_t* wlo = whi + 32 * WST;
    LAS unsigned* lcnt = (LAS unsigned*)(F.lds + 2 * 32 * WST * 2);
    LAS unsigned* gbase = lcnt + 32;
    LAS unsigned* ent_e = gbase + 32;
    LAS float* ent_w = (LAS float*)(ent_e + 512);
    const float* Wr = F.in[19]; const float* br = F.in[20]; const float* gain = F.in[18]; const float* X = F.in[0];
    const bf16_t* D1 = (const bf16_t*)F.out + (size_t)T * 1024;
    unsigned char* H2 = F.dry ? WSP(unsigned char, WS_A) : (unsigned char*)F.out;
    unsigned* cnt = WSP(unsigned, WS_CTL) + CW_CNT + (F.dry ? 32 : 0); int* LTOK = F.dry ? (int*)(F.ws + WS_A + 70 * MB) : WSP(int, WS_LTOK); int* LSLOT = F.dry ? (int*)(F.ws + WS_A + 75 * MB) : WSP(int, WS_LSLOT); float* LWT = F.dry ? (float*)(F.ws + WS_A + 80 * MB) : WSP(float, WS_LWT);
    { f32x4 wv[16];
#pragma unroll
      for (int q = 0; q < 16; ++q) wv[q] = *((const f32x4*)Wr + F.tid + q * NTHR);
#pragma unroll
      for (int q = 0; q < 16; ++q) { const int i4 = F.tid + q * NTHR, k = i4 >> 3, e0 = (i4 & 7) * 4; const float g = gain[k];
#pragma unroll
          for (int c = 0; c < 4; ++c) { const float v = wv[q][c] * g; const unsigned h = f2bf(v); const float vh = __builtin_bit_cast(float, h << 16);
              whi[(e0 + c) * WST + k] = (bf16_t)h; wlo[(e0 + c) * WST + k] = (bf16_t)f2bf(v - vh); } } }
    const int lane = F.lane, tl = lane & 15, kq = lane >> 4;
    for (int tb = F.bid; tb < T / 128; tb += F.G) {
        if (F.tid < 32) lcnt[F.tid] = 0u;
        if (!F.dry) { const f32x4* ps = (const f32x4*)(F.in[1] + (size_t)tb * 128 * 256); u32x2* pd = (u32x2*)(WSP(bf16_t, WS_PBF) + (size_t)tb * 128 * 256);
#pragma unroll 4
            for (int q = 0; q < 16; ++q) { const f32x4 v = ps[F.tid + q * NTHR]; u32x2 w; w.x = pk2(v.x, v.y); w.y = pk2(v.z, v.w); pd[F.tid + q * NTHR] = w; } }
        __syncthreads();
        const int tok0 = tb * 128 + F.wave * 16, tok = tok0 + tl;
        const float* xrow = X + (size_t)tok * 1024 + 8 * kq; const bf16_t* drow = D1 + (size_t)tok * 1024 + 8 * kq;
        f32x4 acc[2]; acc[0] = (f32x4){0.f, 0.f, 0.f, 0.f}; acc[1] = acc[0]; float ss = 0.f;
#pragma unroll 16
        for (int st = 0; st < 32; ++st) {
            const f32x4 x0 = *(const f32x4*)(xrow + 32 * st), x1 = *(const f32x4*)(xrow + 32 * st + 4); const u32x4 dd = *(const u32x4*)(drow + 32 * st);
            const f32x4 g0 = *(const f32x4*)(gain + 32 * st + 8 * kq), g1 = *(const f32x4*)(gain + 32 * st + 8 * kq + 4);
            float r[8] = {x0.x + bflo(dd.x), x0.y + bfhi(dd.x), x0.z + bflo(dd.y), x0.w + bfhi(dd.y), x1.x + bflo(dd.z), x1.y + bfhi(dd.z), x1.z + bflo(dd.w), x1.w + bfhi(dd.w)};
            { u32x2 o; o.x = pk4_fp8(r[0] * g0.x, r[1] * g0.y, r[2] * g0.z, r[3] * g0.w); o.y = pk4_fp8(r[4] * g1.x, r[5] * g1.y, r[6] * g1.z, r[7] * g1.w); *(u32x2*)(H2 + (size_t)tok * 1024 + 32 * st + 8 * kq) = o; }
            u32x4 ah, al;
#pragma unroll
            for (int p = 0; p < 4; ++p) { ss = __builtin_fmaf(r[2 * p], r[2 * p], ss); ss = __builtin_fmaf(r[2 * p + 1], r[2 * p + 1], ss);
                const unsigned hw = pk2(r[2 * p], r[2 * p + 1]); ah[p] = hw; al[p] = pk2(r[2 * p] - bflo(hw), r[2 * p + 1] - bfhi(hw)); }
            const bf16x8 A_hi = __builtin_bit_cast(bf16x8, ah), A_lo = __builtin_bit_cast(bf16x8, al);
#pragma unroll
            for (int n = 0; n < 2; ++n) { const bf16x8 Bh = *(const LAS bf16x8*)(whi + (16 * n + tl) * WST + 32 * st + 8 * kq), Bl = *(const LAS bf16x8*)(wlo + (16 * n + tl) * WST + 32 * st + 8 * kq);
                acc[n] = __builtin_amdgcn_mfma_f32_16x16x32_bf16(A_hi, Bh, acc[n], 0, 0, 0); acc[n] = __builtin_amdgcn_mfma_f32_16x16x32_bf16(A_hi, Bl, acc[n], 0, 0, 0); acc[n] = __builtin_amdgcn_mfma_f32_16x16x32_bf16(A_lo, Bh, acc[n], 0, 0, 0); }
        }
        ss += __shfl_xor(ss, 16); ss += __shfl_xor(ss, 32);
        const float rstd = 1.0f / sqrtf(ss * (1.f / 1024.f) + EPS);
        if (kq == 0 && !F.dry) WSP(float, WS_CTL)[CW_SSQ + tok] = rstd;
        const float b0 = br[tl], b1 = br[16 + tl];
#pragma unroll
        for (int rg = 0; rg < 4; ++rg) { const float rs = __shfl(rstd, 4 * kq + rg);
            float v0 = acc[0][rg] * rs + b0, v1 = acc[1][rg] * rs + b1; float tv[4]; int te[4];
#pragma unroll
            for (int k = 0; k < 4; ++k) { float bv = v0; int bi = tl; if (v1 > v0) { bv = v1; bi = 16 + tl; }
#pragma unroll
                for (int o = 1; o < 16; o <<= 1) { const float ov = __shfl_xor(bv, o); const int oi = __shfl_xor(bi, o); if (ov > bv || (ov == bv && oi < bi)) { bv = ov; bi = oi; } }
                tv[k] = bv; te[k] = bi; if (bi == tl) v0 = -INFINITY; if (bi == 16 + tl) v1 = -INFINITY; }
            const float e1 = __expf(tv[1] - tv[0]), e2 = __expf(tv[2] - tv[0]), e3 = __expf(tv[3] - tv[0]), inv = 1.0f / (1.0f + e1 + e2 + e3);
            if (tl < 4) { const int e = tl == 0 ? te[0] : tl == 1 ? te[1] : tl == 2 ? te[2] : te[3]; const float w = (tl == 0 ? 1.0f : tl == 1 ? e1 : tl == 2 ? e2 : e3) * inv;
                const int tli = F.wave * 16 + 4 * kq + rg;
                const unsigned pos = __hip_atomic_fetch_add(lcnt + e, 1u, __ATOMIC_RELAXED, __HIP_MEMORY_SCOPE_WORKGROUP);
                ent_e[tli * 4 + tl] = (unsigned)e | (pos << 8); ent_w[tli * 4 + tl] = w; }
        }
        __syncthreads();
        if (F.tid < 32) gbase[F.tid] = __hip_atomic_fetch_add(cnt + F.tid, lcnt[F.tid], __ATOMIC_RELAXED, __HIP_MEMORY_SCOPE_AGENT);
        __syncthreads();
        { const unsigned ee = ent_e[F.tid]; const int e = ee & 255, pos = (int)(gbase[e] + (ee >> 8)); const int tok_ = tb * 128 + (F.tid >> 2);
          LTOK[(size_t)e * T + pos] = tok_; LSLOT[(size_t)e * T + pos] = tok_ * 4 + (F.tid & 3); LWT[(size_t)e * T + pos] = ent_w[F.tid]; }
        __syncthreads();
    }
}

struct MoeTab { LAS int* cnt; LAS int* ntile; LAS int* cumu; LAS int* offs; LAS unsigned short* rowl; };
template <int NPN> __device__ __forceinline__ bool moe_unit(const MoeTab& tab, int L, pg::Unit& u) {
    if (L >= tab.cumu[32]) return false; int e = 0;
#pragma unroll 1
    for (int k = 1; k < 32; ++k) if (tab.cumu[k] <= L) e = k;
    const int rem = L - tab.cumu[e], ntl = tab.ntile[e]; u.g = e; u.pn = rem / ntl; u.pm = rem % ntl; return true;
}
template <int NPN> __device__ __forceinline__ MoeTab moe_tab_build(Frame& F, bool gather) {
    MoeTab t; t.cnt = (LAS int*)(F.lds + 131072); t.ntile = t.cnt + 32; t.cumu = t.ntile + 32; t.offs = t.cumu + 40; t.rowl = (LAS unsigned short*)(F.lds + 131072 + 1024);
    __syncthreads();
    if (F.tid < 32) t.cnt[F.tid] = (int)__hip_atomic_load(WSP(unsigned, WS_CTL) + CW_CNT + F.tid, __ATOMIC_RELAXED, __HIP_MEMORY_SCOPE_AGENT);
    __syncthreads();
    if (F.tid == 0) { int cu = 0, of = 0;
        for (int e = 0; e < 32; ++e) { const int n = t.cnt[e]; const int nt_ = (n + 255) >> 8; t.ntile[e] = nt_; t.cumu[e] = cu; t.offs[e] = of; cu += nt_ * NPN; of += n; }
        t.cumu[32] = cu; t.offs[32] = of; }
    __syncthreads();
    if (gather) {
        const int* ltok = WSP(int, WS_LTOK);
        for (int i = 0; i < 17; ++i) { pg::Unit u; if (!moe_unit<NPN>(t, i * F.G + F.bid, u)) break;
            if (F.tid < 256) { int r = u.pm * 256 + F.tid; const int n = t.cnt[u.g]; r = r < n ? r : n - 1; t.rowl[i * 256 + F.tid] = (unsigned short)ltok[(size_t)u.g * T + r]; } }
        __syncthreads();
    }
    return t;
}
template <int NPN> struct ProbMoe {
    const char* A; const char* W; MoeTab tab; unsigned ldb_bytes; int nt, G, c; bool gather; int hot;
    __device__ bool next(int i, pg::Unit& u) const { u.li = i; const bool ok = moe_unit<NPN>(tab, i * G + c, u); if (hot) { u.li = 0; u.g = 0; u.pn = 0; u.pm = 0; } return ok; }
    __device__ const char* a_base(const pg::Unit&) const { return A; }
    __device__ unsigned a_off(const pg::Unit& u, int row, int col) const {
        unsigned arow;
        if (gather) arow = (unsigned)tab.rowl[u.li * 256 + row];
        else { int r = u.pm * 256 + row; const int n = tab.cnt[u.g]; r = r < n ? r : n - 1; arow = (unsigned)(tab.offs[u.g] + r); }
        return arow * 1024u + (unsigned)col * 2u; }
    __device__ const char* b_base(const pg::Unit& u) const { return W + ((size_t)u.g * (NPN * 256) + u.pn * 256) * 1024; }
};
struct EpiMoe1 { unsigned char* Aout; const float* bgate; const float* bup; const float* rstd; MoeTab tab; int dry;
    __device__ __forceinline__ void operator()(f32x4 (&acc)[2][2][4][2], const pg::Unit& u, int wr, int wc, int fr, int fq) const {
        if (dry >= 3) return;
        const int e = u.g, n = tab.cnt[e], off = tab.offs[e];
        const int col = u.pn * 128 + wc * 32 + fq * 8;
        f32x4 bg[2], bu[2];
#pragma unroll
        for (int nn = 0; nn < 2; ++nn) { bg[nn] = *(const f32x4*)(bgate + e * 1024 + col + 4 * nn); bu[nn] = *(const f32x4*)(bup + e * 1024 + col + 4 * nn); }
        float rs_[8];
#pragma unroll
        for (int q = 0; q < 8; ++q) rs_[q] = 0.03125f * rstd[tab.rowl[u.li * 256 + (q >> 2) * 128 + wr * 64 + (q & 3) * 16 + fr]];
#pragma unroll
        for (int ai = 0; ai < 2; ++ai)
#pragma unroll
            for (int m = 0; m < 4; ++m) { const int r = u.pm * 256 + ai * 128 + wr * 64 + m * 16 + fr; float o[8];
#pragma unroll
                for (int nn = 0; nn < 2; ++nn) { const f32x4 g4 = acc[ai][0][m][nn] * rs_[ai * 4 + m] + bg[nn], u4 = acc[ai][1][m][nn] * rs_[ai * 4 + m] + bu[nn];
#pragma unroll
                    for (int j = 0; j < 4; ++j) { const float g = fminf(g4[j], 7.0f), uu = fminf(fmaxf(u4[j], -7.0f), 7.0f); o[4 * nn + j] = (uu + 1.0f) * (g * sigmoidf_(1.702f * g)); } }
                u32x2 w; w.x = pk4_fp8(o[0], o[1], o[2], o[3]); w.y = pk4_fp8(o[4], o[5], o[6], o[7]);
                if (r < n) { if (dry != 2) *(u32x2*)(Aout + (size_t)(off + r) * 1024 + col) = w; else asm volatile("" :: "v"(w.x), "v"(w.y)); } }
    }
};
struct EpiMoe2 { unsigned char* ws; unsigned char* outb; const float* bdown; const int* lslot; const float* lwt; MoeTab tab;
    __device__ __forceinline__ void operator()(f32x4 (&acc)[2][2][4][2], const pg::Unit& u, int wr, int wc, int fr, int fq) const {
        const int e = u.g, n = tab.cnt[e];
        int sl[8]; float wt[8];
#pragma unroll
        for (int q = 0; q < 8; ++q) { int r = u.pm * 256 + (q >> 2) * 128 + wr * 64 + (q & 3) * 16 + fr; r = r < n ? r : n - 1; sl[q] = lslot[(size_t)e * T + r]; wt[q] = lwt[(size_t)e * T + r]; }
        f32x4 bd[2][2];
#pragma unroll
        for (int bj = 0; bj < 2; ++bj)
#pragma unroll
            for (int nn = 0; nn < 2; ++nn) bd[bj][nn] = *(const f32x4*)(bdown + e * 1024 + u.pn * 256 + bj * 128 + wc * 32 + nn * 16 + fq * 4);
#pragma unroll
        for (int ai = 0; ai < 2; ++ai)
#pragma unroll
            for (int m = 0; m < 4; ++m) { const int r = u.pm * 256 + ai * 128 + wr * 64 + m * 16 + fr; if (r < n) { const int s_ = sl[ai * 4 + m]; const float w_ = wt[ai * 4 + m];
                    unsigned char* dst = ws + WS_W1T + (size_t)s_ * 1024;
#pragma unroll
                    for (int bj = 0; bj < 2; ++bj)
#pragma unroll
                        for (int nn = 0; nn < 2; ++nn) { const int col = u.pn * 256 + bj * 128 + wc * 32 + nn * 16 + fq * 4; const f32x4 v = (acc[ai][bj][m][nn] * 0.03125f + bd[bj][nn]) * (w_ * 16.0f);
                            *(unsigned*)(dst + col) = pk4_fp8(v.x, v.y, v.z, v.w); } } }
    }
};

__device__ __forceinline__ void combine_phase(Frame& F) {
    const int gw = F.bid * 8 + F.wave, NGW = F.G * 8, lane = F.lane;
    const bf16_t* D1 = (const bf16_t*)F.out + (size_t)T * 1024;
    auto slotp = [&](int sl) -> const unsigned* { return (const unsigned*)(F.ws + WS_W1T + (size_t)sl * 1024) + lane; };
    for (int tok = gw; tok < T; tok += NGW) {
        const f32x4* xr = (const f32x4*)(F.in[0] + (size_t)tok * 1024) + lane; const u32x2* dr = (const u32x2*)(D1 + (size_t)tok * 1024) + lane;
        f32x4 v[4]; u32x2 d1[4]; unsigned d[4][4];
#pragma unroll
        for (int j = 0; j < 4; ++j) { v[j] = xr[64 * j]; d1[j] = dr[64 * j]; }
#pragma unroll
        for (int k = 0; k < 4; ++k) { const unsigned* sr = slotp(tok * 4 + k);
#pragma unroll
            for (int j = 0; j < 4; ++j) d[k][j] = sr[64 * j]; }
#pragma unroll
        for (int j = 0; j < 4; ++j) { v[j].x += bflo(d1[j].x); v[j].y += bfhi(d1[j].x); v[j].z += bflo(d1[j].y); v[j].w += bfhi(d1[j].y); }
#pragma unroll
        for (int k = 0; k < 4; ++k)
#pragma unroll
            for (int j = 0; j < 4; ++j) { const f32x2_t lo = __builtin_amdgcn_cvt_pk_f32_fp8((int)d[k][j], false), hi2 = __builtin_amdgcn_cvt_pk_f32_fp8((int)d[k][j], true);
                v[j].x += lo[0] * 0.0625f; v[j].y += lo[1] * 0.0625f; v[j].z += hi2[0] * 0.0625f; v[j].w += hi2[1] * 0.0625f; }
        u32x2* r2 = (u32x2*)(WSP(bf16_t, WS_R2) + (size_t)tok * 1024) + lane; unsigned* rb = (unsigned*)(WSP(unsigned char, WS_R2BF) + (size_t)tok * 1024) + lane;
#pragma unroll
        for (int j = 0; j < 4; ++j) { u32x2 w; w.x = pk2(v[j].x, v[j].y); w.y = pk2(v[j].z, v[j].w); r2[64 * j] = w; rb[64 * j] = pk4_fp8(v[j].x, v[j].y, v[j].z, v[j].w); }
    }
}
__device__ __forceinline__ void final_norm_phase(Frame& F) {
    const int gw = F.bid * 8 + F.wave, NGW = F.G * 8, lane = F.lane; const f32x4* gr = (const f32x4*)F.in[29] + lane;
    for (int tok = gw; tok < T; tok += NGW) {
        const u32x2* xr = (const u32x2*)(WSP(bf16_t, WS_E) + (size_t)tok * 1024) + lane; f32x4 v[4]; float s = 0.f;
#pragma unroll
        for (int j = 0; j < 4; ++j) { const u32x2 d = xr[64 * j]; v[j] = (f32x4){bflo(d.x), bfhi(d.x), bflo(d.y), bfhi(d.y)}; s += (v[j].x * v[j].x + v[j].y * v[j].y) + (v[j].z * v[j].z + v[j].w * v[j].w); }
        const float rstd = 1.0f / sqrtf(wave_sum(s) * (1.f / 1024.f) + EPS);
        f32x4* xw = F.dry ? (f32x4*)(WSP(float, WS_A) + (size_t)tok * 1024) + lane : (f32x4*)(F.out + (size_t)tok * 1024) + lane;
#pragma unroll
        for (int j = 0; j < 4; ++j) { const f32x4 g = gr[64 * j]; xw[64 * j] = (f32x4){v[j].x * rstd * g.x, v[j].y * rstd * g.y, v[j].z * rstd * g.z, v[j].w * rstd * g.w}; }
    }
}
constexpr size_t WS_BAR = 512 * 1024;
#define XB_TMO      128
#define XB_XCNT(j)  (256  + 64 * (j))
#define XB_XSUB(j)  (1280 + 64 * (j))
#define XB_XGEN(j)  (2304 + 64 * (j))
#define XB_TOP      3328
#define XB_TOPGEN   3392
#define XCD_BAR_WORDS 3456
#define XB_SPIN_CAP (1u << 18)
__device__ __forceinline__ unsigned xb_ld(unsigned* p)              { return __hip_atomic_load(p, __ATOMIC_RELAXED, __HIP_MEMORY_SCOPE_AGENT); }
__device__ __forceinline__ unsigned xb_add(unsigned* p, unsigned v) { return __hip_atomic_fetch_add(p, v, __ATOMIC_RELAXED, __HIP_MEMORY_SCOPE_AGENT); }
__device__ __forceinline__ unsigned xb_xcc_id() { return (unsigned)__builtin_amdgcn_s_getreg((3 << 11) | 20) & 0xFu; }
#define XB_SPIN(cond, bar) do { unsigned _sp = 0; while (cond) { __builtin_amdgcn_s_sleep(1); \
    if ((++_sp & 255u) == 0u) { if (xb_ld(&(bar)[XB_TMO])) break; if (_sp > XB_SPIN_CAP) { atomicAdd(&(bar)[XB_TMO], 1u); break; } } } } while (0)
struct XcdBarrier { unsigned* bar; unsigned x; volatile LAS unsigned* st; };
__device__ __forceinline__ XcdBarrier xcd_barrier_post(unsigned* bar, volatile LAS unsigned* st) {
    XcdBarrier b; b.bar = bar; b.x = xb_xcc_id(); b.st = st;
    if (threadIdx.x == 0) (void)xb_add(&bar[XB_XCNT(b.x)], 1u);
    return b;
}
__device__ __forceinline__ void xcd_barrier_complete(unsigned* bar, unsigned x, unsigned& nloc, unsigned& nx) {
    const unsigned G = gridDim.x * gridDim.y * gridDim.z;
    unsigned sum, cnt, mine, sp = 0u;
    for (;;) {
        sum = 0u; cnt = 0u; mine = 0u;
#pragma unroll
        for (unsigned j = 0; j < 16; ++j) { const unsigned c = xb_ld(&bar[XB_XCNT(j)]); sum += c; cnt += (c > 0u) ? 1u : 0u; mine = (j == x) ? c : mine; }
        if (sum == G) break;
        __builtin_amdgcn_s_sleep(1);
        if ((++sp & 255u) == 0u) { if (xb_ld(&bar[XB_TMO])) break; if (sp > XB_SPIN_CAP) { atomicAdd(&bar[XB_TMO], 1u); break; } }
    }
    nloc = mine > 0u ? mine : 1u; nx = cnt > 0u ? cnt : 1u;
}
__device__ __forceinline__ void xcd_barrier(const XcdBarrier& b) {
    asm volatile("s_waitcnt vmcnt(0)" ::: "memory");
    __syncthreads();
    if (threadIdx.x == 0) {
        unsigned* bar = b.bar;
        __builtin_amdgcn_s_waitcnt(0);
        unsigned nloc = b.st[0], nx = b.st[1];
        if (nloc == 0u) { xcd_barrier_complete(bar, b.x, nloc, nx); b.st[0] = nloc; b.st[1] = nx; }
        const unsigned old = xb_add(&bar[XB_XSUB(b.x)], 1u);
        const unsigned gen = old / nloc;
        if (old + 1u == (gen + 1u) * nloc) {
            __builtin_amdgcn_fence(__ATOMIC_RELEASE, "agent");
            asm volatile("s_waitcnt vmcnt(0)" ::: "memory");
            const unsigned og = xb_add(&bar[XB_TOP], 1u);
            const unsigned tg = og / nx;
            if (og + 1u == (tg + 1u) * nx) xb_add(&bar[XB_TOPGEN], 1u);
            else XB_SPIN(xb_ld(&bar[XB_TOPGEN]) == tg, bar);
            __builtin_amdgcn_fence(__ATOMIC_ACQUIRE, "agent");
            xb_add(&bar[XB_XGEN(b.x)], 1u);
            asm volatile("s_waitcnt vmcnt(0)" ::: "memory");
        } else {
            XB_SPIN(xb_ld(&bar[XB_XGEN(b.x)]) == gen, bar);
            __builtin_amdgcn_fence(__ATOMIC_ACQUIRE, "agent");
            asm volatile("s_waitcnt vmcnt(0)" ::: "memory");
        }
    }
    __syncthreads();
}

constexpr int LDS_BYTES = 147456;
constexpr int NPHASE = 14;
#ifndef MK_MULTI
#define MK_MULTI 0
#endif
struct Args { const float* in[30]; float* out; unsigned char* ws; int ph_lo, ph_hi, dry, pad; };
static_assert(sizeof(Args) == 32 * 8 + 16, "no padding in Args");

__global__ void __launch_bounds__(NTHR, 2) fwd(Args a) {
    extern __shared__ __attribute__((aligned(16))) unsigned char lds_[];
    Frame F;
    F.lds = (LAS unsigned char*)lds_;
    F.tid = threadIdx.x; F.lane = F.tid & 63; F.wave = __builtin_amdgcn_readfirstlane(F.tid >> 6); F.G = gridDim.x; F.bid = blockIdx.x;
#pragma unroll
    for (int i = 0; i < 30; ++i) F.in[i] = a.in[i];
    F.out = a.out; F.ws = a.ws; F.dry = a.dry;
    const int lo = a.ph_lo, hi = a.ph_hi;
#ifndef PHMASK
#define PHMASK 0x3fff
#endif
#define IN(k) (((PHMASK >> (k)) & 1) && lo <= (k) && (k) < hi)
    volatile LAS unsigned* xst = (volatile LAS unsigned*)(F.lds + LDS_BYTES - 64);
    if (F.tid < 2) xst[F.tid] = 0u;
    __syncthreads();
    const XcdBarrier xbar = xcd_barrier_post((unsigned*)(F.ws + WS_BAR), xst);
#define SEAM(k) do { if (IN(k) && IN((k) + 1)) xcd_barrier(xbar); } while (0)
    bf16_t* GS = (bf16_t*)F.out; bf16_t* GA = GS + (size_t)T * 1024;

    if (IN(0)) { p0_prologue(F); __syncthreads(); p0_s5_tables(F); }
    SEAM(0);
    if (IN(1)) {
        EpiInProj E; E.U = WSP(bf16_t, WS_U); E.Q = WSP(bf16_t, WS_Q); E.K = WSP(bf16_t, WS_K); E.V = WSP(bf16_t, WS_V); E.QI = WSP(bf16_t, WS_QIDX); E.KI = WSP(bf16_t, WS_KIDX); E.GS = GS; E.GA = GA;
        E.WI = WSP(float, WS_WIDX); E.bg = F.in[3]; E.c64 = WSP(float, WS_COS64); E.s64 = WSP(float, WS_SIN64); E.c32 = WSP(float, WS_COS32); E.s32 = WSP(float, WS_SIN32);
        { pg::Dense P; P.A = (const char*)WSP(unsigned char, WS_H8); P.B = (const char*)WSP(unsigned char, WS_WIN8); P.lda_bytes = 1024; P.ldb_bytes = 1024; P.nt = 8; P.ord.init(T / 256, 16, F.G, F.bid); P.pn_split = 8; P.pn_skip = 2;
          E.ascale = 0.03125f; pg::gemm_phase<true>(F.lds, P, E); }
        { pg::Dense P; P.A = (const char*)WSP(bf16_t, WS_E); P.B = (const char*)WSP(bf16_t, WS_WINT); P.lda_bytes = 2048; P.ldb_bytes = 2048; P.nt = 16; P.ord.init(T / 256, 2, F.G, F.bid); P.pn_base = 8; P.b_tile0 = 8;
          E.ascale = 1.0f; pg::gemm_phase<false>(F.lds, P, E); }
    }
    SEAM(1);
    if (IN(2)) {
        { ProbS5E P; P.U = (const char*)WSP(bf16_t, WS_U); P.Wg = (const char*)WSP(bf16_t, WS_WG); P.ldb_bytes = 2048; P.nt = 16; P.G = F.G; P.c = F.bid; EpiS5E E; E.E = WSP(float, WS_EF32); pg::gemm_phase(F.lds, P, E); }
        __syncthreads();
        idx_phase(F);
    }
    SEAM(2);
    if (IN(3)) { s5_scan(F); __syncthreads(); attn_phase(F); }
    SEAM(3);
    if (IN(4)) { ProbS5Y P; P.U = (const char*)WSP(bf16_t, WS_U); P.TV = (const char*)WSP(bf16_t, WS_TV); P.ldb_bytes = 2304; P.nt = 18; P.G = F.G; P.c = F.bid; EpiS5Y E; E.Y = WSP(bf16_t, WS_E); pg::gemm_phase(F.lds, P, E); }
    SEAM(4);
    if (IN(5)) { pg::Dense P; P.A = (const char*)WSP(bf16_t, WS_E); P.B = (const char*)WSP(bf16_t, WS_WGLUT); P.lda_bytes = 1024; P.ldb_bytes = 1024; P.nt = 8; P.ord.init(T / 256, 2, F.G, F.bid);
        EpiGlu E; E.YS = WSP(bf16_t, WS_E); E.Y2 = WSP(unsigned char, WS_Y28); E.b = F.in[13]; pg::gemm_phase(F.lds, P, E); }
    SEAM(5);
    if (IN(6)) {
        { pg::Dense P; P.A = (const char*)WSP(unsigned char, WS_Y28); P.B = (const char*)WSP(unsigned char, WS_WSB8); P.lda_bytes = 512; P.ldb_bytes = 512; P.nt = 4; P.ord.init(T / 256, 4, F.G, F.bid);
          EpiMix<false> E; E.Gt = (const unsigned char*)GS; E.MIX = F.dry ? WSP(bf16_t, WS_U) : GA; E.MIX8 = nullptr; pg::gemm_phase<true>(F.lds, P, E); }
        { pg::Dense P; P.A = (const char*)WSP(unsigned char, WS_YA8); P.B = (const char*)WSP(unsigned char, WS_WAB8); P.lda_bytes = 512; P.ldb_bytes = 512; P.nt = 4; P.ord.init(T / 256, 4, F.G, F.bid);
          EpiMix<true> E; E.Gt = (const unsigned char*)GS + (size_t)T * 1024; E.MIX = F.dry ? WSP(bf16_t, WS_U) : GA; E.MIX8 = F.dry ? WSP(unsigned char, WS_V) : WSP(unsigned char, WS_MIX8); pg::gemm_phase<true>(F.lds, P, E); }
    }
    SEAM(6);
    if (IN(7)) { pg::Dense P; P.A = (const char*)WSP(unsigned char, WS_MIX8); P.B = (const char*)WSP(unsigned char, WS_WO8); P.lda_bytes = 1024; P.ldb_bytes = 1024; P.nt = 8; P.ord.init(T / 256, 4, F.G, F.bid);
        EpiStoreBf E; E.O = GA; E.ldo = 1024; E.sc = 0.03125f; pg::gemm_phase<true>(F.lds, P, E); }
    SEAM(7);
    if (IN(8)) router_phase(F);
    SEAM(8);
    if (IN(9)) { const MoeTab tab = moe_tab_build<8>(F, true);
        ProbMoe<8> P; P.A = (const char*)GS; P.W = (const char*)WSP(bf16_t, WS_W1T); P.tab = tab; P.ldb_bytes = 1024; P.nt = 8; P.G = F.G; P.c = F.bid; P.gather = true; P.hot = (F.dry == 4);
        EpiMoe1 E; E.Aout = WSP(unsigned char, WS_A); E.bgate = F.in[22]; E.bup = F.in[24]; E.rstd = WSP(float, WS_CTL) + CW_SSQ; E.tab = tab; E.dry = F.dry; pg::gemm_phase<true>(F.lds, P, E); }
    SEAM(9);
    if (IN(10)) { const MoeTab tab = moe_tab_build<4>(F, false);
        ProbMoe<4> P; P.A = (const char*)WSP(bf16_t, WS_A); P.W = (const char*)WSP(bf16_t, WS_W2T); P.tab = tab; P.ldb_bytes = 1024; P.nt = 8; P.G = F.G; P.c = F.bid; P.gather = false; P.hot = 0;
        EpiMoe2 E; E.ws = F.ws; E.outb = (unsigned char*)F.out; E.bdown = F.in[26]; E.lslot = WSP(int, WS_LSLOT); E.lwt = WSP(float, WS_LWT); E.tab = tab; pg::gemm_phase<true>(F.lds, P, E);
        { const int total = tab.cumu[32], rounds = (total + F.G - 1) / F.G, nfull = total - (rounds - 1) * F.G, nidle = F.G - nfull;
          const int G2 = nidle > 0 ? nidle : F.G, c2 = nidle > 0 ? F.bid - nfull : F.bid;
          if (c2 >= 0) { pg::Dense P2; P2.A = (const char*)WSP(bf16_t, WS_PBF); P2.B = (const char*)WSP(bf16_t, WS_WPPT); P2.lda_bytes = 512; P2.ldb_bytes = 512; P2.nt = 4; P2.ord.init(T / 256, 4, G2, c2);
              EpiStoreBf E2; E2.O = WSP(bf16_t, WS_PROJ); E2.ldo = 1024; E2.sc = 1.0f; pg::gemm_phase(F.lds, P2, E2); } } }
    SEAM(10);
    if (IN(11)) combine_phase(F);
    SEAM(11);
    if (IN(12)) {
        { pg::Dense P; P.A = (const char*)WSP(unsigned char, WS_R2BF); P.B = (const char*)WSP(unsigned char, WS_WPG8); P.lda_bytes = 1024; P.ldb_bytes = 1024; P.nt = 8; P.ord.init(T / 256, 4, F.G, F.bid);
          EpiPle E; E.R2 = WSP(bf16_t, WS_R2); E.PROJ = WSP(bf16_t, WS_PROJ); E.R3 = WSP(bf16_t, WS_E); pg::gemm_phase<true>(F.lds, P, E); }
    }
    SEAM(12);
    if (IN(13)) { final_norm_phase(F);
#ifdef FP8_SELFTEST
        if (F.bid == 0 && F.wave == 0) { const bool ok = fp8_selftest(F.lane); if (!ok && F.lane == 0) F.out[12345] = __builtin_nanf(""); }
#endif
    }
#undef IN
#undef SEAM
}

extern "C" void kernel_launch(void* const* d_in, const int* in_sizes, int n_in, void* d_out, int out_size, void* d_ws, size_t ws_size, hipStream_t stream) {
    static int grid = 0;
    if (grid == 0) {
        if (n_in != 30 || out_size != T * 1024 || ws_size < WS_END) { fprintf(stderr, "kernel_launch: unexpected shapes (n_in %d, out %d, ws %zu < %zu)\n", n_in, out_size, ws_size, (size_t)WS_END); grid = -1; return; }
        int dev = 0, cus = 0, per_cu = 0;
        hipGetDevice(&dev); hipDeviceGetAttribute(&cus, hipDeviceAttributeMultiprocessorCount, dev);
        hipFuncSetAttribute((const void*)fwd, hipFuncAttributeMaxDynamicSharedMemorySize, LDS_BYTES);
        hipOccupancyMaxActiveBlocksPerMultiprocessor(&per_cu, (const void*)fwd, NTHR, LDS_BYTES);
        if (per_cu < 1) { fprintf(stderr, "kernel_launch: occupancy query says %d blocks per CU\n", per_cu); per_cu = 1; }
        (void)hipGetLastError();
        grid = cus;
    }
    if (grid < 0) return;
    Args a{};
    for (int i = 0; i < 30; ++i) a.in[i] = (const float*)d_in[i];
    a.out = (float*)d_out; a.ws = (unsigned char*)d_ws;
#if MK_MULTI
#ifndef DUP_MASK
#define DUP_MASK 0
#endif
    for (int ph = 0; ph < NPHASE; ++ph) { a.ph_lo = ph; a.ph_hi = ph + 1; const int reps = ((DUP_MASK >> ph) & 1) ? 2 : 1;
        for (int r = 0; r < reps; ++r) { a.dry = (r + 1 < reps && (ph == 3 || ph == 6 || ph == 8 || ph == 13)) ? 1 : 0;
#ifdef DRY9
            if (ph == 9 && r + 1 < reps) a.dry = DRY9;
#endif
 hipLaunchKernelGGL(fwd, dim3(grid), dim3(NTHR), LDS_BYTES, stream, a); } }
#else
    (void)hipMemsetAsync((char*)d_ws + WS_BAR, 0, XCD_BAR_WORDS * 4, stream);
    a.ph_lo = 0; a.ph_hi = NPHASE; void* args[] = {&a};
    hipError_t e = hipLaunchCooperativeKernel((const void*)fwd, dim3(grid), dim3(NTHR), args, LDS_BYTES, stream);
    if (e != hipSuccess) fprintf(stderr, "cooperative launch failed: %s (grid %d)\n", hipGetErrorString(e), grid);
#endif
}
```

```cpp
#include <hip/hip_runtime.h>
#include <hip/hip_cooperative_groups.h>
#include <cstdio>
#include <cstdint>
#include <cmath>
namespace cg = cooperative_groups;

#define LAS __attribute__((address_space(3)))
#define GAS __attribute__((address_space(1)))
typedef unsigned short bf16_t;
typedef short bf16x8 __attribute__((ext_vector_type(8)));
typedef short s16x4 __attribute__((ext_vector_type(4)));
typedef float f32x4 __attribute__((ext_vector_type(4)));
typedef float f32x16 __attribute__((ext_vector_type(16)));
typedef unsigned u32x4 __attribute__((ext_vector_type(4)));
typedef unsigned u32x2 __attribute__((ext_vector_type(2)));

constexpr int LDS_BYTES_C = 147456;
constexpr int NB = 8, SEQ = 4096, DM = 1024, T = NB * SEQ;
constexpr int PLE = 256, NE = 32, TOPK = 4, NSLOT = T * TOPK;
constexpr int INC = 4392, INP = 4608;
constexpr int NGRP = 32, SST = 64;
constexpr float EPS = 1e-6f;
constexpr float C2 = 0.125f * 1.4426950408889634f;
constexpr int NTHR = 512;

constexpr size_t MB = 1000000;
constexpr size_t WS_CTL   = 0;
constexpr size_t WS_COS64 = 1 * MB;
constexpr size_t WS_SIN64 = WS_COS64 + 4096 * 32 * 4;
constexpr size_t WS_COS32 = WS_SIN64 + 4096 * 32 * 4;
constexpr size_t WS_SIN32 = WS_COS32 + 4096 * 16 * 4;
constexpr size_t WS_KG    = 3 * MB;
constexpr size_t WS_L64   = WS_KG + 32 * 64 * 256 * 4;
constexpr size_t WS_XBUF  = 5200000;
constexpr size_t WS_KIDX  = 6 * MB;
constexpr size_t WS_WIDX  = 9 * MB;
constexpr size_t WS_EF32  = 11 * MB;
constexpr size_t WS_WG    = 20 * MB;
constexpr size_t WS_LTOK  = 29 * MB;
constexpr size_t WS_LSLOT = 34 * MB;
constexpr size_t WS_LWT   = 39 * MB;
constexpr size_t WS_SMALL_END = 44 * MB;
constexpr size_t WS_W2T   = WS_SMALL_END;
constexpr size_t SZ_W2T   = (size_t)32 * 1024 * 1024 * 2;
constexpr size_t WS_W1T   = WS_W2T + SZ_W2T;
constexpr size_t SZ_W1T   = (size_t)32 * 2048 * 1024 * 2;
constexpr size_t WS_E     = WS_W1T + SZ_W1T;
constexpr size_t SZ_E     = (size_t)T * 1024 * 2;
constexpr size_t WS_A     = WS_E + SZ_E;
constexpr size_t SZ_A     = (size_t)NSLOT * 1024 * 2;
constexpr size_t WS_TAIL  = WS_A + SZ_A;
constexpr size_t WS_WINT  = WS_TAIL;
constexpr size_t WS_WIN8  = WS_WINT + (size_t)512 * 1024 * 2;
constexpr size_t WS_WGLUT = WS_WIN8 + (size_t)INP * 1024;
constexpr size_t WS_WSB8  = WS_WGLUT + 512 * 512 * 2;
constexpr size_t WS_WAB8  = WS_WSB8 + 1024 * 512;
constexpr size_t WS_WO8   = WS_WAB8 + 1024 * 512;
constexpr size_t WS_WPG8  = WS_WO8 + 1024 * 1024;
constexpr size_t WS_WPPT  = WS_WPG8 + 1024 * 1024;
constexpr size_t WS_END   = WS_WPPT + 1024 * 256 * 2;
static_assert(WS_END <= 604000000ull, "workspace map must fit sum(inputs) bytes");
constexpr size_t WS_U     = WS_A;
constexpr size_t SZ_U     = (size_t)32 * 512 * 1152 * 2;
constexpr size_t WS_Q     = WS_U + SZ_U;
constexpr size_t SZ_QKV   = (size_t)T * 512 * 2;
constexpr size_t WS_K     = WS_Q + SZ_QKV;
constexpr size_t WS_V     = WS_K + SZ_QKV;
constexpr size_t WS_QIDX  = WS_V + SZ_QKV;
constexpr size_t WS_MASK  = WS_QIDX + (size_t)T * 256 * 2;
constexpr size_t WS_TV    = WS_MASK + (size_t)8 * 128 * 4096 * 4;
constexpr size_t SZ_TV    = (size_t)32 * 1024 * 1152 * 2;
static_assert(WS_TV + SZ_TV <= WS_TAIL, "early temporaries fit the A region");
constexpr size_t WS_R2    = WS_A;
constexpr size_t WS_R2BF  = WS_A + (size_t)T * 1024 * 4;
constexpr size_t WS_PBF   = WS_R2BF + (size_t)T * 1024;
constexpr size_t WS_PROJ  = WS_PBF + (size_t)T * 256 * 2;
static_assert(WS_PROJ + (size_t)T * 1024 * 2 <= WS_TAIL, "late users fit the A region");
constexpr size_t WS_H8    = WS_W2T + (size_t)32 * 1024 * 1024;
constexpr size_t WS_YA8   = WS_E + 40 * MB;
constexpr size_t WS_Y28   = WS_K;
constexpr size_t WS_MIX8  = WS_TV;
constexpr int CW_CNT = 64;
constexpr int CW_PCNT = 512;
constexpr int CW_QIDX = 192, CW_QATT = 256;
constexpr int CW_SSQ = 1024;
constexpr int CTL_WORDS = CW_SSQ + T;

__device__ __forceinline__ unsigned f2bf(float f) { unsigned u = __builtin_bit_cast(unsigned, f); return (u + 0x7fffu + ((u >> 16) & 1u)) >> 16; }
typedef float f32x2_t __attribute__((ext_vector_type(2))); typedef __bf16 bf16x2_t __attribute__((ext_vector_type(2)));
__device__ __forceinline__ unsigned pk2(float lo, float hi) { f32x2_t v = {lo, hi}; bf16x2_t b = __builtin_convertvector(v, bf16x2_t); return __builtin_bit_cast(unsigned, b); }
__device__ __forceinline__ float bf2f(unsigned short b) { return __builtin_bit_cast(float, (unsigned)b << 16); }
__device__ __forceinline__ float bflo(unsigned w) { return __builtin_bit_cast(float, w << 16); }
__device__ __forceinline__ float bfhi(unsigned w) { return __builtin_bit_cast(float, w & 0xffff0000u); }
__device__ __forceinline__ float wave_sum(float v) {
#pragma unroll
    for (int o = 1; o < 64; o <<= 1) v += __shfl_xor(v, o);
    return v;
}
__device__ __forceinline__ float sigmoidf_(float x) { return __builtin_amdgcn_rcpf(1.0f + __builtin_amdgcn_exp2f(-1.4426950408889634f * x)); }
__device__ __forceinline__ float gelu_tanh(float x) {
    const float u = 0.7978845608028654f * (x + 0.044715f * x * x * x);
    const float e = __expf(-2.0f * fabsf(u));
    float t = (1.0f - e) / (1.0f + e); t = u < 0.f ? -t : t;
    return 0.5f * x * (1.0f + t);
}


typedef int v8i_t __attribute__((ext_vector_type(8)));
typedef int v4i_t __attribute__((ext_vector_type(4)));
__device__ __forceinline__ unsigned pk4_fp8(float a, float b, float c, float d) { int w = __builtin_amdgcn_cvt_pk_fp8_f32(a, b, 0, false); w = __builtin_amdgcn_cvt_pk_fp8_f32(c, d, w, true); return (unsigned)w; }
#ifdef FP8_SELFTEST
__device__ __forceinline__ bool fp8_selftest(int lane) {
    const int rc = lane & 15, g = lane >> 4; v8i_t a, b;
#pragma unroll
    for (int w = 0; w < 8; ++w) { float av[4], bv[4];
#pragma unroll
        for (int q = 0; q < 4; ++q) { const int bb = w * 4 + q; const int k = bb < 16 ? 16 * g + bb : 64 + 16 * g + (bb - 16);
            av[q] = (float)((rc * 7 + k * 3) % 9 - 4) * 0.5f; bv[q] = (float)((k * 5 + rc * 11) % 7 - 3) * 0.25f; }
        a[w] = (int)pk4_fp8(av[0], av[1], av[2], av[3]); b[w] = (int)pk4_fp8(bv[0], bv[1], bv[2], bv[3]); }
    f32x4 c = {0.f, 0.f, 0.f, 0.f};
    c = __builtin_amdgcn_mfma_scale_f32_16x16x128_f8f6f4(a, b, c, 0, 0, 0, 0x7f7f7f7f, 0, 0x7f7f7f7f);
    bool ok = true;
#pragma unroll
    for (int r = 0; r < 4; ++r) { const int i = 4 * g + r, j = rc; float ref = 0.f;
        for (int k = 0; k < 128; ++k) ref += ((float)((i * 7 + k * 3) % 9 - 4) * 0.5f) * ((float)((k * 5 + j * 11) % 7 - 3) * 0.25f);
        ok = ok && (c[r] == ref); }
    return __all(ok);
}
#endif

namespace pg {
constexpr int BM = 256, BK = 64, HALF = 128, HTB = HALF * BK * 2, STAGE_BYTES = 8 * HTB;
__device__ __forceinline__ int lds_byte(int r, int c) { const int st = (r >> 4) * 2 + (c >> 5), rr = r & 15, cc = c & 31, ob = rr * 64 + cc * 2; return st * 1024 + (ob ^ (((ob >> 9) & 1) << 5)); }
__device__ __forceinline__ void stage_rc(int b, int& R, int& C) { const int st = b / 1024, sb = b % 1024, swz = sb ^ (((sb >> 9) & 1) << 5); R = (st >> 1) * 16 + swz / 64; C = (st & 1) * 32 + (swz % 64) / 2; }
struct Unit { int pm, pn, g, li; };

template <bool FP8 = false, class Prob, class Epi>
__device__ __forceinline__ void gemm_phase(LAS unsigned char* lds, const Prob& P, const Epi& E) {
    const int tid = threadIdx.x, wid = __builtin_amdgcn_readfirstlane(tid >> 6), lane = tid & 63, wr = wid >> 2, wc = wid & 3, fr = lane & 15, fq = lane >> 4;
    const int nt = P.nt;
    int R[2], C[2];
#pragma unroll
    for (int i = 0; i < 2; ++i) stage_rc(tid * 16 + i * 8192, R[i], C[i]);
    unsigned offB[2][2];
#pragma unroll
    for (int h = 0; h < 2; ++h)
#pragma unroll
        for (int i = 0; i < 2; ++i) offB[h][i] = (unsigned)(h * HALF + R[i]) * P.ldb_bytes + (unsigned)C[i] * 2u;
    const unsigned ldsw = (unsigned)wid * 1024u;
    const int aoff = lds_byte(wr * 64 + fr, fq * 8), boff = lds_byte(wc * 32 + fr, fq * 8);
#define PG_SA(b, h) (((b) * 2 + (h)) * HTB)
#define PG_SB(b, h) ((4 + (b) * 2 + (h)) * HTB)
#define PG_STAGE(bufoff, gbase, voff, kbytes) do { _Pragma("unroll") for (int _i = 0; _i < 2; ++_i) \
        __builtin_amdgcn_global_load_lds((const unsigned*)((const char*)(gbase) + (voff)[_i] + (kbytes)), (LAS unsigned*)(lds + (bufoff) + ldsw + _i * 8192), 16, 0, 0); } while (0)
#define PG_CAT8(x0, x1) __builtin_shufflevector(x0, x1, 0, 1, 2, 3, 4, 5, 6, 7)
#define PG_LDA(dst, b, h) do { if constexpr (FP8) { _Pragma("unroll") for (int m = 0; m < 4; ++m) dst##8[m] = PG_CAT8(*(const LAS v4i_t*)(lds + PG_SA(b, h) + aoff + m * 2048), *(const LAS v4i_t*)(lds + PG_SA(b, h) + aoff + m * 2048 + 1024)); } \
        else { _Pragma("unroll") for (int m = 0; m < 4; ++m) _Pragma("unroll") for (int k = 0; k < 2; ++k) dst[m][k] = *(const LAS bf16x8*)(lds + PG_SA(b, h) + aoff + m * 2048 + k * 1024); } } while (0)
#define PG_LDB(dst, b, h) do { if constexpr (FP8) { _Pragma("unroll") for (int n = 0; n < 2; ++n) dst##8[n] = PG_CAT8(*(const LAS v4i_t*)(lds + PG_SB(b, h) + boff + n * 2048), *(const LAS v4i_t*)(lds + PG_SB(b, h) + boff + n * 2048 + 1024)); } \
        else { _Pragma("unroll") for (int n = 0; n < 2; ++n) _Pragma("unroll") for (int k = 0; k < 2; ++k) dst[n][k] = *(const LAS bf16x8*)(lds + PG_SB(b, h) + boff + n * 2048 + k * 1024); } } while (0)
#define PG_MMA(ai, bj, At, Bt) do { __builtin_amdgcn_s_setprio(1); \
        if constexpr (FP8) { _Pragma("unroll") for (int m = 0; m < 4; ++m) _Pragma("unroll") for (int n = 0; n < 2; ++n) \
            asm volatile("v_mfma_scale_f32_16x16x128_f8f6f4 %0, %1, %2, %0, %3, %3 op_sel_hi:[0,0,0]" : "+v"(acc[ai][bj][m][n]) : "v"(Bt##8[n]), "v"(At##8[m]), "v"(sc1)); } \
        else { _Pragma("unroll") for (int m = 0; m < 4; ++m) _Pragma("unroll") for (int n = 0; n < 2; ++n) _Pragma("unroll") for (int k = 0; k < 2; ++k) \
            acc[ai][bj][m][n] = __builtin_amdgcn_mfma_f32_16x16x32_bf16(Bt[n][k], At[m][k], acc[ai][bj][m][n], 0, 0, 0); } \
        __builtin_amdgcn_s_setprio(0); } while (0)
#define PG_WAIT_V(n) asm volatile("s_waitcnt vmcnt(" #n ")" ::: "memory")
#define PG_WAIT_L(n) asm volatile("s_waitcnt lgkmcnt(" #n ")" ::: "memory")
#define PG_BAR __builtin_amdgcn_s_barrier()
#define PG_SCHED __builtin_amdgcn_sched_barrier(0)
    Unit cur, nxt; int ui = 0;
    if (!P.next(0, cur)) return;
    f32x4 acc[2][2][4][2];
#pragma unroll
    for (int a = 0; a < 2; ++a)
#pragma unroll
        for (int b = 0; b < 2; ++b)
#pragma unroll
            for (int m = 0; m < 4; ++m)
#pragma unroll
                for (int n = 0; n < 2; ++n) acc[a][b][m][n] = (f32x4){0.f, 0.f, 0.f, 0.f};
    bf16x8 At[4][2], B0[2][2], B1[2][2]; v8i_t At8[4], B08[2], B18[2]; int sc1 = 0x7f7f7f7f; asm volatile("" : "+v"(sc1));
    const char* cA = P.a_base(cur); const char* cB = P.b_base(cur);
    unsigned cOA[2][2], nOA[2][2];
#pragma unroll
    for (int h = 0; h < 2; ++h)
#pragma unroll
        for (int i = 0; i < 2; ++i) cOA[h][i] = P.a_off(cur, h * HALF + R[i], C[i]);
    PG_STAGE(PG_SB(0, 0), cB, offB[0], 0); PG_STAGE(PG_SB(0, 1), cB, offB[1], 0); PG_STAGE(PG_SA(0, 0), cA, cOA[0], 0); PG_STAGE(PG_SA(0, 1), cA, cOA[1], 0);
    if (wr == 1) PG_BAR;
    PG_WAIT_V(2); PG_BAR;
    PG_STAGE(PG_SB(1, 0), cB, offB[0], 128); PG_STAGE(PG_SA(1, 0), cA, cOA[0], 128); PG_STAGE(PG_SB(1, 1), cB, offB[1], 128);
    PG_WAIT_V(6); PG_BAR;
    for (;;) {
        const bool has_next = P.next(ui + 1, nxt);
        const char* nA = has_next ? P.a_base(nxt) : cA; const char* nB = has_next ? P.b_base(nxt) : cB;
#pragma unroll
        for (int h = 0; h < 2; ++h)
#pragma unroll
            for (int i = 0; i < 2; ++i) nOA[h][i] = has_next ? P.a_off(nxt, h * HALF + R[i], C[i]) : cOA[h][i];
        for (int t = 0; t < nt; t += 2) {
            const bool last = (t == nt - 2);
            const unsigned k1 = (unsigned)(t + 1) * 128u;
            const unsigned k2 = last ? 0u : (unsigned)(t + 2) * 128u, k3 = k2 + 128u;
            const char* a2 = last ? nA : cA; const char* b2 = last ? nB : cB;
            unsigned o2[2][2];
#pragma unroll
            for (int h = 0; h < 2; ++h)
#pragma unroll
                for (int i = 0; i < 2; ++i) o2[h][i] = last ? nOA[h][i] : cOA[h][i];
            PG_LDB(B0, 0, 0); PG_LDB(B1, 0, 1); PG_SCHED; PG_LDA(At, 0, 0); PG_STAGE(PG_SA(1, 1), cA, cOA[1], k1);
            PG_WAIT_V(8); PG_WAIT_L(0); PG_BAR; PG_MMA(0, 0, At, B0); PG_MMA(0, 1, At, B1); PG_BAR; PG_SCHED;
            PG_LDA(At, 0, 1); PG_STAGE(PG_SB(0, 0), b2, offB[0], k2); PG_STAGE(PG_SB(0, 1), b2, offB[1], k2); PG_STAGE(PG_SA(0, 0), a2, o2[0], k2);
            PG_WAIT_V(8); PG_WAIT_L(0); PG_BAR; PG_MMA(1, 0, At, B0); PG_MMA(1, 1, At, B1); PG_BAR; PG_SCHED;
            PG_LDB(B0, 1, 0); PG_LDB(B1, 1, 1); PG_SCHED; PG_LDA(At, 1, 0); PG_STAGE(PG_SA(0, 1), a2, o2[1], k2);
            PG_WAIT_V(8); PG_WAIT_L(0); PG_BAR; PG_MMA(0, 0, At, B0); PG_MMA(0, 1, At, B1); PG_BAR; PG_SCHED;
            PG_LDA(At, 1, 1); PG_STAGE(PG_SB(1, 0), b2, offB[0], k3); PG_STAGE(PG_SB(1, 1), b2, offB[1], k3); PG_STAGE(PG_SA(1, 0), a2, o2[0], k3);
            PG_WAIT_V(8); PG_WAIT_L(0); PG_BAR; PG_MMA(1, 0, At, B0); PG_MMA(1, 1, At, B1); PG_BAR; PG_SCHED;
        }
        if (wr == 0) PG_BAR;
        if constexpr (FP8) asm volatile("s_nop 15\n\ts_nop 15" ::: "memory");
        { int fr_ = fr, fq_ = fq; asm volatile("" : "+v"(fr_), "+v"(fq_));
          E(acc, cur, wr, wc, fr_, fq_);
#ifdef PROBE_EPI2
          asm volatile("" : "+v"(fr_), "+v"(fq_)); E(acc, cur, wr, wc, fr_, fq_);
#endif
        }
        if (!has_next) break;
#pragma unroll
        for (int a = 0; a < 2; ++a)
#pragma unroll
            for (int b = 0; b < 2; ++b)
#pragma unroll
                for (int m = 0; m < 4; ++m)
#pragma unroll
                    for (int n = 0; n < 2; ++n) acc[a][b][m][n] = (f32x4){0.f, 0.f, 0.f, 0.f};
        cur = nxt; cA = nA; cB = nB; ++ui;
#pragma unroll
        for (int h = 0; h < 2; ++h)
#pragma unroll
            for (int i = 0; i < 2; ++i) cOA[h][i] = nOA[h][i];
        if (wr == 1) PG_BAR;
    }
    PG_WAIT_V(0);
    PG_BAR;
#undef PG_SA
#undef PG_SB
#undef PG_STAGE
#undef PG_LDA
#undef PG_LDB
#undef PG_MMA
#undef PG_CAT8
#undef PG_WAIT_V
#undef PG_WAIT_L
#undef PG_BAR
#undef PG_SCHED
}

struct Order {
    int nM, nN, nwg, G, c;
    __device__ void init(int nM_, int nN_, int G_, int c_) { nM = nM_; nN = nN_; nwg = nM * nN; G = G_; c = c_; }
    __device__ bool get(int i, int& pm, int& pn) const {
        const long L = (long)i * G + c; if (L >= nwg) return false;
        int wgid = (int)L; { const int q = nwg / 8, r = nwg % 8, xcd = wgid % 8, off = wgid / 8; wgid = (xcd < r ? xcd * (q + 1) : r * (q + 1) + (xcd - r) * q) + off; }
        const int nig = 8 * nN, gid = wgid / nig, fm = gid * 8, gsz = (nM - fm) < 8 ? (nM - fm) : 8;
        pm = fm + ((wgid % nig) % gsz); pn = (wgid % nig) / gsz; return true;
    }
};
struct Dense {
    const char* A; const char* B; unsigned lda_bytes, ldb_bytes; int nt; Order ord; int pn_base = 0, pn_split = 1 << 30, pn_skip = 0, b_tile0 = 0;
    __device__ bool next(int i, Unit& u) const { u.g = 0; int pp; const bool ok = ord.get(i, u.pm, pp); u.pn = pn_base + pp + (pp >= pn_split ? pn_skip : 0); return ok; }
    __device__ const char* a_base(const Unit& u) const { return A + (size_t)u.pm * 256 * lda_bytes; }
    __device__ unsigned a_off(const Unit&, int row, int col) const { return (unsigned)row * lda_bytes + (unsigned)col * 2u; }
    __device__ const char* b_base(const Unit& u) const { return B + (size_t)(u.pn - b_tile0) * 256 * ldb_bytes; }
};
}

struct Frame {
    LAS unsigned char* lds;
    int tid, lane, wave, G, bid, dry;
    const float* in[30]; float* out; unsigned char* ws;
};
#define WSP(T_, off) ((T_*)(F.ws + (off)))
#define LDS_WAIT() asm volatile("s_waitcnt lgkmcnt(0)" ::: "memory")

template <class DstRow>
__device__ __forceinline__ void transpose_item(const float* W, int K, int N, bf16_t* WT, LAS float* scr, int item, int lane, const DstRow& dstrow) {
    const int nblk = (N + 63) / 64, kb = item / nblk, nb = item % nblk, k0 = 64 * kb, n0 = 64 * nb;
    const int kk = lane >> 4, n4 = (lane & 15) * 4;
    f32x4 v[16];
#pragma unroll
    for (int i = 0; i < 16; ++i) v[i] = *(const f32x4*)(W + (size_t)(k0 + 4 * i + kk) * N + n0 + n4);
#pragma unroll
    for (int i = 0; i < 16; ++i) { LAS float* d = scr + (4 * i + kk) * 65 + n4; d[0] = v[i].x; d[1] = v[i].y; d[2] = v[i].z; d[3] = v[i].w; }
    LDS_WAIT(); asm volatile("" ::: "memory");
    const int c = lane & 7;
#pragma unroll
    for (int j = 0; j < 8; ++j) { const int n = (lane >> 3) + 8 * j; const LAS float* p = scr + (8 * c) * 65 + n; const int dr = dstrow(n0 + n);
        if (dr >= 0) { u32x4 o; o.x = pk2(p[0], p[65]); o.y = pk2(p[130], p[195]); o.z = pk2(p[260], p[325]); o.w = pk2(p[390], p[455]);
            *(u32x4*)(WT + (size_t)dr * K + k0 + 8 * c) = o; } }
    LDS_WAIT(); asm volatile("" ::: "memory");
}
__device__ __forceinline__ void tr8_load(f32x4 (&v)[16], const float* W, int K, int N, int item, int lane) {
    const int nblk = (N + 63) / 64, kb = item / nblk, nb = item % nblk, k0 = 64 * kb, n0 = 64 * nb; const int kk = lane >> 4, n4 = (lane & 15) * 4;
#pragma unroll
    for (int i = 0; i < 16; ++i) v[i] = *(const f32x4*)(W + (size_t)(k0 + 4 * i + kk) * N + n0 + n4);
}
template <class DstRow>
__device__ __forceinline__ void tr8_process(const f32x4 (&v)[16], int K, int N, unsigned char* WT, LAS float* scr, int item, int lane, float scale, const DstRow& dstrow) {
    const int nblk = (N + 63) / 64, kb = item / nblk, nb = item % nblk, k0 = 64 * kb, n0 = 64 * nb; const int kk = lane >> 4, n4 = (lane & 15) * 4;
#pragma unroll
    for (int i = 0; i < 16; ++i) { LAS float* d = scr + (4 * i + kk) * 65 + n4; d[0] = v[i].x * scale; d[1] = v[i].y * scale; d[2] = v[i].z * scale; d[3] = v[i].w * scale; }
    LDS_WAIT(); asm volatile("" ::: "memory");
    const int c = lane & 3;
#pragma unroll
    for (int j = 0; j < 4; ++j) { const int n = (lane >> 2) + 16 * j; const LAS float* p = scr + (16 * c) * 65 + n; const int dr = dstrow(n0 + n);
        u32x4 o; o.x = pk4_fp8(p[0], p[65], p[130], p[195]); o.y = pk4_fp8(p[260], p[325], p[390], p[455]); o.z = pk4_fp8(p[520], p[585], p[650], p[715]); o.w = pk4_fp8(p[780], p[845], p[910], p[975]);
        *(u32x4*)(WT + (size_t)dr * K + k0 + 16 * c) = o; }
    LDS_WAIT(); asm volatile("" ::: "memory");
}
template <class DstRow>
__device__ __forceinline__ void transpose_item_fp8(const float* W, int K, int N, unsigned char* WT, LAS float* scr, int item, int lane, float scale, const DstRow& dstrow) {
    f32x4 v[16]; tr8_load(v, W, K, N, item, lane); tr8_process(v, K, N, WT, scr, item, lane, scale, dstrow);
}
__device__ __forceinline__ int win_dst_row(int c) {
    if (c < 512) return c;
    if (c < 1536) { const int isk = c >= 1024, cc = c - (isk ? 1024 : 512), t = cc >> 8, w = cc & 255, hl = w >> 6, half = (w >> 5) & 1, dd = w & 31; return ((isk ? 4 : 2) + t) * 256 + half * 128 + hl * 32 + dd; }
    if (c < 2048) return 6 * 256 + (c - 1536);
    if (c < 2304) { const int cc = c - 2048, head = cc >> 5, half = (cc >> 4) & 1, dd = cc & 15; return 8 * 256 + half * 128 + head * 16 + dd; }
    if (c < 2336) { const int cc = c - 2304, half = cc >> 4, w = cc & 15; return 9 * 256 + half * 128 + w; }
    if (c < 2344) return 9 * 256 + 16 + (c - 2336);
    if (c < INC) return 2560 + (c - 2344);
    return -1;
}
__device__ __forceinline__ void rms_row_to_bf16(const float* xrow, const float* gain, bf16_t* orow, unsigned char* orow8, int lane) {
    const f32x4* xr = (const f32x4*)xrow + lane; const f32x4* gr = (const f32x4*)gain + lane;
    f32x4 v[4]; float s = 0.f;
#pragma unroll
    for (int j = 0; j < 4; ++j) { v[j] = xr[64 * j]; s += (v[j].x * v[j].x + v[j].y * v[j].y) + (v[j].z * v[j].z + v[j].w * v[j].w); }
    const float rstd = 1.0f / sqrtf(wave_sum(s) * (1.f / 1024.f) + EPS);
    u32x2* o8 = (u32x2*)orow + lane;
#pragma unroll
    for (int j = 0; j < 4; ++j) { const f32x4 g = gr[64 * j]; const float a0 = v[j].x * rstd * g.x, a1 = v[j].y * rstd * g.y, a2 = v[j].z * rstd * g.z, a3 = v[j].w * rstd * g.w;
        u32x2 w; w.x = pk2(a0, a1); w.y = pk2(a2, a3); o8[64 * j] = w; ((unsigned*)orow8)[lane + 64 * j] = pk4_fp8(a0, a1, a2, a3); }
}

__device__ __forceinline__ void p0_prologue(Frame& F) {
    LAS float* scr = (LAS float*)(F.lds + F.wave * 16640);
    const int gw = F.bid * 8 + F.wave, NGW = F.G * 8;
    { unsigned* ctl = WSP(unsigned, WS_CTL); for (int i = F.bid * NTHR + F.tid; i < CTL_WORDS; i += F.G * NTHR) ctl[i] = 0u; }
    { float* c64 = WSP(float, WS_COS64); float* s64 = WSP(float, WS_SIN64); float* c32 = WSP(float, WS_COS32); float* s32 = WSP(float, WS_SIN32);
      for (int i = F.bid * NTHR + F.tid; i < 4096 * 48; i += F.G * NTHR) {
          if (i < 4096 * 32) { const int pos = i >> 5, k = i & 31; const float inv = powf(10000.0f, -(float)k * (2.0f / 64.0f)); const float a = (float)pos * inv; c64[i] = cosf(a); s64[i] = sinf(a); }
          else { const int j = i - 4096 * 32, pos = j >> 4, k = j & 15; const float inv = powf(10000.0f, -(float)k * (2.0f / 32.0f)); const float a = (float)pos * inv; c32[j] = cosf(a); s32[j] = sinf(a); } } }
    { bf16_t* WT = WSP(bf16_t, WS_WINT) + (size_t)256 * 1024; unsigned char* W8 = WSP(unsigned char, WS_WIN8) + (size_t)9 * 256 * 1024;
      for (int i = F.bid * NTHR + F.tid; i < 256 * 128; i += F.G * NTHR) { const int row = i >> 7, ch = i & 127; const int w = row & 127, half = row >> 7;
          const bool used = (w < 16) || (half == 0 && w < 24); if (!used) { *(u32x4*)(WT + (size_t)row * 1024 + ch * 8) = (u32x4){0u, 0u, 0u, 0u}; if (ch < 64) *(u32x4*)(W8 + (size_t)row * 1024 + ch * 16) = (u32x4){0u, 0u, 0u, 0u}; } } }
    constexpr int I_WIN = ((INC + 63) / 64) * (1024 / 64), I_GLU = (512 / 64) * (512 / 64), I_SB = (1024 / 64) * (512 / 64), I_AB = I_SB, I_O = (1024 / 64) * (1024 / 64), I_PG = I_O, I_PP = (1024 / 64) * (256 / 64);
    constexpr int I_E = (1024 / 64) * (1024 / 64);
    constexpr int NDENSE = I_WIN + I_GLU + I_SB + I_AB + I_O + I_PG + I_PP;
    auto ident = [](int n) { return n; };
    for (int it = gw; it < NDENSE; it += NGW) {
        int r = it;
        if (r < I_WIN) {
            const int nblk = (INC + 63) / 64, nb = r % nblk;
            if (nb * 64 + 64 <= INC) { transpose_item_fp8(F.in[2], 1024, INC, WSP(unsigned char, WS_WIN8), scr, r, F.lane, 32.0f, [](int n) { return win_dst_row(n); });
                if (nb * 64 + 64 > 2048 && nb * 64 < 2344) transpose_item(F.in[2], 1024, INC, WSP(bf16_t, WS_WINT), scr, r, F.lane, [](int n) { const int d = win_dst_row(n); return (d >= 2048 && d < 2560) ? d - 2048 : -1; }); }
            else { const int kb = r / nblk, k0 = 64 * kb, n0 = 64 * nb; const int n = n0 + F.lane; const int dr = n < INC ? win_dst_row(n) : -1;
                if (dr >= 0) { unsigned char* o = WSP(unsigned char, WS_WIN8) + (size_t)dr * 1024 + k0;
                    for (int k = 0; k < 64; k += 4) *(unsigned*)(o + k) = pk4_fp8(32.0f * F.in[2][(size_t)(k0 + k) * INC + n], 32.0f * F.in[2][(size_t)(k0 + k + 1) * INC + n], 32.0f * F.in[2][(size_t)(k0 + k + 2) * INC + n], 32.0f * F.in[2][(size_t)(k0 + k + 3) * INC + n]); } }
            continue; } r -= I_WIN;
        if (r < I_GLU) { transpose_item(F.in[12], 512, 512, WSP(bf16_t, WS_WGLUT), scr, r, F.lane, ident); continue; } r -= I_GLU;
        if (r < I_SB) { transpose_item_fp8(F.in[14], 512, 1024, WSP(unsigned char, WS_WSB8), scr, r, F.lane, 32.0f, ident); continue; } r -= I_SB;
        if (r < I_AB) { transpose_item_fp8(F.in[15], 512, 1024, WSP(unsigned char, WS_WAB8), scr, r, F.lane, 32.0f, ident); continue; } r -= I_AB;
        if (r < I_O) { transpose_item_fp8(F.in[16], 1024, 1024, WSP(unsigned char, WS_WO8), scr, r, F.lane, 32.0f, ident); continue; } r -= I_O;
        if (r < I_PG) { transpose_item_fp8(F.in[27], 1024, 1024, WSP(unsigned char, WS_WPG8), scr, r, F.lane, 32.0f, ident); continue; } r -= I_PG;
        transpose_item(F.in[28], 256, 1024, WSP(bf16_t, WS_WPPT), scr, r, F.lane, ident);
    }
    for (int m = gw; m < T; m += NGW) rms_row_to_bf16(F.in[0] + (size_t)m * 1024, F.in[17], WSP(bf16_t, WS_E) + (size_t)m * 1024, WSP(unsigned char, WS_H8) + (size_t)m * 1024, F.lane);
}

__device__ __forceinline__ void p0_s5_tables(Frame& F) {
    LAS float* zr = (LAS float*)F.lds; LAS float* zi = zr + 64; LAS float* bbr = zi + 64; LAS float* bbi = bbr + 1024; LAS float* Lr = bbi + 1024; LAS float* Li = Lr + 512;
    const float* lam_re = F.in[4]; const float* lam_im = F.in[5]; const float* log_dt = F.in[6]; const float* b_re = F.in[7]; const float* b_im = F.in[8];
    const float* c_re = F.in[9]; const float* c_im = F.in[10]; const float* d_skip = F.in[11];
    float* Kg = WSP(float, WS_KG); float* L64 = WSP(float, WS_L64); bf16_t* Wg = WSP(bf16_t, WS_WG); bf16_t* TV = WSP(bf16_t, WS_TV);
    for (int it = F.bid; it < 256; it += F.G) {
        const int g = it >> 3, sub = it & 7, tid = F.tid;
        __syncthreads();
        const float dt = expf(log_dt[g]);
        if (tid < 64) { zr[tid] = lam_re[g * 64 + tid] * dt; zi[tid] = lam_im[g * 64 + tid] * dt; }
        __syncthreads();
        for (int idx = tid; idx < 1024; idx += NTHR) { const int p = idx >> 4, hp = idx & 15;
            const float lr = lam_re[g * 64 + p], li = lam_im[g * 64 + p];
            const float er = expf(zr[p]), cr = er * cosf(zi[p]), ci = er * sinf(zi[p]);
            const float nr = cr - 1.0f, ni = ci, den = lr * lr + li * li;
            const float fr_ = (nr * lr + ni * li) / den, fi_ = (ni * lr - nr * li) / den;
            const float br = b_re[(g * 64 + p) * 16 + hp], bi = b_im[(g * 64 + p) * 16 + hp];
            bbr[idx] = fr_ * br - fi_ * bi; bbi[idx] = fr_ * bi + fi_ * br; }
        { const int lagl = tid >> 6, p = tid & 63; const float n = (float)(8 * sub + lagl); const float mag = expf(n * zr[p]), a = n * zi[p]; Lr[tid] = mag * cosf(a); Li[tid] = mag * sinf(a); }
        __syncthreads();
#pragma unroll 1
        for (int j = 0; j < 4; ++j) { const int o = tid + 512 * j, lagl = o >> 8, h = (o >> 4) & 15, hp = o & 15; float s = 0.f;
            for (int p = 0; p < 64; ++p) { const float cr = c_re[(g * 16 + h) * 64 + p], ci = c_im[(g * 16 + h) * 64 + p], lr = Lr[lagl * 64 + p], li = Li[lagl * 64 + p];
                const float tr = cr * lr - ci * li, ti = cr * li + ci * lr; s += tr * bbr[p * 16 + hp] - ti * bbi[p * 16 + hp]; }
            const int lag = 8 * sub + lagl; if (lag == 0 && h == hp) s += d_skip[g * 16 + h];
            Kg[((g * 64 + lag) * 16 + h) * 16 + hp] = s; }
        { const int pl = tid >> 6, j = tid & 63, p = 8 * sub + pl;
          { const float n = (float)(63 - j); const float mag = expf(n * zr[p]), a = n * zi[p]; const float er = mag * cosf(a), ei = mag * sinf(a);
            unsigned wre[8], wim[8];
#pragma unroll
            for (int q = 0; q < 8; ++q) { const float b0r = bbr[p * 16 + 2 * q], b0i = bbi[p * 16 + 2 * q], b1r = bbr[p * 16 + 2 * q + 1], b1i = bbi[p * 16 + 2 * q + 1];
                wre[q] = pk2(er * b0r - ei * b0i, er * b1r - ei * b1i); wim[q] = pk2(er * b0i + ei * b0r, er * b1i + ei * b1r); }
            u32x4* dre = (u32x4*)(Wg + (size_t)(g * 128 + p) * 1024 + j * 16); u32x4* dim = (u32x4*)(Wg + (size_t)(g * 128 + 64 + p) * 1024 + j * 16);
            dre[0] = (u32x4){wre[0], wre[1], wre[2], wre[3]}; dre[1] = (u32x4){wre[4], wre[5], wre[6], wre[7]};
            dim[0] = (u32x4){wim[0], wim[1], wim[2], wim[3]}; dim[1] = (u32x4){wim[4], wim[5], wim[6], wim[7]}; }
          { const int t = j; const float n = (float)(t + 1); const float mag = expf(n * zr[p]), a = n * zi[p]; const float er = mag * cosf(a), ei = mag * sinf(a);
#pragma unroll 4
            for (int h = 0; h < 16; ++h) { const float cr = c_re[(g * 16 + h) * 64 + p], ci = c_im[(g * 16 + h) * 64 + p];
                bf16_t* d = TV + (size_t)(g * 1024 + t * 16 + h) * 1152 + 1024 + p;
                d[0] = (bf16_t)f2bf(cr * er - ci * ei); d[64] = (bf16_t)f2bf(-(cr * ei + ci * er)); } }
          if (sub == 0 && tid < 64) { const float mag = expf(64.0f * zr[tid]), a = 64.0f * zi[tid]; L64[(g * 64 + tid) * 2] = mag * cosf(a); L64[(g * 64 + tid) * 2 + 1] = mag * sinf(a); }
        }
    }
    __syncthreads();
}
__device__ __forceinline__ void fill_tv_item(unsigned char* wsb, int tid, int item) {
    const float* Kg = (const float*)(wsb + WS_KG); bf16_t* TV = (bf16_t*)(wsb + WS_TV);
#pragma unroll 4
    for (int it = 0; it < 16; ++it) { const int ci = (item * 16 + it) * NTHR + tid;
        const int g = ci >> 17, row = (ci >> 7) & 1023, ch = ci & 127, t = row >> 4, h = row & 15, j = ch >> 1, h0 = (ch & 1) * 8, lag = t - j;
        u32x4 o = (u32x4){0u, 0u, 0u, 0u};
        if (lag >= 0) { const f32x4* sp = (const f32x4*)(Kg + ((g * 64 + lag) * 16 + h) * 16 + h0); const f32x4 a = sp[0], b = sp[1];
            o.x = pk2(a.x, a.y); o.y = pk2(a.z, a.w); o.z = pk2(b.x, b.y); o.w = pk2(b.z, b.w); }
        *(u32x4*)(TV + (size_t)(g * 1024 + row) * 1152 + ch * 8) = o; }
}

struct EpiInProj {
    bf16_t *U, *Q, *K, *V, *QI, *KI, *GS, *GA; float* WI; const float *bg, *c64, *s64, *c32, *s32; float ascale;
    __device__ __forceinline__ void operator()(f32x4 (&acc)[2][2][4][2], const pg::Unit& u, int wr, int wc, int fr, int fq) const {
        const int pn = u.pn, row0 = u.pm * 256 + wr * 64 + fr;
        if (ascale != 1.0f) {
#pragma unroll
            for (int a_ = 0; a_ < 2; ++a_)
#pragma unroll
                for (int b_ = 0; b_ < 2; ++b_)
#pragma unroll
                    for (int m_ = 0; m_ < 4; ++m_)
#pragma unroll
                        for (int n_ = 0; n_ < 2; ++n_) acc[a_][b_][m_][n_] *= ascale; }
        if (pn < 2) {
#pragma unroll
            for (int ai = 0; ai < 2; ++ai)
#pragma unroll
                for (int m = 0; m < 4; ++m) { const int r = row0 + ai * 128 + m * 16;
#pragma unroll
                    for (int bj = 0; bj < 2; ++bj)
#pragma unroll
                        for (int n = 0; n < 2; ++n) { const int c = pn * 256 + bj * 128 + wc * 32 + n * 16 + fq * 4; const int g = c >> 4, hp = c & 15; const f32x4 v = acc[ai][bj][m][n];
                            u32x2 w; w.x = pk2(v.x, v.y); w.y = pk2(v.z, v.w);
                            *(u32x2*)(U + ((size_t)(g * 512 + (r >> 6)) * 1152 + (r & 63) * 16 + hp)) = w; } }
        } else if (pn < 6) {
            bf16_t* O = pn < 4 ? Q : K; const float sc = pn < 4 ? C2 : 1.0f; const int head = (pn & 1) * 4 + wc;
#pragma unroll
            for (int ai = 0; ai < 2; ++ai)
#pragma unroll
                for (int m = 0; m < 4; ++m) { const int r = row0 + ai * 128 + m * 16, l = r & 4095;
#pragma unroll
                    for (int n = 0; n < 2; ++n) { const int dd = n * 16 + fq * 4; const f32x4 cs = *(const f32x4*)(c64 + l * 32 + dd), sn = *(const f32x4*)(s64 + l * 32 + dd);
                        const f32x4 x1 = acc[ai][0][m][n], x2 = acc[ai][1][m][n]; const f32x4 o1 = (x1 * cs - x2 * sn) * sc, o2 = (x2 * cs + x1 * sn) * sc;
                        bf16_t* d = O + (size_t)r * 512 + head * 64 + dd; u32x2 w;
                        w.x = pk2(o1.x, o1.y); w.y = pk2(o1.z, o1.w); *(u32x2*)d = w;
                        w.x = pk2(o2.x, o2.y); w.y = pk2(o2.z, o2.w); *(u32x2*)(d + 32) = w; } }
        } else if (pn < 8) {
#pragma unroll
            for (int ai = 0; ai < 2; ++ai)
#pragma unroll
                for (int m = 0; m < 4; ++m) { const int r = row0 + ai * 128 + m * 16;
#pragma unroll
                    for (int bj = 0; bj < 2; ++bj)
#pragma unroll
                        for (int n = 0; n < 2; ++n) { const int c = (pn - 6) * 256 + bj * 128 + wc * 32 + n * 16 + fq * 4; const f32x4 v = acc[ai][bj][m][n];
                            u32x2 w; w.x = pk2(v.x, v.y); w.y = pk2(v.z, v.w); *(u32x2*)(V + (size_t)r * 512 + c) = w; } }
        } else if (pn == 8) {
#pragma unroll
            for (int ai = 0; ai < 2; ++ai)
#pragma unroll
                for (int m = 0; m < 4; ++m) { const int r = row0 + ai * 128 + m * 16, l = r & 4095;
                    const f32x4 cs = *(const f32x4*)(c32 + l * 16 + fq * 4), sn = *(const f32x4*)(s32 + l * 16 + fq * 4);
#pragma unroll
                    for (int n = 0; n < 2; ++n) { const int head = 2 * wc + n; const f32x4 x1 = acc[ai][0][m][n], x2 = acc[ai][1][m][n]; const f32x4 o1 = x1 * cs - x2 * sn, o2 = x2 * cs + x1 * sn;
                        bf16_t* d = QI + (size_t)r * 256 + head * 32 + fq * 4; u32x2 w;
                        w.x = pk2(o1.x, o1.y); w.y = pk2(o1.z, o1.w); *(u32x2*)d = w;
                        w.x = pk2(o2.x, o2.y); w.y = pk2(o2.z, o2.w); *(u32x2*)(d + 16) = w; } }
        } else if (pn == 9) {
            if (wc == 0) {
#pragma unroll
                for (int ai = 0; ai < 2; ++ai)
#pragma unroll
                    for (int m = 0; m < 4; ++m) { const int r = row0 + ai * 128 + m * 16, l = r & 4095;
                        const f32x4 cs = *(const f32x4*)(c32 + l * 16 + fq * 4), sn = *(const f32x4*)(s32 + l * 16 + fq * 4);
                        const f32x4 x1 = acc[ai][0][m][0], x2 = acc[ai][1][m][0]; const f32x4 o1 = x1 * cs - x2 * sn, o2 = x2 * cs + x1 * sn;
                        bf16_t* d = KI + (size_t)r * 32 + fq * 4; u32x2 w;
                        w.x = pk2(o1.x, o1.y); w.y = pk2(o1.z, o1.w); *(u32x2*)d = w;
                        w.x = pk2(o2.x, o2.y); w.y = pk2(o2.z, o2.w); *(u32x2*)(d + 16) = w;
                        if (fq < 2) *(f32x4*)(WI + (size_t)r * 8 + fq * 4) = acc[ai][0][m][1]; } }
        } else {
#pragma unroll
            for (int bj = 0; bj < 2; ++bj)
#pragma unroll
                for (int n = 0; n < 2; ++n) { const int c = (pn - 10) * 256 + bj * 128 + wc * 32 + n * 16 + fq * 4; const f32x4 b = *(const f32x4*)(bg + c);
                    unsigned char* O = c < 1024 ? (unsigned char*)GS + c : (unsigned char*)GS + (size_t)T * 1024 + (c - 1024);
#pragma unroll
                    for (int ai = 0; ai < 2; ++ai)
#pragma unroll
                        for (int m = 0; m < 4; ++m) { const int r = row0 + ai * 128 + m * 16; const f32x4 v = acc[ai][bj][m][n] + b;
                            *(unsigned*)(O + (size_t)r * 1024) = pk4_fp8(sigmoidf_(v.x), sigmoidf_(v.y), sigmoidf_(v.z), sigmoidf_(v.w)); } }
        }
    }
};

__device__ __forceinline__ void idx_score_tile(bf16x8 k0, bf16x8 k1, const bf16x8 (&qp)[2], const bf16x8 (&qf)[8][2], const float (&w)[8], float (&sc)[16]) {
    const f32x16 z = (f32x16){0.f, 0.f, 0.f, 0.f, 0.f, 0.f, 0.f, 0.f, 0.f, 0.f, 0.f, 0.f, 0.f, 0.f, 0.f, 0.f};
    f32x16 lin = __builtin_amdgcn_mfma_f32_32x32x16_bf16(k0, qp[0], z, 0, 0, 0); lin = __builtin_amdgcn_mfma_f32_32x32x16_bf16(k1, qp[1], lin, 0, 0, 0);
    f32x16 dA = __builtin_amdgcn_mfma_f32_32x32x16_bf16(k0, qf[0][0], z, 0, 0, 0); dA = __builtin_amdgcn_mfma_f32_32x32x16_bf16(k1, qf[0][1], dA, 0, 0, 0);
#pragma unroll
    for (int r = 0; r < 16; ++r) sc[r] = lin[r];
#pragma unroll
    for (int h = 0; h < 8; ++h) {
        f32x16 dB = z;
        if (h < 7) { dB = __builtin_amdgcn_mfma_f32_32x32x16_bf16(k0, qf[h + 1][0], z, 0, 0, 0); dB = __builtin_amdgcn_mfma_f32_32x32x16_bf16(k1, qf[h + 1][1], dB, 0, 0, 0); }
#pragma unroll
        for (int r = 0; r < 16; ++r) sc[r] = __builtin_fmaf(w[h], __builtin_fabsf(dA[r]), sc[r]);
        asm volatile("" : "+v"(sc[0]), "+v"(sc[1]), "+v"(sc[2]), "+v"(sc[3]), "+v"(sc[4]), "+v"(sc[5]), "+v"(sc[6]), "+v"(sc[7]), "+v"(k0));
        asm volatile("" : "+v"(sc[8]), "+v"(sc[9]), "+v"(sc[10]), "+v"(sc[11]), "+v"(sc[12]), "+v"(sc[13]), "+v"(sc[14]), "+v"(sc[15]), "+v"(k1));
        dA = dB;
    }
}
__device__ __forceinline__ unsigned h16_of(float s) { const _Float16 hf = (_Float16)s; return (unsigned)__builtin_bit_cast(unsigned short, hf); }
__device__ __forceinline__ void idx_scan(const LAS unsigned* hq, unsigned need, int mode, unsigned& fb, unsigned& frem) {
    unsigned cum = 0; fb = 0; frem = 1; bool found = false;
    for (int k = 0; k < 256; ++k) { const int bin = mode == 0 ? (k < 128 ? 127 - k : k) : mode == 1 ? 255 - k : k; const unsigned c = hq[bin * 32];
        if (!found && cum + c >= need) { fb = (unsigned)bin; frem = need - cum; found = true; } cum += c; }
}
__device__ __forceinline__ void idx_phase(Frame& F) {
    LAS unsigned* hist = (LAS unsigned*)F.lds;
    LAS unsigned* b1s = hist + 16384; LAS unsigned* r1s = b1s + 64; LAS unsigned* ths = r1s + 64;
    const bf16_t* QI = WSP(bf16_t, WS_QIDX); const bf16_t* KI = WSP(bf16_t, WS_KIDX); const float* WI = WSP(float, WS_WIDX); unsigned* MASK = WSP(unsigned, WS_MASK);
    const int lane = F.lane, r32 = lane & 31, hi = lane >> 5, gq = F.wave & 1, ks = F.wave >> 1;
    LAS int* qslot = (LAS int*)(F.lds + 68 * 1024);
    unsigned* qhead = WSP(unsigned, WS_CTL) + CW_QIDX + (F.dry ? 16 : 0);
    for (;;) {
            __syncthreads();
            if (F.tid == 0) *qslot = (int)__hip_atomic_fetch_add(qhead, 1u, __ATOMIC_RELAXED, __HIP_MEMORY_SCOPE_AGENT);
            __syncthreads();
            const int qpos = *qslot; if (qpos >= 1024) break;
            if (qpos & 1) { if (!F.dry) fill_tv_item(F.ws, F.tid, qpos >> 1); continue; }
            const int un = qpos >> 1;
            const int qb = 63 - (un >> 3), b = un & 7;
            const int q0 = qb * 64 + gq * 32, tok = b * 4096 + q0 + r32, ntile = (qb + 1) * 2;
            bf16x8 qf[8][2], qp[2]; float w[8];
#pragma unroll
            for (int h = 0; h < 8; ++h)
#pragma unroll
                for (int k = 0; k < 2; ++k) qf[h][k] = *(const bf16x8*)(QI + (size_t)tok * 256 + h * 32 + k * 16 + hi * 8);
            { const f32x4 wa = *(const f32x4*)(WI + (size_t)tok * 8), wb = *(const f32x4*)(WI + (size_t)tok * 8 + 4); w[0] = wa.x; w[1] = wa.y; w[2] = wa.z; w[3] = wa.w; w[4] = wb.x; w[5] = wb.y; w[6] = wb.z; w[7] = wb.w; }
#pragma unroll
            for (int k = 0; k < 2; ++k) { float a[8];
#pragma unroll
                for (int j = 0; j < 8; ++j) a[j] = 0.f;
#pragma unroll
                for (int h = 0; h < 8; ++h)
#pragma unroll
                    for (int j = 0; j < 8; ++j) a[j] = __builtin_fmaf(w[h], bf2f((unsigned short)qf[h][k][j]), a[j]);
                u32x4 pkd; pkd.x = pk2(a[0], a[1]); pkd.y = pk2(a[2], a[3]); pkd.z = pk2(a[4], a[5]); pkd.w = pk2(a[6], a[7]); qp[k] = __builtin_bit_cast(bf16x8, pkd); }
            const bf16_t* kbase = KI + (size_t)(b * 4096 + r32) * 32 + hi * 8;
            LAS unsigned* hq = hist + gq * 8192 + r32;
            _Float16 theta = (_Float16)(-INFINITY); float sc[16]; bf16x8 kn0, kn1;
#define IDX_TILES(BODY) do { kn0 = *(const bf16x8*)(kbase + (size_t)ks * 1024); kn1 = *(const bf16x8*)(kbase + (size_t)ks * 1024 + 16); \
            for (int kt = ks; kt < ntile; kt += 4) { const bf16x8 kc0 = kn0, kc1 = kn1; \
                if (kt + 4 < ntile) { kn0 = *(const bf16x8*)(kbase + (size_t)(kt + 4) * 1024); kn1 = *(const bf16x8*)(kbase + (size_t)(kt + 4) * 1024 + 16); } \
                idx_score_tile(kc0, kc1, qp, qf, w, sc); BODY } } while (0)
            if (qb >= 4) {
                for (int i = F.tid; i < 16384; i += NTHR) hist[i] = 0u;
                __syncthreads();
                IDX_TILES({
                    _Pragma("unroll") for (int r = 0; r < 16; ++r) __hip_atomic_fetch_add(hq + (h16_of(sc[r]) >> 8) * 32, 1u, __ATOMIC_RELAXED, __HIP_MEMORY_SCOPE_WORKGROUP); });
                __syncthreads();
                if (ks == 0 && hi == 0) { unsigned fb, fr_; idx_scan(hq, 256u, 0, fb, fr_); b1s[gq * 32 + r32] = fb; r1s[gq * 32 + r32] = fr_; }
                __syncthreads();
                for (int i = F.tid; i < 16384; i += NTHR) hist[i] = 0u;
                __syncthreads();
                const unsigned b1 = b1s[gq * 32 + r32];
                IDX_TILES({
                    _Pragma("unroll") for (int r = 0; r < 16; ++r) { const unsigned hv = h16_of(sc[r]); if ((hv >> 8) == b1) __hip_atomic_fetch_add(hq + (hv & 255u) * 32, 1u, __ATOMIC_RELAXED, __HIP_MEMORY_SCOPE_WORKGROUP); } });
                __syncthreads();
                if (ks == 0 && hi == 0) { unsigned fb, fr_; const unsigned bb = b1s[gq * 32 + r32]; idx_scan(hq, r1s[gq * 32 + r32], bb < 128u ? 1 : 2, fb, fr_); ths[gq * 32 + r32] = (bb << 8) | fb; }
                __syncthreads();
                theta = __builtin_bit_cast(_Float16, (unsigned short)ths[gq * 32 + r32]);
            }
            IDX_TILES({
                unsigned bits = 0u;
                _Pragma("unroll") for (int r = 0; r < 16; ++r) bits |= ((_Float16)sc[r] >= theta ? 1u : 0u) << ((r & 3) + 8 * (r >> 2));
                bits <<= 4 * hi;
                bits |= (unsigned)__shfl_xor((int)bits, 32);
                if (hi == 0) MASK[(size_t)(b * 128 + kt) * 4096 + q0 + r32] = bits; });
#undef IDX_TILES
    }
}

constexpr int CV_IE = (1024 / 64) * (1024 / 64), CV_NITEMS = 3 * 32 * CV_IE, CV_NBLK = CV_NITEMS / 8;
__device__ __forceinline__ void expert_conv_item(LAS unsigned char* lds, unsigned char* ws, int wave, int lane, const float* wg_, const float* wu_, const float* wd_, int bitem) {
    LAS float* scr = (LAS float*)(lds + wave * 16640);
    const int r = bitem * 8 + wave, which = r / (32 * CV_IE), e = (r % (32 * CV_IE)) / CV_IE, item = r % CV_IE;
    auto w1row = [](int c) { const int pn = c >> 7, w = c & 127; return pn * 256 + (w & 96) + ((w >> 2) & 1) * 16 + ((w >> 3) & 3) * 4 + (w & 3); };
    const float* src = (which == 0 ? wg_ : which == 1 ? wu_ : wd_) + (size_t)e * 1024 * 1024;
    if (which == 0) transpose_item_fp8(src, 1024, 1024, ws + WS_W1T + (size_t)e * 2048 * 1024, scr, item, lane, 32.0f, w1row);
    else if (which == 1) transpose_item_fp8(src, 1024, 1024, ws + WS_W1T + (size_t)e * 2048 * 1024, scr, item, lane, 32.0f, [=](int c) { return w1row(c) + 128; });
    else transpose_item_fp8(src, 1024, 1024, ws + WS_W2T + (size_t)e * 1024 * 1024, scr, item, lane, 32.0f, [](int n) { return n; });
}
__device__ __forceinline__ s16x4 vtr(const LAS char* p) { typedef short v4i16_t __attribute__((ext_vector_type(4))); return __builtin_bit_cast(s16x4, __builtin_amdgcn_ds_read_tr16_b64_v4i16((LAS v4i16_t*)p)); }
__device__ __forceinline__ void glds16(const void* gsrc, unsigned lds_dst) {
    unsigned keep; asm volatile("s_mov_b32 %0, m0\n\ts_mov_b32 m0, %2\n\ts_nop 0\n\tglobal_load_lds_dwordx4 %1, off\n\ts_mov_b32 m0, %0" : "=&s"(keep) : "v"(gsrc), "s"(lds_dst) : "memory"); }
__device__ __forceinline__ void attn_phase(Frame& F) {
    const bf16_t* Q = WSP(bf16_t, WS_Q); const bf16_t* K = WSP(bf16_t, WS_K); const bf16_t* V = WSP(bf16_t, WS_V); unsigned char* O = F.dry ? WSP(unsigned char, WS_E) : WSP(unsigned char, WS_YA8); const unsigned* MASK = WSP(unsigned, WS_MASK);
    const int lane = F.lane, r32 = lane & 31, hi = lane >> 5, wv = F.wave;
    const LAS char* ldsc = (const LAS char*)F.lds;
    const unsigned lds0 = (unsigned)(uintptr_t)F.lds;
    constexpr int KOFF = 0, VOFF = 32768, MOFF = 65536;
    const float* const wg_ = F.in[21]; const float* const wu_ = F.in[23]; const float* const wd_ = F.in[25];
    LAS int* qslot = (LAS int*)(F.lds + LDS_BYTES_C - 128);
    unsigned* qhead = WSP(unsigned, WS_CTL) + CW_QATT + (F.dry ? 16 : 0);
    for (;;) {
            __syncthreads();
            if (F.tid == 0) *qslot = (int)__hip_atomic_fetch_add(qhead, 1u, __ATOMIC_RELAXED, __HIP_MEMORY_SCOPE_AGENT);
            __syncthreads();
            const int qp = *qslot; if (qp >= 1024 + CV_NBLK) break;
            if ((qp & 3) != 0 || qp >= 4096) { const int ci = qp < 4096 ? qp - (qp >> 2) - 1 : qp - 1024; if (!F.dry) expert_conv_item(F.lds, F.ws, F.wave, F.lane, wg_, wu_, wd_, ci); continue; }
            const int un = qp >> 2;
            const int qb = 15 - (un >> 6), b = (un >> 3) & 7, h = un & 7;
            const int q0 = qb * 256, NT = 4 * qb + 4, ntw = 4 * qb + (wv >> 1) + 1;
            const size_t tokq = (size_t)b * 4096 + q0 + wv * 32 + r32;
            const bf16_t* ksrc = K + ((size_t)b * 4096 + lane) * 512 + h * 64 + wv * 8;
            const bf16_t* vsrc = V + ((size_t)b * 4096 + 16 * (wv & 3) + (lane >> 2)) * 512 + h * 64 + (wv >> 2) * 32 + (lane & 3) * 8;
            const unsigned* msrc = MASK + ((size_t)b * 128 + (wv & 1)) * 4096 + q0 + lane * 4;
            const unsigned kdst = lds0 + KOFF + wv * 1024, vdst = lds0 + VOFF + wv * 1024, mdst = lds0 + MOFF + (wv & 1) * 1024;
#define ATT_DMA(t_) do { const int tt_ = (t_) < NT ? (t_) : NT - 1; const unsigned sl_ = (unsigned)((t_) & 3); \
        glds16(ksrc + (size_t)tt_ * 64 * 512, (unsigned)__builtin_amdgcn_readfirstlane(kdst + sl_ * 8192u)); \
        glds16(vsrc + (size_t)tt_ * 64 * 512, (unsigned)__builtin_amdgcn_readfirstlane(vdst + sl_ * 8192u)); \
        glds16(msrc + (size_t)tt_ * 2 * 4096, (unsigned)__builtin_amdgcn_readfirstlane(mdst + sl_ * 2048u)); } while (0)
            ATT_DMA(0); ATT_DMA(1); ATT_DMA(2);
            bf16x8 qr[4];
#pragma unroll
            for (int d0 = 0; d0 < 4; ++d0) qr[d0] = *(const bf16x8*)(Q + tokq * 512 + h * 64 + d0 * 16 + hi * 8);
            asm volatile("" : "+v"(qr[0]), "+v"(qr[1]), "+v"(qr[2]), "+v"(qr[3]));
            float m = 0.f; f32x16 o[2], o2, negm;
#pragma unroll
            for (int r = 0; r < 16; ++r) { o[0][r] = 0.f; o[1][r] = 0.f; o2[r] = 0.f; negm[r] = 0.f; }
            const unsigned onew = r32 == 0 ? 0x3f803f80u : 0u; const bf16x8 ones = __builtin_bit_cast(bf16x8, (u32x4){onew, onew, onew, onew});
            const int vlane = ((lane >> 4) & 1) * 32 + (lane & 3) * 8 + (4 * hi + ((lane & 15) >> 2)) * 64;
            for (int t = 0; t < NT; ++t) {
                asm volatile("s_waitcnt vmcnt(6)\n\ts_barrier" ::: "memory");
                ATT_DMA(t + 3);
                if (t < ntw) {
                    const int sl = t & 3;
                    const LAS char* Kb = ldsc + KOFF + sl * 8192; const LAS char* Vb = ldsc + VOFF + sl * 8192 + vlane; const LAS unsigned* Mb = (const LAS unsigned*)(ldsc + MOFF + sl * 2048) + wv * 32 + r32;
                    const int w0 = (int)(Mb[0] >> (4 * hi)), w1 = (int)(Mb[256] >> (4 * hi));
                    f32x16 p0, p1;
                    { const bf16x8 k0 = *(const LAS bf16x8*)(Kb + hi * 1024 + r32 * 16), k1 = *(const LAS bf16x8*)(Kb + hi * 1024 + r32 * 16 + 512);
                      p0 = __builtin_amdgcn_mfma_f32_32x32x16_bf16(k0, qr[0], negm, 0, 0, 0); p1 = __builtin_amdgcn_mfma_f32_32x32x16_bf16(k1, qr[0], negm, 0, 0, 0); }
#pragma unroll
                    for (int d0 = 1; d0 < 4; ++d0) { const bf16x8 k0 = *(const LAS bf16x8*)(Kb + d0 * 2048 + hi * 1024 + r32 * 16), k1 = *(const LAS bf16x8*)(Kb + d0 * 2048 + hi * 1024 + r32 * 16 + 512);
                        p0 = __builtin_amdgcn_mfma_f32_32x32x16_bf16(k0, qr[d0], p0, 0, 0, 0); p1 = __builtin_amdgcn_mfma_f32_32x32x16_bf16(k1, qr[d0], p1, 0, 0, 0); }
                    float rm = __builtin_fmaxf(p0[0], p1[0]);
#pragma unroll
                    for (int r = 1; r < 16; ++r) rm = __builtin_fmaxf(rm, __builtin_fmaxf(p0[r], p1[r]));
                    rm = __builtin_fmaxf(rm, __shfl_xor(rm, 32));
                    if (t == 0 || __any(rm > 0.f)) {
                        const float dl = t == 0 ? rm : __builtin_fmaxf(rm, 0.f), f = __builtin_amdgcn_exp2f(-dl);
                        m += dl;
#pragma unroll
                        for (int r = 0; r < 16; ++r) { negm[r] = -m; o[0][r] *= f; o[1][r] *= f; o2[r] *= f; p0[r] -= dl; p1[r] -= dl; }
                    }
#pragma unroll
                    for (int r = 0; r < 16; ++r) { const int bp = (r & 3) + 8 * (r >> 2);
                        p0[r] = __uint_as_float(__float_as_uint(__builtin_amdgcn_exp2f(p0[r])) & (unsigned)__builtin_amdgcn_sbfe(w0, bp, 1));
                        p1[r] = __uint_as_float(__float_as_uint(__builtin_amdgcn_exp2f(p1[r])) & (unsigned)__builtin_amdgcn_sbfe(w1, bp, 1)); }
                    u32x4 pw[4];
#pragma unroll
                    for (int q = 0; q < 4; ++q) { pw[0][q] = pk2(p0[2 * q], p0[2 * q + 1]); pw[1][q] = pk2(p0[8 + 2 * q], p0[8 + 2 * q + 1]); pw[2][q] = pk2(p1[2 * q], p1[2 * q + 1]); pw[3][q] = pk2(p1[8 + 2 * q], p1[8 + 2 * q + 1]); }
#pragma unroll
                    for (int d0 = 0; d0 < 2; ++d0)
#pragma unroll
                        for (int kk = 0; kk < 4; ++kk) { const s16x4 lo = vtr(Vb + d0 * 4096 + kk * 1024), hh = vtr(Vb + d0 * 4096 + kk * 1024 + 512);
                            const bf16x8 vf = (bf16x8){lo[0], lo[1], lo[2], lo[3], hh[0], hh[1], hh[2], hh[3]};
                            o[d0] = __builtin_amdgcn_mfma_f32_32x32x16_bf16(vf, __builtin_bit_cast(bf16x8, pw[kk]), o[d0], 0, 0, 0); }
#pragma unroll
                    for (int kk = 0; kk < 4; ++kk) o2 = __builtin_amdgcn_mfma_f32_32x32x16_bf16(ones, __builtin_bit_cast(bf16x8, pw[kk]), o2, 0, 0, 0);
                }
            }
            asm volatile("s_waitcnt vmcnt(0) lgkmcnt(0)\n\ts_barrier" ::: "memory");
#undef ATT_DMA
            const float lt = __shfl(o2[0], r32), inv = 1.0f / lt;
#pragma unroll
            for (int d0 = 0; d0 < 2; ++d0)
#pragma unroll
                for (int g4 = 0; g4 < 4; ++g4) { unsigned w = pk4_fp8(o[d0][4 * g4] * inv, o[d0][4 * g4 + 1] * inv, o[d0][4 * g4 + 2] * inv, o[d0][4 * g4 + 3] * inv);
#ifdef ABL_ATTN
                    w = 0u;
#endif
                    *(unsigned*)(O + tokq * 512 + h * 64 + d0 * 32 + g4 * 8 + hi * 4) = w; }
        }
}

struct ProbS5E {
    const char* U; const char* Wg; unsigned ldb_bytes; int nt, G, c;
    __device__ bool next(int i, pg::Unit& u) const { const int L = i * G + c; if (L >= 64) return false; u.g = L >> 1; u.pm = L & 1; u.pn = 0; return true; }
    __device__ const char* a_base(const pg::Unit& u) const { return U + ((size_t)u.g * 512 + u.pm * 256) * 2304; }
    __device__ unsigned a_off(const pg::Unit&, int row, int col) const { return (unsigned)row * 2304u + (unsigned)col * 2u; }
    __device__ const char* b_base(const pg::Unit& u) const { return Wg + (size_t)u.g * 128 * 2048; }
};
struct EpiS5E { float* E;
    __device__ __forceinline__ void operator()(f32x4 (&acc)[2][2][4][2], const pg::Unit& u, int wr, int wc, int fr, int fq) const {
#pragma unroll
        for (int ai = 0; ai < 2; ++ai)
#pragma unroll
            for (int m = 0; m < 4; ++m) { const int r = u.pm * 256 + ai * 128 + wr * 64 + m * 16 + fr;
#pragma unroll
                for (int n = 0; n < 2; ++n) *(f32x4*)(E + ((size_t)u.g * 512 + r) * 128 + wc * 32 + n * 16 + fq * 4) = acc[ai][0][m][n]; }
    }
};
__device__ __forceinline__ void s5_scan(Frame& F) {
    if (F.wave != 0) return;
    const float* E = WSP(float, WS_EF32); const float* L64 = WSP(float, WS_L64); bf16_t* U = WSP(bf16_t, WS_U);
    for (int gid = F.bid * 64 + F.lane; gid < 32 * 8 * 64; gid += F.G * 64) {
        const int p = gid & 63, b = (gid >> 6) & 7, g = gid >> 9;
        const float lr = L64[(g * 64 + p) * 2], li = L64[(g * 64 + p) * 2 + 1]; float sr = 0.f, si = 0.f;
        const size_t m0 = (size_t)g * 512 + b * 64;
#pragma unroll 1
        for (int c0 = 0; c0 < 64; c0 += 16) { float er[16], ei[16];
#pragma unroll
            for (int c = 0; c < 16; ++c) { er[c] = E[(m0 + c0 + c) * 128 + p]; ei[c] = E[(m0 + c0 + c) * 128 + 64 + p]; }
#pragma unroll
            for (int c = 0; c < 16; ++c) { const size_t m = m0 + c0 + c;
                U[m * 1152 + 1024 + p] = (bf16_t)f2bf(sr); U[m * 1152 + 1088 + p] = (bf16_t)f2bf(si);
                const float nr = lr * sr - li * si + er[c], ni = lr * si + li * sr + ei[c]; sr = nr; si = ni; } }
    }
}
struct ProbS5Y {
    const char* U; const char* TV; unsigned ldb_bytes; int nt, G, c;
    __device__ bool next(int i, pg::Unit& u) const { const int L = i * G + c; if (L >= 256) return false; u.g = L >> 3; u.pm = (L >> 2) & 1; u.pn = L & 3; return true; }
    __device__ const char* a_base(const pg::Unit& u) const { return U + ((size_t)u.g * 512 + u.pm * 256) * 2304; }
    __device__ unsigned a_off(const pg::Unit&, int row, int col) const { return (unsigned)row * 2304u + (unsigned)col * 2u; }
    __device__ const char* b_base(const pg::Unit& u) const { return TV + ((size_t)u.g * 1024 + u.pn * 256) * 2304; }
};
struct EpiS5Y { bf16_t* Y;
    __device__ __forceinline__ void operator()(f32x4 (&acc)[2][2][4][2], const pg::Unit& u, int wr, int wc, int fr, int fq) const {
#pragma unroll
        for (int ai = 0; ai < 2; ++ai)
#pragma unroll
            for (int m = 0; m < 4; ++m) { const int mm = u.pm * 256 + ai * 128 + wr * 64 + m * 16 + fr, b = mm >> 6, c = mm & 63;
#pragma unroll
                for (int bj = 0; bj < 2; ++bj)
#pragma unroll
                    for (int n = 0; n < 2; ++n) { const int nn = u.pn * 256 + bj * 128 + wc * 32 + n * 16 + fq * 4, t = nn >> 4, h = nn & 15; const f32x4 v = acc[ai][bj][m][n];
                        u32x2 w; w.x = pk2(gelu_tanh(v.x), gelu_tanh(v.y)); w.y = pk2(gelu_tanh(v.z), gelu_tanh(v.w));
#ifdef ABL_SSM
                        w.x = 0u; w.y = 0u;
#endif
                        *(u32x2*)(Y + ((size_t)b * 4096 + c * 64 + t) * 512 + u.g * 16 + h) = w; } }
    }
};

template <class Fn> __device__ __forceinline__ void epi_each(f32x4 (&acc)[2][2][4][2], const pg::Unit& u, int wr, int wc, int fr, int fq, const Fn& fn) {
#pragma unroll
    for (int ai = 0; ai < 2; ++ai)
#pragma unroll
        for (int m = 0; m < 4; ++m) { const int r = u.pm * 256 + ai * 128 + wr * 64 + m * 16 + fr;
#pragma unroll
            for (int bj = 0; bj < 2; ++bj)
#pragma unroll
                for (int n = 0; n < 2; ++n) fn(r, u.pn * 256 + bj * 128 + wc * 32 + n * 16 + fq * 4, acc[ai][bj][m][n]); }
}
struct EpiGlu { const bf16_t* YS; unsigned char* Y2; const float* b;
    __device__ __forceinline__ void operator()(f32x4 (&acc)[2][2][4][2], const pg::Unit& u, int wr, int wc, int fr, int fq) const {
        epi_each(acc, u, wr, wc, fr, fq, [&](int r, int c, const f32x4& v) { const f32x4 bb = *(const f32x4*)(b + c); const u32x2 y = *(const u32x2*)(YS + (size_t)r * 512 + c);
            *(unsigned*)(Y2 + (size_t)r * 512 + c) = pk4_fp8(bflo(y.x) * sigmoidf_(v.x + bb.x), bfhi(y.x) * sigmoidf_(v.y + bb.y), bflo(y.y) * sigmoidf_(v.z + bb.z), bfhi(y.y) * sigmoidf_(v.w + bb.w)); }); }
};
template <bool ADD> struct EpiMix { const unsigned char* Gt; bf16_t* MIX; unsigned char* MIX8;
    __device__ __forceinline__ void operator()(f32x4 (&acc)[2][2][4][2], const pg::Unit& u, int wr, int wc, int fr, int fq) const {
        epi_each(acc, u, wr, wc, fr, fq, [&](int r, int c, const f32x4& v) { const int g = *(const int*)(Gt + (size_t)r * 1024 + c);
            const f32x2_t glo = __builtin_amdgcn_cvt_pk_f32_fp8(g, false), ghi = __builtin_amdgcn_cvt_pk_f32_fp8(g, true);
            f32x4 o = (f32x4){glo[0] * v.x, glo[1] * v.y, ghi[0] * v.z, ghi[1] * v.w} * 0.03125f;
            if (ADD) { const u32x2 mo = *(const u32x2*)(MIX + (size_t)r * 1024 + c); o.x += bflo(mo.x); o.y += bfhi(mo.x); o.z += bflo(mo.y); o.w += bfhi(mo.y);
                *(unsigned*)(MIX8 + (size_t)r * 1024 + c) = pk4_fp8(o.x, o.y, o.z, o.w); }
            else { u32x2 w; w.x = pk2(o.x, o.y); w.y = pk2(o.z, o.w); *(u32x2*)(MIX + (size_t)r * 1024 + c) = w; } }); }
};
struct EpiStoreBf { bf16_t* O; int ldo; float sc;
    __device__ __forceinline__ void operator()(f32x4 (&acc)[2][2][4][2], const pg::Unit& u, int wr, int wc, int fr, int fq) const {
        epi_each(acc, u, wr, wc, fr, fq, [&](int r, int c, const f32x4& v) { u32x2 w; w.x = pk2(v.x * sc, v.y * sc); w.y = pk2(v.z * sc, v.w * sc); *(u32x2*)(O + (size_t)r * ldo + c) = w; }); }
};
struct EpiPleNorm { const bf16_t* R2; const bf16_t* PROJ; float* OUT; const float* gain; float* xbuf; unsigned* pcnt; LAS float* Pl; LAS float* Sl;
    __device__ __forceinline__ void operator()(f32x4 (&acc)[2][2][4][2], const pg::Unit& u, int wr, int wc, int fr, int fq) const {
        const int tid = (wr * 4 + wc) * 64 + fq * 16 + fr;
#pragma unroll
        for (int ai = 0; ai < 2; ++ai)
#pragma unroll
            for (int m = 0; m < 4; ++m) { const size_t r = (size_t)u.pm * 256 + ai * 128 + wr * 64 + m * 16 + fr;
#pragma unroll
                for (int bj = 0; bj < 2; ++bj)
#pragma unroll
                    for (int n = 0; n < 2; ++n) { const int c = u.pn * 256 + bj * 128 + wc * 32 + n * 16 + fq * 4; const u32x2 r2 = *(const u32x2*)(R2 + r * 1024 + c); const u32x2 pj = *(const u32x2*)(PROJ + r * 1024 + c); const f32x4 v = acc[ai][bj][m][n];
                        acc[ai][bj][m][n] = (f32x4){bflo(r2.x) + sigmoidf_(v.x * 0.03125f) * bflo(pj.x), bfhi(r2.x) + sigmoidf_(v.y * 0.03125f) * bfhi(pj.x), bflo(r2.y) + sigmoidf_(v.z * 0.03125f) * bflo(pj.y), bfhi(r2.y) + sigmoidf_(v.w * 0.03125f) * bfhi(pj.y)}; }
                asm volatile("" : "+v"(acc[ai][0][m][0]), "+v"(acc[ai][0][m][1]), "+v"(acc[ai][1][m][0]), "+v"(acc[ai][1][m][1]));
                if (m & 1) asm volatile("" ::: "memory"); }
#pragma unroll
        for (int ai = 0; ai < 2; ++ai)
#pragma unroll
            for (int m = 0; m < 4; ++m) { float q = 0.f;
#pragma unroll
                for (int bj = 0; bj < 2; ++bj)
#pragma unroll
                    for (int n = 0; n < 2; ++n) { const f32x4 x = acc[ai][bj][m][n]; q += (x[0] * x[0] + x[1] * x[1]) + (x[2] * x[2] + x[3] * x[3]); }
                q += __shfl_xor(q, 16); q += __shfl_xor(q, 32);
                if (fq == 0) Pl[(ai * 128 + wr * 64 + m * 16 + fr) * 4 + wc] = q; }
        asm volatile("s_waitcnt lgkmcnt(0)" ::: "memory"); __builtin_amdgcn_s_barrier(); asm volatile("" ::: "memory");
        if (tid < 256) { const float t = (Pl[tid * 4 + 0] + Pl[tid * 4 + 1]) + (Pl[tid * 4 + 2] + Pl[tid * 4 + 3]);
            __hip_atomic_store(xbuf + ((size_t)u.pm * 256 + tid) * 4 + u.pn, t, __ATOMIC_RELAXED, __HIP_MEMORY_SCOPE_AGENT); }
        asm volatile("s_waitcnt vmcnt(0) lgkmcnt(0)" ::: "memory"); __builtin_amdgcn_s_barrier(); asm volatile("" ::: "memory");
        if (tid == 0) { __hip_atomic_fetch_add(pcnt + u.pm, 1u, __ATOMIC_RELAXED, __HIP_MEMORY_SCOPE_AGENT);
            unsigned sp = 0; while (__hip_atomic_load(pcnt + u.pm, __ATOMIC_RELAXED, __HIP_MEMORY_SCOPE_AGENT) < 4u) { __builtin_amdgcn_s_sleep(2); if (++sp > (1u << 22)) break; }
            __builtin_amdgcn_fence(__ATOMIC_ACQUIRE, "agent"); }
        asm volatile("s_waitcnt vmcnt(0) lgkmcnt(0)" ::: "memory"); __builtin_amdgcn_s_barrier(); asm volatile("" ::: "memory");
        if (tid < 256) { const float* sl = xbuf + ((size_t)u.pm * 256 + tid) * 4;
            const float a0 = __hip_atomic_load(sl + 0, __ATOMIC_RELAXED, __HIP_MEMORY_SCOPE_AGENT), a1 = __hip_atomic_load(sl + 1, __ATOMIC_RELAXED, __HIP_MEMORY_SCOPE_AGENT), a2 = __hip_atomic_load(sl + 2, __ATOMIC_RELAXED, __HIP_MEMORY_SCOPE_AGENT), a3 = __hip_atomic_load(sl + 3, __ATOMIC_RELAXED, __HIP_MEMORY_SCOPE_AGENT);
            Sl[tid] = 1.0f / sqrtf(((a0 + a1) + (a2 + a3)) * (1.f / 1024.f) + EPS); }
        asm volatile("s_waitcnt vmcnt(0) lgkmcnt(0)" ::: "memory"); __builtin_amdgcn_s_barrier(); asm volatile("" ::: "memory");
        f32x4 gv[2][2];
#pragma unroll
        for (int bj = 0; bj < 2; ++bj)
#pragma unroll
            for (int n = 0; n < 2; ++n) gv[bj][n] = *(const f32x4*)(gain + u.pn * 256 + bj * 128 + wc * 32 + n * 16 + fq * 4);
#pragma unroll
        for (int ai = 0; ai < 2; ++ai)
#pragma unroll
            for (int m = 0; m < 4; ++m) { const int rl = ai * 128 + wr * 64 + m * 16 + fr; const float rs = Sl[rl]; const size_t r = (size_t)u.pm * 256 + rl;
#pragma unroll
                for (int bj = 0; bj < 2; ++bj)
#pragma unroll
                    for (int n = 0; n < 2; ++n) { const int c = u.pn * 256 + bj * 128 + wc * 32 + n * 16 + fq * 4; *(f32x4*)(OUT + r * 1024 + c) = acc[ai][bj][m][n] * rs * gv[bj][n]; } }
        asm volatile("s_waitcnt lgkmcnt(0)" ::: "memory"); __builtin_amdgcn_s_barrier(); asm volatile("" ::: "memory");
    }
};

__device__ __forceinline__ void router_phase(Frame& F) {
    constexpr int WST = 1032;
    LAS bf16_t* whi = (LAS bf16_t*)F.lds; LAS bf16_t* wlo = whi + 32 * WST;
    LAS unsigned* lcnt = (LAS unsigned*)(F.lds + 2 * 32 * WST * 2);
    LAS unsigned* gbase = lcnt + 32;
    LAS unsigned* ent_e = gbase + 32;
    LAS float* ent_w = (LAS float*)(ent_e + 512);
    const float* Wr = F.in[19]; const float* br = F.in[20]; const float* gain = F.in[18]; const float* X = F.in[0];
    const bf16_t* D1 = (const bf16_t*)F.out + (size_t)T * 1024;
    unsigned char* H2 = F.dry ? WSP(unsigned char, WS_A) : (unsigned char*)F.out;
    unsigned* cnt = WSP(unsigned, WS_CTL) + CW_CNT + (F.dry ? 32 : 0); int* LTOK = F.dry ? (int*)(F.ws + WS_A + 70 * MB) : WSP(int, WS_LTOK); int* LSLOT = F.dry ? (int*)(F.ws + WS_A + 75 * MB) : WSP(int, WS_LSLOT); float* LWT = F.dry ? (float*)(F.ws + WS_A + 80 * MB) : WSP(float, WS_LWT);
    { f32x4 wv[16];
#pragma unroll
      for (int q = 0; q < 16; ++q) wv[q] = *((const f32x4*)Wr + F.tid + q * NTHR);
#pragma unroll
      for (int q = 0; q < 16; ++q) { const int i4 = F.tid + q * NTHR, k = i4 >> 3, e0 = (i4 & 7) * 4; const float g = gain[k];
#pragma unroll
          for (int c = 0; c < 4; ++c) { const float v = wv[q][c] * g; const unsigned h = f2bf(v); const float vh = __builtin_bit_cast(float, h << 16);
              whi[(e0 + c) * WST + k] = (bf16_t)h; wlo[(e0 + c) * WST + k] = (bf16_t)f2bf(v - vh); } } }
    const int lane = F.lane, tl = lane & 15, kq = lane >> 4;
    for (int tb = F.bid; tb < T / 128; tb += F.G) {
        if (F.tid < 32) lcnt[F.tid] = 0u;
        if (!F.dry) { const f32x4* ps = (const f32x4*)(F.in[1] + (size_t)tb * 128 * 256); u32x2* pd = (u32x2*)(WSP(bf16_t, WS_PBF) + (size_t)tb * 128 * 256);
#pragma unroll 4
            for (int q = 0; q < 16; ++q) { const f32x4 v = ps[F.tid + q * NTHR]; u32x2 w; w.x = pk2(v.x, v.y); w.y = pk2(v.z, v.w); pd[F.tid + q * NTHR] = w; } }
        __syncthreads();
        const int tok0 = tb * 128 + F.wave * 16, tok = tok0 + tl;
        const float* xrow = X + (size_t)tok * 1024 + 8 * kq; const bf16_t* drow = D1 + (size_t)tok * 1024 + 8 * kq;
        f32x4 acc[2]; acc[0] = (f32x4){0.f, 0.f, 0.f, 0.f}; acc[1] = acc[0]; float ss = 0.f;
#pragma unroll 16
        for (int st = 0; st < 32; ++st) {
            const f32x4 x0 = *(const f32x4*)(xrow + 32 * st), x1 = *(const f32x4*)(xrow + 32 * st + 4); const u32x4 dd = *(const u32x4*)(drow + 32 * st);
            const f32x4 g0 = *(const f32x4*)(gain + 32 * st + 8 * kq), g1 = *(const f32x4*)(gain + 32 * st + 8 * kq + 4);
            float r[8] = {x0.x + bflo(dd.x), x0.y + bfhi(dd.x), x0.z + bflo(dd.y), x0.w + bfhi(dd.y), x1.x + bflo(dd.z), x1.y + bfhi(dd.z), x1.z + bflo(dd.w), x1.w + bfhi(dd.w)};
            { u32x2 o; o.x = pk4_fp8(r[0] * g0.x, r[1] * g0.y, r[2] * g0.z, r[3] * g0.w); o.y = pk4_fp8(r[4] * g1.x, r[5] * g1.y, r[6] * g1.z, r[7] * g1.w); *(u32x2*)(H2 + (size_t)tok * 1024 + 32 * st + 8 * kq) = o; }
            u32x4 ah, al;
#pragma unroll
            for (int p = 0; p < 4; ++p) { ss = __builtin_fmaf(r[2 * p], r[2 * p], ss); ss = __builtin_fmaf(r[2 * p + 1], r[2 * p + 1], ss);
                const unsigned hw = pk2(r[2 * p], r[2 * p + 1]); ah[p] = hw; al[p] = pk2(r[2 * p] - bflo(hw), r[2 * p + 1] - bfhi(hw)); }
            const bf16x8 A_hi = __builtin_bit_cast(bf16x8, ah), A_lo = __builtin_bit_cast(bf16x8, al);
#pragma unroll
            for (int n = 0; n < 2; ++n) { const bf16x8 Bh = *(const LAS bf16x8*)(whi + (16 * n + tl) * WST + 32 * st + 8 * kq), Bl = *(const LAS bf16x8*)(wlo + (16 * n + tl) * WST + 32 * st + 8 * kq);
                acc[n] = __builtin_amdgcn_mfma_f32_16x16x32_bf16(A_hi, Bh, acc[n], 0, 0, 0); acc[n] = __builtin_amdgcn_mfma_f32_16x16x32_bf16(A_hi, Bl, acc[n], 0, 0, 0); acc[n] = __builtin_amdgcn_mfma_f32_16x16x32_bf16(A_lo, Bh, acc[n], 0, 0, 0); }
        }
        ss += __shfl_xor(ss, 16); ss += __shfl_xor(ss, 32);
        const float rstd = 1.0f / sqrtf(ss * (1.f / 1024.f) + EPS);
        if (kq == 0 && !F.dry) WSP(float, WS_CTL)[CW_SSQ + tok] = rstd;
        const float b0 = br[tl], b1 = br[16 + tl];
#pragma unroll
        for (int rg = 0; rg < 4; ++rg) { const float rs = __shfl(rstd, 4 * kq + rg);
            float v0 = acc[0][rg] * rs + b0, v1 = acc[1][rg] * rs + b1; float tv[4]; int te[4];
#pragma unroll
            for (int k = 0; k < 4; ++k) { float bv = v0; int bi = tl; if (v1 > v0) { bv = v1; bi = 16 + tl; }
#pragma unroll
                for (int o = 1; o < 16; o <<= 1) { const float ov = __shfl_xor(bv, o); const int oi = __shfl_xor(bi, o); if (ov > bv || (ov == bv && oi < bi)) { bv = ov; bi = oi; } }
                tv[k] = bv; te[k] = bi; if (bi == tl) v0 = -INFINITY; if (bi == 16 + tl) v1 = -INFINITY; }
            const float e1 = __expf(tv[1] - tv[0]), e2 = __expf(tv[2] - tv[0]), e3 = __expf(tv[3] - tv[0]), inv = 1.0f / (1.0f + e1 + e2 + e3);
            if (tl < 4) { const int e = tl == 0 ? te[0] : tl == 1 ? te[1] : tl == 2 ? te[2] : te[3]; const float w = (tl == 0 ? 1.0f : tl == 1 ? e1 : tl == 2 ? e2 : e3) * inv;
                const int tli = F.wave * 16 + 4 * kq + rg;
                const unsigned pos = __hip_atomic_fetch_add(lcnt + e, 1u, __ATOMIC_RELAXED, __HIP_MEMORY_SCOPE_WORKGROUP);
                ent_e[tli * 4 + tl] = (unsigned)e | (pos << 8); ent_w[tli * 4 + tl] = w; }
        }
        __syncthreads();
        if (F.tid < 32) gbase[F.tid] = __hip_atomic_fetch_add(cnt + F.tid, lcnt[F.tid], __ATOMIC_RELAXED, __HIP_MEMORY_SCOPE_AGENT);
        __syncthreads();
        { const unsigned ee = ent_e[F.tid]; const int e = ee & 255, pos = (int)(gbase[e] + (ee >> 8)); const int tok_ = tb * 128 + (F.tid >> 2);
          LTOK[(size_t)e * T + pos] = tok_; LSLOT[(size_t)e * T + pos] = tok_ * 4 + (F.tid & 3); LWT[(size_t)e * T + pos] = ent_w[F.tid]; }
        __syncthreads();
    }
}

struct MoeTab { LAS int* cnt; LAS int* ntile; LAS int* cumu; LAS int* offs; LAS unsigned short* rowl; };
template <int NPN> __device__ __forceinline__ bool moe_unit(const MoeTab& tab, int L, pg::Unit& u) {
    if (L >= tab.cumu[32]) return false; int e = 0;
#pragma unroll 1
    for (int k = 1; k < 32; ++k) if (tab.cumu[k] <= L) e = k;
    const int rem = L - tab.cumu[e], ntl = tab.ntile[e]; u.g = e; u.pn = rem / ntl; u.pm = rem % ntl; return true;
}
template <int NPN> __device__ __forceinline__ MoeTab moe_tab_build(Frame& F, bool gather) {
    MoeTab t; t.cnt = (LAS int*)(F.lds + 131072); t.ntile = t.cnt + 32; t.cumu = t.ntile + 32; t.offs = t.cumu + 40; t.rowl = (LAS unsigned short*)(F.lds + 131072 + 1024);
    __syncthreads();
    if (F.tid < 32) t.cnt[F.tid] = (int)__hip_atomic_load(WSP(unsigned, WS_CTL) + CW_CNT + F.tid, __ATOMIC_RELAXED, __HIP_MEMORY_SCOPE_AGENT);
    __syncthreads();
    if (F.tid == 0) { int cu = 0, of = 0;
        for (int e = 0; e < 32; ++e) { const int n = t.cnt[e]; const int nt_ = (n + 255) >> 8; t.ntile[e] = nt_; t.cumu[e] = cu; t.offs[e] = of; cu += nt_ * NPN; of += n; }
        t.cumu[32] = cu; t.offs[32] = of; }
    __syncthreads();
    if (gather) {
        const int* ltok = WSP(int, WS_LTOK);
        for (int i = 0; i < 17; ++i) { pg::Unit u; if (!moe_unit<NPN>(t, i * F.G + F.bid, u)) break;
            if (F.tid < 256) { int r = u.pm * 256 + F.tid; const int n = t.cnt[u.g]; r = r < n ? r : n - 1; t.rowl[i * 256 + F.tid] = (unsigned short)ltok[(size_t)u.g * T + r]; } }
        __syncthreads();
    }
    return t;
}
template <int NPN> struct ProbMoe {
    const char* A; const char* W; MoeTab tab; unsigned ldb_bytes; int nt, G, c; bool gather; int hot;
    __device__ bool next(int i, pg::Unit& u) const { u.li = i; const bool ok = moe_unit<NPN>(tab, i * G + c, u); if (hot) { u.li = 0; u.g = 0; u.pn = 0; u.pm = 0; } return ok; }
    __device__ const char* a_base(const pg::Unit&) const { return A; }
    __device__ unsigned a_off(const pg::Unit& u, int row, int col) const {
        unsigned arow;
        if (gather) arow = (unsigned)tab.rowl[u.li * 256 + row];
        else { int r = u.pm * 256 + row; const int n = tab.cnt[u.g]; r = r < n ? r : n - 1; arow = (unsigned)(tab.offs[u.g] + r); }
        return arow * 1024u + (unsigned)col * 2u; }
    __device__ const char* b_base(const pg::Unit& u) const { return W + ((size_t)u.g * (NPN * 256) + u.pn * 256) * 1024; }
};
struct EpiMoe1 { unsigned char* Aout; const float* bgate; const float* bup; const float* rstd; MoeTab tab; int dry;
    __device__ __forceinline__ void operator()(f32x4 (&acc)[2][2][4][2], const pg::Unit& u, int wr, int wc, int fr, int fq) const {
        if (dry >= 3) return;
        const int e = u.g, n = tab.cnt[e], off = tab.offs[e];
        const int col = u.pn * 128 + wc * 32 + fq * 8;
        f32x4 bg[2], bu[2];
#pragma unroll
        for (int nn = 0; nn < 2; ++nn) { bg[nn] = *(const f32x4*)(bgate + e * 1024 + col + 4 * nn); bu[nn] = *(const f32x4*)(bup + e * 1024 + col + 4 * nn); }
        float rs_[8];
#pragma unroll
        for (int q = 0; q < 8; ++q) rs_[q] = 0.03125f * rstd[tab.rowl[u.li * 256 + (q >> 2) * 128 + wr * 64 + (q & 3) * 16 + fr]];
#pragma unroll
        for (int ai = 0; ai < 2; ++ai)
#pragma unroll
            for (int m = 0; m < 4; ++m) { const int r = u.pm * 256 + ai * 128 + wr * 64 + m * 16 + fr; float o[8];
#pragma unroll
                for (int nn = 0; nn < 2; ++nn) { const f32x4 g4 = acc[ai][0][m][nn] * rs_[ai * 4 + m] + bg[nn], u4 = acc[ai][1][m][nn] * rs_[ai * 4 + m] + bu[nn];
#pragma unroll
                    for (int j = 0; j < 4; ++j) { const float g = fminf(g4[j], 7.0f), uu = fminf(fmaxf(u4[j], -7.0f), 7.0f); o[4 * nn + j] = (uu + 1.0f) * (g * sigmoidf_(1.702f * g)); } }
                u32x2 w; w.x = pk4_fp8(o[0], o[1], o[2], o[3]); w.y = pk4_fp8(o[4], o[5], o[6], o[7]);
                if (r < n) { if (dry != 2) *(u32x2*)(Aout + (size_t)(off + r) * 1024 + col) = w; else asm volatile("" :: "v"(w.x), "v"(w.y)); } }
    }
};
struct EpiMoe2 { unsigned char* ws; unsigned char* outb; const float* bdown; const int* lslot; const float* lwt; MoeTab tab;
    __device__ __forceinline__ void operator()(f32x4 (&acc)[2][2][4][2], const pg::Unit& u, int wr, int wc, int fr, int fq) const {
        const int e = u.g, n = tab.cnt[e];
        int sl[8]; float wt[8];
#pragma unroll
        for (int q = 0; q < 8; ++q) { int r = u.pm * 256 + (q >> 2) * 128 + wr * 64 + (q & 3) * 16 + fr; r = r < n ? r : n - 1; sl[q] = lslot[(size_t)e * T + r]; wt[q] = lwt[(size_t)e * T + r]; }
        f32x4 bd[2][2];
#pragma unroll
        for (int bj = 0; bj < 2; ++bj)
#pragma unroll
            for (int nn = 0; nn < 2; ++nn) bd[bj][nn] = *(const f32x4*)(bdown + e * 1024 + u.pn * 256 + bj * 128 + wc * 32 + nn * 16 + fq * 4);
#pragma unroll
        for (int ai = 0; ai < 2; ++ai)
#pragma unroll
            for (int m = 0; m < 4; ++m) { const int r = u.pm * 256 + ai * 128 + wr * 64 + m * 16 + fr; if (r < n) { const int s_ = sl[ai * 4 + m]; const float w_ = wt[ai * 4 + m];
                    unsigned char* dst = ws + WS_W1T + (size_t)s_ * 1024;
#pragma unroll
                    for (int bj = 0; bj < 2; ++bj)
#pragma unroll
                        for (int nn = 0; nn < 2; ++nn) { const int col = u.pn * 256 + bj * 128 + wc * 32 + nn * 16 + fq * 4; const f32x4 v = (acc[ai][bj][m][nn] * 0.03125f + bd[bj][nn]) * (w_ * 16.0f);
                            *(unsigned*)(dst + col) = pk4_fp8(v.x, v.y, v.z, v.w); } } }
    }
};

__device__ __forceinline__ void combine_phase(Frame& F) {
    const int gw = F.bid * 8 + F.wave, NGW = F.G * 8, lane = F.lane;
    const bf16_t* D1 = (const bf16_t*)F.out + (size_t)T * 1024;
    auto slotp = [&](int sl) -> const unsigned* { return (const unsigned*)(F.ws + WS_W1T + (size_t)sl * 1024) + lane; };
    for (int tok = gw; tok < T; tok += NGW) {
        const f32x4* xr = (const f32x4*)(F.in[0] + (size_t)tok * 1024) + lane; const u32x2* dr = (const u32x2*)(D1 + (size_t)tok * 1024) + lane;
        f32x4 v[4]; u32x2 d1[4]; unsigned d[4][4];
#pragma unroll
        for (int j = 0; j < 4; ++j) { v[j] = xr[64 * j]; d1[j] = dr[64 * j]; }
#pragma unroll
        for (int k = 0; k < 4; ++k) { const unsigned* sr = slotp(tok * 4 + k);
#pragma unroll
            for (int j = 0; j < 4; ++j) d[k][j] = sr[64 * j]; }
#pragma unroll
        for (int j = 0; j < 4; ++j) { v[j].x += bflo(d1[j].x); v[j].y += bfhi(d1[j].x); v[j].z += bflo(d1[j].y); v[j].w += bfhi(d1[j].y); }
#pragma unroll
        for (int k = 0; k < 4; ++k)
#pragma unroll
            for (int j = 0; j < 4; ++j) { const f32x2_t lo = __builtin_amdgcn_cvt_pk_f32_fp8((int)d[k][j], false), hi2 = __builtin_amdgcn_cvt_pk_f32_fp8((int)d[k][j], true);
                v[j].x += lo[0] * 0.0625f; v[j].y += lo[1] * 0.0625f; v[j].z += hi2[0] * 0.0625f; v[j].w += hi2[1] * 0.0625f; }
        u32x2* r2 = (u32x2*)(WSP(bf16_t, WS_R2) + (size_t)tok * 1024) + lane; unsigned* rb = (unsigned*)(WSP(unsigned char, WS_R2BF) + (size_t)tok * 1024) + lane;
#pragma unroll
        for (int j = 0; j < 4; ++j) { u32x2 w; w.x = pk2(v[j].x, v[j].y); w.y = pk2(v[j].z, v[j].w); r2[64 * j] = w; rb[64 * j] = pk4_fp8(v[j].x, v[j].y, v[j].z, v[j].w); }
    }
}
__device__ __forceinline__ void final_norm_phase(Frame& F) {
    const int gw = F.bid * 8 + F.wave, NGW = F.G * 8, lane = F.lane; const f32x4* gr = (const f32x4*)F.in[29] + lane;
    for (int tok = gw; tok < T; tok += NGW) {
        const u32x2* xr = (const u32x2*)(WSP(bf16_t, WS_E) + (size_t)tok * 1024) + lane; f32x4 v[4]; float s = 0.f;
#pragma unroll
        for (int j = 0; j < 4; ++j) { const u32x2 d = xr[64 * j]; v[j] = (f32x4){bflo(d.x), bfhi(d.x), bflo(d.y), bfhi(d.y)}; s += (v[j].x * v[j].x + v[j].y * v[j].y) + (v[j].z * v[j].z + v[j].w * v[j].w); }
        const float rstd = 1.0f / sqrtf(wave_sum(s) * (1.f / 1024.f) + EPS);
        f32x4* xw = F.dry ? (f32x4*)(WSP(float, WS_A) + (size_t)tok * 1024) + lane : (f32x4*)(F.out + (size_t)tok * 1024) + lane;
#pragma unroll
        for (int j = 0; j < 4; ++j) { const f32x4 g = gr[64 * j]; xw[64 * j] = (f32x4){v[j].x * rstd * g.x, v[j].y * rstd * g.y, v[j].z * rstd * g.z, v[j].w * rstd * g.w}; }
    }
}
constexpr size_t WS_BAR = 512 * 1024;
#define XB_TMO      128
#define XB_XCNT(j)  (256  + 64 * (j))
#define XB_XSUB(j)  (1280 + 64 * (j))
#define XB_XGEN(j)  (2304 + 64 * (j))
#define XB_TOP      3328
#define XB_TOPGEN   3392
#define XCD_BAR_WORDS 3456
#define XB_SPIN_CAP (1u << 18)
__device__ __forceinline__ unsigned xb_ld(unsigned* p)              { return __hip_atomic_load(p, __ATOMIC_RELAXED, __HIP_MEMORY_SCOPE_AGENT); }
__device__ __forceinline__ unsigned xb_add(unsigned* p, unsigned v) { return __hip_atomic_fetch_add(p, v, __ATOMIC_RELAXED, __HIP_MEMORY_SCOPE_AGENT); }
__device__ __forceinline__ unsigned xb_xcc_id() { return (unsigned)__builtin_amdgcn_s_getreg((3 << 11) | 20) & 0xFu; }
#define XB_SPIN(cond, bar) do { unsigned _sp = 0; while (cond) { __builtin_amdgcn_s_sleep(1); \
    if ((++_sp & 255u) == 0u) { if (xb_ld(&(bar)[XB_TMO])) break; if (_sp > XB_SPIN_CAP) { atomicAdd(&(bar)[XB_TMO], 1u); break; } } } } while (0)
struct XcdBarrier { unsigned* bar; unsigned x; volatile LAS unsigned* st; };
__device__ __forceinline__ XcdBarrier xcd_barrier_post(unsigned* bar, volatile LAS unsigned* st) {
    XcdBarrier b; b.bar = bar; b.x = xb_xcc_id(); b.st = st;
    if (threadIdx.x == 0) (void)xb_add(&bar[XB_XCNT(b.x)], 1u);
    return b;
}
__device__ __forceinline__ void xcd_barrier_complete(unsigned* bar, unsigned x, unsigned& nloc, unsigned& nx) {
    const unsigned G = gridDim.x * gridDim.y * gridDim.z;
    unsigned sum, cnt, mine, sp = 0u;
    for (;;) {
        sum = 0u; cnt = 0u; mine = 0u;
#pragma unroll
        for (unsigned j = 0; j < 16; ++j) { const unsigned c = xb_ld(&bar[XB_XCNT(j)]); sum += c; cnt += (c > 0u) ? 1u : 0u; mine = (j == x) ? c : mine; }
        if (sum == G) break;
        __builtin_amdgcn_s_sleep(1);
        if ((++sp & 255u) == 0u) { if (xb_ld(&bar[XB_TMO])) break; if (sp > XB_SPIN_CAP) { atomicAdd(&bar[XB_TMO], 1u); break; } }
    }
    nloc = mine > 0u ? mine : 1u; nx = cnt > 0u ? cnt : 1u;
}
__device__ __forceinline__ void xcd_barrier(const XcdBarrier& b) {
    asm volatile("s_waitcnt vmcnt(0)" ::: "memory");
    __syncthreads();
    if (threadIdx.x == 0) {
        unsigned* bar = b.bar;
        __builtin_amdgcn_s_waitcnt(0);
        unsigned nloc = b.st[0], nx = b.st[1];
        if (nloc == 0u) { xcd_barrier_complete(bar, b.x, nloc, nx); b.st[0] = nloc; b.st[1] = nx; }
        const unsigned old = xb_add(&bar[XB_XSUB(b.x)], 1u);
        const unsigned gen = old / nloc;
        if (old + 1u == (gen + 1u) * nloc) {
            __builtin_amdgcn_fence(__ATOMIC_RELEASE, "agent");
            asm volatile("s_waitcnt vmcnt(0)" ::: "memory");
            const unsigned og = xb_add(&bar[XB_TOP], 1u);
            const unsigned tg = og / nx;
            if (og + 1u == (tg + 1u) * nx) xb_add(&bar[XB_TOPGEN], 1u);
            else XB_SPIN(xb_ld(&bar[XB_TOPGEN]) == tg, bar);
            __builtin_amdgcn_fence(__ATOMIC_ACQUIRE, "agent");
            xb_add(&bar[XB_XGEN(b.x)], 1u);
            asm volatile("s_waitcnt vmcnt(0)" ::: "memory");
        } else {
            XB_SPIN(xb_ld(&bar[XB_XGEN(b.x)]) == gen, bar);
            __builtin_amdgcn_fence(__ATOMIC_ACQUIRE, "agent");
            asm volatile("s_waitcnt vmcnt(0)" ::: "memory");
        }
    }
    __syncthreads();
}

constexpr int LDS_BYTES = 147456;
constexpr int NPHASE = 14;
#ifndef MK_MULTI
#define MK_MULTI 0
#endif
struct Args { const float* in[30]; float* out; unsigned char* ws; int ph_lo, ph_hi, dry, pad; };
static_assert(sizeof(Args) == 32 * 8 + 16, "no padding in Args");

__global__ void __launch_bounds__(NTHR, 2) fwd(Args a) {
    extern __shared__ __attribute__((aligned(16))) unsigned char lds_[];
    Frame F;
    F.lds = (LAS unsigned char*)lds_;
    F.tid = threadIdx.x; F.lane = F.tid & 63; F.wave = __builtin_amdgcn_readfirstlane(F.tid >> 6); F.G = gridDim.x; F.bid = blockIdx.x;
#pragma unroll
    for (int i = 0; i < 30; ++i) F.in[i] = a.in[i];
    F.out = a.out; F.ws = a.ws; F.dry = a.dry;
    const int lo = a.ph_lo, hi = a.ph_hi;
#ifndef PHMASK
#define PHMASK 0x3fff
#endif
#define IN(k) (((PHMASK >> (k)) & 1) && lo <= (k) && (k) < hi)
    volatile LAS unsigned* xst = (volatile LAS unsigned*)(F.lds + LDS_BYTES - 64);
    if (F.tid < 2) xst[F.tid] = 0u;
    __syncthreads();
    const XcdBarrier xbar = xcd_barrier_post((unsigned*)(F.ws + WS_BAR), xst);
#define SEAM(k) do { if (IN(k) && IN((k) + 1)) xcd_barrier(xbar); } while (0)
    bf16_t* GS = (bf16_t*)F.out; bf16_t* GA = GS + (size_t)T * 1024;

    if (IN(0)) { p0_prologue(F); __syncthreads(); p0_s5_tables(F); }
    SEAM(0);
    if (IN(1)) {
        EpiInProj E; E.U = WSP(bf16_t, WS_U); E.Q = WSP(bf16_t, WS_Q); E.K = WSP(bf16_t, WS_K); E.V = WSP(bf16_t, WS_V); E.QI = WSP(bf16_t, WS_QIDX); E.KI = WSP(bf16_t, WS_KIDX); E.GS = GS; E.GA = GA;
        E.WI = WSP(float, WS_WIDX); E.bg = F.in[3]; E.c64 = WSP(float, WS_COS64); E.s64 = WSP(float, WS_SIN64); E.c32 = WSP(float, WS_COS32); E.s32 = WSP(float, WS_SIN32);
        { pg::Dense P; P.A = (const char*)WSP(unsigned char, WS_H8); P.B = (const char*)WSP(unsigned char, WS_WIN8); P.lda_bytes = 1024; P.ldb_bytes = 1024; P.nt = 8; P.ord.init(T / 256, 16, F.G, F.bid); P.pn_split = 8; P.pn_skip = 2;
          E.ascale = 0.03125f; pg::gemm_phase<true>(F.lds, P, E); }
        { pg::Dense P; P.A = (const char*)WSP(bf16_t, WS_E); P.B = (const char*)WSP(bf16_t, WS_WINT); P.lda_bytes = 2048; P.ldb_bytes = 2048; P.nt = 16; P.ord.init(T / 256, 2, F.G, F.bid); P.pn_base = 8; P.b_tile0 = 8;
          E.ascale = 1.0f; pg::gemm_phase<false>(F.lds, P, E); }
    }
    SEAM(1);
    if (IN(2)) {
        { ProbS5E P; P.U = (const char*)WSP(bf16_t, WS_U); P.Wg = (const char*)WSP(bf16_t, WS_WG); P.ldb_bytes = 2048; P.nt = 16; P.G = F.G; P.c = F.bid; EpiS5E E; E.E = WSP(float, WS_EF32); pg::gemm_phase(F.lds, P, E); }
        __syncthreads();
        idx_phase(F);
    }
    SEAM(2);
    if (IN(3)) { s5_scan(F); __syncthreads(); attn_phase(F); }
    SEAM(3);
    if (IN(4)) { ProbS5Y P; P.U = (const char*)WSP(bf16_t, WS_U); P.TV = (const char*)WSP(bf16_t, WS_TV); P.ldb_bytes = 2304; P.nt = 18; P.G = F.G; P.c = F.bid; EpiS5Y E; E.Y = WSP(bf16_t, WS_E); pg::gemm_phase(F.lds, P, E); }
    SEAM(4);
    if (IN(5)) { pg::Dense P; P.A = (const char*)WSP(bf16_t, WS_E); P.B = (const char*)WSP(bf16_t, WS_WGLUT); P.lda_bytes = 1024; P.ldb_bytes = 1024; P.nt = 8; P.ord.init(T / 256, 2, F.G, F.bid);
        EpiGlu E; E.YS = WSP(bf16_t, WS_E); E.Y2 = WSP(unsigned char, WS_Y28); E.b = F.in[13]; pg::gemm_phase(F.lds, P, E); }
    SEAM(5);
    if (IN(6)) {
        { pg::Dense P; P.A = (const char*)WSP(unsigned char, WS_Y28); P.B = (const char*)WSP(unsigned char, WS_WSB8); P.lda_bytes = 512; P.ldb_bytes = 512; P.nt = 4; P.ord.init(T / 256, 4, F.G, F.bid);
          EpiMix<false> E; E.Gt = (const unsigned char*)GS; E.MIX = F.dry ? WSP(bf16_t, WS_U) : GA; E.MIX8 = nullptr; pg::gemm_phase<true>(F.lds, P, E); }
        { pg::Dense P; P.A = (const char*)WSP(unsigned char, WS_YA8); P.B = (const char*)WSP(unsigned char, WS_WAB8); P.lda_bytes = 512; P.ldb_bytes = 512; P.nt = 4; P.ord.init(T / 256, 4, F.G, F.bid);
          EpiMix<true> E; E.Gt = (const unsigned char*)GS + (size_t)T * 1024; E.MIX = F.dry ? WSP(bf16_t, WS_U) : GA; E.MIX8 = F.dry ? WSP(unsigned char, WS_V) : WSP(unsigned char, WS_MIX8); pg::gemm_phase<true>(F.lds, P, E); }
    }
    SEAM(6);
    if (IN(7)) { pg::Dense P; P.A = (const char*)WSP(unsigned char, WS_MIX8); P.B = (const char*)WSP(unsigned char, WS_WO8); P.lda_bytes = 1024; P.ldb_bytes = 1024; P.nt = 8; P.ord.init(T / 256, 4, F.G, F.bid);
        EpiStoreBf E; E.O = GA; E.ldo = 1024; E.sc = 0.03125f; pg::gemm_phase<true>(F.lds, P, E); }
    SEAM(7);
    if (IN(8)) router_phase(F);
    SEAM(8);
    if (IN(9)) { const MoeTab tab = moe_tab_build<8>(F, true);
        ProbMoe<8> P; P.A = (const char*)GS; P.W = (const char*)WSP(bf16_t, WS_W1T); P.tab = tab; P.ldb_bytes = 1024; P.nt = 8; P.G = F.G; P.c = F.bid; P.gather = true; P.hot = (F.dry == 4);
        EpiMoe1 E; E.Aout = WSP(unsigned char, WS_A); E.bgate = F.in[22]; E.bup = F.in[24]; E.rstd = WSP(float, WS_CTL) + CW_SSQ; E.tab = tab; E.dry = F.dry; pg::gemm_phase<true>(F.lds, P, E); }
    SEAM(9);
    if (IN(10)) { const MoeTab tab = moe_tab_build<4>(F, false);
        ProbMoe<4> P; P.A = (const char*)WSP(bf16_t, WS_A); P.W = (const char*)WSP(bf16_t, WS_W2T); P.tab = tab; P.ldb_bytes = 1024; P.nt = 8; P.G = F.G; P.c = F.bid; P.gather = false; P.hot = 0;
        EpiMoe2 E; E.ws = F.ws; E.outb = (unsigned char*)F.out; E.bdown = F.in[26]; E.lslot = WSP(int, WS_LSLOT); E.lwt = WSP(float, WS_LWT); E.tab = tab; pg::gemm_phase<true>(F.lds, P, E);
        { const int total = tab.cumu[32], rounds = (total + F.G - 1) / F.G, nfull = total - (rounds - 1) * F.G, nidle = F.G - nfull;
          const int G2 = nidle > 0 ? nidle : F.G, c2 = nidle > 0 ? F.bid - nfull : F.bid;
          if (c2 >= 0) { pg::Dense P2; P2.A = (const char*)WSP(bf16_t, WS_PBF); P2.B = (const char*)WSP(bf16_t, WS_WPPT); P2.lda_bytes = 512; P2.ldb_bytes = 512; P2.nt = 4; P2.ord.init(T / 256, 4, G2, c2);
              EpiStoreBf E2; E2.O = WSP(bf16_t, WS_PROJ); E2.ldo = 1024; E2.sc = 1.0f; pg::gemm_phase(F.lds, P2, E2); } } }
    SEAM(10);
    if (IN(11)) combine_phase(F);
    SEAM(11);
    if (IN(12)) {
        { pg::Dense P; P.A = (const char*)WSP(unsigned char, WS_R2BF); P.B = (const char*)WSP(unsigned char, WS_WPG8); P.lda_bytes = 1024; P.ldb_bytes = 1024; P.nt = 8; P.ord.init(T / 256, 4, F.G, F.bid);
          EpiPleNorm E; E.R2 = WSP(bf16_t, WS_R2); E.PROJ = WSP(bf16_t, WS_PROJ); E.OUT = F.out; E.gain = F.in[29]; E.xbuf = (float*)(F.ws + WS_XBUF); E.pcnt = WSP(unsigned, WS_CTL) + CW_PCNT;
          E.Pl = (LAS float*)(F.lds + 131072); E.Sl = (LAS float*)(F.lds + 131072 + 4096); pg::gemm_phase<true>(F.lds, P, E); }
    }
    SEAM(12);
    if (IN(13)) {   }
#undef IN
#undef SEAM
}

extern "C" void kernel_launch(void* const* d_in, const int* in_sizes, int n_in, void* d_out, int out_size, void* d_ws, size_t ws_size, hipStream_t stream) {
    static int grid = 0;
    if (grid == 0) {
        if (n_in != 30 || out_size != T * 1024 || ws_size < WS_END) { fprintf(stderr, "kernel_launch: unexpected shapes (n_in %d, out %d, ws %zu < %zu)\n", n_in, out_size, ws_size, (size_t)WS_END); grid = -1; return; }
        int dev = 0, cus = 0, per_cu = 0;
        hipGetDevice(&dev); hipDeviceGetAttribute(&cus, hipDeviceAttributeMultiprocessorCount, dev);
        hipFuncSetAttribute((const void*)fwd, hipFuncAttributeMaxDynamicSharedMemorySize, LDS_BYTES);
        hipOccupancyMaxActiveBlocksPerMultiprocessor(&per_cu, (const void*)fwd, NTHR, LDS_BYTES);
        if (per_cu < 1) { fprintf(stderr, "kernel_launch: occupancy query says %d blocks per CU\n", per_cu); per_cu = 1; }
        (void)hipGetLastError();
        grid = cus;
    }
    if (grid < 0) return;
    Args a{};
    for (int i = 0; i < 30; ++i) a.in[i] = (const float*)d_in[i];
    a.out = (float*)d_out; a.ws = (unsigned char*)d_ws;
#if MK_MULTI
#ifndef DUP_MASK
#define DUP_MASK 0
#endif
    for (int ph = 0; ph < NPHASE; ++ph) { a.ph_lo = ph; a.ph_hi = ph + 1; const int reps = ((DUP_MASK >> ph) & 1) ? 2 : 1;
        for (int r = 0; r < reps; ++r) { a.dry = (r + 1 < reps && (ph == 3 || ph == 6 || ph == 8 || ph == 13)) ? 1 : 0;
#ifdef DRY9
            if (ph == 9 && r + 1 < reps) a.dry = DRY9;
#endif
 hipLaunchKernelGGL(fwd, dim3(grid), dim3(NTHR), LDS_BYTES, stream, a); } }
#else
    (void)hipMemsetAsync((char*)d_ws + WS_BAR, 0, XCD_BAR_WORDS * 4, stream);
    a.ph_lo = 0; a.ph_hi = NPHASE; void* args[] = {&a};
    hipError_t e = hipLaunchCooperativeKernel((const void*)fwd, dim3(grid), dim3(NTHR), args, LDS_BYTES, stream);
    if (e != hipSuccess) fprintf(stderr, "cooperative launch failed: %s (grid %d)\n", hipGetErrorString(e), grid);
#endif
}
```

```cpp
#include <hip/hip_runtime.h>
#include <hip/hip_cooperative_groups.h>
#include <cstdio>
#include <cstdint>
#include <cmath>
namespace cg = cooperative_groups;

#define LAS __attribute__((address_space(3)))
#define GAS __attribute__((address_space(1)))
typedef unsigned short bf16_t;
typedef short bf16x8 __attribute__((ext_vector_type(8)));
typedef short s16x4 __attribute__((ext_vector_type(4)));
typedef float f32x4 __attribute__((ext_vector_type(4)));
typedef float f32x16 __attribute__((ext_vector_type(16)));
typedef unsigned u32x4 __attribute__((ext_vector_type(4)));
typedef unsigned u32x2 __attribute__((ext_vector_type(2)));

constexpr int LDS_BYTES_C = 147456;
constexpr int NB = 8, SEQ = 4096, DM = 1024, T = NB * SEQ;
constexpr int PLE = 256, NE = 32, TOPK = 4, NSLOT = T * TOPK;
constexpr int INC = 4392, INP = 4608;
constexpr int NGRP = 32, SST = 64;
constexpr float EPS = 1e-6f;
constexpr float C2 = 0.125f * 1.4426950408889634f;
constexpr int NTHR = 512;

constexpr size_t MB = 1000000;
constexpr size_t WS_CTL   = 0;
constexpr size_t WS_COS64 = 1 * MB;
constexpr size_t WS_SIN64 = WS_COS64 + 4096 * 32 * 4;
constexpr size_t WS_COS32 = WS_SIN64 + 4096 * 32 * 4;
constexpr size_t WS_SIN32 = WS_COS32 + 4096 * 16 * 4;
constexpr size_t WS_KG    = 3 * MB;
constexpr size_t WS_L64   = WS_KG + 32 * 64 * 256 * 4;
constexpr size_t WS_XBUF  = 5200000;
constexpr size_t WS_KIDX  = 6 * MB;
constexpr size_t WS_WIDX  = 9 * MB;
constexpr size_t WS_EF32  = 11 * MB;
constexpr size_t WS_WG    = 20 * MB;
constexpr size_t WS_LTOK  = 29 * MB;
constexpr size_t WS_LSLOT = 34 * MB;
constexpr size_t WS_LWT   = 39 * MB;
constexpr size_t WS_SMALL_END = 44 * MB;
constexpr size_t WS_W2T   = WS_SMALL_END;
constexpr size_t SZ_W2T   = (size_t)32 * 1024 * 1024 * 2;
constexpr size_t WS_W1T   = WS_W2T + SZ_W2T;
constexpr size_t SZ_W1T   = (size_t)32 * 2048 * 1024 * 2;
constexpr size_t WS_E     = WS_W1T + SZ_W1T;
constexpr size_t SZ_E     = (size_t)T * 1024 * 2;
constexpr size_t WS_A     = WS_E + SZ_E;
constexpr size_t SZ_A     = (size_t)NSLOT * 1024 * 2;
constexpr size_t WS_TAIL  = WS_A + SZ_A;
constexpr size_t WS_WINT  = WS_TAIL;
constexpr size_t WS_WIN8  = WS_WINT + (size_t)512 * 1024 * 2;
constexpr size_t WS_WGLUT = WS_WIN8 + (size_t)INP * 1024;
constexpr size_t WS_WSB8  = WS_WGLUT + 512 * 512 * 2;
constexpr size_t WS_WAB8  = WS_WSB8 + 1024 * 512;
constexpr size_t WS_WO8   = WS_WAB8 + 1024 * 512;
constexpr size_t WS_WPG8  = WS_WO8 + 1024 * 1024;
constexpr size_t WS_WPPT  = WS_WPG8 + 1024 * 1024;
constexpr size_t WS_END   = WS_WPPT + 1024 * 256 * 2;
static_assert(WS_END <= 604000000ull, "workspace map must fit sum(inputs) bytes");
constexpr size_t WS_U     = WS_A;
constexpr size_t SZ_U     = (size_t)32 * 512 * 1152 * 2;
constexpr size_t WS_Q     = WS_U + SZ_U;
constexpr size_t SZ_QKV   = (size_t)T * 512 * 2;
constexpr size_t WS_K     = WS_Q + SZ_QKV;
constexpr size_t WS_V     = WS_K + SZ_QKV;
constexpr size_t WS_QIDX  = WS_V + SZ_QKV;
constexpr size_t WS_MASK  = WS_QIDX + (size_t)T * 256 * 2;
constexpr size_t WS_TV    = WS_MASK + (size_t)8 * 128 * 4096 * 4;
constexpr size_t SZ_TV    = (size_t)32 * 1024 * 1152 * 2;
static_assert(WS_TV + SZ_TV <= WS_TAIL, "early temporaries fit the A region");
constexpr size_t WS_R2    = WS_A;
constexpr size_t WS_R2BF  = WS_A + (size_t)T * 1024 * 4;
constexpr size_t WS_PBF   = WS_R2BF + (size_t)T * 1024;
constexpr size_t WS_PROJ  = WS_PBF + (size_t)T * 256 * 2;
static_assert(WS_PROJ + (size_t)T * 1024 * 2 <= WS_TAIL, "late users fit the A region");
constexpr size_t WS_H8    = WS_W2T + (size_t)32 * 1024 * 1024;
constexpr size_t WS_YA8   = WS_E + 40 * MB;
constexpr size_t WS_Y28   = WS_K;
constexpr size_t WS_MIX8  = WS_TV;
constexpr int CW_CNT = 64;
constexpr int CW_PCNT = 512;
constexpr int CW_QIDX = 192, CW_QATT = 256;
constexpr int CW_SSQ = 1024;
constexpr int CTL_WORDS = CW_SSQ + T;

__device__ __forceinline__ unsigned f2bf(float f) { unsigned u = __builtin_bit_cast(unsigned, f); return (u + 0x7fffu + ((u >> 16) & 1u)) >> 16; }
typedef float f32x2_t __attribute__((ext_vector_type(2))); typedef __bf16 bf16x2_t __attribute__((ext_vector_type(2)));
__device__ __forceinline__ unsigned pk2(float lo, float hi) { f32x2_t v = {lo, hi}; bf16x2_t b = __builtin_convertvector(v, bf16x2_t); return __builtin_bit_cast(unsigned, b); }
__device__ __forceinline__ float bf2f(unsigned short b) { return __builtin_bit_cast(float, (unsigned)b << 16); }
__device__ __forceinline__ float bflo(unsigned w) { return __builtin_bit_cast(float, w << 16); }
__device__ __forceinline__ float bfhi(unsigned w) { return __builtin_bit_cast(float, w & 0xffff0000u); }
__device__ __forceinline__ float wave_sum(float v) {
#pragma unroll
    for (int o = 1; o < 64; o <<= 1) v += __shfl_xor(v, o);
    return v;
}
__device__ __forceinline__ float sigmoidf_(float x) { return __builtin_amdgcn_rcpf(1.0f + __builtin_amdgcn_exp2f(-1.4426950408889634f * x)); }
__device__ __forceinline__ float gelu_tanh(float x) {
    const float u = 0.7978845608028654f * (x + 0.044715f * x * x * x);
    const float e = __expf(-2.0f * fabsf(u));
    float t = (1.0f - e) / (1.0f + e); t = u < 0.f ? -t : t;
    return 0.5f * x * (1.0f + t);
}


typedef int v8i_t __attribute__((ext_vector_type(8)));
typedef int v4i_t __attribute__((ext_vector_type(4)));
__device__ __forceinline__ unsigned pk4_fp8(float a, float b, float c, float d) { int w = __builtin_amdgcn_cvt_pk_fp8_f32(a, b, 0, false); w = __builtin_amdgcn_cvt_pk_fp8_f32(c, d, w, true); return (unsigned)w; }
#ifdef FP8_SELFTEST
__device__ __forceinline__ bool fp8_selftest(int lane) {
    const int rc = lane & 15, g = lane >> 4; v8i_t a, b;
#pragma unroll
    for (int w = 0; w < 8; ++w) { float av[4], bv[4];
#pragma unroll
        for (int q = 0; q < 4; ++q) { const int bb = w * 4 + q; const int k = bb < 16 ? 16 * g + bb : 64 + 16 * g + (bb - 16);
            av[q] = (float)((rc * 7 + k * 3) % 9 - 4) * 0.5f; bv[q] = (float)((k * 5 + rc * 11) % 7 - 3) * 0.25f; }
        a[w] = (int)pk4_fp8(av[0], av[1], av[2], av[3]); b[w] = (int)pk4_fp8(bv[0], bv[1], bv[2], bv[3]); }
    f32x4 c = {0.f, 0.f, 0.f, 0.f};
    c = __builtin_amdgcn_mfma_scale_f32_16x16x128_f8f6f4(a, b, c, 0, 0, 0, 0x7f7f7f7f, 0, 0x7f7f7f7f);
    bool ok = true;
#pragma unroll
    for (int r = 0; r < 4; ++r) { const int i = 4 * g + r, j = rc; float ref = 0.f;
        for (int k = 0; k < 128; ++k) ref += ((float)((i * 7 + k * 3) % 9 - 4) * 0.5f) * ((float)((k * 5 + j * 11) % 7 - 3) * 0.25f);
        ok = ok && (c[r] == ref); }
    return __all(ok);
}
#endif

namespace pg {
constexpr int BM = 256, BK = 64, HALF = 128, HTB = HALF * BK * 2, STAGE_BYTES = 8 * HTB;
__device__ __forceinline__ int lds_byte(int r, int c) { const int st = (r >> 4) * 2 + (c >> 5), rr = r & 15, cc = c & 31, ob = rr * 64 + cc * 2; return st * 1024 + (ob ^ (((ob >> 9) & 1) << 5)); }
__device__ __forceinline__ void stage_rc(int b, int& R, int& C) { const int st = b / 1024, sb = b % 1024, swz = sb ^ (((sb >> 9) & 1) << 5); R = (st >> 1) * 16 + swz / 64; C = (st & 1) * 32 + (swz % 64) / 2; }
struct Unit { int pm, pn, g, li; };

template <bool FP8 = false, class Prob, class Epi>
__device__ __forceinline__ void gemm_phase(LAS unsigned char* lds, const Prob& P, const Epi& E) {
    const int tid = threadIdx.x, wid = __builtin_amdgcn_readfirstlane(tid >> 6), lane = tid & 63, wr = wid >> 2, wc = wid & 3, fr = lane & 15, fq = lane >> 4;
    const int nt = P.nt;
    int R[2], C[2];
#pragma unroll
    for (int i = 0; i < 2; ++i) stage_rc(tid * 16 + i * 8192, R[i], C[i]);
    unsigned offB[2][2];
#pragma unroll
    for (int h = 0; h < 2; ++h)
#pragma unroll
        for (int i = 0; i < 2; ++i) offB[h][i] = (unsigned)(h * HALF + R[i]) * P.ldb_bytes + (unsigned)C[i] * 2u;
    const unsigned ldsw = (unsigned)wid * 1024u;
    const int aoff = lds_byte(wr * 64 + fr, fq * 8), boff = lds_byte(wc * 32 + fr, fq * 8);
#define PG_SA(b, h) (((b) * 2 + (h)) * HTB)
#define PG_SB(b, h) ((4 + (b) * 2 + (h)) * HTB)
#define PG_STAGE(bufoff, gbase, voff, kbytes) do { _Pragma("unroll") for (int _i = 0; _i < 2; ++_i) \
        __builtin_amdgcn_global_load_lds((const unsigned*)((const char*)(gbase) + (voff)[_i] + (kbytes)), (LAS unsigned*)(lds + (bufoff) + ldsw + _i * 8192), 16, 0, 0); } while (0)
#define PG_CAT8(x0, x1) __builtin_shufflevector(x0, x1, 0, 1, 2, 3, 4, 5, 6, 7)
#define PG_LDA(dst, b, h) do { if constexpr (FP8) { _Pragma("unroll") for (int m = 0; m < 4; ++m) dst##8[m] = PG_CAT8(*(const LAS v4i_t*)(lds + PG_SA(b, h) + aoff + m * 2048), *(const LAS v4i_t*)(lds + PG_SA(b, h) + aoff + m * 2048 + 1024)); } \
        else { _Pragma("unroll") for (int m = 0; m < 4; ++m) _Pragma("unroll") for (int k = 0; k < 2; ++k) dst[m][k] = *(const LAS bf16x8*)(lds + PG_SA(b, h) + aoff + m * 2048 + k * 1024); } } while (0)
#define PG_LDB(dst, b, h) do { if constexpr (FP8) { _Pragma("unroll") for (int n = 0; n < 2; ++n) dst##8[n] = PG_CAT8(*(const LAS v4i_t*)(lds + PG_SB(b, h) + boff + n * 2048), *(const LAS v4i_t*)(lds + PG_SB(b, h) + boff + n * 2048 + 1024)); } \
        else { _Pragma("unroll") for (int n = 0; n < 2; ++n) _Pragma("unroll") for (int k = 0; k < 2; ++k) dst[n][k] = *(const LAS bf16x8*)(lds + PG_SB(b, h) + boff + n * 2048 + k * 1024); } } while (0)
#define PG_MMA(ai, bj, At, Bt) do { __builtin_amdgcn_s_setprio(1); \
        if constexpr (FP8) { _Pragma("unroll") for (int m = 0; m < 4; ++m) _Pragma("unroll") for (int n = 0; n < 2; ++n) \
            asm volatile("v_mfma_scale_f32_16x16x128_f8f6f4 %0, %1, %2, %0, %3, %3 op_sel_hi:[0,0,0]" : "+v"(acc[ai][bj][m][n]) : "v"(Bt##8[n]), "v"(At##8[m]), "v"(sc1)); } \
        else { _Pragma("unroll") for (int m = 0; m < 4; ++m) _Pragma("unroll") for (int n = 0; n < 2; ++n) _Pragma("unroll") for (int k = 0; k < 2; ++k) \
            acc[ai][bj][m][n] = __builtin_amdgcn_mfma_f32_16x16x32_bf16(Bt[n][k], At[m][k], acc[ai][bj][m][n], 0, 0, 0); } \
        __builtin_amdgcn_s_setprio(0); } while (0)
#define PG_WAIT_V(n) asm volatile("s_waitcnt vmcnt(" #n ")" ::: "memory")
#define PG_WAIT_L(n) asm volatile("s_waitcnt lgkmcnt(" #n ")" ::: "memory")
#define PG_BAR __builtin_amdgcn_s_barrier()
#define PG_SCHED __builtin_amdgcn_sched_barrier(0)
    Unit cur, nxt; int ui = 0;
    if (!P.next(0, cur)) return;
    f32x4 acc[2][2][4][2];
#pragma unroll
    for (int a = 0; a < 2; ++a)
#pragma unroll
        for (int b = 0; b < 2; ++b)
#pragma unroll
            for (int m = 0; m < 4; ++m)
#pragma unroll
                for (int n = 0; n < 2; ++n) acc[a][b][m][n] = (f32x4){0.f, 0.f, 0.f, 0.f};
    bf16x8 At[4][2], B0[2][2], B1[2][2]; v8i_t At8[4], B08[2], B18[2]; int sc1 = 0x7f7f7f7f; asm volatile("" : "+v"(sc1));
    const char* cA = P.a_base(cur); const char* cB = P.b_base(cur);
    unsigned cOA[2][2], nOA[2][2];
#pragma unroll
    for (int h = 0; h < 2; ++h)
#pragma unroll
        for (int i = 0; i < 2; ++i) cOA[h][i] = P.a_off(cur, h * HALF + R[i], C[i]);
    PG_STAGE(PG_SB(0, 0), cB, offB[0], 0); PG_STAGE(PG_SB(0, 1), cB, offB[1], 0); PG_STAGE(PG_SA(0, 0), cA, cOA[0], 0); PG_STAGE(PG_SA(0, 1), cA, cOA[1], 0);
    if (wr == 1) PG_BAR;
    PG_WAIT_V(2); PG_BAR;
    PG_STAGE(PG_SB(1, 0), cB, offB[0], 128); PG_STAGE(PG_SA(1, 0), cA, cOA[0], 128); PG_STAGE(PG_SB(1, 1), cB, offB[1], 128);
    PG_WAIT_V(6); PG_BAR;
    for (;;) {
        const bool has_next = P.next(ui + 1, nxt);
        const char* nA = has_next ? P.a_base(nxt) : cA; const char* nB = has_next ? P.b_base(nxt) : cB;
#pragma unroll
        for (int h = 0; h < 2; ++h)
#pragma unroll
            for (int i = 0; i < 2; ++i) nOA[h][i] = has_next ? P.a_off(nxt, h * HALF + R[i], C[i]) : cOA[h][i];
        for (int t = 0; t < nt; t += 2) {
            const bool last = (t == nt - 2);
            const unsigned k1 = (unsigned)(t + 1) * 128u;
            const unsigned k2 = last ? 0u : (unsigned)(t + 2) * 128u, k3 = k2 + 128u;
            const char* a2 = last ? nA : cA; const char* b2 = last ? nB : cB;
            unsigned o2[2][2];
#pragma unroll
            for (int h = 0; h < 2; ++h)
#pragma unroll
                for (int i = 0; i < 2; ++i) o2[h][i] = last ? nOA[h][i] : cOA[h][i];
            PG_LDB(B0, 0, 0); PG_LDB(B1, 0, 1); PG_SCHED; PG_LDA(At, 0, 0); PG_STAGE(PG_SA(1, 1), cA, cOA[1], k1);
            PG_WAIT_V(8); PG_WAIT_L(0); PG_BAR; PG_MMA(0, 0, At, B0); PG_MMA(0, 1, At, B1); PG_BAR; PG_SCHED;
            PG_LDA(At, 0, 1); PG_STAGE(PG_SB(0, 0), b2, offB[0], k2); PG_STAGE(PG_SB(0, 1), b2, offB[1], k2); PG_STAGE(PG_SA(0, 0), a2, o2[0], k2);
            PG_WAIT_V(8); PG_WAIT_L(0); PG_BAR; PG_MMA(1, 0, At, B0); PG_MMA(1, 1, At, B1); PG_BAR; PG_SCHED;
            PG_LDB(B0, 1, 0); PG_LDB(B1, 1, 1); PG_SCHED; PG_LDA(At, 1, 0); PG_STAGE(PG_SA(0, 1), a2, o2[1], k2);
            PG_WAIT_V(8); PG_WAIT_L(0); PG_BAR; PG_MMA(0, 0, At, B0); PG_MMA(0, 1, At, B1); PG_BAR; PG_SCHED;
            PG_LDA(At, 1, 1); PG_STAGE(PG_SB(1, 0), b2, offB[0], k3); PG_STAGE(PG_SB(1, 1), b2, offB[1], k3); PG_STAGE(PG_SA(1, 0), a2, o2[0], k3);
            PG_WAIT_V(8); PG_WAIT_L(0); PG_BAR; PG_MMA(1, 0, At, B0); PG_MMA(1, 1, At, B1); PG_BAR; PG_SCHED;
        }
        if (wr == 0) PG_BAR;
        if constexpr (FP8) asm volatile("s_nop 15\n\ts_nop 15" ::: "memory");
        { int fr_ = fr, fq_ = fq; asm volatile("" : "+v"(fr_), "+v"(fq_));
          E(acc, cur, wr, wc, fr_, fq_);
#ifdef PROBE_EPI2
          asm volatile("" : "+v"(fr_), "+v"(fq_)); E(acc, cur, wr, wc, fr_, fq_);
#endif
        }
        if (!has_next) break;
#pragma unroll
        for (int a = 0; a < 2; ++a)
#pragma unroll
            for (int b = 0; b < 2; ++b)
#pragma unroll
                for (int m = 0; m < 4; ++m)
#pragma unroll
                    for (int n = 0; n < 2; ++n) acc[a][b][m][n] = (f32x4){0.f, 0.f, 0.f, 0.f};
        cur = nxt; cA = nA; cB = nB; ++ui;
#pragma unroll
        for (int h = 0; h < 2; ++h)
#pragma unroll
            for (int i = 0; i < 2; ++i) cOA[h][i] = nOA[h][i];
        if (wr == 1) PG_BAR;
    }
    PG_WAIT_V(0);
    PG_BAR;
#undef PG_SA
#undef PG_SB
#undef PG_STAGE
#undef PG_LDA
#undef PG_LDB
#undef PG_MMA
#undef PG_CAT8
#undef PG_WAIT_V
#undef PG_WAIT_L
#undef PG_BAR
#undef PG_SCHED
}

struct Order {
    int nM, nN, nwg, G, c;
    __device__ void init(int nM_, int nN_, int G_, int c_) { nM = nM_; nN = nN_; nwg = nM * nN; G = G_; c = c_; }
    __device__ bool get(int i, int& pm, int& pn) const {
        const long L = (long)i * G + c; if (L >= nwg) return false;
        int wgid = (int)L; { const int q = nwg / 8, r = nwg % 8, xcd = wgid % 8, off = wgid / 8; wgid = (xcd < r ? xcd * (q + 1) : r * (q + 1) + (xcd - r) * q) + off; }
        const int nig = 8 * nN, gid = wgid / nig, fm = gid * 8, gsz = (nM - fm) < 8 ? (nM - fm) : 8;
        pm = fm + ((wgid % nig) % gsz); pn = (wgid % nig) / gsz; return true;
    }
};
struct Dense {
    const char* A; const char* B; unsigned lda_bytes, ldb_bytes; int nt; Order ord; int pn_base = 0, pn_split = 1 << 30, pn_skip = 0, b_tile0 = 0;
    __device__ bool next(int i, Unit& u) const { u.g = 0; int pp; const bool ok = ord.get(i, u.pm, pp); u.pn = pn_base + pp + (pp >= pn_split ? pn_skip : 0); return ok; }
    __device__ const char* a_base(const Unit& u) const { return A + (size_t)u.pm * 256 * lda_bytes; }
    __device__ unsigned a_off(const Unit&, int row, int col) const { return (unsigned)row * lda_bytes + (unsigned)col * 2u; }
    __device__ const char* b_base(const Unit& u) const { return B + (size_t)(u.pn - b_tile0) * 256 * ldb_bytes; }
};
}

struct Frame {
    LAS unsigned char* lds;
    int tid, lane, wave, G, bid, dry;
    const float* in[30]; float* out; unsigned char* ws;
};
#define WSP(T_, off) ((T_*)(F.ws + (off)))
#define LDS_WAIT() asm volatile("s_waitcnt lgkmcnt(0)" ::: "memory")

template <class DstRow>
__device__ __forceinline__ void transpose_item(const float* W, int K, int N, bf16_t* WT, LAS float* scr, int item, int lane, const DstRow& dstrow) {
    const int nblk = (N + 63) / 64, kb = item / nblk, nb = item % nblk, k0 = 64 * kb, n0 = 64 * nb;
    const int kk = lane >> 4, n4 = (lane & 15) * 4;
    f32x4 v[16];
#pragma unroll
    for (int i = 0; i < 16; ++i) v[i] = *(const f32x4*)(W + (size_t)(k0 + 4 * i + kk) * N + n0 + n4);
#pragma unroll
    for (int i = 0; i < 16; ++i) { LAS float* d = scr + (4 * i + kk) * 65 + n4; d[0] = v[i].x; d[1] = v[i].y; d[2] = v[i].z; d[3] = v[i].w; }
    LDS_WAIT(); asm volatile("" ::: "memory");
    const int c = lane & 7;
#pragma unroll
    for (int j = 0; j < 8; ++j) { const int n = (lane >> 3) + 8 * j; const LAS float* p = scr + (8 * c) * 65 + n; const int dr = dstrow(n0 + n);
        if (dr >= 0) { u32x4 o; o.x = pk2(p[0], p[65]); o.y = pk2(p[130], p[195]); o.z = pk2(p[260], p[325]); o.w = pk2(p[390], p[455]);
            *(u32x4*)(WT + (size_t)dr * K + k0 + 8 * c) = o; } }
    LDS_WAIT(); asm volatile("" ::: "memory");
}
__device__ __forceinline__ void tr8_load(f32x4 (&v)[16], const float* W, int K, int N, int item, int lane) {
    const int nblk = (N + 63) / 64, kb = item / nblk, nb = item % nblk, k0 = 64 * kb, n0 = 64 * nb; const int kk = lane >> 4, n4 = (lane & 15) * 4;
#pragma unroll
    for (int i = 0; i < 16; ++i) v[i] = *(const f32x4*)(W + (size_t)(k0 + 4 * i + kk) * N + n0 + n4);
}
template <class DstRow>
__device__ __forceinline__ void tr8_process(const f32x4 (&v)[16], int K, int N, unsigned char* WT, LAS float* scr, int item, int lane, float scale, const DstRow& dstrow) {
    const int nblk = (N + 63) / 64, kb = item / nblk, nb = item % nblk, k0 = 64 * kb, n0 = 64 * nb; const int kk = lane >> 4, n4 = (lane & 15) * 4;
#pragma unroll
    for (int i = 0; i < 16; ++i) { LAS float* d = scr + (4 * i + kk) * 65 + n4; d[0] = v[i].x * scale; d[1] = v[i].y * scale; d[2] = v[i].z * scale; d[3] = v[i].w * scale; }
    LDS_WAIT(); asm volatile("" ::: "memory");
    const int c = lane & 3;
#pragma unroll
    for (int j = 0; j < 4; ++j) { const int n = (lane >> 2) + 16 * j; const LAS float* p = scr + (16 * c) * 65 + n; const int dr = dstrow(n0 + n);
        u32x4 o; o.x = pk4_fp8(p[0], p[65], p[130], p[195]); o.y = pk4_fp8(p[260], p[325], p[390], p[455]); o.z = pk4_fp8(p[520], p[585], p[650], p[715]); o.w = pk4_fp8(p[780], p[845], p[910], p[975]);
        *(u32x4*)(WT + (size_t)dr * K + k0 + 16 * c) = o; }
    LDS_WAIT(); asm volatile("" ::: "memory");
}
template <class DstRow>
__device__ __forceinline__ void transpose_item_fp8(const float* W, int K, int N, unsigned char* WT, LAS float* scr, int item, int lane, float scale, const DstRow& dstrow) {
    f32x4 v[16]; tr8_load(v, W, K, N, item, lane); tr8_process(v, K, N, WT, scr, item, lane, scale, dstrow);
}
__device__ __forceinline__ int win_dst_row(int c) {
    if (c < 512) return c;
    if (c < 1536) { const int isk = c >= 1024, cc = c - (isk ? 1024 : 512), t = cc >> 8, w = cc & 255, hl = w >> 6, half = (w >> 5) & 1, dd = w & 31; return ((isk ? 4 : 2) + t) * 256 + half * 128 + hl * 32 + dd; }
    if (c < 2048) return 6 * 256 + (c - 1536);
    if (c < 2304) { const int cc = c - 2048, head = cc >> 5, half = (cc >> 4) & 1, dd = cc & 15; return 8 * 256 + half * 128 + head * 16 + dd; }
    if (c < 2336) { const int cc = c - 2304, half = cc >> 4, w = cc & 15; return 9 * 256 + half * 128 + w; }
    if (c < 2344) return 9 * 256 + 16 + (c - 2336);
    if (c < INC) return 2560 + (c - 2344);
    return -1;
}
__device__ __forceinline__ void rms_row_to_bf16(const float* xrow, const float* gain, bf16_t* orow, unsigned char* orow8, int lane) {
    const f32x4* xr = (const f32x4*)xrow + lane; const f32x4* gr = (const f32x4*)gain + lane;
    f32x4 v[4]; float s = 0.f;
#pragma unroll
    for (int j = 0; j < 4; ++j) { v[j] = xr[64 * j]; s += (v[j].x * v[j].x + v[j].y * v[j].y) + (v[j].z * v[j].z + v[j].w * v[j].w); }
    const float rstd = 1.0f / sqrtf(wave_sum(s) * (1.f / 1024.f) + EPS);
    u32x2* o8 = (u32x2*)orow + lane;
#pragma unroll
    for (int j = 0; j < 4; ++j) { const f32x4 g = gr[64 * j]; const float a0 = v[j].x * rstd * g.x, a1 = v[j].y * rstd * g.y, a2 = v[j].z * rstd * g.z, a3 = v[j].w * rstd * g.w;
        u32x2 w; w.x = pk2(a0, a1); w.y = pk2(a2, a3); o8[64 * j] = w; ((unsigned*)orow8)[lane + 64 * j] = pk4_fp8(a0, a1, a2, a3); }
}

__device__ __forceinline__ void p0_prologue(Frame& F) {
    LAS float* scr = (LAS float*)(F.lds + F.wave * 16640);
    const int gw = F.bid * 8 + F.wave, NGW = F.G * 8;
    { unsigned* ctl = WSP(unsigned, WS_CTL); for (int i = F.bid * NTHR + F.tid; i < CTL_WORDS; i += F.G * NTHR) ctl[i] = 0u; }
    { float* c64 = WSP(float, WS_COS64); float* s64 = WSP(float, WS_SIN64); float* c32 = WSP(float, WS_COS32); float* s32 = WSP(float, WS_SIN32);
      for (int i = F.bid * NTHR + F.tid; i < 4096 * 48; i += F.G * NTHR) {
          if (i < 4096 * 32) { const int pos = i >> 5, k = i & 31; const float inv = powf(10000.0f, -(float)k * (2.0f / 64.0f)); const float a = (float)pos * inv; c64[i] = cosf(a); s64[i] = sinf(a); }
          else { const int j = i - 4096 * 32, pos = j >> 4, k = j & 15; const float inv = powf(10000.0f, -(float)k * (2.0f / 32.0f)); const float a = (float)pos * inv; c32[j] = cosf(a); s32[j] = sinf(a); } } }
    { bf16_t* WT = WSP(bf16_t, WS_WINT) + (size_t)256 * 1024; unsigned char* W8 = WSP(unsigned char, WS_WIN8) + (size_t)9 * 256 * 1024;
      for (int i = F.bid * NTHR + F.tid; i < 256 * 128; i += F.G * NTHR) { const int row = i >> 7, ch = i & 127; const int w = row & 127, half = row >> 7;
          const bool used = (w < 16) || (half == 0 && w < 24); if (!used) { *(u32x4*)(WT + (size_t)row * 1024 + ch * 8) = (u32x4){0u, 0u, 0u, 0u}; if (ch < 64) *(u32x4*)(W8 + (size_t)row * 1024 + ch * 16) = (u32x4){0u, 0u, 0u, 0u}; } } }
    constexpr int I_WIN = ((INC + 63) / 64) * (1024 / 64), I_GLU = (512 / 64) * (512 / 64), I_SB = (1024 / 64) * (512 / 64), I_AB = I_SB, I_O = (1024 / 64) * (1024 / 64), I_PG = I_O, I_PP = (1024 / 64) * (256 / 64);
    constexpr int I_E = (1024 / 64) * (1024 / 64);
    constexpr int NDENSE = I_WIN + I_GLU + I_SB + I_AB + I_O + I_PG + I_PP;
    auto ident = [](int n) { return n; };
    for (int it = gw; it < NDENSE; it += NGW) {
        int r = it;
        if (r < I_WIN) {
            const int nblk = (INC + 63) / 64, nb = r % nblk;
            if (nb * 64 + 64 <= INC) { transpose_item_fp8(F.in[2], 1024, INC, WSP(unsigned char, WS_WIN8), scr, r, F.lane, 32.0f, [](int n) { return win_dst_row(n); });
                if (nb * 64 + 64 > 2048 && nb * 64 < 2344) transpose_item(F.in[2], 1024, INC, WSP(bf16_t, WS_WINT), scr, r, F.lane, [](int n) { const int d = win_dst_row(n); return (d >= 2048 && d < 2560) ? d - 2048 : -1; }); }
            else { const int kb = r / nblk, k0 = 64 * kb, n0 = 64 * nb; const int n = n0 + F.lane; const int dr = n < INC ? win_dst_row(n) : -1;
                if (dr >= 0) { unsigned char* o = WSP(unsigned char, WS_WIN8) + (size_t)dr * 1024 + k0;
                    for (int k = 0; k < 64; k += 4) *(unsigned*)(o + k) = pk4_fp8(32.0f * F.in[2][(size_t)(k0 + k) * INC + n], 32.0f * F.in[2][(size_t)(k0 + k + 1) * INC + n], 32.0f * F.in[2][(size_t)(k0 + k + 2) * INC + n], 32.0f * F.in[2][(size_t)(k0 + k + 3) * INC + n]); } }
            continue; } r -= I_WIN;
        if (r < I_GLU) { transpose_item(F.in[12], 512, 512, WSP(bf16_t, WS_WGLUT), scr, r, F.lane, ident); continue; } r -= I_GLU;
        if (r < I_SB) { transpose_item_fp8(F.in[14], 512, 1024, WSP(unsigned char, WS_WSB8), scr, r, F.lane, 32.0f, ident); continue; } r -= I_SB;
        if (r < I_AB) { transpose_item_fp8(F.in[15], 512, 1024, WSP(unsigned char, WS_WAB8), scr, r, F.lane, 32.0f, ident); continue; } r -= I_AB;
        if (r < I_O) { transpose_item_fp8(F.in[16], 1024, 1024, WSP(unsigned char, WS_WO8), scr, r, F.lane, 32.0f, ident); continue; } r -= I_O;
        if (r < I_PG) { transpose_item_fp8(F.in[27], 1024, 1024, WSP(unsigned char, WS_WPG8), scr, r, F.lane, 32.0f, ident); continue; } r -= I_PG;
        transpose_item(F.in[28], 256, 1024, WSP(bf16_t, WS_WPPT), scr, r, F.lane, ident);
    }
    for (int m = gw; m < T; m += NGW) rms_row_to_bf16(F.in[0] + (size_t)m * 1024, F.in[17], WSP(bf16_t, WS_E) + (size_t)m * 1024, WSP(unsigned char, WS_H8) + (size_t)m * 1024, F.lane);
}

__device__ __forceinline__ void p0_s5_tables(Frame& F) {
    LAS float* zr = (LAS float*)F.lds; LAS float* zi = zr + 64; LAS float* bbr = zi + 64; LAS float* bbi = bbr + 1024; LAS float* Lr = bbi + 1024; LAS float* Li = Lr + 512;
    const float* lam_re = F.in[4]; const float* lam_im = F.in[5]; const float* log_dt = F.in[6]; const float* b_re = F.in[7]; const float* b_im = F.in[8];
    const float* c_re = F.in[9]; const float* c_im = F.in[10]; const float* d_skip = F.in[11];
    float* Kg = WSP(float, WS_KG); float* L64 = WSP(float, WS_L64); bf16_t* Wg = WSP(bf16_t, WS_WG); bf16_t* TV = WSP(bf16_t, WS_TV);
    for (int it = F.bid; it < 256; it += F.G) {
        const int g = it >> 3, sub = it & 7, tid = F.tid;
        __syncthreads();
        const float dt = expf(log_dt[g]);
        if (tid < 64) { zr[tid] = lam_re[g * 64 + tid] * dt; zi[tid] = lam_im[g * 64 + tid] * dt; }
        __syncthreads();
        for (int idx = tid; idx < 1024; idx += NTHR) { const int p = idx >> 4, hp = idx & 15;
            const float lr = lam_re[g * 64 + p], li = lam_im[g * 64 + p];
            const float er = expf(zr[p]), cr = er * cosf(zi[p]), ci = er * sinf(zi[p]);
            const float nr = cr - 1.0f, ni = ci, den = lr * lr + li * li;
            const float fr_ = (nr * lr + ni * li) / den, fi_ = (ni * lr - nr * li) / den;
            const float br = b_re[(g * 64 + p) * 16 + hp], bi = b_im[(g * 64 + p) * 16 + hp];
            bbr[idx] = fr_ * br - fi_ * bi; bbi[idx] = fr_ * bi + fi_ * br; }
        { const int lagl = tid >> 6, p = tid & 63; const float n = (float)(8 * sub + lagl); const float mag = expf(n * zr[p]), a = n * zi[p]; Lr[tid] = mag * cosf(a); Li[tid] = mag * sinf(a); }
        __syncthreads();
#pragma unroll 1
        for (int j = 0; j < 4; ++j) { const int o = tid + 512 * j, lagl = o >> 8, h = (o >> 4) & 15, hp = o & 15; float s = 0.f;
            for (int p = 0; p < 64; ++p) { const float cr = c_re[(g * 16 + h) * 64 + p], ci = c_im[(g * 16 + h) * 64 + p], lr = Lr[lagl * 64 + p], li = Li[lagl * 64 + p];
                const float tr = cr * lr - ci * li, ti = cr * li + ci * lr; s += tr * bbr[p * 16 + hp] - ti * bbi[p * 16 + hp]; }
            const int lag = 8 * sub + lagl; if (lag == 0 && h == hp) s += d_skip[g * 16 + h];
            Kg[((g * 64 + lag) * 16 + h) * 16 + hp] = s; }
        { const int pl = tid >> 6, j = tid & 63, p = 8 * sub + pl;
          { const float n = (float)(63 - j); const float mag = expf(n * zr[p]), a = n * zi[p]; const float er = mag * cosf(a), ei = mag * sinf(a);
            unsigned wre[8], wim[8];
#pragma unroll
            for (int q = 0; q < 8; ++q) { const float b0r = bbr[p * 16 + 2 * q], b0i = bbi[p * 16 + 2 * q], b1r = bbr[p * 16 + 2 * q + 1], b1i = bbi[p * 16 + 2 * q + 1];
                wre[q] = pk2(er * b0r - ei * b0i, er * b1r - ei * b1i); wim[q] = pk2(er * b0i + ei * b0r, er * b1i + ei * b1r); }
            u32x4* dre = (u32x4*)(Wg + (size_t)(g * 128 + p) * 1024 + j * 16); u32x4* dim = (u32x4*)(Wg + (size_t)(g * 128 + 64 + p) * 1024 + j * 16);
            dre[0] = (u32x4){wre[0], wre[1], wre[2], wre[3]}; dre[1] = (u32x4){wre[4], wre[5], wre[6], wre[7]};
            dim[0] = (u32x4){wim[0], wim[1], wim[2], wim[3]}; dim[1] = (u32x4){wim[4], wim[5], wim[6], wim[7]}; }
          { const int t = j; const float n = (float)(t + 1); const float mag = expf(n * zr[p]), a = n * zi[p]; const float er = mag * cosf(a), ei = mag * sinf(a);
#pragma unroll 4
            for (int h = 0; h < 16; ++h) { const float cr = c_re[(g * 16 + h) * 64 + p], ci = c_im[(g * 16 + h) * 64 + p];
                bf16_t* d = TV + (size_t)(g * 1024 + t * 16 + h) * 1152 + 1024 + p;
                d[0] = (bf16_t)f2bf(cr * er - ci * ei); d[64] = (bf16_t)f2bf(-(cr * ei + ci * er)); } }
          if (sub == 0 && tid < 64) { const float mag = expf(64.0f * zr[tid]), a = 64.0f * zi[tid]; L64[(g * 64 + tid) * 2] = mag * cosf(a); L64[(g * 64 + tid) * 2 + 1] = mag * sinf(a); }
        }
    }
    __syncthreads();
}
__device__ __forceinline__ void fill_tv_item(unsigned char* wsb, int tid, int item) {
    const float* Kg = (const float*)(wsb + WS_KG); bf16_t* TV = (bf16_t*)(wsb + WS_TV);
#pragma unroll 4
    for (int it = 0; it < 16; ++it) { const int ci = (item * 16 + it) * NTHR + tid;
        const int g = ci >> 17, row = (ci >> 7) & 1023, ch = ci & 127, t = row >> 4, h = row & 15, j = ch >> 1, h0 = (ch & 1) * 8, lag = t - j;
        u32x4 o = (u32x4){0u, 0u, 0u, 0u};
        if (lag >= 0) { const f32x4* sp = (const f32x4*)(Kg + ((g * 64 + lag) * 16 + h) * 16 + h0); const f32x4 a = sp[0], b = sp[1];
            o.x = pk2(a.x, a.y); o.y = pk2(a.z, a.w); o.z = pk2(b.x, b.y); o.w = pk2(b.z, b.w); }
        *(u32x4*)(TV + (size_t)(g * 1024 + row) * 1152 + ch * 8) = o; }
}

struct EpiInProj {
    bf16_t *U, *Q, *K, *V, *QI, *KI, *GS, *GA; float* WI; const float *bg, *c64, *s64, *c32, *s32; float ascale;
    __device__ __forceinline__ void operator()(f32x4 (&acc)[2][2][4][2], const pg::Unit& u, int wr, int wc, int fr, int fq) const {
        const int pn = u.pn, row0 = u.pm * 256 + wr * 64 + fr;
        if (ascale != 1.0f) {
#pragma unroll
            for (int a_ = 0; a_ < 2; ++a_)
#pragma unroll
                for (int b_ = 0; b_ < 2; ++b_)
#pragma unroll
                    for (int m_ = 0; m_ < 4; ++m_)
#pragma unroll
                        for (int n_ = 0; n_ < 2; ++n_) acc[a_][b_][m_][n_] *= ascale; }
        if (pn < 2) {
#pragma unroll
            for (int ai = 0; ai < 2; ++ai)
#pragma unroll
                for (int m = 0; m < 4; ++m) { const int r = row0 + ai * 128 + m * 16;
#pragma unroll
                    for (int bj = 0; bj < 2; ++bj)
#pragma unroll
                        for (int n = 0; n < 2; ++n) { const int c = pn * 256 + bj * 128 + wc * 32 + n * 16 + fq * 4; const int g = c >> 4, hp = c & 15; const f32x4 v = acc[ai][bj][m][n];
                            u32x2 w; w.x = pk2(v.x, v.y); w.y = pk2(v.z, v.w);
                            *(u32x2*)(U + ((size_t)(g * 512 + (r >> 6)) * 1152 + (r & 63) * 16 + hp)) = w; } }
        } else if (pn < 6) {
            bf16_t* O = pn < 4 ? Q : K; const float sc = pn < 4 ? C2 : 1.0f; const int head = (pn & 1) * 4 + wc;
#pragma unroll
            for (int ai = 0; ai < 2; ++ai)
#pragma unroll
                for (int m = 0; m < 4; ++m) { const int r = row0 + ai * 128 + m * 16, l = r & 4095;
#pragma unroll
                    for (int n = 0; n < 2; ++n) { const int dd = n * 16 + fq * 4; const f32x4 cs = *(const f32x4*)(c64 + l * 32 + dd), sn = *(const f32x4*)(s64 + l * 32 + dd);
                        const f32x4 x1 = acc[ai][0][m][n], x2 = acc[ai][1][m][n]; const f32x4 o1 = (x1 * cs - x2 * sn) * sc, o2 = (x2 * cs + x1 * sn) * sc;
                        bf16_t* d = O + (size_t)r * 512 + head * 64 + dd; u32x2 w;
                        w.x = pk2(o1.x, o1.y); w.y = pk2(o1.z, o1.w); *(u32x2*)d = w;
                        w.x = pk2(o2.x, o2.y); w.y = pk2(o2.z, o2.w); *(u32x2*)(d + 32) = w; } }
        } else if (pn < 8) {
#pragma unroll
            for (int ai = 0; ai < 2; ++ai)
#pragma unroll
                for (int m = 0; m < 4; ++m) { const int r = row0 + ai * 128 + m * 16;
#pragma unroll
                    for (int bj = 0; bj < 2; ++bj)
#pragma unroll
                        for (int n = 0; n < 2; ++n) { const int c = (pn - 6) * 256 + bj * 128 + wc * 32 + n * 16 + fq * 4; const f32x4 v = acc[ai][bj][m][n];
                            u32x2 w; w.x = pk2(v.x, v.y); w.y = pk2(v.z, v.w); *(u32x2*)(V + (size_t)r * 512 + c) = w; } }
        } else if (pn == 8) {
#pragma unroll
            for (int ai = 0; ai < 2; ++ai)
#pragma unroll
                for (int m = 0; m < 4; ++m) { const int r = row0 + ai * 128 + m * 16, l = r & 4095;
                    const f32x4 cs = *(const f32x4*)(c32 + l * 16 + fq * 4), sn = *(const f32x4*)(s32 + l * 16 + fq * 4);
#pragma unroll
                    for (int n = 0; n < 2; ++n) { const int head = 2 * wc + n; const f32x4 x1 = acc[ai][0][m][n], x2 = acc[ai][1][m][n]; const f32x4 o1 = x1 * cs - x2 * sn, o2 = x2 * cs + x1 * sn;
                        bf16_t* d = QI + (size_t)r * 256 + head * 32 + fq * 4; u32x2 w;
                        w.x = pk2(o1.x, o1.y); w.y = pk2(o1.z, o1.w); *(u32x2*)d = w;
                        w.x = pk2(o2.x, o2.y); w.y = pk2(o2.z, o2.w); *(u32x2*)(d + 16) = w; } }
        } else if (pn == 9) {
            if (wc == 0) {
#pragma unroll
                for (int ai = 0; ai < 2; ++ai)
#pragma unroll
                    for (int m = 0; m < 4; ++m) { const int r = row0 + ai * 128 + m * 16, l = r & 4095;
                        const f32x4 cs = *(const f32x4*)(c32 + l * 16 + fq * 4), sn = *(const f32x4*)(s32 + l * 16 + fq * 4);
                        const f32x4 x1 = acc[ai][0][m][0], x2 = acc[ai][1][m][0]; const f32x4 o1 = x1 * cs - x2 * sn, o2 = x2 * cs + x1 * sn;
                        bf16_t* d = KI + (size_t)r * 32 + fq * 4; u32x2 w;
                        w.x = pk2(o1.x, o1.y); w.y = pk2(o1.z, o1.w); *(u32x2*)d = w;
                        w.x = pk2(o2.x, o2.y); w.y = pk2(o2.z, o2.w); *(u32x2*)(d + 16) = w;
                        if (fq < 2) *(f32x4*)(WI + (size_t)r * 8 + fq * 4) = acc[ai][0][m][1]; } }
        } else {
#pragma unroll
            for (int bj = 0; bj < 2; ++bj)
#pragma unroll
                for (int n = 0; n < 2; ++n) { const int c = (pn - 10) * 256 + bj * 128 + wc * 32 + n * 16 + fq * 4; const f32x4 b = *(const f32x4*)(bg + c);
                    unsigned char* O = c < 1024 ? (unsigned char*)GS + c : (unsigned char*)GS + (size_t)T * 1024 + (c - 1024);
#pragma unroll
                    for (int ai = 0; ai < 2; ++ai)
#pragma unroll
                        for (int m = 0; m < 4; ++m) { const int r = row0 + ai * 128 + m * 16; const f32x4 v = acc[ai][bj][m][n] + b;
                            *(unsigned*)(O + (size_t)r * 1024) = pk4_fp8(sigmoidf_(v.x), sigmoidf_(v.y), sigmoidf_(v.z), sigmoidf_(v.w)); } }
        }
    }
};

__device__ __forceinline__ void idx_score_tile(bf16x8 k0, bf16x8 k1, const bf16x8 (&qp)[2], const bf16x8 (&qf)[8][2], const float (&w)[8], float (&sc)[16]) {
    const f32x16 z = (f32x16){0.f, 0.f, 0.f, 0.f, 0.f, 0.f, 0.f, 0.f, 0.f, 0.f, 0.f, 0.f, 0.f, 0.f, 0.f, 0.f};
    f32x16 lin = __builtin_amdgcn_mfma_f32_32x32x16_bf16(k0, qp[0], z, 0, 0, 0); lin = __builtin_amdgcn_mfma_f32_32x32x16_bf16(k1, qp[1], lin, 0, 0, 0);
    f32x16 dA = __builtin_amdgcn_mfma_f32_32x32x16_bf16(k0, qf[0][0], z, 0, 0, 0); dA = __builtin_amdgcn_mfma_f32_32x32x16_bf16(k1, qf[0][1], dA, 0, 0, 0);
#pragma unroll
    for (int r = 0; r < 16; ++r) sc[r] = lin[r];
#pragma unroll
    for (int h = 0; h < 8; ++h) {
        f32x16 dB = z;
        if (h < 7) { dB = __builtin_amdgcn_mfma_f32_32x32x16_bf16(k0, qf[h + 1][0], z, 0, 0, 0); dB = __builtin_amdgcn_mfma_f32_32x32x16_bf16(k1, qf[h + 1][1], dB, 0, 0, 0); }
#pragma unroll
        for (int r = 0; r < 16; ++r) sc[r] = __builtin_fmaf(w[h], __builtin_fabsf(dA[r]), sc[r]);
        asm volatile("" : "+v"(sc[0]), "+v"(sc[1]), "+v"(sc[2]), "+v"(sc[3]), "+v"(sc[4]), "+v"(sc[5]), "+v"(sc[6]), "+v"(sc[7]), "+v"(k0));
        asm volatile("" : "+v"(sc[8]), "+v"(sc[9]), "+v"(sc[10]), "+v"(sc[11]), "+v"(sc[12]), "+v"(sc[13]), "+v"(sc[14]), "+v"(sc[15]), "+v"(k1));
        dA = dB;
    }
}
__device__ __forceinline__ unsigned h16_of(float s) { const _Float16 hf = (_Float16)s; return (unsigned)__builtin_bit_cast(unsigned short, hf); }
__device__ __forceinline__ void idx_scan(const LAS unsigned* hq, unsigned need, int mode, unsigned& fb, unsigned& frem) {
    unsigned cum = 0; fb = 0; frem = 1; bool found = false;
    for (int k = 0; k < 256; ++k) { const int bin = mode == 0 ? (k < 128 ? 127 - k : k) : mode == 1 ? 255 - k : k; const unsigned c = hq[bin * 32];
        if (!found && cum + c >= need) { fb = (unsigned)bin; frem = need - cum; found = true; } cum += c; }
}
__device__ __forceinline__ void idx_phase(Frame& F) {
    LAS unsigned* hist = (LAS unsigned*)F.lds;
    LAS unsigned* b1s = hist + 16384; LAS unsigned* r1s = b1s + 64; LAS unsigned* ths = r1s + 64;
    const bf16_t* QI = WSP(bf16_t, WS_QIDX); const bf16_t* KI = WSP(bf16_t, WS_KIDX); const float* WI = WSP(float, WS_WIDX); unsigned* MASK = WSP(unsigned, WS_MASK);
    const int lane = F.lane, r32 = lane & 31, hi = lane >> 5, gq = F.wave & 1, ks = F.wave >> 1;
    LAS int* qslot = (LAS int*)(F.lds + 68 * 1024);
    unsigned* qhead = WSP(unsigned, WS_CTL) + CW_QIDX + (F.dry ? 16 : 0);
    for (;;) {
            __syncthreads();
            if (F.tid == 0) *qslot = (int)__hip_atomic_fetch_add(qhead, 1u, __ATOMIC_RELAXED, __HIP_MEMORY_SCOPE_AGENT);
            __syncthreads();
            const int qpos = *qslot; if (qpos >= 1024) break;
            if (qpos & 1) { if (!F.dry) fill_tv_item(F.ws, F.tid, qpos >> 1); continue; }
            const int un = qpos >> 1;
            const int qb = 63 - (un >> 3), b = un & 7;
            const int q0 = qb * 64 + gq * 32, tok = b * 4096 + q0 + r32, ntile = (qb + 1) * 2;
            bf16x8 qf[8][2], qp[2]; float w[8];
#pragma unroll
            for (int h = 0; h < 8; ++h)
#pragma unroll
                for (int k = 0; k < 2; ++k) qf[h][k] = *(const bf16x8*)(QI + (size_t)tok * 256 + h * 32 + k * 16 + hi * 8);
            { const f32x4 wa = *(const f32x4*)(WI + (size_t)tok * 8), wb = *(const f32x4*)(WI + (size_t)tok * 8 + 4); w[0] = wa.x; w[1] = wa.y; w[2] = wa.z; w[3] = wa.w; w[4] = wb.x; w[5] = wb.y; w[6] = wb.z; w[7] = wb.w; }
#pragma unroll
            for (int k = 0; k < 2; ++k) { float a[8];
#pragma unroll
                for (int j = 0; j < 8; ++j) a[j] = 0.f;
#pragma unroll
                for (int h = 0; h < 8; ++h)
#pragma unroll
                    for (int j = 0; j < 8; ++j) a[j] = __builtin_fmaf(w[h], bf2f((unsigned short)qf[h][k][j]), a[j]);
                u32x4 pkd; pkd.x = pk2(a[0], a[1]); pkd.y = pk2(a[2], a[3]); pkd.z = pk2(a[4], a[5]); pkd.w = pk2(a[6], a[7]); qp[k] = __builtin_bit_cast(bf16x8, pkd); }
            const bf16_t* kbase = KI + (size_t)(b * 4096 + r32) * 32 + hi * 8;
            LAS unsigned* hq = hist + gq * 8192 + r32;
            _Float16 theta = (_Float16)(-INFINITY); float sc[16]; bf16x8 kn0, kn1;
#define IDX_TILES(BODY) do { kn0 = *(const bf16x8*)(kbase + (size_t)ks * 1024); kn1 = *(const bf16x8*)(kbase + (size_t)ks * 1024 + 16); \
            for (int kt = ks; kt < ntile; kt += 4) { const bf16x8 kc0 = kn0, kc1 = kn1; \
                if (kt + 4 < ntile) { kn0 = *(const bf16x8*)(kbase + (size_t)(kt + 4) * 1024); kn1 = *(const bf16x8*)(kbase + (size_t)(kt + 4) * 1024 + 16); } \
                idx_score_tile(kc0, kc1, qp, qf, w, sc); BODY } } while (0)
            if (qb >= 4) {
                for (int i = F.tid; i < 16384; i += NTHR) hist[i] = 0u;
                __syncthreads();
                IDX_TILES({
                    _Pragma("unroll") for (int r = 0; r < 16; ++r) __hip_atomic_fetch_add(hq + (h16_of(sc[r]) >> 8) * 32, 1u, __ATOMIC_RELAXED, __HIP_MEMORY_SCOPE_WORKGROUP); });
                __syncthreads();
                if (ks == 0 && hi == 0) { unsigned fb, fr_; idx_scan(hq, 256u, 0, fb, fr_); b1s[gq * 32 + r32] = fb; r1s[gq * 32 + r32] = fr_; }
                __syncthreads();
                for (int i = F.tid; i < 16384; i += NTHR) hist[i] = 0u;
                __syncthreads();
                const unsigned b1 = b1s[gq * 32 + r32];
                IDX_TILES({
                    _Pragma("unroll") for (int r = 0; r < 16; ++r) { const unsigned hv = h16_of(sc[r]); if ((hv >> 8) == b1) __hip_atomic_fetch_add(hq + (hv & 255u) * 32, 1u, __ATOMIC_RELAXED, __HIP_MEMORY_SCOPE_WORKGROUP); } });
                __syncthreads();
                if (ks == 0 && hi == 0) { unsigned fb, fr_; const unsigned bb = b1s[gq * 32 + r32]; idx_scan(hq, r1s[gq * 32 + r32], bb < 128u ? 1 : 2, fb, fr_); ths[gq * 32 + r32] = (bb << 8) | fb; }
                __syncthreads();
                theta = __builtin_bit_cast(_Float16, (unsigned short)ths[gq * 32 + r32]);
            }
            IDX_TILES({
                unsigned bits = 0u;
                _Pragma("unroll") for (int r = 0; r < 16; ++r) bits |= ((_Float16)sc[r] >= theta ? 1u : 0u) << ((r & 3) + 8 * (r >> 2));
                bits <<= 4 * hi;
                bits |= (unsigned)__shfl_xor((int)bits, 32);
                if (hi == 0) MASK[(size_t)(b * 128 + kt) * 4096 + q0 + r32] = bits; });
#undef IDX_TILES
    }
}

constexpr int CV_IE = (1024 / 64) * (1024 / 64), CV_NITEMS = 3 * 32 * CV_IE, CV_NBLK = CV_NITEMS / 8;
__device__ __forceinline__ void expert_conv_item(LAS unsigned char* lds, unsigned char* ws, int wave, int lane, const float* wg_, const float* wu_, const float* wd_, int bitem) {
    LAS float* scr = (LAS float*)(lds + wave * 16640);
    const int r = bitem * 8 + wave, which = r / (32 * CV_IE), e = (r % (32 * CV_IE)) / CV_IE, item = r % CV_IE;
    auto w1row = [](int c) { const int pn = c >> 7, w = c & 127; return pn * 256 + (w & 96) + ((w >> 2) & 1) * 16 + ((w >> 3) & 3) * 4 + (w & 3); };
    const float* src = (which == 0 ? wg_ : which == 1 ? wu_ : wd_) + (size_t)e * 1024 * 1024;
    if (which == 0) transpose_item_fp8(src, 1024, 1024, ws + WS_W1T + (size_t)e * 2048 * 1024, scr, item, lane, 32.0f, w1row);
    else if (which == 1) transpose_item_fp8(src, 1024, 1024, ws + WS_W1T + (size_t)e * 2048 * 1024, scr, item, lane, 32.0f, [=](int c) { return w1row(c) + 128; });
    else transpose_item_fp8(src, 1024, 1024, ws + WS_W2T + (size_t)e * 1024 * 1024, scr, item, lane, 32.0f, [](int n) { return n; });
}
__device__ __forceinline__ s16x4 vtr(const LAS char* p) { typedef short v4i16_t __attribute__((ext_vector_type(4))); return __builtin_bit_cast(s16x4, __builtin_amdgcn_ds_read_tr16_b64_v4i16((LAS v4i16_t*)p)); }
__device__ __forceinline__ void glds16(const void* gsrc, unsigned lds_dst) {
    unsigned keep; asm volatile("s_mov_b32 %0, m0\n\ts_mov_b32 m0, %2\n\ts_nop 0\n\tglobal_load_lds_dwordx4 %1, off\n\ts_mov_b32 m0, %0" : "=&s"(keep) : "v"(gsrc), "s"(lds_dst) : "memory"); }
__device__ __forceinline__ void attn_phase(Frame& F) {
    const bf16_t* Q = WSP(bf16_t, WS_Q); const bf16_t* K = WSP(bf16_t, WS_K); const bf16_t* V = WSP(bf16_t, WS_V); unsigned char* O = F.dry ? WSP(unsigned char, WS_E) : WSP(unsigned char, WS_YA8); const unsigned* MASK = WSP(unsigned, WS_MASK);
    const int lane = F.lane, r32 = lane & 31, hi = lane >> 5, wv = F.wave;
    const LAS char* ldsc = (const LAS char*)F.lds;
    const unsigned lds0 = (unsigned)(uintptr_t)F.lds;
    constexpr int KOFF = 0, VOFF = 32768, MOFF = 65536;
    const float* const wg_ = F.in[21]; const float* const wu_ = F.in[23]; const float* const wd_ = F.in[25];
    LAS int* qslot = (LAS int*)(F.lds + LDS_BYTES_C - 128);
    unsigned* qhead = WSP(unsigned, WS_CTL) + CW_QATT + (F.dry ? 16 : 0);
    for (;;) {
            __syncthreads();
            if (F.tid == 0) *qslot = (int)__hip_atomic_fetch_add(qhead, 1u, __ATOMIC_RELAXED, __HIP_MEMORY_SCOPE_AGENT);
            __syncthreads();
            const int qp = *qslot; if (qp >= 1024 + CV_NBLK) break;
            if ((qp & 3) != 0 || qp >= 4096) { const int ci = qp < 4096 ? qp - (qp >> 2) - 1 : qp - 1024; if (!F.dry) expert_conv_item(F.lds, F.ws, F.wave, F.lane, wg_, wu_, wd_, ci); continue; }
            const int un = qp >> 2;
            const int qb = 15 - (un >> 6), b = (un >> 3) & 7, h = un & 7;
            const int q0 = qb * 256, NT = 4 * qb + 4, ntw = 4 * qb + (wv >> 1) + 1;
            const size_t tokq = (size_t)b * 4096 + q0 + wv * 32 + r32;
            const bf16_t* ksrc = K + ((size_t)b * 4096 + lane) * 512 + h * 64 + wv * 8;
            const bf16_t* vsrc = V + ((size_t)b * 4096 + 16 * (wv & 3) + (lane >> 2)) * 512 + h * 64 + (wv >> 2) * 32 + (lane & 3) * 8;
            const unsigned* msrc = MASK + ((size_t)b * 128 + (wv & 1)) * 4096 + q0 + lane * 4;
            const unsigned kdst = lds0 + KOFF + wv * 1024, vdst = lds0 + VOFF + wv * 1024, mdst = lds0 + MOFF + (wv & 1) * 1024;
#define ATT_DMA(t_) do { const int tt_ = (t_) < NT ? (t_) : NT - 1; const unsigned sl_ = (unsigned)((t_) & 3); \
        glds16(ksrc + (size_t)tt_ * 64 * 512, (unsigned)__builtin_amdgcn_readfirstlane(kdst + sl_ * 8192u)); \
        glds16(vsrc + (size_t)tt_ * 64 * 512, (unsigned)__builtin_amdgcn_readfirstlane(vdst + sl_ * 8192u)); \
        glds16(msrc + (size_t)tt_ * 2 * 4096, (unsigned)__builtin_amdgcn_readfirstlane(mdst + sl_ * 2048u)); } while (0)
            ATT_DMA(0); ATT_DMA(1); ATT_DMA(2);
            bf16x8 qr[4];
#pragma unroll
            for (int d0 = 0; d0 < 4; ++d0) qr[d0] = *(const bf16x8*)(Q + tokq * 512 + h * 64 + d0 * 16 + hi * 8);
            asm volatile("" : "+v"(qr[0]), "+v"(qr[1]), "+v"(qr[2]), "+v"(qr[3]));
            float m = 0.f; f32x16 o[2], o2, negm;
#pragma unroll
            for (int r = 0; r < 16; ++r) { o[0][r] = 0.f; o[1][r] = 0.f; o2[r] = 0.f; negm[r] = 0.f; }
            const unsigned onew = r32 == 0 ? 0x3f803f80u : 0u; const bf16x8 ones = __builtin_bit_cast(bf16x8, (u32x4){onew, onew, onew, onew});
            const int vlane = ((lane >> 4) & 1) * 32 + (lane & 3) * 8 + (4 * hi + ((lane & 15) >> 2)) * 64;
            for (int t = 0; t < NT; ++t) {
                asm volatile("s_waitcnt vmcnt(6)\n\ts_barrier" ::: "memory");
                ATT_DMA(t + 3);
                if (t < ntw) {
                    const int sl = t & 3;
                    const LAS char* Kb = ldsc + KOFF + sl * 8192; const LAS char* Vb = ldsc + VOFF + sl * 8192 + vlane; const LAS unsigned* Mb = (const LAS unsigned*)(ldsc + MOFF + sl * 2048) + wv * 32 + r32;
                    const int w0 = (int)(Mb[0] >> (4 * hi)), w1 = (int)(Mb[256] >> (4 * hi));
                    f32x16 p0, p1;
                    { const bf16x8 k0 = *(const LAS bf16x8*)(Kb + hi * 1024 + r32 * 16), k1 = *(const LAS bf16x8*)(Kb + hi * 1024 + r32 * 16 + 512);
                      p0 = __builtin_amdgcn_mfma_f32_32x32x16_bf16(k0, qr[0], negm, 0, 0, 0); p1 = __builtin_amdgcn_mfma_f32_32x32x16_bf16(k1, qr[0], negm, 0, 0, 0); }
#pragma unroll
                    for (int d0 = 1; d0 < 4; ++d0) { const bf16x8 k0 = *(const LAS bf16x8*)(Kb + d0 * 2048 + hi * 1024 + r32 * 16), k1 = *(const LAS bf16x8*)(Kb + d0 * 2048 + hi * 1024 + r32 * 16 + 512);
                        p0 = __builtin_amdgcn_mfma_f32_32x32x16_bf16(k0, qr[d0], p0, 0, 0, 0); p1 = __builtin_amdgcn_mfma_f32_32x32x16_bf16(k1, qr[d0], p1, 0, 0, 0); }
                    float rm = __builtin_fmaxf(p0[0], p1[0]);
#pragma unroll
                    for (int r = 1; r < 16; ++r) rm = __builtin_fmaxf(rm, __builtin_fmaxf(p0[r], p1[r]));
                    rm = __builtin_fmaxf(rm, __shfl_xor(rm, 32));
                    if (t == 0 || __any(rm > 0.f)) {
                        const float dl = t == 0 ? rm : __builtin_fmaxf(rm, 0.f), f = __builtin_amdgcn_exp2f(-dl);
                        m += dl;
#pragma unroll
                        for (int r = 0; r < 16; ++r) { negm[r] = -m; o[0][r] *= f; o[1][r] *= f; o2[r] *= f; p0[r] -= dl; p1[r] -= dl; }
                    }
#pragma unroll
                    for (int r = 0; r < 16; ++r) { const int bp = (r & 3) + 8 * (r >> 2);
                        p0[r] = __uint_as_float(__float_as_uint(__builtin_amdgcn_exp2f(p0[r])) & (unsigned)__builtin_amdgcn_sbfe(w0, bp, 1));
                        p1[r] = __uint_as_float(__float_as_uint(__builtin_amdgcn_exp2f(p1[r])) & (unsigned)__builtin_amdgcn_sbfe(w1, bp, 1)); }
                    u32x4 pw[4];
#pragma unroll
                    for (int q = 0; q < 4; ++q) { pw[0][q] = pk2(p0[2 * q], p0[2 * q + 1]); pw[1][q] = pk2(p0[8 + 2 * q], p0[8 + 2 * q + 1]); pw[2][q] = pk2(p1[2 * q], p1[2 * q + 1]); pw[3][q] = pk2(p1[8 + 2 * q], p1[8 + 2 * q + 1]); }
#pragma unroll
                    for (int d0 = 0; d0 < 2; ++d0)
#pragma unroll
                        for (int kk = 0; kk < 4; ++kk) { const s16x4 lo = vtr(Vb + d0 * 4096 + kk * 1024), hh = vtr(Vb + d0 * 4096 + kk * 1024 + 512);
                            const bf16x8 vf = (bf16x8){lo[0], lo[1], lo[2], lo[3], hh[0], hh[1], hh[2], hh[3]};
                            o[d0] = __builtin_amdgcn_mfma_f32_32x32x16_bf16(vf, __builtin_bit_cast(bf16x8, pw[kk]), o[d0], 0, 0, 0); }
#pragma unroll
                    for (int kk = 0; kk < 4; ++kk) o2 = __builtin_amdgcn_mfma_f32_32x32x16_bf16(ones, __builtin_bit_cast(bf16x8, pw[kk]), o2, 0, 0, 0);
                }
            }
            asm volatile("s_waitcnt vmcnt(0) lgkmcnt(0)\n\ts_barrier" ::: "memory");
#undef ATT_DMA
            const float lt = __shfl(o2[0], r32), inv = 1.0f / lt;
#pragma unroll
            for (int d0 = 0; d0 < 2; ++d0)
#pragma unroll
                for (int g4 = 0; g4 < 4; ++g4) { unsigned w = pk4_fp8(o[d0][4 * g4] * inv, o[d0][4 * g4 + 1] * inv, o[d0][4 * g4 + 2] * inv, o[d0][4 * g4 + 3] * inv);
#ifdef ABL_ATTN
                    w = 0u;
#endif
                    *(unsigned*)(O + tokq * 512 + h * 64 + d0 * 32 + g4 * 8 + hi * 4) = w; }
        }
}

struct ProbS5E {
    const char* U; const char* Wg; unsigned ldb_bytes; int nt, G, c;
    __device__ bool next(int i, pg::Unit& u) const { const int L = i * G + c; if (L >= 64) return false; u.g = L >> 1; u.pm = L & 1; u.pn = 0; return true; }
    __device__ const char* a_base(const pg::Unit& u) const { return U + ((size_t)u.g * 512 + u.pm * 256) * 2304; }
    __device__ unsigned a_off(const pg::Unit&, int row, int col) const { return (unsigned)row * 2304u + (unsigned)col * 2u; }
    __device__ const char* b_base(const pg::Unit& u) const { return Wg + (size_t)u.g * 128 * 2048; }
};
struct EpiS5E { float* E;
    __device__ __forceinline__ void operator()(f32x4 (&acc)[2][2][4][2], const pg::Unit& u, int wr, int wc, int fr, int fq) const {
#pragma unroll
        for (int ai = 0; ai < 2; ++ai)
#pragma unroll
            for (int m = 0; m < 4; ++m) { const int r = u.pm * 256 + ai * 128 + wr * 64 + m * 16 + fr;
#pragma unroll
                for (int n = 0; n < 2; ++n) *(f32x4*)(E + ((size_t)u.g * 512 + r) * 128 + wc * 32 + n * 16 + fq * 4) = acc[ai][0][m][n]; }
    }
};
__device__ __forceinline__ void s5_scan(Frame& F) {
    if (F.wave != 0) return;
    const float* E = WSP(float, WS_EF32); const float* L64 = WSP(float, WS_L64); bf16_t* U = WSP(bf16_t, WS_U);
    for (int gid = F.bid * 64 + F.lane; gid < 32 * 8 * 64; gid += F.G * 64) {
        const int p = gid & 63, b = (gid >> 6) & 7, g = gid >> 9;
        const float lr = L64[(g * 64 + p) * 2], li = L64[(g * 64 + p) * 2 + 1]; float sr = 0.f, si = 0.f;
        const size_t m0 = (size_t)g * 512 + b * 64;
#pragma unroll 1
        for (int c0 = 0; c0 < 64; c0 += 16) { float er[16], ei[16];
#pragma unroll
            for (int c = 0; c < 16; ++c) { er[c] = E[(m0 + c0 + c) * 128 + p]; ei[c] = E[(m0 + c0 + c) * 128 + 64 + p]; }
#pragma unroll
            for (int c = 0; c < 16; ++c) { const size_t m = m0 + c0 + c;
                U[m * 1152 + 1024 + p] = (bf16_t)f2bf(sr); U[m * 1152 + 1088 + p] = (bf16_t)f2bf(si);
                const float nr = lr * sr - li * si + er[c], ni = lr * si + li * sr + ei[c]; sr = nr; si = ni; } }
    }
}
struct ProbS5Y {
    const char* U; const char* TV; unsigned ldb_bytes; int nt, G, c;
    __device__ bool next(int i, pg::Unit& u) const { const int L = i * G + c; if (L >= 256) return false; u.g = L >> 3; u.pm = (L >> 2) & 1; u.pn = L & 3; return true; }
    __device__ const char* a_base(const pg::Unit& u) const { return U + ((size_t)u.g * 512 + u.pm * 256) * 2304; }
    __device__ unsigned a_off(const pg::Unit&, int row, int col) const { return (unsigned)row * 2304u + (unsigned)col * 2u; }
    __device__ const char* b_base(const pg::Unit& u) const { return TV + ((size_t)u.g * 1024 + u.pn * 256) * 2304; }
};
struct EpiS5Y { bf16_t* Y;
    __device__ __forceinline__ void operator()(f32x4 (&acc)[2][2][4][2], const pg::Unit& u, int wr, int wc, int fr, int fq) const {
#pragma unroll
        for (int ai = 0; ai < 2; ++ai)
#pragma unroll
            for (int m = 0; m < 4; ++m) { const int mm = u.pm * 256 + ai * 128 + wr * 64 + m * 16 + fr, b = mm >> 6, c = mm & 63;
#pragma unroll
                for (int bj = 0; bj < 2; ++bj)
#pragma unroll
                    for (int n = 0; n < 2; ++n) { const int nn = u.pn * 256 + bj * 128 + wc * 32 + n * 16 + fq * 4, t = nn >> 4, h = nn & 15; const f32x4 v = acc[ai][bj][m][n];
                        u32x2 w; w.x = pk2(gelu_tanh(v.x), gelu_tanh(v.y)); w.y = pk2(gelu_tanh(v.z), gelu_tanh(v.w));
#ifdef ABL_SSM
                        w.x = 0u; w.y = 0u;
#endif
                        *(u32x2*)(Y + ((size_t)b * 4096 + c * 64 + t) * 512 + u.g * 16 + h) = w; } }
    }
};

template <class Fn> __device__ __forceinline__ void epi_each(f32x4 (&acc)[2][2][4][2], const pg::Unit& u, int wr, int wc, int fr, int fq, const Fn& fn) {
#pragma unroll
    for (int ai = 0; ai < 2; ++ai)
#pragma unroll
        for (int m = 0; m < 4; ++m) { const int r = u.pm * 256 + ai * 128 + wr * 64 + m * 16 + fr;
#pragma unroll
            for (int bj = 0; bj < 2; ++bj)
#pragma unroll
                for (int n = 0; n < 2; ++n) fn(r, u.pn * 256 + bj * 128 + wc * 32 + n * 16 + fq * 4, acc[ai][bj][m][n]); }
}
struct EpiGlu { const bf16_t* YS; unsigned char* Y2; const float* b;
    __device__ __forceinline__ void operator()(f32x4 (&acc)[2][2][4][2], const pg::Unit& u, int wr, int wc, int fr, int fq) const {
        epi_each(acc, u, wr, wc, fr, fq, [&](int r, int c, const f32x4& v) { const f32x4 bb = *(const f32x4*)(b + c); const u32x2 y = *(const u32x2*)(YS + (size_t)r * 512 + c);
            *(unsigned*)(Y2 + (size_t)r * 512 + c) = pk4_fp8(bflo(y.x) * sigmoidf_(v.x + bb.x), bfhi(y.x) * sigmoidf_(v.y + bb.y), bflo(y.y) * sigmoidf_(v.z + bb.z), bfhi(y.y) * sigmoidf_(v.w + bb.w)); }); }
};
template <bool ADD> struct EpiMix { const unsigned char* Gt; bf16_t* MIX; unsigned char* MIX8;
    __device__ __forceinline__ void operator()(f32x4 (&acc)[2][2][4][2], const pg::Unit& u, int wr, int wc, int fr, int fq) const {
        epi_each(acc, u, wr, wc, fr, fq, [&](int r, int c, const f32x4& v) { const int g = *(const int*)(Gt + (size_t)r * 1024 + c);
            const f32x2_t glo = __builtin_amdgcn_cvt_pk_f32_fp8(g, false), ghi = __builtin_amdgcn_cvt_pk_f32_fp8(g, true);
            f32x4 o = (f32x4){glo[0] * v.x, glo[1] * v.y, ghi[0] * v.z, ghi[1] * v.w} * 0.03125f;
            if (ADD) { const u32x2 mo = *(const u32x2*)(MIX + (size_t)r * 1024 + c); o.x += bflo(mo.x); o.y += bfhi(mo.x); o.z += bflo(mo.y); o.w += bfhi(mo.y);
                *(unsigned*)(MIX8 + (size_t)r * 1024 + c) = pk4_fp8(o.x, o.y, o.z, o.w); }
            else { u32x2 w; w.x = pk2(o.x, o.y); w.y = pk2(o.z, o.w); *(u32x2*)(MIX + (size_t)r * 1024 + c) = w; } }); }
};
struct EpiStoreBf { bf16_t* O; int ldo; float sc;
    __device__ __forceinline__ void operator()(f32x4 (&acc)[2][2][4][2], const pg::Unit& u, int wr, int wc, int fr, int fq) const {
        epi_each(acc, u, wr, wc, fr, fq, [&](int r, int c, const f32x4& v) { u32x2 w; w.x = pk2(v.x * sc, v.y * sc); w.y = pk2(v.z * sc, v.w * sc); *(u32x2*)(O + (size_t)r * ldo + c) = w; }); }
};
struct EpiPleNorm { const bf16_t* R2; const bf16_t* PROJ; float* OUT; const float* gain; float* xbuf; unsigned* pcnt; LAS float* Pl; LAS float* Sl;
    __device__ __forceinline__ void operator()(f32x4 (&acc)[2][2][4][2], const pg::Unit& u, int wr, int wc, int fr, int fq) const {
        const int tid = (wr * 4 + wc) * 64 + fq * 16 + fr;
#pragma unroll
        for (int ai = 0; ai < 2; ++ai)
#pragma unroll
            for (int m = 0; m < 4; ++m) { const size_t r = (size_t)u.pm * 256 + ai * 128 + wr * 64 + m * 16 + fr;
#pragma unroll
                for (int bj = 0; bj < 2; ++bj)
#pragma unroll
                    for (int n = 0; n < 2; ++n) { const int c = u.pn * 256 + bj * 128 + wc * 32 + n * 16 + fq * 4; const u32x2 r2 = *(const u32x2*)(R2 + r * 1024 + c); const u32x2 pj = *(const u32x2*)(PROJ + r * 1024 + c); const f32x4 v = acc[ai][bj][m][n];
                        acc[ai][bj][m][n] = (f32x4){bflo(r2.x) + sigmoidf_(v.x * 0.03125f) * bflo(pj.x), bfhi(r2.x) + sigmoidf_(v.y * 0.03125f) * bfhi(pj.x), bflo(r2.y) + sigmoidf_(v.z * 0.03125f) * bflo(pj.y), bfhi(r2.y) + sigmoidf_(v.w * 0.03125f) * bfhi(pj.y)}; }
                asm volatile("" : "+v"(acc[ai][0][m][0]), "+v"(acc[ai][0][m][1]), "+v"(acc[ai][1][m][0]), "+v"(acc[ai][1][m][1]));
                if (m & 1) asm volatile("" ::: "memory"); }
#pragma unroll
        for (int ai = 0; ai < 2; ++ai)
#pragma unroll
            for (int m = 0; m < 4; ++m) { float q = 0.f;
#pragma unroll
                for (int bj = 0; bj < 2; ++bj)
#pragma unroll
                    for (int n = 0; n < 2; ++n) { const f32x4 x = acc[ai][bj][m][n]; q += (x[0] * x[0] + x[1] * x[1]) + (x[2] * x[2] + x[3] * x[3]); }
                q += __shfl_xor(q, 16); q += __shfl_xor(q, 32);
                if (fq == 0) Pl[(ai * 128 + wr * 64 + m * 16 + fr) * 4 + wc] = q; }
        asm volatile("s_waitcnt lgkmcnt(0)" ::: "memory"); __builtin_amdgcn_s_barrier(); asm volatile("" ::: "memory");
        if (tid < 256) { const float t = (Pl[tid * 4 + 0] + Pl[tid * 4 + 1]) + (Pl[tid * 4 + 2] + Pl[tid * 4 + 3]);
            __hip_atomic_store(xbuf + ((size_t)u.pm * 256 + tid) * 4 + u.pn, t, __ATOMIC_RELAXED, __HIP_MEMORY_SCOPE_AGENT); }
        asm volatile("s_waitcnt vmcnt(0) lgkmcnt(0)" ::: "memory"); __builtin_amdgcn_s_barrier(); asm volatile("" ::: "memory");
        if (tid == 0) { __hip_atomic_fetch_add(pcnt + u.pm, 1u, __ATOMIC_RELAXED, __HIP_MEMORY_SCOPE_AGENT);
            unsigned sp = 0; while (__hip_atomic_load(pcnt + u.pm, __ATOMIC_RELAXED, __HIP_MEMORY_SCOPE_AGENT) < 4u) { __builtin_amdgcn_s_sleep(2); if (++sp > (1u << 22)) break; }
            __builtin_amdgcn_fence(__ATOMIC_ACQUIRE, "agent"); }
        asm volatile("s_waitcnt vmcnt(0) lgkmcnt(0)" ::: "memory"); __builtin_amdgcn_s_barrier(); asm volatile("" ::: "memory");
        if (tid < 256) { const float* sl = xbuf + ((size_t)u.pm * 256 + tid) * 4;
            const float a0 = __hip_atomic_load(sl + 0, __ATOMIC_RELAXED, __HIP_MEMORY_SCOPE_AGENT), a1 = __hip_atomic_load(sl + 1, __ATOMIC_RELAXED, __HIP_MEMORY_SCOPE_AGENT), a2 = __hip_atomic_load(sl + 2, __ATOMIC_RELAXED, __HIP_MEMORY_SCOPE_AGENT), a3 = __hip_atomic_load(sl + 3, __ATOMIC_RELAXED, __HIP_MEMORY_SCOPE_AGENT);
            Sl[tid] = 1.0f / sqrtf(((a0 + a1) + (a2 + a3)) * (1.f / 1024.f) + EPS); }
        asm volatile("s_waitcnt vmcnt(0) lgkmcnt(0)" ::: "memory"); __builtin_amdgcn_s_barrier(); asm volatile("" ::: "memory");
        f32x4 gv[2][2];
#pragma unroll
        for (int bj = 0; bj < 2; ++bj)
#pragma unroll
            for (int n = 0; n < 2; ++n) gv[bj][n] = *(const f32x4*)(gain + u.pn * 256 + bj * 128 + wc * 32 + n * 16 + fq * 4);
#pragma unroll
        for (int ai = 0; ai < 2; ++ai)
#pragma unroll
            for (int m = 0; m < 4; ++m) { const int rl = ai * 128 + wr * 64 + m * 16 + fr; const float rs = Sl[rl]; const size_t r = (size_t)u.pm * 256 + rl;
#pragma unroll
                for (int bj = 0; bj < 2; ++bj)
#pragma unroll
                    for (int n = 0; n < 2; ++n) { const int c = u.pn * 256 + bj * 128 + wc * 32 + n * 16 + fq * 4; *(f32x4*)(OUT + r * 1024 + c) = acc[ai][bj][m][n] * rs * gv[bj][n]; } }
        asm volatile("s_waitcnt lgkmcnt(0)" ::: "memory"); __builtin_amdgcn_s_barrier(); asm volatile("" ::: "memory");
    }
};

__device__ __forceinline__ void router_phase(Frame& F) {
    constexpr int WST = 1032;
    LAS bf16_t* whi = (LAS bf16_t*)F.lds; LAS bf16_t* wlo = whi + 32 * WST;
    LAS unsigned* lcnt = (LAS unsigned*)(F.lds + 2 * 32 * WST * 2);
    LAS unsigned* gbase = lcnt + 32;
    LAS unsigned* ent_e = gbase + 32;
    LAS float* ent_w = (LAS float*)(ent_e + 512);
    const float* Wr = F.in[19]; const float* br = F.in[20]; const float* gain = F.in[18]; const float* X = F.in[0];
    const bf16_t* D1 = (const bf16_t*)F.out + (size_t)T * 1024;
    unsigned char* H2 = F.dry ? WSP(unsigned char, WS_A) : (unsigned char*)F.out;
    unsigned* cnt = WSP(unsigned, WS_CTL) + CW_CNT + (F.dry ? 32 : 0); int* LTOK = F.dry ? (int*)(F.ws + WS_A + 70 * MB) : WSP(int, WS_LTOK); int* LSLOT = F.dry ? (int*)(F.ws + WS_A + 75 * MB) : WSP(int, WS_LSLOT); float* LWT = F.dry ? (float*)(F.ws + WS_A + 80 * MB) : WSP(float, WS_LWT);
    { f32x4 wv[16];
#pragma unroll
      for (int q = 0; q < 16; ++q) wv[q] = *((const f32x4*)Wr + F.tid + q * NTHR);
#pragma unroll
      for (int q = 0; q < 16; ++q) { const int i4 = F.tid + q * NTHR, k = i4 >> 3, e0 = (i4 & 7) * 4; const float g = gain[k];
#pragma unroll
          for (int c = 0; c < 4; ++c) { const float v = wv[q][c] * g; const unsigned h = f2bf(v); const float vh = __builtin_bit_cast(float, h << 16);
              whi[(e0 + c) * WST + k] = (bf16_t)h; wlo[(e0 + c) * WST + k] = (bf16_t)f2bf(v - vh); } } }
    const int lane = F.lane, tl = lane & 15, kq = lane >> 4;
    for (int tb = F.bid; tb < T / 128; tb += F.G) {
        if (F.tid < 32) lcnt[F.tid] = 0u;
        if (!F.dry) { const f32x4* ps = (const f32x4*)(F.in[1] + (size_t)tb * 128 * 256); u32x2* pd = (u32x2*)(WSP(bf16_t, WS_PBF) + (size_t)tb * 128 * 256);
#pragma unroll 4
            for (int q = 0; q < 16; ++q) { const f32x4 v = ps[F.tid + q * NTHR]; u32x2 w; w.x = pk2(v.x, v.y); w.y = pk2(v.z, v.w); pd[F.tid + q * NTHR] = w; } }
        __syncthreads();
        const int tok0 = tb * 128 + F.wave * 16, tok = tok0 + tl;
        const float* xrow = X + (size_t)tok * 1024 + 8 * kq; const bf16_t* drow = D1 + (size_t)tok * 1024 + 8 * kq;
        f32x4 acc[2]; acc[0] = (f32x4){0.f, 0.f, 0.f, 0.f}; acc[1] = acc[0]; float ss = 0.f;
#pragma unroll 16
        for (int st = 0; st < 32; ++st) {
            const f32x4 x0 = *(const f32x4*)(xrow + 32 * st), x1 = *(const f32x4*)(xrow + 32 * st + 4); const u32x4 dd = *(const u32x4*)(drow + 32 * st);
            const f32x4 g0 = *(const f32x4*)(gain + 32 * st + 8 * kq), g1 = *(const f32x4*)(gain + 32 * st + 8 * kq + 4);
            float r[8] = {x0.x + bflo(dd.x), x0.y + bfhi(dd.x), x0.z + bflo(dd.y), x0.w + bfhi(dd.y), x1.x + bflo(dd.z), x1.y + bfhi(dd.z), x1.z + bflo(dd.w), x1.w + bfhi(dd.w)};
            { u32x2 o; o.x = pk4_fp8(r[0] * g0.x, r[1] * g0.y, r[2] * g0.z, r[3] * g0.w); o.y = pk4_fp8(r[4] * g1.x, r[5] * g1.y, r[6] * g1.z, r[7] * g1.w); *(u32x2*)(H2 + (size_t)tok * 1024 + 32 * st + 8 * kq) = o; }
            u32x4 ah, al;
#pragma unroll
            for (int p = 0; p < 4; ++p) { ss = __builtin_fmaf(r[2 * p], r[2 * p], ss); ss = __builtin_fmaf(r[2 * p + 1], r[2 * p + 1], ss);
                const unsigned hw = pk2(r[2 * p], r[2 * p + 1]); ah[p] = hw; al[p] = pk2(r[2 * p] - bflo(hw), r[2 * p + 1] - bfhi(hw)); }
            const bf16x8 A_hi = __builtin_bit_cast(bf16x8, ah), A_lo = __builtin_bit_cast(bf16x8, al);
#pragma unroll
            for (int n = 0; n < 2; ++n) { const bf16x8 Bh = *(const LAS bf16x8*)(whi + (16 * n + tl) * WST + 32 * st + 8 * kq), Bl = *(const LAS bf16x8*)(wlo + (16 * n + tl) * WST + 32 * st + 8 * kq);
                acc[n] = __builtin_amdgcn_mfma_f32_16x16x32_bf16(A_hi, Bh, acc[n], 0, 0, 0); acc[n] = __builtin_amdgcn_mfma_f32_16x16x32_bf16(A_hi, Bl, acc[n], 0, 0, 0); acc[n] = __builtin_amdgcn_mfma_f32_16x16x32_bf16(A_lo, Bh, acc[n], 0, 0, 0); }
        }
        ss += __shfl_xor(ss, 16); ss += __shfl_xor(ss, 32);
        const float rstd = 1.0f / sqrtf(ss * (1.f / 1024.f) + EPS);
        if (kq == 0 && !F.dry) WSP(float, WS_CTL)[CW_SSQ + tok] = rstd;
        const float b0 = br[tl], b1 = br[16 + tl];
#pragma unroll
        for (int rg = 0; rg < 4; ++rg) { const float rs = __shfl(rstd, 4 * kq + rg);
            float v0 = acc[0][rg] * rs + b0, v1 = acc[1][rg] * rs + b1; float tv[4]; int te[4];
#pragma unroll
            for (int k = 0; k < 4; ++k) { float bv = v0; int bi = tl; if (v1 > v0) { bv = v1; bi = 16 + tl; }
#pragma unroll
                for (int o = 1; o < 16; o <<= 1) { const float ov = __shfl_xor(bv, o); const int oi = __shfl_xor(bi, o); if (ov > bv || (ov == bv && oi < bi)) { bv = ov; bi = oi; } }
                tv[k] = bv; te[k] = bi; if (bi == tl) v0 = -INFINITY; if (bi == 16 + tl) v1 = -INFINITY; }
            const float e1 = __expf(tv[1] - tv[0]), e2 = __expf(tv[2] - tv[0]), e3 = __expf(tv[3] - tv[0]), inv = 1.0f / (1.0f + e1 + e2 + e3);
            if (tl < 4) { const int e = tl == 0 ? te[0] : tl == 1 ? te[1] : tl == 2 ? te[2] : te[3]; const float w = (tl == 0 ? 1.0f : tl == 1 ? e1 : tl == 2 ? e2 : e3) * inv;
                const int tli = F.wave * 16 + 4 * kq + rg;
                const unsigned pos = __hip_atomic_fetch_add(lcnt + e, 1u, __ATOMIC_RELAXED, __HIP_MEMORY_SCOPE_WORKGROUP);
                ent_e[tli * 4 + tl] = (unsigned)e | (pos << 8); ent_w[tli * 4 + tl] = w; }
        }
        __syncthreads();
        if (F.tid < 32) gbase[F.tid] = __hip_atomic_fetch_add(cnt + F.tid, lcnt[F.tid], __ATOMIC_RELAXED, __HIP_MEMORY_SCOPE_AGENT);
        __syncthreads();
        { const unsigned ee = ent_e[F.tid]; const int e = ee & 255, pos = (int)(gbase[e] + (ee >> 8)); const int tok_ = tb * 128 + (F.tid >> 2);
          LTOK[(size_t)e * T + pos] = tok_; LSLOT[(size_t)e * T + pos] = tok_ * 4 + (F.tid & 3); LWT[(size_t)e * T + pos] = ent_w[F.tid]; }
        __syncthreads();
    }
}

struct MoeTab { LAS int* cnt; LAS int* ntile; LAS int* cumu; LAS int* offs; LAS unsigned short* rowl; };
template <int NPN> __device__ __forceinline__ bool moe_unit(const MoeTab& tab, int L, pg::Unit& u) {
    if (L >= tab.cumu[32]) return false; int e = 0;
#pragma unroll 1
    for (int k = 1; k < 32; ++k) if (tab.cumu[k] <= L) e = k;
    const int rem = L - tab.cumu[e], ntl = tab.ntile[e]; u.g = e; u.pn = rem / ntl; u.pm = rem % ntl; return true;
}
template <int NPN> __device__ __forceinline__ MoeTab moe_tab_build(Frame& F, bool gather) {
    MoeTab t; t.cnt = (LAS int*)(F.lds + 131072); t.ntile = t.cnt + 32; t.cumu = t.ntile + 32; t.offs = t.cumu + 40; t.rowl = (LAS unsigned short*)(F.lds + 131072 + 1024);
    __syncthreads();
    if (F.tid < 32) t.cnt[F.tid] = (int)__hip_atomic_load(WSP(unsigned, WS_CTL) + CW_CNT + F.tid, __ATOMIC_RELAXED, __HIP_MEMORY_SCOPE_AGENT);
    __syncthreads();
    if (F.tid == 0) { int cu = 0, of = 0;
        for (int e = 0; e < 32; ++e) { const int n = t.cnt[e]; const int nt_ = (n + 255) >> 8; t.ntile[e] = nt_; t.cumu[e] = cu; t.offs[e] = of; cu += nt_ * NPN; of += n; }
        t.cumu[32] = cu; t.offs[32] = of; }
    __syncthreads();
    if (gather) {
        const int* ltok = WSP(int, WS_LTOK);
        for (int i = 0; i < 17; ++i) { pg::Unit u; if (!moe_unit<NPN>(t, i * F.G + F.bid, u)) break;
            if (F.tid < 256) { int r = u.pm * 256 + F.tid; const int n = t.cnt[u.g]; r = r < n ? r : n - 1; t.rowl[i * 256 + F.tid] = (unsigned short)ltok[(size_t)u.g * T + r]; } }
        __syncthreads();
    }
    return t;
}
template <int NPN> struct ProbMoe {
    const char* A; const char* W; MoeTab tab; unsigned ldb_bytes; int nt, G, c; bool gather; int hot;
    __device__ bool next(int i, pg::Unit& u) const { u.li = i; const bool ok = moe_unit<NPN>(tab, i * G + c, u); if (hot) { u.li = 0; u.g = 0; u.pn = 0; u.pm = 0; } return ok; }
    __device__ const char* a_base(const pg::Unit&) const { return A; }
    __device__ unsigned a_off(const pg::Unit& u, int row, int col) const {
        unsigned arow;
        if (gather) arow = (unsigned)tab.rowl[u.li * 256 + row];
        else { int r = u.pm * 256 + row; const int n = tab.cnt[u.g]; r = r < n ? r : n - 1; arow = (unsigned)(tab.offs[u.g] + r); }
        return arow * 1024u + (unsigned)col * 2u; }
    __device__ const char* b_base(const pg::Unit& u) const { return W + ((size_t)u.g * (NPN * 256) + u.pn * 256) * 1024; }
};
struct EpiMoe1 { unsigned char* Aout; const float* bgate; const float* bup; const float* rstd; MoeTab tab; int dry;
    __device__ __forceinline__ void operator()(f32x4 (&acc)[2][2][4][2], const pg::Unit& u, int wr, int wc, int fr, int fq) const {
        if (dry >= 3) return;
        const int e = u.g, n = tab.cnt[e], off = tab.offs[e];
        const int col = u.pn * 128 + wc * 32 + fq * 8;
        f32x4 bg[2], bu[2];
#pragma unroll
        for (int nn = 0; nn < 2; ++nn) { bg[nn] = *(const f32x4*)(bgate + e * 1024 + col + 4 * nn); bu[nn] = *(const f32x4*)(bup + e * 1024 + col + 4 * nn); }
        float rs_[8];
#pragma unroll
        for (int q = 0; q < 8; ++q) rs_[q] = 0.03125f * rstd[tab.rowl[u.li * 256 + (q >> 2) * 128 + wr * 64 + (q & 3) * 16 + fr]];
#pragma unroll
        for (int ai = 0; ai < 2; ++ai)
#pragma unroll
            for (int m = 0; m < 4; ++m) { const int r = u.pm * 256 + ai * 128 + wr * 64 + m * 16 + fr; float o[8];
#pragma unroll
                for (int nn = 0; nn < 2; ++nn) { const f32x4 g4 = acc[ai][0][m][nn] * rs_[ai * 4 + m] + bg[nn], u4 = acc[ai][1][m][nn] * rs_[ai * 4 + m] + bu[nn];
#pragma unroll
                    for (int j = 0; j < 4; ++j) { const float g = fminf(g4[j], 7.0f), uu = fminf(fmaxf(u4[j], -7.0f), 7.0f); o[4 * nn + j] = (uu + 1.0f) * (g * sigmoidf_(1.702f * g)); } }
                u32x2 w; w.x = pk4_fp8(o[0], o[1], o[2], o[3]); w.y = pk4_fp8(o[4], o[5], o[6], o[7]);
                if (r < n) { if (dry != 2) *(u32x2*)(Aout + (size_t)(off + r) * 1024 + col) = w; else asm volatile("" :: "v"(w.x), "v"(w.y)); } }
    }
};
struct EpiMoe2 { unsigned char* ws; unsigned char* outb; const float* bdown; const int* lslot; const float* lwt; MoeTab tab;
    __device__ __forceinline__ void operator()(f32x4 (&acc)[2][2][4][2], const pg::Unit& u, int wr, int wc, int fr, int fq) const {
        const int e = u.g, n = tab.cnt[e];
        int sl[8]; float wt[8];
#pragma unroll
        for (int q = 0; q < 8; ++q) { int r = u.pm * 256 + (q >> 2) * 128 + wr * 64 + (q & 3) * 16 + fr; r = r < n ? r : n - 1; sl[q] = lslot[(size_t)e * T + r]; wt[q] = lwt[(size_t)e * T + r]; }
        f32x4 bd[2][2];
#pragma unroll
        for (int bj = 0; bj < 2; ++bj)
#pragma unroll
            for (int nn = 0; nn < 2; ++nn) bd[bj][nn] = *(const f32x4*)(bdown + e * 1024 + u.pn * 256 + bj * 128 + wc * 32 + nn * 16 + fq * 4);
#pragma unroll
        for (int ai = 0; ai < 2; ++ai)
#pragma unroll
            for (int m = 0; m < 4; ++m) { const int r = u.pm * 256 + ai * 128 + wr * 64 + m * 16 + fr; if (r < n) { const int s_ = sl[ai * 4 + m]; const float w_ = wt[ai * 4 + m];
                    unsigned char* dst = ws + WS_W1T + (size_t)s_ * 1024;
#pragma unroll
                    for (int bj = 0; bj < 2; ++bj)
#pragma unroll
                        for (int nn = 0; nn < 2; ++nn) { const int col = u.pn * 256 + bj * 128 + wc * 32 + nn * 16 + fq * 4; const f32x4 v = (acc[ai][bj][m][nn] * 0.03125f + bd[bj][nn]) * (w_ * 16.0f);
                            *(unsigned*)(dst + col) = pk4_fp8(v.x, v.y, v.z, v.w); } } }
    }
};

__device__ __forceinline__ void combine_phase(Frame& F) {
    const int gw = F.bid * 8 + F.wave, NGW = F.G * 8, lane = F.lane;
    const bf16_t* D1 = (const bf16_t*)F.out + (size_t)T * 1024;
    auto slotp = [&](int sl) -> const unsigned* { return (const unsigned*)(F.ws + WS_W1T + (size_t)sl * 1024) + lane; };
    for (int tok = gw; tok < T; tok += NGW) {
        const f32x4* xr = (const f32x4*)(F.in[0] + (size_t)tok * 1024) + lane; const u32x2* dr = (const u32x2*)(D1 + (size_t)tok * 1024) + lane;
        f32x4 v[4]; u32x2 d1[4]; unsigned d[4][4];
#pragma unroll
        for (int j = 0; j < 4; ++j) { v[j] = xr[64 * j]; d1[j] = dr[64 * j]; }
#pragma unroll
        for (int k = 0; k < 4; ++k) { const unsigned* sr = slotp(tok * 4 + k);
#pragma unroll
            for (int j = 0; j < 4; ++j) d[k][j] = sr[64 * j]; }
#pragma unroll
        for (int j = 0; j < 4; ++j) { v[j].x += bflo(d1[j].x); v[j].y += bfhi(d1[j].x); v[j].z += bflo(d1[j].y); v[j].w += bfhi(d1[j].y); }
#pragma unroll
        for (int k = 0; k < 4; ++k)
#pragma unroll
            for (int j = 0; j < 4; ++j) { const f32x2_t lo = __builtin_amdgcn_cvt_pk_f32_fp8((int)d[k][j], false), hi2 = __builtin_amdgcn_cvt_pk_f32_fp8((int)d[k][j], true);
                v[j].x += lo[0] * 0.0625f; v[j].y += lo[1] * 0.0625f; v[j].z += hi2[0] * 0.0625f; v[j].w += hi2[1] * 0.0625f; }
        u32x2* r2 = (u32x2*)(WSP(bf16_t, WS_R2) + (size_t)tok * 1024) + lane; unsigned* rb = (unsigned*)(WSP(unsigned char, WS_R2BF) + (size_t)tok * 1024) + lane;
#pragma unroll
        for (int j = 0; j < 4; ++j) { u32x2 w; w.x = pk2(v[j].x, v[j].y); w.y = pk2(v[j].z, v[j].w); r2[64 * j] = w; rb[64 * j] = pk4_fp8(v[j].x, v[j].y, v[j].z, v[j].w); }
    }
}
__device__ __forceinline__ void final_norm_phase(Frame& F) {
    const int gw = F.bid * 8 + F.wave, NGW = F.G * 8, lane = F.lane; const f32x4* gr = (const f32x4*)F.in[29] + lane;
    for (int tok = gw; tok < T; tok += NGW) {
        const u32x2* xr = (const u32x2*)(WSP(bf16_t, WS_E) + (size_t)tok * 1024) + lane; f32x4 v[4]; float s = 0.f;
#pragma unroll
        for (int j = 0; j < 4; ++j) { const u32x2 d = xr[64 * j]; v[j] = (f32x4){bflo(d.x), bfhi(d.x), bflo(d.y), bfhi(d.y)}; s += (v[j].x * v[j].x + v[j].y * v[j].y) + (v[j].z * v[j].z + v[j].w * v[j].w); }
        const float rstd = 1.0f / sqrtf(wave_sum(s) * (1.f / 1024.f) + EPS);
        f32x4* xw = F.dry ? (f32x4*)(WSP(float, WS_A) + (size_t)tok * 1024) + lane : (f32x4*)(F.out + (size_t)tok * 1024) + lane;
#pragma unroll
        for (int j = 0; j < 4; ++j) { const f32x4 g = gr[64 * j]; xw[64 * j] = (f32x4){v[j].x * rstd * g.x, v[j].y * rstd * g.y, v[j].z * rstd * g.z, v[j].w * rstd * g.w}; }
    }
}
constexpr size_t WS_BAR = 512 * 1024;
#define XB_TMO      128
#define XB_XCNT(j)  (256  + 64 * (j))
#define XB_XSUB(j)  (1280 + 64 * (j))
#define XB_XGEN(j)  (2304 + 64 * (j))
#define XB_TOP      3328
#define XB_TOPGEN   3392
#define XCD_BAR_WORDS 3456
#define XB_SPIN_CAP (1u << 18)
__device__ __forceinline__ unsigned xb_ld(unsigned* p)              { return __hip_atomic_load(p, __ATOMIC_RELAXED, __HIP_MEMORY_SCOPE_AGENT); }
__device__ __forceinline__ unsigned xb_add(unsigned* p, unsigned v) { return __hip_atomic_fetch_add(p, v, __ATOMIC_RELAXED, __HIP_MEMORY_SCOPE_AGENT); }
__device__ __forceinline__ unsigned xb_xcc_id() { return (unsigned)__builtin_amdgcn_s_getreg((3 << 11) | 20) & 0xFu; }
#define XB_SPIN(cond, bar) do { unsigned _sp = 0; while (cond) { __builtin_amdgcn_s_sleep(1); \
    if ((++_sp & 255u) == 0u) { if (xb_ld(&(bar)[XB_TMO])) break; if (_sp > XB_SPIN_CAP) { atomicAdd(&(bar)[XB_TMO], 1u); break; } } } } while (0)
struct XcdBarrier { unsigned* bar; unsigned x; volatile LAS unsigned* st; };
__device__ __forceinline__ XcdBarrier xcd_barrier_post(unsigned* bar, volatile LAS unsigned* st) {
    XcdBarrier b; b.bar = bar; b.x = xb_xcc_id(); b.st = st;
    if (threadIdx.x == 0) (void)xb_add(&bar[XB_XCNT(b.x)], 1u);
    return b;
}
__device__ __forceinline__ void xcd_barrier_complete(unsigned* bar, unsigned x, unsigned& nloc, unsigned& nx) {
    const unsigned G = gridDim.x * gridDim.y * gridDim.z;
    unsigned sum, cnt, mine, sp = 0u;
    for (;;) {
        sum = 0u; cnt = 0u; mine = 0u;
#pragma unroll
        for (unsigned j = 0; j < 16; ++j) { const unsigned c = xb_ld(&bar[XB_XCNT(j)]); sum += c; cnt += (c > 0u) ? 1u : 0u; mine = (j == x) ? c : mine; }
        if (sum == G) break;
        __builtin_amdgcn_s_sleep(1);
        if ((++sp & 255u) == 0u) { if (xb_ld(&bar[XB_TMO])) break; if (sp > XB_SPIN_CAP) { atomicAdd(&bar[XB_TMO], 1u); break; } }
    }
    nloc = mine > 0u ? mine : 1u; nx = cnt > 0u ? cnt : 1u;
}
__device__ __forceinline__ void xcd_barrier(const XcdBarrier& b) {
    asm volatile("s_waitcnt vmcnt(0)" ::: "memory");
    __syncthreads();
    if (threadIdx.x == 0) {
        unsigned* bar = b.bar;
        __builtin_amdgcn_s_waitcnt(0);
        unsigned nloc = b.st[0], nx = b.st[1];
        if (nloc == 0u) { xcd_barrier_complete(bar, b.x, nloc, nx); b.st[0] = nloc; b.st[1] = nx; }
        const unsigned old = xb_add(&bar[XB_XSUB(b.x)], 1u);
        const unsigned gen = old / nloc;
        if (old + 1u == (gen + 1u) * nloc) {
            __builtin_amdgcn_fence(__ATOMIC_RELEASE, "agent");
            asm volatile("s_waitcnt vmcnt(0)" ::: "memory");
            const unsigned og = xb_add(&bar[XB_TOP], 1u);
            const unsigned tg = og / nx;
            if (og + 1u == (tg + 1u) * nx) xb_add(&bar[XB_TOPGEN], 1u);
            else XB_SPIN(xb_ld(&bar[XB_TOPGEN]) == tg, bar);
            __builtin_amdgcn_fence(__ATOMIC_ACQUIRE, "agent");
            xb_add(&bar[XB_XGEN(b.x)], 1u);
            asm volatile("s_waitcnt vmcnt(0)" ::: "memory");
        } else {
            XB_SPIN(xb_ld(&bar[XB_XGEN(b.x)]) == gen, bar);
            __builtin_amdgcn_fence(__ATOMIC_ACQUIRE, "agent");
            asm volatile("s_waitcnt vmcnt(0)" ::: "memory");
        }
    }
    __syncthreads();
}

constexpr int LDS_BYTES = 147456;
constexpr int NPHASE = 14;
#ifndef MK_MULTI
#define MK_MULTI 0
#endif
struct Args { const float* in[30]; float* out; unsigned char* ws; int ph_lo, ph_hi, dry, pad; };
static_assert(sizeof(Args) == 32 * 8 + 16, "no padding in Args");

__global__ void __launch_bounds__(NTHR, 2) fwd(Args a) {
    extern __shared__ __attribute__((aligned(16))) unsigned char lds_[];
    Frame F;
    F.lds = (LAS unsigned char*)lds_;
    F.tid = threadIdx.x; F.lane = F.tid & 63; F.wave = __builtin_amdgcn_readfirstlane(F.tid >> 6); F.G = gridDim.x; F.bid = blockIdx.x;
#pragma unroll
    for (int i = 0; i < 30; ++i) F.in[i] = a.in[i];
    F.out = a.out; F.ws = a.ws; F.dry = a.dry;
    const int lo = a.ph_lo, hi = a.ph_hi;
#ifndef PHMASK
#define PHMASK 0x3fff
#endif
#define IN(k) (((PHMASK >> (k)) & 1) && lo <= (k) && (k) < hi)
    volatile LAS unsigned* xst = (volatile LAS unsigned*)(F.lds + LDS_BYTES - 64);
    if (F.tid < 2) xst[F.tid] = 0u;
    __syncthreads();
    const XcdBarrier xbar = xcd_barrier_post((unsigned*)(F.ws + WS_BAR), xst);
#define SEAM(k) do { if (IN(k) && IN((k) + 1)) xcd_barrier(xbar); } while (0)
    bf16_t* GS = (bf16_t*)F.out; bf16_t* GA = GS + (size_t)T * 1024;

    if (IN(0)) { p0_prologue(F); __syncthreads(); p0_s5_tables(F); }
    SEAM(0);
    if (IN(1)) {
        EpiInProj E; E.U = WSP(bf16_t, WS_U); E.Q = WSP(bf16_t, WS_Q); E.K = WSP(bf16_t, WS_K); E.V = WSP(bf16_t, WS_V); E.QI = WSP(bf16_t, WS_QIDX); E.KI = WSP(bf16_t, WS_KIDX); E.GS = GS; E.GA = GA;
        E.WI = WSP(float, WS_WIDX); E.bg = F.in[3]; E.c64 = WSP(float, WS_COS64); E.s64 = WSP(float, WS_SIN64); E.c32 = WSP(float, WS_COS32); E.s32 = WSP(float, WS_SIN32);
        { pg::Dense P; P.A = (const char*)WSP(unsigned char, WS_H8); P.B = (const char*)WSP(unsigned char, WS_WIN8); P.lda_bytes = 1024; P.ldb_bytes = 1024; P.nt = 8; P.ord.init(T / 256, 16, F.G, F.bid); P.pn_split = 8; P.pn_skip = 2;
          E.ascale = 0.03125f; pg::gemm_phase<true>(F.lds, P, E); }
        { pg::Dense P; P.A = (const char*)WSP(bf16_t, WS_E); P.B = (const char*)WSP(bf16_t, WS_WINT); P.lda_bytes = 2048; P.ldb_bytes = 2048; P.nt = 16; P.ord.init(T / 256, 2, F.G, F.bid); P.pn_base = 8; P.b_tile0 = 8;
          E.ascale = 1.0f; pg::gemm_phase<false>(F.lds, P, E); }
    }
    SEAM(1);
    if (IN(2)) {
        { ProbS5E P; P.U = (const char*)WSP(bf16_t, WS_U); P.Wg = (const char*)WSP(bf16_t, WS_WG); P.ldb_bytes = 2048; P.nt = 16; P.G = F.G; P.c = F.bid; EpiS5E E; E.E = WSP(float, WS_EF32); pg::gemm_phase(F.lds, P, E); }
        __syncthreads();
        idx_phase(F);
    }
    SEAM(2);
    if (IN(3)) { s5_scan(F); __syncthreads(); attn_phase(F); }
    SEAM(3);
    if (IN(4)) { ProbS5Y P; P.U = (const char*)WSP(bf16_t, WS_U); P.TV = (const char*)WSP(bf16_t, WS_TV); P.ldb_bytes = 2304; P.nt = 18; P.G = F.G; P.c = F.bid; EpiS5Y E; E.Y = WSP(bf16_t, WS_E); pg::gemm_phase(F.lds, P, E); }
    SEAM(4);
    if (IN(5)) { pg::Dense P; P.A = (const char*)WSP(bf16_t, WS_E); P.B = (const char*)WSP(bf16_t, WS_WGLUT); P.lda_bytes = 1024; P.ldb_bytes = 1024; P.nt = 8; P.ord.init(T / 256, 2, F.G, F.bid);
        EpiGlu E; E.YS = WSP(bf16_t, WS_E); E.Y2 = WSP(unsigned char, WS_Y28); E.b = F.in[13]; pg::gemm_phase(F.lds, P, E); }
    SEAM(5);
    if (IN(6)) {
        { pg::Dense P; P.A = (const char*)WSP(unsigned char, WS_Y28); P.B = (const char*)WSP(unsigned char, WS_WSB8); P.lda_bytes = 512; P.ldb_bytes = 512; P.nt = 4; P.ord.init(T / 256, 4, F.G, F.bid);
          EpiMix<false> E; E.Gt = (const unsigned char*)GS; E.MIX = F.dry ? WSP(bf16_t, WS_U) : GA; E.MIX8 = nullptr; pg::gemm_phase<true>(F.lds, P, E); }
        { pg::Dense P; P.A = (const char*)WSP(unsigned char, WS_YA8); P.B = (const char*)WSP(unsigned char, WS_WAB8); P.lda_bytes = 512; P.ldb_bytes = 512; P.nt = 4; P.ord.init(T / 256, 4, F.G, F.bid);
          EpiMix<true> E; E.Gt = (const unsigned char*)GS + (size_t)T * 1024; E.MIX = F.dry ? WSP(bf16_t, WS_U) : GA; E.MIX8 = F.dry ? WSP(unsigned char, WS_V) : WSP(unsigned char, WS_MIX8); pg::gemm_phase<true>(F.lds, P, E); }
    }
    SEAM(6);
    if (IN(7)) { pg::Dense P; P.A = (const char*)WSP(unsigned char, WS_MIX8); P.B = (const char*)WSP(unsigned char, WS_WO8); P.lda_bytes = 1024; P.ldb_bytes = 1024; P.nt = 8; P.ord.init(T / 256, 4, F.G, F.bid);
        EpiStoreBf E; E.O = GA; E.ldo = 1024; E.sc = 0.03125f; pg::gemm_phase<true>(F.lds, P, E); }
    SEAM(7);
    if (IN(8)) router_phase(F);
    SEAM(8);
    if (IN(9)) { const MoeTab tab = moe_tab_build<8>(F, true);
        ProbMoe<8> P; P.A = (const char*)GS; P.W = (const char*)WSP(bf16_t, WS_W1T); P.tab = tab; P.ldb_bytes = 1024; P.nt = 8; P.G = F.G; P.c = F.bid; P.gather = true; P.hot = (F.dry == 4);
        EpiMoe1 E; E.Aout = WSP(unsigned char, WS_A); E.bgate = F.in[22]; E.bup = F.in[24]; E.rstd = WSP(float, WS_CTL) + CW_SSQ; E.tab = tab; E.dry = F.dry; pg::gemm_phase<true>(F.lds, P, E); }
    SEAM(9);
    if (IN(10)) { const MoeTab tab = moe_tab_build<4>(F, false);
        ProbMoe<4> P; P.A = (const char*)WSP(bf16_t, WS_A); P.W = (const char*)WSP(bf16_t, WS_W2T); P.tab = tab; P.ldb_bytes = 1024; P.nt = 8; P.G = F.G; P.c = F.bid; P.gather = false; P.hot = 0;
        EpiMoe2 E; E.ws = F.ws; E.outb = (unsigned char*)F.out; E.bdown = F.in[26]; E.lslot = WSP(int, WS_LSLOT); E.lwt = WSP(float, WS_LWT); E.tab = tab; pg::gemm_phase<true>(F.lds, P, E);
        { const int total = tab.cumu[32], rounds = (total + F.G - 1) / F.G, nfull = total - (rounds - 1) * F.G, nidle = F.G - nfull;
          const int G2 = nidle > 0 ? nidle : F.G, c2 = nidle > 0 ? F.bid - nfull : F.bid;
          if (c2 >= 0) { pg::Dense P2; P2.A = (const char*)WSP(bf16_t, WS_PBF); P2.B = (const char*)WSP(bf16_t, WS_WPPT); P2.lda_bytes = 512; P2.ldb_bytes = 512; P2.nt = 4; P2.ord.init(T / 256, 4, G2, c2);
              EpiStoreBf E2; E2.O = WSP(bf16_t, WS_PROJ); E2.ldo = 1024; E2.sc = 1.0f; pg::gemm_phase(F.lds, P2, E2); } } }
    SEAM(10);
    if (IN(11)) combine_phase(F);
    SEAM(11);
    if (IN(12)) {
        { pg::Dense P; P.A = (const char*)WSP(unsigned char, WS_R2BF); P.B = (const char*)WSP(unsigned char, WS_WPG8); P.lda_bytes = 1024; P.ldb_bytes = 1024; P.nt = 8; P.ord.init(T / 256, 4, F.G, F.bid);
          EpiPleNorm E; E.R2 = WSP(bf16_t, WS_R2); E.PROJ = WSP(bf16_t, WS_PROJ); E.OUT = F.out; E.gain = F.in[29]; E.xbuf = (float*)(F.ws + WS_XBUF); E.pcnt = WSP(unsigned, WS_CTL) + CW_PCNT;
          E.Pl = (LAS float*)(F.lds + 131072); E.Sl = (LAS float*)(F.lds + 131072 + 4096); pg::gemm_phase<true>(F.lds, P, E); }
    }
#undef IN
#undef SEAM
}

extern "C" void kernel_launch(void* const* d_in, const int* in_sizes, int n_in, void* d_out, int out_size, void* d_ws, size_t ws_size, hipStream_t stream) {
    static int grid = 0;
    if (grid == 0) {
        if (n_in != 30 || out_size != T * 1024 || ws_size < WS_END) { fprintf(stderr, "kernel_launch: unexpected shapes (n_in %d, out %d, ws %zu < %zu)\n", n_in, out_size, ws_size, (size_t)WS_END); grid = -1; return; }
        int dev = 0, cus = 0, per_cu = 0;
        hipGetDevice(&dev); hipDeviceGetAttribute(&cus, hipDeviceAttributeMultiprocessorCount, dev);
        hipFuncSetAttribute((const void*)fwd, hipFuncAttributeMaxDynamicSharedMemorySize, LDS_BYTES);
        hipOccupancyMaxActiveBlocksPerMultiprocessor(&per_cu, (const void*)fwd, NTHR, LDS_BYTES);
        if (per_cu < 1) { fprintf(stderr, "kernel_launch: occupancy query says %d blocks per CU\n", per_cu); per_cu = 1; }
        (void)hipGetLastError();
        grid = cus;
    }
    if (grid < 0) return;
    Args a{};
    for (int i = 0; i < 30; ++i) a.in[i] = (const float*)d_in[i];
    a.out = (float*)d_out; a.ws = (unsigned char*)d_ws;
#if MK_MULTI
#ifndef DUP_MASK
#define DUP_MASK 0
#endif
    for (int ph = 0; ph < NPHASE; ++ph) { a.ph_lo = ph; a.ph_hi = ph + 1; const int reps = ((DUP_MASK >> ph) & 1) ? 2 : 1;
        for (int r = 0; r < reps; ++r) { a.dry = (r + 1 < reps && (ph == 3 || ph == 6 || ph == 8 || ph == 13)) ? 1 : 0;
#ifdef DRY9
            if (ph == 9 && r + 1 < reps) a.dry = DRY9;
#endif
 hipLaunchKernelGGL(fwd, dim3(grid), dim3(NTHR), LDS_BYTES, stream, a); } }
#else
    (void)hipMemsetAsync((char*)d_ws + WS_BAR, 0, XCD_BAR_WORDS * 4, stream);
    a.ph_lo = 0; a.ph_hi = NPHASE; void* args[] = {&a};
    hipError_t e = hipLaunchCooperativeKernel((const void*)fwd, dim3(grid), dim3(NTHR), args, LDS_BYTES, stream);
    if (e != hipSuccess) fprintf(stderr, "cooperative launch failed: %s (grid %d)\n", hipGetErrorString(e), grid);
#endif
}
```

```cpp
#include <hip/hip_runtime.h>
#include <hip/hip_cooperative_groups.h>
#include <cstdio>
#include <cstdint>
#include <cmath>
namespace cg = cooperative_groups;

#define LAS __attribute__((address_space(3)))
#define GAS __attribute__((address_space(1)))
typedef unsigned short bf16_t;
typedef short bf16x8 __attribute__((ext_vector_type(8)));
typedef short s16x4 __attribute__((ext_vector_type(4)));
typedef float f32x4 __attribute__((ext_vector_type(4)));
typedef float f32x16 __attribute__((ext_vector_type(16)));
typedef unsigned u32x4 __attribute__((ext_vector_type(4)));
typedef unsigned u32x2 __attribute__((ext_vector_type(2)));

constexpr int LDS_BYTES_C = 147456;
constexpr int NB = 8, SEQ = 4096, DM = 1024, T = NB * SEQ;
constexpr int PLE = 256, NE = 32, TOPK = 4, NSLOT = T * TOPK;
constexpr int INC = 4392, INP = 4608;
constexpr int NGRP = 32, SST = 64;
constexpr float EPS = 1e-6f;
constexpr float C2 = 0.125f * 1.4426950408889634f;
constexpr int NTHR = 512;

constexpr size_t MB = 1000000;
constexpr size_t WS_CTL   = 0;
constexpr size_t WS_COS64 = 1 * MB;
constexpr size_t WS_SIN64 = WS_COS64 + 4096 * 32 * 4;
constexpr size_t WS_COS32 = WS_SIN64 + 4096 * 32 * 4;
constexpr size_t WS_SIN32 = WS_COS32 + 4096 * 16 * 4;
constexpr size_t WS_KG    = 3 * MB;
constexpr size_t WS_L64   = WS_KG + 32 * 64 * 256 * 4;
constexpr size_t WS_XBUF  = 5200000;
constexpr size_t WS_KIDX  = 6 * MB;
constexpr size_t WS_WIDX  = 9 * MB;
constexpr size_t WS_EF32  = 11 * MB;
constexpr size_t WS_WG    = 20 * MB;
constexpr size_t WS_LTOK  = 29 * MB;
constexpr size_t WS_LSLOT = 34 * MB;
constexpr size_t WS_LWT   = 39 * MB;
constexpr size_t WS_SMALL_END = 44 * MB;
constexpr size_t WS_W2T   = WS_SMALL_END;
constexpr size_t SZ_W2T   = (size_t)32 * 1024 * 1024 * 2;
constexpr size_t WS_W1T   = WS_W2T + SZ_W2T;
constexpr size_t SZ_W1T   = (size_t)32 * 2048 * 1024 * 2;
constexpr size_t WS_E     = WS_W1T + SZ_W1T;
constexpr size_t SZ_E     = (size_t)T * 1024 * 2;
constexpr size_t WS_A     = WS_E + SZ_E;
constexpr size_t SZ_A     = (size_t)NSLOT * 1024 * 2;
constexpr size_t WS_TAIL  = WS_A + SZ_A;
constexpr size_t WS_WINT  = WS_TAIL;
constexpr size_t WS_WIN8  = WS_WINT + (size_t)512 * 1024 * 2;
constexpr size_t WS_WGLUT = WS_WIN8 + (size_t)INP * 1024;
constexpr size_t WS_WSB8  = WS_WGLUT + 512 * 512 * 2;
constexpr size_t WS_WAB8  = WS_WSB8 + 1024 * 512;
constexpr size_t WS_WO8   = WS_WAB8 + 1024 * 512;
constexpr size_t WS_WPG8  = WS_WO8 + 1024 * 1024;
constexpr size_t WS_WPPT  = WS_WPG8 + 1024 * 1024;
constexpr size_t WS_END   = WS_WPPT + 1024 * 256 * 2;
static_assert(WS_END <= 604000000ull, "workspace map must fit sum(inputs) bytes");
constexpr size_t WS_U     = WS_A;
constexpr size_t SZ_U     = (size_t)32 * 512 * 1152 * 2;
constexpr size_t WS_Q     = WS_U + SZ_U;
constexpr size_t SZ_QKV   = (size_t)T * 512 * 2;
constexpr size_t WS_K     = WS_Q + SZ_QKV;
constexpr size_t WS_V     = WS_K + SZ_QKV;
constexpr size_t WS_QIDX  = WS_V + SZ_QKV;
constexpr size_t WS_MASK  = WS_QIDX + (size_t)T * 256 * 2;
constexpr size_t WS_TV    = WS_MASK + (size_t)8 * 128 * 4096 * 4;
constexpr size_t SZ_TV    = (size_t)32 * 1024 * 1152 * 2;
static_assert(WS_TV + SZ_TV <= WS_TAIL, "early temporaries fit the A region");
constexpr size_t WS_R2    = WS_A;
constexpr size_t WS_R2BF  = WS_A + (size_t)T * 1024 * 4;
constexpr size_t WS_PBF   = WS_R2BF + (size_t)T * 1024;
constexpr size_t WS_PROJ  = WS_PBF + (size_t)T * 256 * 2;
static_assert(WS_PROJ + (size_t)T * 1024 * 2 <= WS_TAIL, "late users fit the A region");
constexpr size_t WS_H8    = WS_W2T + (size_t)32 * 1024 * 1024;
constexpr size_t WS_YA8   = WS_E + 40 * MB;
constexpr size_t WS_Y28   = WS_K;
constexpr size_t WS_MIX8  = WS_TV;
constexpr int CW_CNT = 64;
constexpr int CW_PCNT = 512;
constexpr int CW_QIDX = 192, CW_QATT = 256;
constexpr int CW_SSQ = 1024;
constexpr int CTL_WORDS = CW_SSQ + T;

__device__ __forceinline__ unsigned f2bf(float f) { unsigned u = __builtin_bit_cast(unsigned, f); return (u + 0x7fffu + ((u >> 16) & 1u)) >> 16; }
typedef float f32x2_t __attribute__((ext_vector_type(2))); typedef __bf16 bf16x2_t __attribute__((ext_vector_type(2)));
__device__ __forceinline__ unsigned pk2(float lo, float hi) { f32x2_t v = {lo, hi}; bf16x2_t b = __builtin_convertvector(v, bf16x2_t); return __builtin_bit_cast(unsigned, b); }
__device__ __forceinline__ float bf2f(unsigned short b) { return __builtin_bit_cast(float, (unsigned)b << 16); }
__device__ __forceinline__ float bflo(unsigned w) { return __builtin_bit_cast(float, w << 16); }
__device__ __forceinline__ float bfhi(unsigned w) { return __builtin_bit_cast(float, w & 0xffff0000u); }
__device__ __forceinline__ float wave_sum(float v) {
#pragma unroll
    for (int o = 1; o < 64; o <<= 1) v += __shfl_xor(v, o);
    return v;
}
__device__ __forceinline__ float sigmoidf_(float x) { return __builtin_amdgcn_rcpf(1.0f + __builtin_amdgcn_exp2f(-1.4426950408889634f * x)); }
__device__ __forceinline__ float gelu_tanh(float x) {
    const float u = 0.7978845608028654f * (x + 0.044715f * x * x * x);
    const float e = __expf(-2.0f * fabsf(u));
    float t = (1.0f - e) / (1.0f + e); t = u < 0.f ? -t : t;
    return 0.5f * x * (1.0f + t);
}


typedef int v8i_t __attribute__((ext_vector_type(8)));
typedef int v4i_t __attribute__((ext_vector_type(4)));
__device__ __forceinline__ unsigned pk4_fp8(float a, float b, float c, float d) { int w = __builtin_amdgcn_cvt_pk_fp8_f32(a, b, 0, false); w = __builtin_amdgcn_cvt_pk_fp8_f32(c, d, w, true); return (unsigned)w; }
#ifdef FP8_SELFTEST
__device__ __forceinline__ bool fp8_selftest(int lane) {
    const int rc = lane & 15, g = lane >> 4; v8i_t a, b;
#pragma unroll
    for (int w = 0; w < 8; ++w) { float av[4], bv[4];
#pragma unroll
        for (int q = 0; q < 4; ++q) { const int bb = w * 4 + q; const int k = bb < 16 ? 16 * g + bb : 64 + 16 * g + (bb - 16);
            av[q] = (float)((rc * 7 + k * 3) % 9 - 4) * 0.5f; bv[q] = (float)((k * 5 + rc * 11) % 7 - 3) * 0.25f; }
        a[w] = (int)pk4_fp8(av[0], av[1], av[2], av[3]); b[w] = (int)pk4_fp8(bv[0], bv[1], bv[2], bv[3]); }
    f32x4 c = {0.f, 0.f, 0.f, 0.f};
    c = __builtin_amdgcn_mfma_scale_f32_16x16x128_f8f6f4(a, b, c, 0, 0, 0, 0x7f7f7f7f, 0, 0x7f7f7f7f);
    bool ok = true;
#pragma unroll
    for (int r = 0; r < 4; ++r) { const int i = 4 * g + r, j = rc; float ref = 0.f;
        for (int k = 0; k < 128; ++k) ref += ((float)((i * 7 + k * 3) % 9 - 4) * 0.5f) * ((float)((k * 5 + j * 11) % 7 - 3) * 0.25f);
        ok = ok && (c[r] == ref); }
    return __all(ok);
}
#endif

__device__ __forceinline__ int perm16_row(int c) { const int t = c & ~255, w = c & 255; return t + ((w >> 3) & 1) * 128 + (w >> 6) * 32 + ((w >> 2) & 1) * 16 + ((w >> 4) & 3) * 4 + (w & 3); }

__device__ __forceinline__ f32x4 bf4(u32x2 w) { return (f32x4){bflo(w.x), bfhi(w.x), bflo(w.y), bfhi(w.y)}; }
__device__ __forceinline__ f32x4 f84(unsigned w) { const f32x2_t lo = __builtin_amdgcn_cvt_pk_f32_fp8((int)w, false), hi = __builtin_amdgcn_cvt_pk_f32_fp8((int)w, true); return (f32x4){lo[0], lo[1], hi[0], hi[1]}; }
__device__ __forceinline__ u32x2 pkbf4(f32x4 v) { u32x2 w; w.x = pk2(v.x, v.y); w.y = pk2(v.z, v.w); return w; }
__device__ __forceinline__ unsigned pkf84(f32x4 v) { return pk4_fp8(v.x, v.y, v.z, v.w); }
__device__ __forceinline__ f32x4 sig4(f32x4 v) { return (f32x4){sigmoidf_(v.x), sigmoidf_(v.y), sigmoidf_(v.z), sigmoidf_(v.w)}; }

namespace pg {
constexpr int BM = 256, BK = 64, HALF = 128, HTB = HALF * BK * 2, STAGE_BYTES = 8 * HTB;
__device__ __forceinline__ int lds_byte(int r, int c) { const int st = (r >> 4) * 2 + (c >> 5), rr = r & 15, cc = c & 31, ob = rr * 64 + cc * 2; return st * 1024 + (ob ^ (((ob >> 9) & 1) << 5)); }
__device__ __forceinline__ void stage_rc(int b, int& R, int& C) { const int st = b / 1024, sb = b % 1024, swz = sb ^ (((sb >> 9) & 1) << 5); R = (st >> 1) * 16 + swz / 64; C = (st & 1) * 32 + (swz % 64) / 2; }
struct Unit { int pm, pn, g, li; };

template <bool FP8 = false, class Prob, class Epi>
__device__ __forceinline__ void gemm_phase(LAS unsigned char* lds, const Prob& P, const Epi& E) {
    const int tid = threadIdx.x, wid = __builtin_amdgcn_readfirstlane(tid >> 6), lane = tid & 63, wr = wid >> 2, wc = wid & 3, fr = lane & 15, fq = lane >> 4;
    const int nt = P.nt;
    int R[2], C[2];
#pragma unroll
    for (int i = 0; i < 2; ++i) stage_rc(tid * 16 + i * 8192, R[i], C[i]);
    unsigned offB[2][2];
#pragma unroll
    for (int h = 0; h < 2; ++h)
#pragma unroll
        for (int i = 0; i < 2; ++i) offB[h][i] = (unsigned)(h * HALF + R[i]) * P.ldb_bytes + (unsigned)C[i] * 2u;
    const unsigned ldsw = (unsigned)wid * 1024u;
    const int aoff = lds_byte(wr * 64 + fr, fq * 8), boff = lds_byte(wc * 32 + fr, fq * 8);
#define PG_SA(b, h) (((b) * 2 + (h)) * HTB)
#define PG_SB(b, h) ((4 + (b) * 2 + (h)) * HTB)
#define PG_STAGE(bufoff, gbase, voff, kbytes) do { _Pragma("unroll") for (int _i = 0; _i < 2; ++_i) \
        __builtin_amdgcn_global_load_lds((const unsigned*)((const char*)(gbase) + (voff)[_i] + (kbytes)), (LAS unsigned*)(lds + (bufoff) + ldsw + _i * 8192), 16, 0, 0); } while (0)
#define PG_CAT8(x0, x1) __builtin_shufflevector(x0, x1, 0, 1, 2, 3, 4, 5, 6, 7)
#define PG_LDA(dst, b, h) do { if constexpr (FP8) { _Pragma("unroll") for (int m = 0; m < 4; ++m) dst##8[m] = PG_CAT8(*(const LAS v4i_t*)(lds + PG_SA(b, h) + aoff + m * 2048), *(const LAS v4i_t*)(lds + PG_SA(b, h) + aoff + m * 2048 + 1024)); } \
        else { _Pragma("unroll") for (int m = 0; m < 4; ++m) _Pragma("unroll") for (int k = 0; k < 2; ++k) dst[m][k] = *(const LAS bf16x8*)(lds + PG_SA(b, h) + aoff + m * 2048 + k * 1024); } } while (0)
#define PG_LDB(dst, b, h) do { if constexpr (FP8) { _Pragma("unroll") for (int n = 0; n < 2; ++n) dst##8[n] = PG_CAT8(*(const LAS v4i_t*)(lds + PG_SB(b, h) + boff + n * 2048), *(const LAS v4i_t*)(lds + PG_SB(b, h) + boff + n * 2048 + 1024)); } \
        else { _Pragma("unroll") for (int n = 0; n < 2; ++n) _Pragma("unroll") for (int k = 0; k < 2; ++k) dst[n][k] = *(const LAS bf16x8*)(lds + PG_SB(b, h) + boff + n * 2048 + k * 1024); } } while (0)
#define PG_MMA(ai, bj, At, Bt) do { __builtin_amdgcn_s_setprio(1); \
        if constexpr (FP8) { _Pragma("unroll") for (int m = 0; m < 4; ++m) _Pragma("unroll") for (int n = 0; n < 2; ++n) \
            asm volatile("v_mfma_scale_f32_16x16x128_f8f6f4 %0, %1, %2, %0, %3, %3 op_sel_hi:[0,0,0]" : "+v"(acc[ai][bj][m][n]) : "v"(Bt##8[n]), "v"(At##8[m]), "v"(sc1)); } \
        else { _Pragma("unroll") for (int m = 0; m < 4; ++m) _Pragma("unroll") for (int n = 0; n < 2; ++n) _Pragma("unroll") for (int k = 0; k < 2; ++k) \
            acc[ai][bj][m][n] = __builtin_amdgcn_mfma_f32_16x16x32_bf16(Bt[n][k], At[m][k], acc[ai][bj][m][n], 0, 0, 0); } \
        __builtin_amdgcn_s_setprio(0); } while (0)
#define PG_WAIT_V(n) asm volatile("s_waitcnt vmcnt(" #n ")" ::: "memory")
#define PG_WAIT_L(n) asm volatile("s_waitcnt lgkmcnt(" #n ")" ::: "memory")
#define PG_BAR __builtin_amdgcn_s_barrier()
#define PG_SCHED __builtin_amdgcn_sched_barrier(0)
    Unit cur, nxt; int ui = 0;
    if (!P.next(0, cur)) return;
    f32x4 acc[2][2][4][2];
#pragma unroll
    for (int a = 0; a < 2; ++a)
#pragma unroll
        for (int b = 0; b < 2; ++b)
#pragma unroll
            for (int m = 0; m < 4; ++m)
#pragma unroll
                for (int n = 0; n < 2; ++n) acc[a][b][m][n] = (f32x4){0.f, 0.f, 0.f, 0.f};
    bf16x8 At[4][2], B0[2][2], B1[2][2]; v8i_t At8[4], B08[2], B18[2]; int sc1 = 0x7f7f7f7f; asm volatile("" : "+v"(sc1));
    const char* cA = P.a_base(cur); const char* cB = P.b_base(cur);
    unsigned cOA[2][2], nOA[2][2];
#pragma unroll
    for (int h = 0; h < 2; ++h)
#pragma unroll
        for (int i = 0; i < 2; ++i) cOA[h][i] = P.a_off(cur, h * HALF + R[i], C[i]);
    PG_STAGE(PG_SB(0, 0), cB, offB[0], 0); PG_STAGE(PG_SB(0, 1), cB, offB[1], 0); PG_STAGE(PG_SA(0, 0), cA, cOA[0], 0); PG_STAGE(PG_SA(0, 1), cA, cOA[1], 0);
    if (wr == 1) PG_BAR;
    PG_WAIT_V(2); PG_BAR;
    PG_STAGE(PG_SB(1, 0), cB, offB[0], 128); PG_STAGE(PG_SA(1, 0), cA, cOA[0], 128); PG_STAGE(PG_SB(1, 1), cB, offB[1], 128);
    PG_WAIT_V(6); PG_BAR;
    for (;;) {
        const bool has_next = P.next(ui + 1, nxt);
        const char* nA = has_next ? P.a_base(nxt) : cA; const char* nB = has_next ? P.b_base(nxt) : cB;
#pragma unroll
        for (int h = 0; h < 2; ++h)
#pragma unroll
            for (int i = 0; i < 2; ++i) nOA[h][i] = has_next ? P.a_off(nxt, h * HALF + R[i], C[i]) : cOA[h][i];
        for (int t = 0; t < nt; t += 2) {
            const bool last = (t == nt - 2);
            const unsigned k1 = (unsigned)(t + 1) * 128u;
            const unsigned k2 = last ? 0u : (unsigned)(t + 2) * 128u, k3 = k2 + 128u;
            const char* a2 = last ? nA : cA; const char* b2 = last ? nB : cB;
            unsigned o2[2][2];
#pragma unroll
            for (int h = 0; h < 2; ++h)
#pragma unroll
                for (int i = 0; i < 2; ++i) o2[h][i] = last ? nOA[h][i] : cOA[h][i];
            PG_LDB(B0, 0, 0); PG_LDB(B1, 0, 1); PG_SCHED; PG_LDA(At, 0, 0); PG_STAGE(PG_SA(1, 1), cA, cOA[1], k1);
            PG_WAIT_V(8); PG_WAIT_L(0); PG_BAR; PG_MMA(0, 0, At, B0); PG_MMA(0, 1, At, B1); PG_BAR; PG_SCHED;
            PG_LDA(At, 0, 1); PG_STAGE(PG_SB(0, 0), b2, offB[0], k2); PG_STAGE(PG_SB(0, 1), b2, offB[1], k2); PG_STAGE(PG_SA(0, 0), a2, o2[0], k2);
            PG_WAIT_V(8); PG_WAIT_L(0); PG_BAR; PG_MMA(1, 0, At, B0); PG_MMA(1, 1, At, B1); PG_BAR; PG_SCHED;
            PG_LDB(B0, 1, 0); PG_LDB(B1, 1, 1); PG_SCHED; PG_LDA(At, 1, 0); PG_STAGE(PG_SA(0, 1), a2, o2[1], k2);
            PG_WAIT_V(8); PG_WAIT_L(0); PG_BAR; PG_MMA(0, 0, At, B0); PG_MMA(0, 1, At, B1); PG_BAR; PG_SCHED;
            PG_LDA(At, 1, 1); PG_STAGE(PG_SB(1, 0), b2, offB[0], k3); PG_STAGE(PG_SB(1, 1), b2, offB[1], k3); PG_STAGE(PG_SA(1, 0), a2, o2[0], k3);
            PG_WAIT_V(8); PG_WAIT_L(0); PG_BAR; PG_MMA(1, 0, At, B0); PG_MMA(1, 1, At, B1); PG_BAR; PG_SCHED;
        }
        if (wr == 0) PG_BAR;
        if constexpr (FP8) asm volatile("s_nop 15\n\ts_nop 15" ::: "memory");
        { int fr_ = fr, fq_ = fq; asm volatile("" : "+v"(fr_), "+v"(fq_));
          E(acc, cur, wr, wc, fr_, fq_);
#ifdef PROBE_EPI2
          asm volatile("" : "+v"(fr_), "+v"(fq_)); E(acc, cur, wr, wc, fr_, fq_);
#endif
        }
        if (!has_next) break;
#pragma unroll
        for (int a = 0; a < 2; ++a)
#pragma unroll
            for (int b = 0; b < 2; ++b)
#pragma unroll
                for (int m = 0; m < 4; ++m)
#pragma unroll
                    for (int n = 0; n < 2; ++n) acc[a][b][m][n] = (f32x4){0.f, 0.f, 0.f, 0.f};
        cur = nxt; cA = nA; cB = nB; ++ui;
#pragma unroll
        for (int h = 0; h < 2; ++h)
#pragma unroll
            for (int i = 0; i < 2; ++i) cOA[h][i] = nOA[h][i];
        if (wr == 1) PG_BAR;
    }
    PG_WAIT_V(0);
    PG_BAR;
#undef PG_SA
#undef PG_SB
#undef PG_STAGE
#undef PG_LDA
#undef PG_LDB
#undef PG_MMA
#undef PG_CAT8
#undef PG_WAIT_V
#undef PG_WAIT_L
#undef PG_BAR
#undef PG_SCHED
}

struct Order {
    int nM, nN, nwg, G, c;
    __device__ void init(int nM_, int nN_, int G_, int c_) { nM = nM_; nN = nN_; nwg = nM * nN; G = G_; c = c_; }
    __device__ bool get(int i, int& pm, int& pn) const {
        const long L = (long)i * G + c; if (L >= nwg) return false;
        int wgid = (int)L; { const int q = nwg / 8, r = nwg % 8, xcd = wgid % 8, off = wgid / 8; wgid = (xcd < r ? xcd * (q + 1) : r * (q + 1) + (xcd - r) * q) + off; }
        const int nig = 8 * nN, gid = wgid / nig, fm = gid * 8, gsz = (nM - fm) < 8 ? (nM - fm) : 8;
        pm = fm + ((wgid % nig) % gsz); pn = (wgid % nig) / gsz; return true;
    }
};
struct Dense {
    const char* A; const char* B; unsigned lda_bytes, ldb_bytes; int nt; Order ord; int pn_base = 0, pn_split = 1 << 30, pn_skip = 0, b_tile0 = 0;
    __device__ bool next(int i, Unit& u) const { u.g = 0; int pp; const bool ok = ord.get(i, u.pm, pp); u.pn = pn_base + pp + (pp >= pn_split ? pn_skip : 0); return ok; }
    __device__ const char* a_base(const Unit& u) const { return A + (size_t)u.pm * 256 * lda_bytes; }
    __device__ unsigned a_off(const Unit&, int row, int col) const { return (unsigned)row * lda_bytes + (unsigned)col * 2u; }
    __device__ const char* b_base(const Unit& u) const { return B + (size_t)(u.pn - b_tile0) * 256 * ldb_bytes; }
};
}

struct Frame {
    LAS unsigned char* lds;
    int tid, lane, wave, G, bid, dry;
    const float* in[30]; float* out; unsigned char* ws;
};
#define WSP(T_, off) ((T_*)(F.ws + (off)))
#define LDS_WAIT() asm volatile("s_waitcnt lgkmcnt(0)" ::: "memory")

template <class DstRow>
__device__ __forceinline__ void transpose_item(const float* W, int K, int N, bf16_t* WT, LAS float* scr, int item, int lane, const DstRow& dstrow) {
    const int nblk = (N + 63) / 64, kb = item / nblk, nb = item % nblk, k0 = 64 * kb, n0 = 64 * nb;
    const int kk = lane >> 4, n4 = (lane & 15) * 4;
    f32x4 v[16];
#pragma unroll
    for (int i = 0; i < 16; ++i) v[i] = *(const f32x4*)(W + (size_t)(k0 + 4 * i + kk) * N + n0 + n4);
#pragma unroll
    for (int i = 0; i < 16; ++i) { LAS float* d = scr + (4 * i + kk) * 65 + n4; d[0] = v[i].x; d[1] = v[i].y; d[2] = v[i].z; d[3] = v[i].w; }
    LDS_WAIT(); asm volatile("" ::: "memory");
    const int c = lane & 7;
#pragma unroll
    for (int j = 0; j < 8; ++j) { const int n = (lane >> 3) + 8 * j; const LAS float* p = scr + (8 * c) * 65 + n; const int dr = dstrow(n0 + n);
        if (dr >= 0) { u32x4 o; o.x = pk2(p[0], p[65]); o.y = pk2(p[130], p[195]); o.z = pk2(p[260], p[325]); o.w = pk2(p[390], p[455]);
            *(u32x4*)(WT + (size_t)dr * K + k0 + 8 * c) = o; } }
    LDS_WAIT(); asm volatile("" ::: "memory");
}
__device__ __forceinline__ void tr8_load(f32x4 (&v)[16], const float* W, int K, int N, int item, int lane) {
    const int nblk = (N + 63) / 64, kb = item / nblk, nb = item % nblk, k0 = 64 * kb, n0 = 64 * nb; const int kk = lane >> 4, n4 = (lane & 15) * 4;
#pragma unroll
    for (int i = 0; i < 16; ++i) v[i] = *(const f32x4*)(W + (size_t)(k0 + 4 * i + kk) * N + n0 + n4);
}
template <class DstRow>
__device__ __forceinline__ void tr8_process(const f32x4 (&v)[16], int K, int N, unsigned char* WT, LAS float* scr, int item, int lane, float scale, const DstRow& dstrow) {
    const int nblk = (N + 63) / 64, kb = item / nblk, nb = item % nblk, k0 = 64 * kb, n0 = 64 * nb; const int kk = lane >> 4, n4 = (lane & 15) * 4;
#pragma unroll
    for (int i = 0; i < 16; ++i) { LAS float* d = scr + (4 * i + kk) * 65 + n4; d[0] = v[i].x * scale; d[1] = v[i].y * scale; d[2] = v[i].z * scale; d[3] = v[i].w * scale; }
    LDS_WAIT(); asm volatile("" ::: "memory");
    const int c = lane & 3;
#pragma unroll
    for (int j = 0; j < 4; ++j) { const int n = (lane >> 2) + 16 * j; const LAS float* p = scr + (16 * c) * 65 + n; const int dr = dstrow(n0 + n);
        u32x4 o; o.x = pk4_fp8(p[0], p[65], p[130], p[195]); o.y = pk4_fp8(p[260], p[325], p[390], p[455]); o.z = pk4_fp8(p[520], p[585], p[650], p[715]); o.w = pk4_fp8(p[780], p[845], p[910], p[975]);
        *(u32x4*)(WT + (size_t)dr * K + k0 + 16 * c) = o; }
    LDS_WAIT(); asm volatile("" ::: "memory");
}
template <class DstRow>
__device__ __forceinline__ void transpose_item_fp8(const float* W, int K, int N, unsigned char* WT, LAS float* scr, int item, int lane, float scale, const DstRow& dstrow) {
    f32x4 v[16]; tr8_load(v, W, K, N, item, lane); tr8_process(v, K, N, WT, scr, item, lane, scale, dstrow);
}
__device__ __forceinline__ int win_dst_row(int c) {
    if (c < 512) return perm16_row(c);
    if (c < 1536) { const int isk = c >= 1024, cc = c - (isk ? 1024 : 512), t = cc >> 8, w = cc & 255; return ((isk ? 4 : 2) + t) * 256 + ((w >> 5) & 1) * 128 + (w >> 6) * 32 + ((w >> 2) & 1) * 16 + ((w >> 3) & 3) * 4 + (w & 3); }
    if (c < 2048) return 1536 + perm16_row(c - 1536);
    if (c < 2304) { const int w = c - 2048, head = w >> 5, bj = (w >> 4) & 1, dd = w & 15; return 2048 + bj * 128 + (head >> 1) * 32 + ((dd >> 2) & 1) * 16 + (2 * (head & 1) + (dd >> 3)) * 4 + (dd & 3); }
    if (c < 2336) { const int cc = c - 2304, half = cc >> 4, w = cc & 15; return 9 * 256 + half * 128 + w; }
    if (c < 2344) return 9 * 256 + 16 + (c - 2336);
    if (c < INC) return 2560 + perm16_row(c - 2344);
    return -1;
}
__device__ __forceinline__ void rms_row_to_bf16(const float* xrow, const float* gain, bf16_t* orow, unsigned char* orow8, int lane) {
    const f32x4* xr = (const f32x4*)xrow + lane; const f32x4* gr = (const f32x4*)gain + lane;
    f32x4 v[4]; float s = 0.f;
#pragma unroll
    for (int j = 0; j < 4; ++j) { v[j] = xr[64 * j]; s += (v[j].x * v[j].x + v[j].y * v[j].y) + (v[j].z * v[j].z + v[j].w * v[j].w); }
    const float rstd = 1.0f / sqrtf(wave_sum(s) * (1.f / 1024.f) + EPS);
    u32x2* o8 = (u32x2*)orow + lane;
#pragma unroll
    for (int j = 0; j < 4; ++j) { const f32x4 g = gr[64 * j]; const float a0 = v[j].x * rstd * g.x, a1 = v[j].y * rstd * g.y, a2 = v[j].z * rstd * g.z, a3 = v[j].w * rstd * g.w;
        u32x2 w; w.x = pk2(a0, a1); w.y = pk2(a2, a3); o8[64 * j] = w; ((unsigned*)orow8)[lane + 64 * j] = pk4_fp8(a0, a1, a2, a3); }
}

__device__ __forceinline__ void p0_prologue(Frame& F) {
    LAS float* scr = (LAS float*)(F.lds + F.wave * 16640);
    const int gw = F.bid * 8 + F.wave, NGW = F.G * 8;
    { unsigned* ctl = WSP(unsigned, WS_CTL); for (int i = F.bid * NTHR + F.tid; i < CTL_WORDS; i += F.G * NTHR) ctl[i] = 0u; }
    { float* c64 = WSP(float, WS_COS64); float* s64 = WSP(float, WS_SIN64); float* c32 = WSP(float, WS_COS32); float* s32 = WSP(float, WS_SIN32);
      for (int i = F.bid * NTHR + F.tid; i < 4096 * 48; i += F.G * NTHR) {
          if (i < 4096 * 32) { const int pos = i >> 5, k = i & 31; const float inv = powf(10000.0f, -(float)k * (2.0f / 64.0f)); const float a = (float)pos * inv; c64[i] = cosf(a); s64[i] = sinf(a); }
          else { const int j = i - 4096 * 32, pos = j >> 4, k = j & 15; const float inv = powf(10000.0f, -(float)k * (2.0f / 32.0f)); const float a = (float)pos * inv; c32[j] = cosf(a); s32[j] = sinf(a); } } }
    { bf16_t* WT = WSP(bf16_t, WS_WINT) + (size_t)256 * 1024; unsigned char* W8 = WSP(unsigned char, WS_WIN8) + (size_t)9 * 256 * 1024;
      for (int i = F.bid * NTHR + F.tid; i < 256 * 128; i += F.G * NTHR) { const int row = i >> 7, ch = i & 127; const int w = row & 127, half = row >> 7;
          const bool used = (w < 16) || (half == 0 && w < 24); if (!used) { *(u32x4*)(WT + (size_t)row * 1024 + ch * 8) = (u32x4){0u, 0u, 0u, 0u}; if (ch < 64) *(u32x4*)(W8 + (size_t)row * 1024 + ch * 16) = (u32x4){0u, 0u, 0u, 0u}; } } }
    constexpr int I_WIN = ((INC + 63) / 64) * (1024 / 64), I_GLU = (512 / 64) * (512 / 64), I_SB = (1024 / 64) * (512 / 64), I_AB = I_SB, I_O = (1024 / 64) * (1024 / 64), I_PG = I_O, I_PP = (1024 / 64) * (256 / 64);
    constexpr int I_E = (1024 / 64) * (1024 / 64);
    constexpr int NDENSE = I_WIN + I_GLU + I_SB + I_AB + I_O + I_PG + I_PP;
    auto p16 = [](int n) { return perm16_row(n); };
    for (int it = gw; it < NDENSE; it += NGW) {
        int r = it;
        if (r < I_WIN) {
            const int nblk = (INC + 63) / 64, nb = r % nblk;
            if (nb * 64 + 64 <= INC) { transpose_item_fp8(F.in[2], 1024, INC, WSP(unsigned char, WS_WIN8), scr, r, F.lane, 32.0f, [](int n) { return win_dst_row(n); });
                if (nb * 64 + 64 > 2048 && nb * 64 < 2344) transpose_item(F.in[2], 1024, INC, WSP(bf16_t, WS_WINT), scr, r, F.lane, [](int n) { const int d = win_dst_row(n); return (d >= 2048 && d < 2560) ? d - 2048 : -1; }); }
            else { const int kb = r / nblk, k0 = 64 * kb, n0 = 64 * nb; const int n = n0 + F.lane; const int dr = n < INC ? win_dst_row(n) : -1;
                if (dr >= 0) { unsigned char* o = WSP(unsigned char, WS_WIN8) + (size_t)dr * 1024 + k0;
                    for (int k = 0; k < 64; k += 4) *(unsigned*)(o + k) = pk4_fp8(32.0f * F.in[2][(size_t)(k0 + k) * INC + n], 32.0f * F.in[2][(size_t)(k0 + k + 1) * INC + n], 32.0f * F.in[2][(size_t)(k0 + k + 2) * INC + n], 32.0f * F.in[2][(size_t)(k0 + k + 3) * INC + n]); } }
            continue; } r -= I_WIN;
        if (r < I_GLU) { transpose_item(F.in[12], 512, 512, WSP(bf16_t, WS_WGLUT), scr, r, F.lane, p16); continue; } r -= I_GLU;
        if (r < I_SB) { transpose_item_fp8(F.in[14], 512, 1024, WSP(unsigned char, WS_WSB8), scr, r, F.lane, 32.0f, p16); continue; } r -= I_SB;
        if (r < I_AB) { transpose_item_fp8(F.in[15], 512, 1024, WSP(unsigned char, WS_WAB8), scr, r, F.lane, 32.0f, p16); continue; } r -= I_AB;
        if (r < I_O) { transpose_item_fp8(F.in[16], 1024, 1024, WSP(unsigned char, WS_WO8), scr, r, F.lane, 32.0f, p16); continue; } r -= I_O;
        if (r < I_PG) { transpose_item_fp8(F.in[27], 1024, 1024, WSP(unsigned char, WS_WPG8), scr, r, F.lane, 32.0f, p16); continue; } r -= I_PG;
        transpose_item(F.in[28], 256, 1024, WSP(bf16_t, WS_WPPT), scr, r, F.lane, p16);
    }
    for (int m = gw; m < T; m += NGW) rms_row_to_bf16(F.in[0] + (size_t)m * 1024, F.in[17], WSP(bf16_t, WS_E) + (size_t)m * 1024, WSP(unsigned char, WS_H8) + (size_t)m * 1024, F.lane);
}

__device__ __forceinline__ void p0_s5_tables(Frame& F) {
    LAS float* zr = (LAS float*)F.lds; LAS float* zi = zr + 64; LAS float* bbr = zi + 64; LAS float* bbi = bbr + 1024; LAS float* Lr = bbi + 1024; LAS float* Li = Lr + 512;
    const float* lam_re = F.in[4]; const float* lam_im = F.in[5]; const float* log_dt = F.in[6]; const float* b_re = F.in[7]; const float* b_im = F.in[8];
    const float* c_re = F.in[9]; const float* c_im = F.in[10]; const float* d_skip = F.in[11];
    float* Kg = WSP(float, WS_KG); float* L64 = WSP(float, WS_L64); bf16_t* Wg = WSP(bf16_t, WS_WG); bf16_t* TV = WSP(bf16_t, WS_TV);
    for (int it = F.bid; it < 256; it += F.G) {
        const int g = it >> 3, sub = it & 7, tid = F.tid;
        __syncthreads();
        const float dt = expf(log_dt[g]);
        if (tid < 64) { zr[tid] = lam_re[g * 64 + tid] * dt; zi[tid] = lam_im[g * 64 + tid] * dt; }
        __syncthreads();
        for (int idx = tid; idx < 1024; idx += NTHR) { const int p = idx >> 4, hp = idx & 15;
            const float lr = lam_re[g * 64 + p], li = lam_im[g * 64 + p];
            const float er = expf(zr[p]), cr = er * cosf(zi[p]), ci = er * sinf(zi[p]);
            const float nr = cr - 1.0f, ni = ci, den = lr * lr + li * li;
            const float fr_ = (nr * lr + ni * li) / den, fi_ = (ni * lr - nr * li) / den;
            const float br = b_re[(g * 64 + p) * 16 + hp], bi = b_im[(g * 64 + p) * 16 + hp];
            bbr[idx] = fr_ * br - fi_ * bi; bbi[idx] = fr_ * bi + fi_ * br; }
        { const int lagl = tid >> 6, p = tid & 63; const float n = (float)(8 * sub + lagl); const float mag = expf(n * zr[p]), a = n * zi[p]; Lr[tid] = mag * cosf(a); Li[tid] = mag * sinf(a); }
        __syncthreads();
#pragma unroll 1
        for (int j = 0; j < 4; ++j) { const int o = tid + 512 * j, lagl = o >> 8, h = (o >> 4) & 15, hp = o & 15; float s = 0.f;
            for (int p = 0; p < 64; ++p) { const float cr = c_re[(g * 16 + h) * 64 + p], ci = c_im[(g * 16 + h) * 64 + p], lr = Lr[lagl * 64 + p], li = Li[lagl * 64 + p];
                const float tr = cr * lr - ci * li, ti = cr * li + ci * lr; s += tr * bbr[p * 16 + hp] - ti * bbi[p * 16 + hp]; }
            const int lag = 8 * sub + lagl; if (lag == 0 && h == hp) s += d_skip[g * 16 + h];
            Kg[((g * 64 + lag) * 16 + h) * 16 + hp] = s; }
        { const int pl = tid >> 6, j = tid & 63, p = 8 * sub + pl;
          { const float n = (float)(63 - j); const float mag = expf(n * zr[p]), a = n * zi[p]; const float er = mag * cosf(a), ei = mag * sinf(a);
            unsigned wre[8], wim[8];
#pragma unroll
            for (int q = 0; q < 8; ++q) { const float b0r = bbr[p * 16 + 2 * q], b0i = bbi[p * 16 + 2 * q], b1r = bbr[p * 16 + 2 * q + 1], b1i = bbi[p * 16 + 2 * q + 1];
                wre[q] = pk2(er * b0r - ei * b0i, er * b1r - ei * b1i); wim[q] = pk2(er * b0i + ei * b0r, er * b1i + ei * b1r); }
            u32x4* dre = (u32x4*)(Wg + (size_t)(g * 128 + p) * 1024 + j * 16); u32x4* dim = (u32x4*)(Wg + (size_t)(g * 128 + 64 + p) * 1024 + j * 16);
            dre[0] = (u32x4){wre[0], wre[1], wre[2], wre[3]}; dre[1] = (u32x4){wre[4], wre[5], wre[6], wre[7]};
            dim[0] = (u32x4){wim[0], wim[1], wim[2], wim[3]}; dim[1] = (u32x4){wim[4], wim[5], wim[6], wim[7]}; }
          { const int t = j; const float n = (float)(t + 1); const float mag = expf(n * zr[p]), a = n * zi[p]; const float er = mag * cosf(a), ei = mag * sinf(a);
#pragma unroll 4
            for (int h = 0; h < 16; ++h) { const float cr = c_re[(g * 16 + h) * 64 + p], ci = c_im[(g * 16 + h) * 64 + p];
                bf16_t* d = TV + (size_t)(g * 1024 + t * 16 + h) * 1152 + 1024 + p;
                d[0] = (bf16_t)f2bf(cr * er - ci * ei); d[64] = (bf16_t)f2bf(-(cr * ei + ci * er)); } }
          if (sub == 0 && tid < 64) { const float mag = expf(64.0f * zr[tid]), a = 64.0f * zi[tid]; L64[(g * 64 + tid) * 2] = mag * cosf(a); L64[(g * 64 + tid) * 2 + 1] = mag * sinf(a); }
        }
    }
    __syncthreads();
}
__device__ __forceinline__ void fill_tv_item(unsigned char* wsb, int tid, int item) {
    const float* Kg = (const float*)(wsb + WS_KG); bf16_t* TV = (bf16_t*)(wsb + WS_TV);
#pragma unroll 4
    for (int it = 0; it < 16; ++it) { const int ci = (item * 16 + it) * NTHR + tid;
        const int g = ci >> 17, row = (ci >> 7) & 1023, ch = ci & 127, t = row >> 4, h = row & 15, j = ch >> 1, h0 = (ch & 1) * 8, lag = t - j;
        u32x4 o = (u32x4){0u, 0u, 0u, 0u};
        if (lag >= 0) { const f32x4* sp = (const f32x4*)(Kg + ((g * 64 + lag) * 16 + h) * 16 + h0); const f32x4 a = sp[0], b = sp[1];
            o.x = pk2(a.x, a.y); o.y = pk2(a.z, a.w); o.z = pk2(b.x, b.y); o.w = pk2(b.z, b.w); }
        *(u32x4*)(TV + (size_t)(g * 1024 + row) * 1152 + ch * 8) = o; }
}

struct EpiInProj {
    bf16_t *U, *Q, *K, *V, *QI, *KI, *GS, *GA; float* WI; const float *bg, *c64, *s64, *c32, *s32; float ascale;
    __device__ __forceinline__ void operator()(f32x4 (&acc)[2][2][4][2], const pg::Unit& u, int wr, int wc, int fr, int fq) const {
        const int pn = u.pn, row0 = u.pm * 256 + wr * 64 + fr;
        if (ascale != 1.0f) {
#pragma unroll
            for (int a_ = 0; a_ < 2; ++a_)
#pragma unroll
                for (int b_ = 0; b_ < 2; ++b_)
#pragma unroll
                    for (int m_ = 0; m_ < 4; ++m_)
#pragma unroll
                        for (int n_ = 0; n_ < 2; ++n_) acc[a_][b_][m_][n_] *= ascale; }
        auto st32 = [](bf16_t* d, const f32x4& a, const f32x4& b) { const u32x2 x = pkbf4(a), y = pkbf4(b); *(u32x4*)d = (u32x4){x.x, x.y, y.x, y.y}; };
        if (pn < 2 || pn == 6 || pn == 7) {
            const int c0 = (pn & 1) * 256 + wc * 64 + fq * 16;
#pragma unroll
            for (int ai = 0; ai < 2; ++ai)
#pragma unroll
                for (int m = 0; m < 4; ++m) { const int r = row0 + ai * 128 + m * 16;
                    bf16_t* d = pn < 2 ? U + ((size_t)((c0 >> 4) * 512 + (r >> 6)) * 1152 + (r & 63) * 16) : V + (size_t)r * 512 + c0;
                    st32(d, acc[ai][0][m][0], acc[ai][0][m][1]); st32(d + 8, acc[ai][1][m][0], acc[ai][1][m][1]); }
        } else if (pn < 6) {
            bf16_t* O = pn < 4 ? Q : K; const float sc = pn < 4 ? C2 : 1.0f; const int head = (pn & 1) * 4 + wc, dd = fq * 8;
#pragma unroll
            for (int ai = 0; ai < 2; ++ai)
#pragma unroll
                for (int m = 0; m < 4; ++m) { const int r = row0 + ai * 128 + m * 16, l = r & 4095; bf16_t* d = O + (size_t)r * 512 + head * 64 + dd; f32x4 o1[2], o2[2];
#pragma unroll
                    for (int n = 0; n < 2; ++n) { const f32x4 cs = *(const f32x4*)(c64 + l * 32 + dd + 4 * n), sn = *(const f32x4*)(s64 + l * 32 + dd + 4 * n); const f32x4 x1 = acc[ai][0][m][n], x2 = acc[ai][1][m][n];
                        o1[n] = (x1 * cs - x2 * sn) * sc; o2[n] = (x2 * cs + x1 * sn) * sc; }
                    st32(d, o1[0], o1[1]); st32(d + 32, o2[0], o2[1]); }
        } else if (pn == 8) {
            const int head = 2 * wc + (fq >> 1), dd = (fq & 1) * 8;
#pragma unroll
            for (int ai = 0; ai < 2; ++ai)
#pragma unroll
                for (int m = 0; m < 4; ++m) { const int r = row0 + ai * 128 + m * 16, l = r & 4095; bf16_t* d = QI + (size_t)r * 256 + head * 32 + dd; f32x4 o1[2], o2[2];
#pragma unroll
                    for (int n = 0; n < 2; ++n) { const f32x4 cs = *(const f32x4*)(c32 + l * 16 + dd + 4 * n), sn = *(const f32x4*)(s32 + l * 16 + dd + 4 * n); const f32x4 x1 = acc[ai][0][m][n], x2 = acc[ai][1][m][n];
                        o1[n] = x1 * cs - x2 * sn; o2[n] = x2 * cs + x1 * sn; }
                    st32(d, o1[0], o1[1]); st32(d + 16, o2[0], o2[1]); }
        } else if (pn == 9) {
            if (wc == 0) {
#pragma unroll
                for (int ai = 0; ai < 2; ++ai)
#pragma unroll
                    for (int m = 0; m < 4; ++m) { const int r = row0 + ai * 128 + m * 16, l = r & 4095;
                        const f32x4 cs = *(const f32x4*)(c32 + l * 16 + fq * 4), sn = *(const f32x4*)(s32 + l * 16 + fq * 4);
                        const f32x4 x1 = acc[ai][0][m][0], x2 = acc[ai][1][m][0]; const f32x4 o1 = x1 * cs - x2 * sn, o2 = x2 * cs + x1 * sn;
                        bf16_t* d = KI + (size_t)r * 32 + fq * 4; *(u32x2*)d = pkbf4(o1); *(u32x2*)(d + 16) = pkbf4(o2);
                        if (fq < 2) *(f32x4*)(WI + (size_t)r * 8 + fq * 4) = acc[ai][0][m][1]; } }
        } else {
            const int gc = (pn - 10) * 256 + wc * 64 + fq * 16; f32x4 b[4];
#pragma unroll
            for (int q = 0; q < 4; ++q) b[q] = *(const f32x4*)(bg + gc + 4 * q);
            unsigned char* O = (unsigned char*)GS + (gc < 1024 ? (size_t)gc : (size_t)T * 1024 + (gc - 1024));
#pragma unroll
            for (int ai = 0; ai < 2; ++ai)
#pragma unroll
                for (int m = 0; m < 4; ++m) { const int r = row0 + ai * 128 + m * 16;
                    *(u32x4*)(O + (size_t)r * 1024) = (u32x4){pkf84(sig4(acc[ai][0][m][0] + b[0])), pkf84(sig4(acc[ai][0][m][1] + b[1])), pkf84(sig4(acc[ai][1][m][0] + b[2])), pkf84(sig4(acc[ai][1][m][1] + b[3]))}; }
        }
    }
};

__device__ __forceinline__ void idx_score_tile(bf16x8 k0, bf16x8 k1, const bf16x8 (&qp)[2], const bf16x8 (&qf)[8][2], const float (&w)[8], float (&sc)[16]) {
    const f32x16 z = (f32x16){0.f, 0.f, 0.f, 0.f, 0.f, 0.f, 0.f, 0.f, 0.f, 0.f, 0.f, 0.f, 0.f, 0.f, 0.f, 0.f};
    f32x16 lin = __builtin_amdgcn_mfma_f32_32x32x16_bf16(k0, qp[0], z, 0, 0, 0); lin = __builtin_amdgcn_mfma_f32_32x32x16_bf16(k1, qp[1], lin, 0, 0, 0);
    f32x16 dA = __builtin_amdgcn_mfma_f32_32x32x16_bf16(k0, qf[0][0], z, 0, 0, 0); dA = __builtin_amdgcn_mfma_f32_32x32x16_bf16(k1, qf[0][1], dA, 0, 0, 0);
#pragma unroll
    for (int r = 0; r < 16; ++r) sc[r] = lin[r];
#pragma unroll
    for (int h = 0; h < 8; ++h) {
        f32x16 dB = z;
        if (h < 7) { dB = __builtin_amdgcn_mfma_f32_32x32x16_bf16(k0, qf[h + 1][0], z, 0, 0, 0); dB = __builtin_amdgcn_mfma_f32_32x32x16_bf16(k1, qf[h + 1][1], dB, 0, 0, 0); }
#pragma unroll
        for (int r = 0; r < 16; ++r) sc[r] = __builtin_fmaf(w[h], __builtin_fabsf(dA[r]), sc[r]);
        asm volatile("" : "+v"(sc[0]), "+v"(sc[1]), "+v"(sc[2]), "+v"(sc[3]), "+v"(sc[4]), "+v"(sc[5]), "+v"(sc[6]), "+v"(sc[7]), "+v"(k0));
        asm volatile("" : "+v"(sc[8]), "+v"(sc[9]), "+v"(sc[10]), "+v"(sc[11]), "+v"(sc[12]), "+v"(sc[13]), "+v"(sc[14]), "+v"(sc[15]), "+v"(k1));
        dA = dB;
    }
}
__device__ __forceinline__ unsigned h16_of(float s) { const _Float16 hf = (_Float16)s; return (unsigned)__builtin_bit_cast(unsigned short, hf); }
__device__ __forceinline__ void idx_scan(const LAS unsigned* hq, unsigned need, int mode, unsigned& fb, unsigned& frem) {
    unsigned cum = 0; fb = 0; frem = 1; bool found = false;
    for (int k = 0; k < 256; ++k) { const int bin = mode == 0 ? (k < 128 ? 127 - k : k) : mode == 1 ? 255 - k : k; const unsigned c = hq[bin * 32];
        if (!found && cum + c >= need) { fb = (unsigned)bin; frem = need - cum; found = true; } cum += c; }
}
__device__ __forceinline__ void idx_phase(Frame& F) {
    LAS unsigned* hist = (LAS unsigned*)F.lds;
    LAS unsigned* b1s = hist + 16384; LAS unsigned* r1s = b1s + 64; LAS unsigned* ths = r1s + 64;
    const bf16_t* QI = WSP(bf16_t, WS_QIDX); const bf16_t* KI = WSP(bf16_t, WS_KIDX); const float* WI = WSP(float, WS_WIDX); unsigned* MASK = WSP(unsigned, WS_MASK);
    const int lane = F.lane, r32 = lane & 31, hi = lane >> 5, gq = F.wave & 1, ks = F.wave >> 1;
    LAS int* qslot = (LAS int*)(F.lds + 68 * 1024);
    unsigned* qhead = WSP(unsigned, WS_CTL) + CW_QIDX + (F.dry ? 16 : 0);
    for (;;) {
            __syncthreads();
            if (F.tid == 0) *qslot = (int)__hip_atomic_fetch_add(qhead, 1u, __ATOMIC_RELAXED, __HIP_MEMORY_SCOPE_AGENT);
            __syncthreads();
            const int qpos = *qslot; if (qpos >= 1024) break;
            if (qpos & 1) { if (!F.dry) fill_tv_item(F.ws, F.tid, qpos >> 1); continue; }
            const int un = qpos >> 1;
            const int qb = 63 - (un >> 3), b = un & 7;
            const int q0 = qb * 64 + gq * 32, tok = b * 4096 + q0 + r32, ntile = (qb + 1) * 2;
            bf16x8 qf[8][2], qp[2]; float w[8];
#pragma unroll
            for (int h = 0; h < 8; ++h)
#pragma unroll
                for (int k = 0; k < 2; ++k) qf[h][k] = *(const bf16x8*)(QI + (size_t)tok * 256 + h * 32 + k * 16 + hi * 8);
            { const f32x4 wa = *(const f32x4*)(WI + (size_t)tok * 8), wb = *(const f32x4*)(WI + (size_t)tok * 8 + 4); w[0] = wa.x; w[1] = wa.y; w[2] = wa.z; w[3] = wa.w; w[4] = wb.x; w[5] = wb.y; w[6] = wb.z; w[7] = wb.w; }
#pragma unroll
            for (int k = 0; k < 2; ++k) { float a[8];
#pragma unroll
                for (int j = 0; j < 8; ++j) a[j] = 0.f;
#pragma unroll
                for (int h = 0; h < 8; ++h)
#pragma unroll
                    for (int j = 0; j < 8; ++j) a[j] = __builtin_fmaf(w[h], bf2f((unsigned short)qf[h][k][j]), a[j]);
                u32x4 pkd; pkd.x = pk2(a[0], a[1]); pkd.y = pk2(a[2], a[3]); pkd.z = pk2(a[4], a[5]); pkd.w = pk2(a[6], a[7]); qp[k] = __builtin_bit_cast(bf16x8, pkd); }
            const bf16_t* kbase = KI + (size_t)(b * 4096 + r32) * 32 + hi * 8;
            LAS unsigned* hq = hist + gq * 8192 + r32;
            _Float16 theta = (_Float16)(-INFINITY); float sc[16]; bf16x8 kn0, kn1;
#define IDX_TILES(BODY) do { kn0 = *(const bf16x8*)(kbase + (size_t)ks * 1024); kn1 = *(const bf16x8*)(kbase + (size_t)ks * 1024 + 16); \
            for (int kt = ks; kt < ntile; kt += 4) { const bf16x8 kc0 = kn0, kc1 = kn1; \
                if (kt + 4 < ntile) { kn0 = *(const bf16x8*)(kbase + (size_t)(kt + 4) * 1024); kn1 = *(const bf16x8*)(kbase + (size_t)(kt + 4) * 1024 + 16); } \
                idx_score_tile(kc0, kc1, qp, qf, w, sc); BODY } } while (0)
            if (qb >= 4) {
                for (int i = F.tid; i < 16384; i += NTHR) hist[i] = 0u;
                __syncthreads();
                IDX_TILES({
                    _Pragma("unroll") for (int r = 0; r < 16; ++r) __hip_atomic_fetch_add(hq + (h16_of(sc[r]) >> 8) * 32, 1u, __ATOMIC_RELAXED, __HIP_MEMORY_SCOPE_WORKGROUP); });
                __syncthreads();
                if (ks == 0 && hi == 0) { unsigned fb, fr_; idx_scan(hq, 256u, 0, fb, fr_); b1s[gq * 32 + r32] = fb; r1s[gq * 32 + r32] = fr_; }
                __syncthreads();
                for (int i = F.tid; i < 16384; i += NTHR) hist[i] = 0u;
                __syncthreads();
                const unsigned b1 = b1s[gq * 32 + r32];
                IDX_TILES({
                    _Pragma("unroll") for (int r = 0; r < 16; ++r) { const unsigned hv = h16_of(sc[r]); if ((hv >> 8) == b1) __hip_atomic_fetch_add(hq + (hv & 255u) * 32, 1u, __ATOMIC_RELAXED, __HIP_MEMORY_SCOPE_WORKGROUP); } });
                __syncthreads();
                if (ks == 0 && hi == 0) { unsigned fb, fr_; const unsigned bb = b1s[gq * 32 + r32]; idx_scan(hq, r1s[gq * 32 + r32], bb < 128u ? 1 : 2, fb, fr_); ths[gq * 32 + r32] = (bb << 8) | fb; }
                __syncthreads();
                theta = __builtin_bit_cast(_Float16, (unsigned short)ths[gq * 32 + r32]);
            }
            IDX_TILES({
                unsigned bits = 0u;
                _Pragma("unroll") for (int r = 0; r < 16; ++r) bits |= ((_Float16)sc[r] >= theta ? 1u : 0u) << ((r & 3) + 8 * (r >> 2));
                bits <<= 4 * hi;
                bits |= (unsigned)__shfl_xor((int)bits, 32);
                if (hi == 0) MASK[(size_t)(b * 128 + kt) * 4096 + q0 + r32] = bits; });
#undef IDX_TILES
    }
}

constexpr int CV_IE = (1024 / 64) * (1024 / 64), CV_NITEMS = 3 * 32 * CV_IE, CV_NBLK = CV_NITEMS / 8;
__device__ __forceinline__ void expert_conv_item(LAS unsigned char* lds, unsigned char* ws, int wave, int lane, const float* wg_, const float* wu_, const float* wd_, int bitem) {
    LAS float* scr = (LAS float*)(lds + wave * 16640);
    const int r = bitem * 8 + wave, which = r / (32 * CV_IE), e = (r % (32 * CV_IE)) / CV_IE, item = r % CV_IE;
    auto w1row = [](int c) { const int pn = c >> 7, w = c & 127; return pn * 256 + (w & 96) + ((w >> 2) & 1) * 16 + ((w >> 3) & 3) * 4 + (w & 3); };
    const float* src = (which == 0 ? wg_ : which == 1 ? wu_ : wd_) + (size_t)e * 1024 * 1024;
    if (which == 0) transpose_item_fp8(src, 1024, 1024, ws + WS_W1T + (size_t)e * 2048 * 1024, scr, item, lane, 32.0f, w1row);
    else if (which == 1) transpose_item_fp8(src, 1024, 1024, ws + WS_W1T + (size_t)e * 2048 * 1024, scr, item, lane, 32.0f, [=](int c) { return w1row(c) + 128; });
    else transpose_item_fp8(src, 1024, 1024, ws + WS_W2T + (size_t)e * 1024 * 1024, scr, item, lane, 32.0f, [](int n) { return perm16_row(n); });
}
__device__ __forceinline__ s16x4 vtr(const LAS char* p) { typedef short v4i16_t __attribute__((ext_vector_type(4))); return __builtin_bit_cast(s16x4, __builtin_amdgcn_ds_read_tr16_b64_v4i16((LAS v4i16_t*)p)); }
__device__ __forceinline__ void glds16(const void* gsrc, unsigned lds_dst) {
    unsigned keep; asm volatile("s_mov_b32 %0, m0\n\ts_mov_b32 m0, %2\n\ts_nop 0\n\tglobal_load_lds_dwordx4 %1, off\n\ts_mov_b32 m0, %0" : "=&s"(keep) : "v"(gsrc), "s"(lds_dst) : "memory"); }
__device__ __forceinline__ void attn_phase(Frame& F) {
    const bf16_t* Q = WSP(bf16_t, WS_Q); const bf16_t* K = WSP(bf16_t, WS_K); const bf16_t* V = WSP(bf16_t, WS_V); unsigned char* O = F.dry ? WSP(unsigned char, WS_E) : WSP(unsigned char, WS_YA8); const unsigned* MASK = WSP(unsigned, WS_MASK);
    const int lane = F.lane, r32 = lane & 31, hi = lane >> 5, wv = F.wave;
    const LAS char* ldsc = (const LAS char*)F.lds;
    const unsigned lds0 = (unsigned)(uintptr_t)F.lds;
    constexpr int KOFF = 0, VOFF = 32768, MOFF = 65536;
    const float* const wg_ = F.in[21]; const float* const wu_ = F.in[23]; const float* const wd_ = F.in[25];
    LAS int* qslot = (LAS int*)(F.lds + LDS_BYTES_C - 128);
    unsigned* qhead = WSP(unsigned, WS_CTL) + CW_QATT + (F.dry ? 16 : 0);
    for (;;) {
            __syncthreads();
            if (F.tid == 0) *qslot = (int)__hip_atomic_fetch_add(qhead, 1u, __ATOMIC_RELAXED, __HIP_MEMORY_SCOPE_AGENT);
            __syncthreads();
            const int qp = *qslot; if (qp >= 1024 + CV_NBLK) break;
            if ((qp & 3) != 0 || qp >= 4096) { const int ci = qp < 4096 ? qp - (qp >> 2) - 1 : qp - 1024; if (!F.dry) expert_conv_item(F.lds, F.ws, F.wave, F.lane, wg_, wu_, wd_, ci); continue; }
            const int un = qp >> 2;
            const int qb = 15 - (un >> 6), b = (un >> 3) & 7, h = un & 7;
            const int q0 = qb * 256, NT = 4 * qb + 4, ntw = 4 * qb + (wv >> 1) + 1;
            const size_t tokq = (size_t)b * 4096 + q0 + wv * 32 + r32;
            const bf16_t* ksrc = K + ((size_t)b * 4096 + lane) * 512 + h * 64 + wv * 8;
            const bf16_t* vsrc = V + ((size_t)b * 4096 + 16 * (wv & 3) + (lane >> 2)) * 512 + h * 64 + (wv >> 2) * 32 + (lane & 3) * 8;
            const unsigned* msrc = MASK + ((size_t)b * 128 + (wv & 1)) * 4096 + q0 + lane * 4;
            const unsigned kdst = lds0 + KOFF + wv * 1024, vdst = lds0 + VOFF + wv * 1024, mdst = lds0 + MOFF + (wv & 1) * 1024;
#define ATT_DMA(t_) do { const int tt_ = (t_) < NT ? (t_) : NT - 1; const unsigned sl_ = (unsigned)((t_) & 3); \
        glds16(ksrc + (size_t)tt_ * 64 * 512, (unsigned)__builtin_amdgcn_readfirstlane(kdst + sl_ * 8192u)); \
        glds16(vsrc + (size_t)tt_ * 64 * 512, (unsigned)__builtin_amdgcn_readfirstlane(vdst + sl_ * 8192u)); \
        glds16(msrc + (size_t)tt_ * 2 * 4096, (unsigned)__builtin_amdgcn_readfirstlane(mdst + sl_ * 2048u)); } while (0)
            ATT_DMA(0); ATT_DMA(1); ATT_DMA(2);
            bf16x8 qr[4];
#pragma unroll
            for (int d0 = 0; d0 < 4; ++d0) qr[d0] = *(const bf16x8*)(Q + tokq * 512 + h * 64 + d0 * 16 + hi * 8);
            asm volatile("" : "+v"(qr[0]), "+v"(qr[1]), "+v"(qr[2]), "+v"(qr[3]));
            float m = 0.f; f32x16 o[2], o2, negm;
#pragma unroll
            for (int r = 0; r < 16; ++r) { o[0][r] = 0.f; o[1][r] = 0.f; o2[r] = 0.f; negm[r] = 0.f; }
            const unsigned onew = r32 == 0 ? 0x3f803f80u : 0u; const bf16x8 ones = __builtin_bit_cast(bf16x8, (u32x4){onew, onew, onew, onew});
            const int vlane = ((lane >> 4) & 1) * 32 + (lane & 3) * 8 + (4 * hi + ((lane & 15) >> 2)) * 64;
            for (int t = 0; t < NT; ++t) {
                asm volatile("s_waitcnt vmcnt(6)\n\ts_barrier" ::: "memory");
                ATT_DMA(t + 3);
                if (t < ntw) {
                    const int sl = t & 3;
                    const LAS char* Kb = ldsc + KOFF + sl * 8192; const LAS char* Vb = ldsc + VOFF + sl * 8192 + vlane; const LAS unsigned* Mb = (const LAS unsigned*)(ldsc + MOFF + sl * 2048) + wv * 32 + r32;
                    const int w0 = (int)(Mb[0] >> (4 * hi)), w1 = (int)(Mb[256] >> (4 * hi));
                    f32x16 p0, p1;
                    { const bf16x8 k0 = *(const LAS bf16x8*)(Kb + hi * 1024 + r32 * 16), k1 = *(const LAS bf16x8*)(Kb + hi * 1024 + r32 * 16 + 512);
                      p0 = __builtin_amdgcn_mfma_f32_32x32x16_bf16(k0, qr[0], negm, 0, 0, 0); p1 = __builtin_amdgcn_mfma_f32_32x32x16_bf16(k1, qr[0], negm, 0, 0, 0); }
#pragma unroll
                    for (int d0 = 1; d0 < 4; ++d0) { const bf16x8 k0 = *(const LAS bf16x8*)(Kb + d0 * 2048 + hi * 1024 + r32 * 16), k1 = *(const LAS bf16x8*)(Kb + d0 * 2048 + hi * 1024 + r32 * 16 + 512);
                        p0 = __builtin_amdgcn_mfma_f32_32x32x16_bf16(k0, qr[d0], p0, 0, 0, 0); p1 = __builtin_amdgcn_mfma_f32_32x32x16_bf16(k1, qr[d0], p1, 0, 0, 0); }
                    float rm = __builtin_fmaxf(p0[0], p1[0]);
#pragma unroll
                    for (int r = 1; r < 16; ++r) rm = __builtin_fmaxf(rm, __builtin_fmaxf(p0[r], p1[r]));
                    rm = __builtin_fmaxf(rm, __shfl_xor(rm, 32));
                    if (t == 0 || __any(rm > 0.f)) {
                        const float dl = t == 0 ? rm : __builtin_fmaxf(rm, 0.f), f = __builtin_amdgcn_exp2f(-dl);
                        m += dl;
#pragma unroll
                        for (int r = 0; r < 16; ++r) { negm[r] = -m; o[0][r] *= f; o[1][r] *= f; o2[r] *= f; p0[r] -= dl; p1[r] -= dl; }
                    }
#pragma unroll
                    for (int r = 0; r < 16; ++r) { const int bp = (r & 3) + 8 * (r >> 2);
                        p0[r] = __uint_as_float(__float_as_uint(__builtin_amdgcn_exp2f(p0[r])) & (unsigned)__builtin_amdgcn_sbfe(w0, bp, 1));
                        p1[r] = __uint_as_float(__float_as_uint(__builtin_amdgcn_exp2f(p1[r])) & (unsigned)__builtin_amdgcn_sbfe(w1, bp, 1)); }
                    u32x4 pw[4];
#pragma unroll
                    for (int q = 0; q < 4; ++q) { pw[0][q] = pk2(p0[2 * q], p0[2 * q + 1]); pw[1][q] = pk2(p0[8 + 2 * q], p0[8 + 2 * q + 1]); pw[2][q] = pk2(p1[2 * q], p1[2 * q + 1]); pw[3][q] = pk2(p1[8 + 2 * q], p1[8 + 2 * q + 1]); }
#pragma unroll
                    for (int d0 = 0; d0 < 2; ++d0)
#pragma unroll
                        for (int kk = 0; kk < 4; ++kk) { const s16x4 lo = vtr(Vb + d0 * 4096 + kk * 1024), hh = vtr(Vb + d0 * 4096 + kk * 1024 + 512);
                            const bf16x8 vf = (bf16x8){lo[0], lo[1], lo[2], lo[3], hh[0], hh[1], hh[2], hh[3]};
                            o[d0] = __builtin_amdgcn_mfma_f32_32x32x16_bf16(vf, __builtin_bit_cast(bf16x8, pw[kk]), o[d0], 0, 0, 0); }
#pragma unroll
                    for (int kk = 0; kk < 4; ++kk) o2 = __builtin_amdgcn_mfma_f32_32x32x16_bf16(ones, __builtin_bit_cast(bf16x8, pw[kk]), o2, 0, 0, 0);
                }
            }
            asm volatile("s_waitcnt vmcnt(0) lgkmcnt(0)\n\ts_barrier" ::: "memory");
#undef ATT_DMA
            const float lt = __shfl(o2[0], r32), inv = 1.0f / lt;
#pragma unroll
            for (int d0 = 0; d0 < 2; ++d0)
#pragma unroll
                for (int g4 = 0; g4 < 4; ++g4) { unsigned w = pk4_fp8(o[d0][4 * g4] * inv, o[d0][4 * g4 + 1] * inv, o[d0][4 * g4 + 2] * inv, o[d0][4 * g4 + 3] * inv);
#ifdef ABL_ATTN
                    w = 0u;
#endif
                    *(unsigned*)(O + tokq * 512 + h * 64 + d0 * 32 + g4 * 8 + hi * 4) = w; }
        }
}

struct ProbS5E {
    const char* U; const char* Wg; unsigned ldb_bytes; int nt, G, c;
    __device__ bool next(int i, pg::Unit& u) const { const int L = i * G + c; if (L >= 64) return false; u.g = L >> 1; u.pm = L & 1; u.pn = 0; return true; }
    __device__ const char* a_base(const pg::Unit& u) const { return U + ((size_t)u.g * 512 + u.pm * 256) * 2304; }
    __device__ unsigned a_off(const pg::Unit&, int row, int col) const { return (unsigned)row * 2304u + (unsigned)col * 2u; }
    __device__ const char* b_base(const pg::Unit& u) const { return Wg + (size_t)u.g * 128 * 2048; }
};
struct EpiS5E { float* E;
    __device__ __forceinline__ void operator()(f32x4 (&acc)[2][2][4][2], const pg::Unit& u, int wr, int wc, int fr, int fq) const {
#pragma unroll
        for (int ai = 0; ai < 2; ++ai)
#pragma unroll
            for (int m = 0; m < 4; ++m) { const int r = u.pm * 256 + ai * 128 + wr * 64 + m * 16 + fr;
#pragma unroll
                for (int n = 0; n < 2; ++n) *(f32x4*)(E + ((size_t)u.g * 512 + r) * 128 + wc * 32 + n * 16 + fq * 4) = acc[ai][0][m][n]; }
    }
};
__device__ __forceinline__ void s5_scan(Frame& F) {
    if (F.wave != 0) return;
    const float* E = WSP(float, WS_EF32); const float* L64 = WSP(float, WS_L64); bf16_t* U = WSP(bf16_t, WS_U);
    for (int gid = F.bid * 64 + F.lane; gid < 32 * 8 * 64; gid += F.G * 64) {
        const int p = gid & 63, b = (gid >> 6) & 7, g = gid >> 9;
        const float lr = L64[(g * 64 + p) * 2], li = L64[(g * 64 + p) * 2 + 1]; float sr = 0.f, si = 0.f;
        const size_t m0 = (size_t)g * 512 + b * 64;
#pragma unroll 1
        for (int c0 = 0; c0 < 64; c0 += 16) { float er[16], ei[16];
#pragma unroll
            for (int c = 0; c < 16; ++c) { er[c] = E[(m0 + c0 + c) * 128 + p]; ei[c] = E[(m0 + c0 + c) * 128 + 64 + p]; }
#pragma unroll
            for (int c = 0; c < 16; ++c) { const size_t m = m0 + c0 + c;
                U[m * 1152 + 1024 + p] = (bf16_t)f2bf(sr); U[m * 1152 + 1088 + p] = (bf16_t)f2bf(si);
                const float nr = lr * sr - li * si + er[c], ni = lr * si + li * sr + ei[c]; sr = nr; si = ni; } }
    }
}
struct ProbS5Y {
    const char* U; const char* TV; unsigned ldb_bytes; int nt, G, c;
    __device__ bool next(int i, pg::Unit& u) const { const int L = i * G + c; if (L >= 256) return false; u.g = L >> 3; u.pm = (L >> 2) & 1; u.pn = L & 3; return true; }
    __device__ const char* a_base(const pg::Unit& u) const { return U + ((size_t)u.g * 512 + u.pm * 256) * 2304; }
    __device__ unsigned a_off(const pg::Unit&, int row, int col) const { return (unsigned)row * 2304u + (unsigned)col * 2u; }
    __device__ const char* b_base(const pg::Unit& u) const { return TV + ((size_t)u.g * 1024 + u.pn * 256) * 2304; }
};
struct EpiS5Y { bf16_t* Y;
    __device__ __forceinline__ void operator()(f32x4 (&acc)[2][2][4][2], const pg::Unit& u, int wr, int wc, int fr, int fq) const {
#pragma unroll
        for (int ai = 0; ai < 2; ++ai)
#pragma unroll
            for (int m = 0; m < 4; ++m) { const int mm = u.pm * 256 + ai * 128 + wr * 64 + m * 16 + fr, b = mm >> 6, c = mm & 63;
#pragma unroll
                for (int bj = 0; bj < 2; ++bj)
#pragma unroll
                    for (int n = 0; n < 2; ++n) { const int nn = u.pn * 256 + bj * 128 + wc * 32 + n * 16 + fq * 4, t = nn >> 4, h = nn & 15; const f32x4 v = acc[ai][bj][m][n];
                        u32x2 w; w.x = pk2(gelu_tanh(v.x), gelu_tanh(v.y)); w.y = pk2(gelu_tanh(v.z), gelu_tanh(v.w));
#ifdef ABL_SSM
                        w.x = 0u; w.y = 0u;
#endif
                        *(u32x2*)(Y + ((size_t)b * 4096 + c * 64 + t) * 512 + u.g * 16 + h) = w; } }
    }
};

template <class Fn> __device__ __forceinline__ void epi_each(f32x4 (&acc)[2][2][4][2], const pg::Unit& u, int wr, int wc, int fr, int fq, const Fn& fn) {
#pragma unroll
    for (int ai = 0; ai < 2; ++ai)
#pragma unroll
        for (int m = 0; m < 4; ++m) { const int r = u.pm * 256 + ai * 128 + wr * 64 + m * 16 + fr;
#pragma unroll
            for (int bj = 0; bj < 2; ++bj)
#pragma unroll
                for (int n = 0; n < 2; ++n) fn(r, u.pn * 256 + bj * 128 + wc * 32 + n * 16 + fq * 4, acc[ai][bj][m][n]); }
}
template <class Fn> __device__ __forceinline__ void epi_each16(f32x4 (&acc)[2][2][4][2], const pg::Unit& u, int wr, int wc, int fr, int fq, const Fn& fn) {
#pragma unroll
    for (int ai = 0; ai < 2; ++ai)
#pragma unroll
        for (int m = 0; m < 4; ++m) fn(u.pm * 256 + ai * 128 + wr * 64 + m * 16 + fr, u.pn * 256 + wc * 64 + fq * 16, acc[ai][0][m][0], acc[ai][0][m][1], acc[ai][1][m][0], acc[ai][1][m][1]);
}
struct EpiGlu { const bf16_t* YS; unsigned char* Y2; const float* b;
    __device__ __forceinline__ void operator()(f32x4 (&acc)[2][2][4][2], const pg::Unit& u, int wr, int wc, int fr, int fq) const {
        epi_each16(acc, u, wr, wc, fr, fq, [&](int r, int c, const f32x4& v0, const f32x4& v1, const f32x4& v2, const f32x4& v3) {
            const f32x4* bp = (const f32x4*)(b + c); const u32x4 ya = *(const u32x4*)(YS + (size_t)r * 512 + c), yb = *(const u32x4*)(YS + (size_t)r * 512 + c + 8);
            u32x4 o; o.x = pkf84(bf4((u32x2){ya.x, ya.y}) * sig4(v0 + bp[0])); o.y = pkf84(bf4((u32x2){ya.z, ya.w}) * sig4(v1 + bp[1])); o.z = pkf84(bf4((u32x2){yb.x, yb.y}) * sig4(v2 + bp[2])); o.w = pkf84(bf4((u32x2){yb.z, yb.w}) * sig4(v3 + bp[3]));
            *(u32x4*)(Y2 + (size_t)r * 512 + c) = o; }); }
};
template <bool ADD> struct EpiMix { const unsigned char* Gt; bf16_t* MIX; unsigned char* MIX8;
    __device__ __forceinline__ void operator()(f32x4 (&acc)[2][2][4][2], const pg::Unit& u, int wr, int wc, int fr, int fq) const {
        epi_each16(acc, u, wr, wc, fr, fq, [&](int r, int c, const f32x4& v0, const f32x4& v1, const f32x4& v2, const f32x4& v3) {
            const u32x4 g = *(const u32x4*)(Gt + (size_t)r * 1024 + c);
            f32x4 o0 = f84(g.x) * v0 * 0.03125f, o1 = f84(g.y) * v1 * 0.03125f, o2 = f84(g.z) * v2 * 0.03125f, o3 = f84(g.w) * v3 * 0.03125f;
            if (ADD) { const u32x4 ma = *(const u32x4*)(MIX + (size_t)r * 1024 + c), mb = *(const u32x4*)(MIX + (size_t)r * 1024 + c + 8);
                o0 += bf4((u32x2){ma.x, ma.y}); o1 += bf4((u32x2){ma.z, ma.w}); o2 += bf4((u32x2){mb.x, mb.y}); o3 += bf4((u32x2){mb.z, mb.w});
                *(u32x4*)(MIX8 + (size_t)r * 1024 + c) = (u32x4){pkf84(o0), pkf84(o1), pkf84(o2), pkf84(o3)}; }
            else { const u32x2 a = pkbf4(o0), b_ = pkbf4(o1), c_ = pkbf4(o2), d = pkbf4(o3);
                *(u32x4*)(MIX + (size_t)r * 1024 + c) = (u32x4){a.x, a.y, b_.x, b_.y}; *(u32x4*)(MIX + (size_t)r * 1024 + c + 8) = (u32x4){c_.x, c_.y, d.x, d.y}; } }); }
};
struct EpiStoreBf { bf16_t* O; int ldo; float sc;
    __device__ __forceinline__ void operator()(f32x4 (&acc)[2][2][4][2], const pg::Unit& u, int wr, int wc, int fr, int fq) const {
        epi_each16(acc, u, wr, wc, fr, fq, [&](int r, int c, const f32x4& v0, const f32x4& v1, const f32x4& v2, const f32x4& v3) {
            const u32x2 a = pkbf4(v0 * sc), b_ = pkbf4(v1 * sc), c_ = pkbf4(v2 * sc), d = pkbf4(v3 * sc);
            *(u32x4*)(O + (size_t)r * ldo + c) = (u32x4){a.x, a.y, b_.x, b_.y}; *(u32x4*)(O + (size_t)r * ldo + c + 8) = (u32x4){c_.x, c_.y, d.x, d.y}; }); }
};
struct EpiPleNorm { const bf16_t* R2; const bf16_t* PROJ; float* OUT; const float* gain; float* xbuf; unsigned* pcnt; LAS float* Pl; LAS float* Sl;
    __device__ __forceinline__ void operator()(f32x4 (&acc)[2][2][4][2], const pg::Unit& u, int wr, int wc, int fr, int fq) const {
        const int tid = (wr * 4 + wc) * 64 + fq * 16 + fr;
        const int c0 = u.pn * 256 + wc * 64 + fq * 16;
#pragma unroll
        for (int ai = 0; ai < 2; ++ai)
#pragma unroll
            for (int m = 0; m < 4; ++m) { const size_t r = (size_t)u.pm * 256 + ai * 128 + wr * 64 + m * 16 + fr;
                const u32x4 ra = *(const u32x4*)(R2 + r * 1024 + c0), rb = *(const u32x4*)(R2 + r * 1024 + c0 + 8), pa = *(const u32x4*)(PROJ + r * 1024 + c0), pb = *(const u32x4*)(PROJ + r * 1024 + c0 + 8);
                acc[ai][0][m][0] = bf4((u32x2){ra.x, ra.y}) + sig4(acc[ai][0][m][0] * 0.03125f) * bf4((u32x2){pa.x, pa.y});
                acc[ai][0][m][1] = bf4((u32x2){ra.z, ra.w}) + sig4(acc[ai][0][m][1] * 0.03125f) * bf4((u32x2){pa.z, pa.w});
                acc[ai][1][m][0] = bf4((u32x2){rb.x, rb.y}) + sig4(acc[ai][1][m][0] * 0.03125f) * bf4((u32x2){pb.x, pb.y});
                acc[ai][1][m][1] = bf4((u32x2){rb.z, rb.w}) + sig4(acc[ai][1][m][1] * 0.03125f) * bf4((u32x2){pb.z, pb.w});
                asm volatile("" : "+v"(acc[ai][0][m][0]), "+v"(acc[ai][0][m][1]), "+v"(acc[ai][1][m][0]), "+v"(acc[ai][1][m][1]));
                if (m & 1) asm volatile("" ::: "memory"); }
#pragma unroll
        for (int ai = 0; ai < 2; ++ai)
#pragma unroll
            for (int m = 0; m < 4; ++m) { float q = 0.f;
#pragma unroll
                for (int bj = 0; bj < 2; ++bj)
#pragma unroll
                    for (int n = 0; n < 2; ++n) { const f32x4 x = acc[ai][bj][m][n]; q += (x[0] * x[0] + x[1] * x[1]) + (x[2] * x[2] + x[3] * x[3]); }
                q += __shfl_xor(q, 16); q += __shfl_xor(q, 32);
                if (fq == 0) Pl[(ai * 128 + wr * 64 + m * 16 + fr) * 4 + wc] = q; }
        asm volatile("s_waitcnt lgkmcnt(0)" ::: "memory"); __builtin_amdgcn_s_barrier(); asm volatile("" ::: "memory");
        if (tid < 256) { const float t = (Pl[tid * 4 + 0] + Pl[tid * 4 + 1]) + (Pl[tid * 4 + 2] + Pl[tid * 4 + 3]);
            __hip_atomic_store(xbuf + ((size_t)u.pm * 256 + tid) * 4 + u.pn, t, __ATOMIC_RELAXED, __HIP_MEMORY_SCOPE_AGENT); }
        asm volatile("s_waitcnt vmcnt(0) lgkmcnt(0)" ::: "memory"); __builtin_amdgcn_s_barrier(); asm volatile("" ::: "memory");
        if (tid == 0) { __hip_atomic_fetch_add(pcnt + u.pm, 1u, __ATOMIC_RELAXED, __HIP_MEMORY_SCOPE_AGENT);
            unsigned sp = 0; while (__hip_atomic_load(pcnt + u.pm, __ATOMIC_RELAXED, __HIP_MEMORY_SCOPE_AGENT) < 4u) { __builtin_amdgcn_s_sleep(2); if (++sp > (1u << 22)) break; }
            __builtin_amdgcn_fence(__ATOMIC_ACQUIRE, "agent"); }
        asm volatile("s_waitcnt vmcnt(0) lgkmcnt(0)" ::: "memory"); __builtin_amdgcn_s_barrier(); asm volatile("" ::: "memory");
        if (tid < 256) { const float* sl = xbuf + ((size_t)u.pm * 256 + tid) * 4;
            const float a0 = __hip_atomic_load(sl + 0, __ATOMIC_RELAXED, __HIP_MEMORY_SCOPE_AGENT), a1 = __hip_atomic_load(sl + 1, __ATOMIC_RELAXED, __HIP_MEMORY_SCOPE_AGENT), a2 = __hip_atomic_load(sl + 2, __ATOMIC_RELAXED, __HIP_MEMORY_SCOPE_AGENT), a3 = __hip_atomic_load(sl + 3, __ATOMIC_RELAXED, __HIP_MEMORY_SCOPE_AGENT);
            Sl[tid] = 1.0f / sqrtf(((a0 + a1) + (a2 + a3)) * (1.f / 1024.f) + EPS); }
        asm volatile("s_waitcnt vmcnt(0) lgkmcnt(0)" ::: "memory"); __builtin_amdgcn_s_barrier(); asm volatile("" ::: "memory");
        f32x4 gv[4];
#pragma unroll
        for (int q = 0; q < 4; ++q) gv[q] = *(const f32x4*)(gain + c0 + 4 * q);
#pragma unroll
        for (int ai = 0; ai < 2; ++ai)
#pragma unroll
            for (int m = 0; m < 4; ++m) { const int rl = ai * 128 + wr * 64 + m * 16 + fr; const float rs = Sl[rl]; f32x4* op = (f32x4*)(OUT + ((size_t)u.pm * 256 + rl) * 1024 + c0);
                op[0] = acc[ai][0][m][0] * rs * gv[0]; op[1] = acc[ai][0][m][1] * rs * gv[1]; op[2] = acc[ai][1][m][0] * rs * gv[2]; op[3] = acc[ai][1][m][1] * rs * gv[3]; }
        asm volatile("s_waitcnt lgkmcnt(0)" ::: "memory"); __builtin_amdgcn_s_barrier(); asm volatile("" ::: "memory");
    }
};

__device__ __forceinline__ void router_phase(Frame& F) {
    constexpr int WST = 1032;
    LAS bf16_t* whi = (LAS bf16_t*)F.lds; LAS bf16_t* wlo = whi + 32 * WST;
    LAS unsigned* lcnt = (LAS unsigned*)(F.lds + 2 * 32 * WST * 2);
    LAS unsigned* gbase = lcnt + 32;
    LAS unsigned* ent_e = gbase + 32;
    LAS float* ent_w = (LAS float*)(ent_e + 512);
    const float* Wr = F.in[19]; const float* br = F.in[20]; const float* gain = F.in[18]; const float* X = F.in[0];
    const bf16_t* D1 = (const bf16_t*)F.out + (size_t)T * 1024;
    unsigned char* H2 = F.dry ? WSP(unsigned char, WS_A) : (unsigned char*)F.out;
    unsigned* cnt = WSP(unsigned, WS_CTL) + CW_CNT + (F.dry ? 32 : 0); int* LTOK = F.dry ? (int*)(F.ws + WS_A + 70 * MB) : WSP(int, WS_LTOK); int* LSLOT = F.dry ? (int*)(F.ws + WS_A + 75 * MB) : WSP(int, WS_LSLOT); float* LWT = F.dry ? (float*)(F.ws + WS_A + 80 * MB) : WSP(float, WS_LWT);
    { f32x4 wv[16];
#pragma unroll
      for (int q = 0; q < 16; ++q) wv[q] = *((const f32x4*)Wr + F.tid + q * NTHR);
#pragma unroll
      for (int q = 0; q < 16; ++q) { const int i4 = F.tid + q * NTHR, k = i4 >> 3, e0 = (i4 & 7) * 4; const float g = gain[k];
#pragma unroll
          for (int c = 0; c < 4; ++c) { const float v = wv[q][c] * g; const unsigned h = f2bf(v); const float vh = __builtin_bit_cast(float, h << 16);
              whi[(e0 + c) * WST + k] = (bf16_t)h; wlo[(e0 + c) * WST + k] = (bf16_t)f2bf(v - vh); } } }
    const int lane = F.lane, tl = lane & 15, kq = lane >> 4;
    for (int tb = F.bid; tb < T / 128; tb += F.G) {
        if (F.tid < 32) lcnt[F.tid] = 0u;
        if (!F.dry) { const f32x4* ps = (const f32x4*)(F.in[1] + (size_t)tb * 128 * 256); u32x2* pd = (u32x2*)(WSP(bf16_t, WS_PBF) + (size_t)tb * 128 * 256);
#pragma unroll 4
            for (int q = 0; q < 16; ++q) { const f32x4 v = ps[F.tid + q * NTHR]; u32x2 w; w.x = pk2(v.x, v.y); w.y = pk2(v.z, v.w); pd[F.tid + q * NTHR] = w; } }
        __syncthreads();
        const int tok0 = tb * 128 + F.wave * 16, tok = tok0 + tl;
        const float* xrow = X + (size_t)tok * 1024 + 8 * kq; const bf16_t* drow = D1 + (size_t)tok * 1024 + 8 * kq;
        f32x4 acc[2]; acc[0] = (f32x4){0.f, 0.f, 0.f, 0.f}; acc[1] = acc[0]; float ss = 0.f;
#pragma unroll 16
        for (int st = 0; st < 32; ++st) {
            const f32x4 x0 = *(const f32x4*)(xrow + 32 * st), x1 = *(const f32x4*)(xrow + 32 * st + 4); const u32x4 dd = *(const u32x4*)(drow + 32 * st);
            const f32x4 g0 = *(const f32x4*)(gain + 32 * st + 8 * kq), g1 = *(const f32x4*)(gain + 32 * st + 8 * kq + 4);
            float r[8] = {x0.x + bflo(dd.x), x0.y + bfhi(dd.x), x0.z + bflo(dd.y), x0.w + bfhi(dd.y), x1.x + bflo(dd.z), x1.y + bfhi(dd.z), x1.z + bflo(dd.w), x1.w + bfhi(dd.w)};
            { u32x2 o; o.x = pk4_fp8(r[0] * g0.x, r[1] * g0.y, r[2] * g0.z, r[3] * g0.w); o.y = pk4_fp8(r[4] * g1.x, r[5] * g1.y, r[6] * g1.z, r[7] * g1.w); *(u32x2*)(H2 + (size_t)tok * 1024 + 32 * st + 8 * kq) = o; }
            u32x4 ah, al;
#pragma unroll
            for (int p = 0; p < 4; ++p) { ss = __builtin_fmaf(r[2 * p], r[2 * p], ss); ss = __builtin_fmaf(r[2 * p + 1], r[2 * p + 1], ss);
                const unsigned hw = pk2(r[2 * p], r[2 * p + 1]); ah[p] = hw; al[p] = pk2(r[2 * p] - bflo(hw), r[2 * p + 1] - bfhi(hw)); }
            const bf16x8 A_hi = __builtin_bit_cast(bf16x8, ah), A_lo = __builtin_bit_cast(bf16x8, al);
#pragma unroll
            for (int n = 0; n < 2; ++n) { const bf16x8 Bh = *(const LAS bf16x8*)(whi + (16 * n + tl) * WST + 32 * st + 8 * kq), Bl = *(const LAS bf16x8*)(wlo + (16 * n + tl) * WST + 32 * st + 8 * kq);
                acc[n] = __builtin_amdgcn_mfma_f32_16x16x32_bf16(A_hi, Bh, acc[n], 0, 0, 0); acc[n] = __builtin_amdgcn_mfma_f32_16x16x32_bf16(A_hi, Bl, acc[n], 0, 0, 0); acc[n] = __builtin_amdgcn_mfma_f32_16x16x32_bf16(A_lo, Bh, acc[n], 0, 0, 0); }
        }
        ss += __shfl_xor(ss, 16); ss += __shfl_xor(ss, 32);
        const float rstd = 1.0f / sqrtf(ss * (1.f / 1024.f) + EPS);
        if (kq == 0 && !F.dry) WSP(float, WS_CTL)[CW_SSQ + tok] = rstd;
        const float b0 = br[tl], b1 = br[16 + tl];
#pragma unroll
        for (int rg = 0; rg < 4; ++rg) { const float rs = __shfl(rstd, 4 * kq + rg);
            float v0 = acc[0][rg] * rs + b0, v1 = acc[1][rg] * rs + b1; float tv[4]; int te[4];
#pragma unroll
            for (int k = 0; k < 4; ++k) { float bv = v0; int bi = tl; if (v1 > v0) { bv = v1; bi = 16 + tl; }
#pragma unroll
                for (int o = 1; o < 16; o <<= 1) { const float ov = __shfl_xor(bv, o); const int oi = __shfl_xor(bi, o); if (ov > bv || (ov == bv && oi < bi)) { bv = ov; bi = oi; } }
                tv[k] = bv; te[k] = bi; if (bi == tl) v0 = -INFINITY; if (bi == 16 + tl) v1 = -INFINITY; }
            const float e1 = __expf(tv[1] - tv[0]), e2 = __expf(tv[2] - tv[0]), e3 = __expf(tv[3] - tv[0]), inv = 1.0f / (1.0f + e1 + e2 + e3);
            if (tl < 4) { const int e = tl == 0 ? te[0] : tl == 1 ? te[1] : tl == 2 ? te[2] : te[3]; const float w = (tl == 0 ? 1.0f : tl == 1 ? e1 : tl == 2 ? e2 : e3) * inv;
                const int tli = F.wave * 16 + 4 * kq + rg;
                const unsigned pos = __hip_atomic_fetch_add(lcnt + e, 1u, __ATOMIC_RELAXED, __HIP_MEMORY_SCOPE_WORKGROUP);
                ent_e[tli * 4 + tl] = (unsigned)e | (pos << 8); ent_w[tli * 4 + tl] = w; }
        }
        __syncthreads();
        if (F.tid < 32) gbase[F.tid] = __hip_atomic_fetch_add(cnt + F.tid, lcnt[F.tid], __ATOMIC_RELAXED, __HIP_MEMORY_SCOPE_AGENT);
        __syncthreads();
        { const unsigned ee = ent_e[F.tid]; const int e = ee & 255, pos = (int)(gbase[e] + (ee >> 8)); const int tok_ = tb * 128 + (F.tid >> 2);
          LTOK[(size_t)e * T + pos] = tok_; LSLOT[(size_t)e * T + pos] = tok_ * 4 + (F.tid & 3); LWT[(size_t)e * T + pos] = ent_w[F.tid]; }
        __syncthreads();
    }
}

struct MoeTab { LAS int* cnt; LAS int* ntile; LAS int* cumu; LAS int* offs; LAS unsigned short* rowl; };
template <int NPN> __device__ __forceinline__ bool moe_unit(const MoeTab& tab, int L, pg::Unit& u) {
    if (L >= tab.cumu[32]) return false; int e = 0;
#pragma unroll 1
    for (int k = 1; k < 32; ++k) if (tab.cumu[k] <= L) e = k;
    const int rem = L - tab.cumu[e], ntl = tab.ntile[e]; u.g = e; u.pn = rem / ntl; u.pm = rem % ntl; return true;
}
template <int NPN> __device__ __forceinline__ MoeTab moe_tab_build(Frame& F, bool gather) {
    MoeTab t; t.cnt = (LAS int*)(F.lds + 131072); t.ntile = t.cnt + 32; t.cumu = t.ntile + 32; t.offs = t.cumu + 40; t.rowl = (LAS unsigned short*)(F.lds + 131072 + 1024);
    __syncthreads();
    if (F.tid < 32) t.cnt[F.tid] = (int)__hip_atomic_load(WSP(unsigned, WS_CTL) + CW_CNT + F.tid, __ATOMIC_RELAXED, __HIP_MEMORY_SCOPE_AGENT);
    __syncthreads();
    if (F.tid == 0) { int cu = 0, of = 0;
        for (int e = 0; e < 32; ++e) { const int n = t.cnt[e]; const int nt_ = (n + 255) >> 8; t.ntile[e] = nt_; t.cumu[e] = cu; t.offs[e] = of; cu += nt_ * NPN; of += n; }
        t.cumu[32] = cu; t.offs[32] = of; }
    __syncthreads();
    if (gather) {
        const int* ltok = WSP(int, WS_LTOK);
        for (int i = 0; i < 17; ++i) { pg::Unit u; if (!moe_unit<NPN>(t, i * F.G + F.bid, u)) break;
            if (F.tid < 256) { int r = u.pm * 256 + F.tid; const int n = t.cnt[u.g]; r = r < n ? r : n - 1; t.rowl[i * 256 + F.tid] = (unsigned short)ltok[(size_t)u.g * T + r]; } }
        __syncthreads();
    }
    return t;
}
template <int NPN> struct ProbMoe {
    const char* A; const char* W; MoeTab tab; unsigned ldb_bytes; int nt, G, c; bool gather; int hot;
    __device__ bool next(int i, pg::Unit& u) const { u.li = i; const bool ok = moe_unit<NPN>(tab, i * G + c, u); if (hot) { u.li = 0; u.g = 0; u.pn = 0; u.pm = 0; } return ok; }
    __device__ const char* a_base(const pg::Unit&) const { return A; }
    __device__ unsigned a_off(const pg::Unit& u, int row, int col) const {
        unsigned arow;
        if (gather) arow = (unsigned)tab.rowl[u.li * 256 + row];
        else { int r = u.pm * 256 + row; const int n = tab.cnt[u.g]; r = r < n ? r : n - 1; arow = (unsigned)(tab.offs[u.g] + r); }
        return arow * 1024u + (unsigned)col * 2u; }
    __device__ const char* b_base(const pg::Unit& u) const { return W + ((size_t)u.g * (NPN * 256) + u.pn * 256) * 1024; }
};
struct EpiMoe1 { unsigned char* Aout; const float* bgate; const float* bup; const float* rstd; MoeTab tab; int dry;
    __device__ __forceinline__ void operator()(f32x4 (&acc)[2][2][4][2], const pg::Unit& u, int wr, int wc, int fr, int fq) const {
        if (dry >= 3) return;
        const int e = u.g, n = tab.cnt[e], off = tab.offs[e];
        const int col = u.pn * 128 + wc * 32 + fq * 8;
        f32x4 bg[2], bu[2];
#pragma unroll
        for (int nn = 0; nn < 2; ++nn) { bg[nn] = *(const f32x4*)(bgate + e * 1024 + col + 4 * nn); bu[nn] = *(const f32x4*)(bup + e * 1024 + col + 4 * nn); }
        float rs_[8];
#pragma unroll
        for (int q = 0; q < 8; ++q) rs_[q] = 0.03125f * rstd[tab.rowl[u.li * 256 + (q >> 2) * 128 + wr * 64 + (q & 3) * 16 + fr]];
#pragma unroll
        for (int ai = 0; ai < 2; ++ai)
#pragma unroll
            for (int m = 0; m < 4; ++m) { const int r = u.pm * 256 + ai * 128 + wr * 64 + m * 16 + fr; float o[8];
#pragma unroll
                for (int nn = 0; nn < 2; ++nn) { const f32x4 g4 = acc[ai][0][m][nn] * rs_[ai * 4 + m] + bg[nn], u4 = acc[ai][1][m][nn] * rs_[ai * 4 + m] + bu[nn];
#pragma unroll
                    for (int j = 0; j < 4; ++j) { const float g = fminf(g4[j], 7.0f), uu = fminf(fmaxf(u4[j], -7.0f), 7.0f); o[4 * nn + j] = (uu + 1.0f) * (g * sigmoidf_(1.702f * g)); } }
                u32x2 w; w.x = pk4_fp8(o[0], o[1], o[2], o[3]); w.y = pk4_fp8(o[4], o[5], o[6], o[7]);
                if (r < n) { if (dry != 2) *(u32x2*)(Aout + (size_t)(off + r) * 1024 + col) = w; else asm volatile("" :: "v"(w.x), "v"(w.y)); } }
    }
};
struct EpiMoe2 { unsigned char* ws; unsigned char* outb; const float* bdown; const int* lslot; const float* lwt; MoeTab tab;
    __device__ __forceinline__ void operator()(f32x4 (&acc)[2][2][4][2], const pg::Unit& u, int wr, int wc, int fr, int fq) const {
        const int e = u.g, n = tab.cnt[e];
        int sl[8]; float wt[8];
#pragma unroll
        for (int q = 0; q < 8; ++q) { int r = u.pm * 256 + (q >> 2) * 128 + wr * 64 + (q & 3) * 16 + fr; r = r < n ? r : n - 1; sl[q] = lslot[(size_t)e * T + r]; wt[q] = lwt[(size_t)e * T + r]; }
        const int c0 = u.pn * 256 + wc * 64 + fq * 16;
        f32x4 bd[4];
#pragma unroll
        for (int q = 0; q < 4; ++q) bd[q] = *(const f32x4*)(bdown + e * 1024 + c0 + 4 * q);
#pragma unroll
        for (int ai = 0; ai < 2; ++ai)
#pragma unroll
            for (int m = 0; m < 4; ++m) { const int r = u.pm * 256 + ai * 128 + wr * 64 + m * 16 + fr; if (r < n) { const int s_ = sl[ai * 4 + m]; const float w_ = wt[ai * 4 + m] * 16.0f;
                    unsigned char* dst = ws + WS_W1T + (size_t)s_ * 1024;
                    u32x4 o; o.x = pkf84((acc[ai][0][m][0] * 0.03125f + bd[0]) * w_); o.y = pkf84((acc[ai][0][m][1] * 0.03125f + bd[1]) * w_); o.z = pkf84((acc[ai][1][m][0] * 0.03125f + bd[2]) * w_); o.w = pkf84((acc[ai][1][m][1] * 0.03125f + bd[3]) * w_);
                    *(u32x4*)(dst + c0) = o; } }
    }
};

__device__ __forceinline__ void combine_phase(Frame& F) {
    const int gw = F.bid * 8 + F.wave, NGW = F.G * 8, lane = F.lane;
    const bf16_t* D1 = (const bf16_t*)F.out + (size_t)T * 1024;
    auto slotp = [&](int sl) -> const unsigned* { return (const unsigned*)(F.ws + WS_W1T + (size_t)sl * 1024) + lane; };
    for (int tok = gw; tok < T; tok += NGW) {
        const f32x4* xr = (const f32x4*)(F.in[0] + (size_t)tok * 1024) + lane; const u32x2* dr = (const u32x2*)(D1 + (size_t)tok * 1024) + lane;
        f32x4 v[4]; u32x2 d1[4]; unsigned d[4][4];
#pragma unroll
        for (int j = 0; j < 4; ++j) { v[j] = xr[64 * j]; d1[j] = dr[64 * j]; }
#pragma unroll
        for (int k = 0; k < 4; ++k) { const unsigned* sr = slotp(tok * 4 + k);
#pragma unroll
            for (int j = 0; j < 4; ++j) d[k][j] = sr[64 * j]; }
#pragma unroll
        for (int j = 0; j < 4; ++j) { v[j].x += bflo(d1[j].x); v[j].y += bfhi(d1[j].x); v[j].z += bflo(d1[j].y); v[j].w += bfhi(d1[j].y); }
#pragma unroll
        for (int k = 0; k < 4; ++k)
#pragma unroll
            for (int j = 0; j < 4; ++j) { const f32x2_t lo = __builtin_amdgcn_cvt_pk_f32_fp8((int)d[k][j], false), hi2 = __builtin_amdgcn_cvt_pk_f32_fp8((int)d[k][j], true);
                v[j].x += lo[0] * 0.0625f; v[j].y += lo[1] * 0.0625f; v[j].z += hi2[0] * 0.0625f; v[j].w += hi2[1] * 0.0625f; }
        u32x2* r2 = (u32x2*)(WSP(bf16_t, WS_R2) + (size_t)tok * 1024) + lane; unsigned* rb = (unsigned*)(WSP(unsigned char, WS_R2BF) + (size_t)tok * 1024) + lane;
#pragma unroll
        for (int j = 0; j < 4; ++j) { u32x2 w; w.x = pk2(v[j].x, v[j].y); w.y = pk2(v[j].z, v[j].w); r2[64 * j] = w; rb[64 * j] = pk4_fp8(v[j].x, v[j].y, v[j].z, v[j].w); }
    }
}
__device__ __forceinline__ void final_norm_phase(Frame& F) {
    const int gw = F.bid * 8 + F.wave, NGW = F.G * 8, lane = F.lane; const f32x4* gr = (const f32x4*)F.in[29] + lane;
    for (int tok = gw; tok < T; tok += NGW) {
        const u32x2* xr = (const u32x2*)(WSP(bf16_t, WS_E) + (size_t)tok * 1024) + lane; f32x4 v[4]; float s = 0.f;
#pragma unroll
        for (int j = 0; j < 4; ++j) { const u32x2 d = xr[64 * j]; v[j] = (f32x4){bflo(d.x), bfhi(d.x), bflo(d.y), bfhi(d.y)}; s += (v[j].x * v[j].x + v[j].y * v[j].y) + (v[j].z * v[j].z + v[j].w * v[j].w); }
        const float rstd = 1.0f / sqrtf(wave_sum(s) * (1.f / 1024.f) + EPS);
        f32x4* xw = F.dry ? (f32x4*)(WSP(float, WS_A) + (size_t)tok * 1024) + lane : (f32x4*)(F.out + (size_t)tok * 1024) + lane;
#pragma unroll
        for (int j = 0; j < 4; ++j) { const f32x4 g = gr[64 * j]; xw[64 * j] = (f32x4){v[j].x * rstd * g.x, v[j].y * rstd * g.y, v[j].z * rstd * g.z, v[j].w * rstd * g.w}; }
    }
}
constexpr size_t WS_BAR = 512 * 1024;
#define XB_TMO      128
#define XB_XCNT(j)  (256  + 64 * (j))
#define XB_XSUB(j)  (1280 + 64 * (j))
#define XB_XGEN(j)  (2304 + 64 * (j))
#define XB_TOP      3328
#define XB_TOPGEN   3392
#define XCD_BAR_WORDS 3456
#define XB_SPIN_CAP (1u << 18)
__device__ __forceinline__ unsigned xb_ld(unsigned* p)              { return __hip_atomic_load(p, __ATOMIC_RELAXED, __HIP_MEMORY_SCOPE_AGENT); }
__device__ __forceinline__ unsigned xb_add(unsigned* p, unsigned v) { return __hip_atomic_fetch_add(p, v, __ATOMIC_RELAXED, __HIP_MEMORY_SCOPE_AGENT); }
__device__ __forceinline__ unsigned xb_xcc_id() { return (unsigned)__builtin_amdgcn_s_getreg((3 << 11) | 20) & 0xFu; }
#define XB_SPIN(cond, bar) do { unsigned _sp = 0; while (cond) { __builtin_amdgcn_s_sleep(1); \
    if ((++_sp & 255u) == 0u) { if (xb_ld(&(bar)[XB_TMO])) break; if (_sp > XB_SPIN_CAP) { atomicAdd(&(bar)[XB_TMO], 1u); break; } } } } while (0)
struct XcdBarrier { unsigned* bar; unsigned x; volatile LAS unsigned* st; };
__device__ __forceinline__ XcdBarrier xcd_barrier_post(unsigned* bar, volatile LAS unsigned* st) {
    XcdBarrier b; b.bar = bar; b.x = xb_xcc_id(); b.st = st;
    if (threadIdx.x == 0) (void)xb_add(&bar[XB_XCNT(b.x)], 1u);
    return b;
}
__device__ __forceinline__ void xcd_barrier_complete(unsigned* bar, unsigned x, unsigned& nloc, unsigned& nx) {
    const unsigned G = gridDim.x * gridDim.y * gridDim.z;
    unsigned sum, cnt, mine, sp = 0u;
    for (;;) {
        sum = 0u; cnt = 0u; mine = 0u;
#pragma unroll
        for (unsigned j = 0; j < 16; ++j) { const unsigned c = xb_ld(&bar[XB_XCNT(j)]); sum += c; cnt += (c > 0u) ? 1u : 0u; mine = (j == x) ? c : mine; }
        if (sum == G) break;
        __builtin_amdgcn_s_sleep(1);
        if ((++sp & 255u) == 0u) { if (xb_ld(&bar[XB_TMO])) break; if (sp > XB_SPIN_CAP) { atomicAdd(&bar[XB_TMO], 1u); break; } }
    }
    nloc = mine > 0u ? mine : 1u; nx = cnt > 0u ? cnt : 1u;
}
__device__ __forceinline__ void xcd_barrier(const XcdBarrier& b) {
    asm volatile("s_waitcnt vmcnt(0)" ::: "memory");
    __syncthreads();
    if (threadIdx.x == 0) {
        unsigned* bar = b.bar;
        __builtin_amdgcn_s_waitcnt(0);
        unsigned nloc = b.st[0], nx = b.st[1];
        if (nloc == 0u) { xcd_barrier_complete(bar, b.x, nloc, nx); b.st[0] = nloc; b.st[1] = nx; }
        const unsigned old = xb_add(&bar[XB_XSUB(b.x)], 1u);
        const unsigned gen = old / nloc;
        if (old + 1u == (gen + 1u) * nloc) {
            __builtin_amdgcn_fence(__ATOMIC_RELEASE, "agent");
            asm volatile("s_waitcnt vmcnt(0)" ::: "memory");
            const unsigned og = xb_add(&bar[XB_TOP], 1u);
            const unsigned tg = og / nx;
            if (og + 1u == (tg + 1u) * nx) xb_add(&bar[XB_TOPGEN], 1u);
            else XB_SPIN(xb_ld(&bar[XB_TOPGEN]) == tg, bar);
            __builtin_amdgcn_fence(__ATOMIC_ACQUIRE, "agent");
            xb_add(&bar[XB_XGEN(b.x)], 1u);
            asm volatile("s_waitcnt vmcnt(0)" ::: "memory");
        } else {
            XB_SPIN(xb_ld(&bar[XB_XGEN(b.x)]) == gen, bar);
            __builtin_amdgcn_fence(__ATOMIC_ACQUIRE, "agent");
            asm volatile("s_waitcnt vmcnt(0)" ::: "memory");
        }
    }
    __syncthreads();
}

constexpr int LDS_BYTES = 147456;
constexpr int NPHASE = 14;
#ifndef MK_MULTI
#define MK_MULTI 0
#endif
struct Args { const float* in[30]; float* out; unsigned char* ws; int ph_lo, ph_hi, dry, pad; };
static_assert(sizeof(Args) == 32 * 8 + 16, "no padding in Args");

__global__ void __launch_bounds__(NTHR, 2) fwd(Args a) {
    extern __shared__ __attribute__((aligned(16))) unsigned char lds_[];
    Frame F;
    F.lds = (LAS unsigned char*)lds_;
    F.tid = threadIdx.x; F.lane = F.tid & 63; F.wave = __builtin_amdgcn_readfirstlane(F.tid >> 6); F.G = gridDim.x; F.bid = blockIdx.x;
#pragma unroll
    for (int i = 0; i < 30; ++i) F.in[i] = a.in[i];
    F.out = a.out; F.ws = a.ws; F.dry = a.dry;
    const int lo = a.ph_lo, hi = a.ph_hi;
#ifndef PHMASK
#define PHMASK 0x3fff
#endif
#define IN(k) (((PHMASK >> (k)) & 1) && lo <= (k) && (k) < hi)
    volatile LAS unsigned* xst = (volatile LAS unsigned*)(F.lds + LDS_BYTES - 64);
    if (F.tid < 2) xst[F.tid] = 0u;
    __syncthreads();
    const XcdBarrier xbar = xcd_barrier_post((unsigned*)(F.ws + WS_BAR), xst);
#define SEAM(k) do { if (IN(k) && IN((k) + 1)) xcd_barrier(xbar); } while (0)
    bf16_t* GS = (bf16_t*)F.out; bf16_t* GA = GS + (size_t)T * 1024;

    if (IN(0)) { p0_prologue(F); __syncthreads(); p0_s5_tables(F); }
    SEAM(0);
    if (IN(1)) {
        EpiInProj E; E.U = WSP(bf16_t, WS_U); E.Q = WSP(bf16_t, WS_Q); E.K = WSP(bf16_t, WS_K); E.V = WSP(bf16_t, WS_V); E.QI = WSP(bf16_t, WS_QIDX); E.KI = WSP(bf16_t, WS_KIDX); E.GS = GS; E.GA = GA;
        E.WI = WSP(float, WS_WIDX); E.bg = F.in[3]; E.c64 = WSP(float, WS_COS64); E.s64 = WSP(float, WS_SIN64); E.c32 = WSP(float, WS_COS32); E.s32 = WSP(float, WS_SIN32);
        { pg::Dense P; P.A = (const char*)WSP(unsigned char, WS_H8); P.B = (const char*)WSP(unsigned char, WS_WIN8); P.lda_bytes = 1024; P.ldb_bytes = 1024; P.nt = 8; P.ord.init(T / 256, 16, F.G, F.bid); P.pn_split = 8; P.pn_skip = 2;
          E.ascale = 0.03125f; pg::gemm_phase<true>(F.lds, P, E); }
        { pg::Dense P; P.A = (const char*)WSP(bf16_t, WS_E); P.B = (const char*)WSP(bf16_t, WS_WINT); P.lda_bytes = 2048; P.ldb_bytes = 2048; P.nt = 16; P.ord.init(T / 256, 2, F.G, F.bid); P.pn_base = 8; P.b_tile0 = 8;
          E.ascale = 1.0f; pg::gemm_phase<false>(F.lds, P, E); }
    }
    SEAM(1);
    if (IN(2)) {
        { ProbS5E P; P.U = (const char*)WSP(bf16_t, WS_U); P.Wg = (const char*)WSP(bf16_t, WS_WG); P.ldb_bytes = 2048; P.nt = 16; P.G = F.G; P.c = F.bid; EpiS5E E; E.E = WSP(float, WS_EF32); pg::gemm_phase(F.lds, P, E); }
        __syncthreads();
        idx_phase(F);
    }
    SEAM(2);
    if (IN(3)) { s5_scan(F); __syncthreads(); attn_phase(F); }
    SEAM(3);
    if (IN(4)) { ProbS5Y P; P.U = (const char*)WSP(bf16_t, WS_U); P.TV = (const char*)WSP(bf16_t, WS_TV); P.ldb_bytes = 2304; P.nt = 18; P.G = F.G; P.c = F.bid; EpiS5Y E; E.Y = WSP(bf16_t, WS_E); pg::gemm_phase(F.lds, P, E); }
    SEAM(4);
    if (IN(5)) { pg::Dense P; P.A = (const char*)WSP(bf16_t, WS_E); P.B = (const char*)WSP(bf16_t, WS_WGLUT); P.lda_bytes = 1024; P.ldb_bytes = 1024; P.nt = 8; P.ord.init(T / 256, 2, F.G, F.bid);
        EpiGlu E; E.YS = WSP(bf16_t, WS_E); E.Y2 = WSP(unsigned char, WS_Y28); E.b = F.in[13]; pg::gemm_phase(F.lds, P, E); }
    SEAM(5);
    if (IN(6)) {
        { pg::Dense P; P.A = (const char*)WSP(unsigned char, WS_Y28); P.B = (const char*)WSP(unsigned char, WS_WSB8); P.lda_bytes = 512; P.ldb_bytes = 512; P.nt = 4; P.ord.init(T / 256, 4, F.G, F.bid);
          EpiMix<false> E; E.Gt = (const unsigned char*)GS; E.MIX = F.dry ? WSP(bf16_t, WS_U) : GA; E.MIX8 = nullptr; pg::gemm_phase<true>(F.lds, P, E); }
        { pg::Dense P; P.A = (const char*)WSP(unsigned char, WS_YA8); P.B = (const char*)WSP(unsigned char, WS_WAB8); P.lda_bytes = 512; P.ldb_bytes = 512; P.nt = 4; P.ord.init(T / 256, 4, F.G, F.bid);
          EpiMix<true> E; E.Gt = (const unsigned char*)GS + (size_t)T * 1024; E.MIX = F.dry ? WSP(bf16_t, WS_U) : GA; E.MIX8 = F.dry ? WSP(unsigned char, WS_V) : WSP(unsigned char, WS_MIX8); pg::gemm_phase<true>(F.lds, P, E); }
    }
    SEAM(6);
    if (IN(7)) { pg::Dense P; P.A = (const char*)WSP(unsigned char, WS_MIX8); P.B = (const char*)WSP(unsigned char, WS_WO8); P.lda_bytes = 1024; P.ldb_bytes = 1024; P.nt = 8; P.ord.init(T / 256, 4, F.G, F.bid);
        EpiStoreBf E; E.O = GA; E.ldo = 1024; E.sc = 0.03125f; pg::gemm_phase<true>(F.lds, P, E); }
    SEAM(7);
    if (IN(8)) router_phase(F);
    SEAM(8);
    if (IN(9)) { const MoeTab tab = moe_tab_build<8>(F, true);
        ProbMoe<8> P; P.A = (const char*)GS; P.W = (const char*)WSP(bf16_t, WS_W1T); P.tab = tab; P.ldb_bytes = 1024; P.nt = 8; P.G = F.G; P.c = F.bid; P.gather = true; P.hot = (F.dry == 4);
        EpiMoe1 E; E.Aout = WSP(unsigned char, WS_A); E.bgate = F.in[22]; E.bup = F.in[24]; E.rstd = WSP(float, WS_CTL) + CW_SSQ; E.tab = tab; E.dry = F.dry; pg::gemm_phase<true>(F.lds, P, E); }
    SEAM(9);
    if (IN(10)) { const MoeTab tab = moe_tab_build<4>(F, false);
        ProbMoe<4> P; P.A = (const char*)WSP(bf16_t, WS_A); P.W = (const char*)WSP(bf16_t, WS_W2T); P.tab = tab; P.ldb_bytes = 1024; P.nt = 8; P.G = F.G; P.c = F.bid; P.gather = false; P.hot = 0;
        EpiMoe2 E; E.ws = F.ws; E.outb = (unsigned char*)F.out; E.bdown = F.in[26]; E.lslot = WSP(int, WS_LSLOT); E.lwt = WSP(float, WS_LWT); E.tab = tab; pg::gemm_phase<true>(F.lds, P, E);
        { const int total = tab.cumu[32], rounds = (total + F.G - 1) / F.G, nfull = total - (rounds - 1) * F.G, nidle = F.G - nfull;
          const int G2 = nidle > 0 ? nidle : F.G, c2 = nidle > 0 ? F.bid - nfull : F.bid;
          if (c2 >= 0) { pg::Dense P2; P2.A = (const char*)WSP(bf16_t, WS_PBF); P2.B = (const char*)WSP(bf16_t, WS_WPPT); P2.lda_bytes = 512; P2.ldb_bytes = 512; P2.nt = 4; P2.ord.init(T / 256, 4, G2, c2);
              EpiStoreBf E2; E2.O = WSP(bf16_t, WS_PROJ); E2.ldo = 1024; E2.sc = 1.0f; pg::gemm_phase(F.lds, P2, E2); } } }
    SEAM(10);
    if (IN(11)) combine_phase(F);
    SEAM(11);
    if (IN(12)) {
        { pg::Dense P; P.A = (const char*)WSP(unsigned char, WS_R2BF); P.B = (const char*)WSP(unsigned char, WS_WPG8); P.lda_bytes = 1024; P.ldb_bytes = 1024; P.nt = 8; P.ord.init(T / 256, 4, F.G, F.bid);
          EpiPleNorm E; E.R2 = WSP(bf16_t, WS_R2); E.PROJ = WSP(bf16_t, WS_PROJ); E.OUT = F.out; E.gain = F.in[29]; E.xbuf = (float*)(F.ws + WS_XBUF); E.pcnt = WSP(unsigned, WS_CTL) + CW_PCNT;
          E.Pl = (LAS float*)(F.lds + 131072); E.Sl = (LAS float*)(F.lds + 131072 + 4096); pg::gemm_phase<true>(F.lds, P, E); }
    }
#undef IN
#undef SEAM
}

extern "C" void kernel_launch(void* const* d_in, const int* in_sizes, int n_in, void* d_out, int out_size, void* d_ws, size_t ws_size, hipStream_t stream) {
    static int grid = 0;
    if (grid == 0) {
        if (n_in != 30 || out_size != T * 1024 || ws_size < WS_END) { fprintf(stderr, "kernel_launch: unexpected shapes (n_in %d, out %d, ws %zu < %zu)\n", n_in, out_size, ws_size, (size_t)WS_END); grid = -1; return; }
        int dev = 0, cus = 0, per_cu = 0;
        hipGetDevice(&dev); hipDeviceGetAttribute(&cus, hipDeviceAttributeMultiprocessorCount, dev);
        hipFuncSetAttribute((const void*)fwd, hipFuncAttributeMaxDynamicSharedMemorySize, LDS_BYTES);
        hipOccupancyMaxActiveBlocksPerMultiprocessor(&per_cu, (const void*)fwd, NTHR, LDS_BYTES);
        if (per_cu < 1) { fprintf(stderr, "kernel_launch: occupancy query says %d blocks per CU\n", per_cu); per_cu = 1; }
        (void)hipGetLastError();
        grid = cus;
    }
    if (grid < 0) return;
    Args a{};
    for (int i = 0; i < 30; ++i) a.in[i] = (const float*)d_in[i];
    a.out = (float*)d_out; a.ws = (unsigned char*)d_ws;
#if MK_MULTI
#ifndef DUP_MASK
#define DUP_MASK 0
#endif
    for (int ph = 0; ph < NPHASE; ++ph) { a.ph_lo = ph; a.ph_hi = ph + 1; const int reps = ((DUP_MASK >> ph) & 1) ? 2 : 1;
        for (int r = 0; r < reps; ++r) { a.dry = (r + 1 < reps && (ph == 3 || ph == 6 || ph == 8 || ph == 13)) ? 1 : 0;
#ifdef DRY9
            if (ph == 9 && r + 1 < reps) a.dry = DRY9;
#endif
 hipLaunchKernelGGL(fwd, dim3(grid), dim3(NTHR), LDS_BYTES, stream, a); } }
#else
    (void)hipMemsetAsync((char*)d_ws + WS_BAR, 0, XCD_BAR_WORDS * 4, stream);
    a.ph_lo = 0; a.ph_hi = NPHASE; void* args[] = {&a};
    hipError_t e = hipLaunchCooperativeKernel((const void*)fwd, dim3(grid), dim3(NTHR), args, LDS_BYTES, stream);
    if (e != hipSuccess) fprintf(stderr, "cooperative launch failed: %s (grid %d)\n", hipGetErrorString(e), grid);
#endif
}
```

```cpp
#include <hip/hip_runtime.h>
#include <hip/hip_cooperative_groups.h>
#include <cstdio>
#include <cstdint>
#include <cmath>
namespace cg = cooperative_groups;

#define LAS __attribute__((address_space(3)))
#define GAS __attribute__((address_space(1)))
typedef unsigned short bf16_t;
typedef short bf16x8 __attribute__((ext_vector_type(8)));
typedef short s16x4 __attribute__((ext_vector_type(4)));
typedef float f32x4 __attribute__((ext_vector_type(4)));
typedef float f32x16 __attribute__((ext_vector_type(16)));
typedef unsigned u32x4 __attribute__((ext_vector_type(4)));
typedef unsigned u32x2 __attribute__((ext_vector_type(2)));

constexpr int LDS_BYTES_C = 147456;
constexpr int NB = 8, SEQ = 4096, DM = 1024, T = NB * SEQ;
constexpr int PLE = 256, NE = 32, TOPK = 4, NSLOT = T * TOPK;
constexpr int INC = 4392, INP = 4608;
constexpr int NGRP = 32, SST = 64;
constexpr float EPS = 1e-6f;
constexpr float C2 = 0.125f * 1.4426950408889634f;
constexpr int NTHR = 512;

constexpr size_t MB = 1000000;
constexpr size_t WS_CTL   = 0;
constexpr size_t WS_COS64 = 1 * MB;
constexpr size_t WS_SIN64 = WS_COS64 + 4096 * 32 * 4;
constexpr size_t WS_COS32 = WS_SIN64 + 4096 * 32 * 4;
constexpr size_t WS_SIN32 = WS_COS32 + 4096 * 16 * 4;
constexpr size_t WS_KG    = 3 * MB;
constexpr size_t WS_L64   = WS_KG + 32 * 64 * 256 * 4;
constexpr size_t WS_XBUF  = 5200000;
constexpr size_t WS_KIDX  = 6 * MB;
constexpr size_t WS_WIDX  = 9 * MB;
constexpr size_t WS_EF32  = 11 * MB;
constexpr size_t WS_WG    = 20 * MB;
constexpr size_t WS_LTOK  = 29 * MB;
constexpr size_t WS_LSLOT = 34 * MB;
constexpr size_t WS_LWT   = 39 * MB;
constexpr size_t WS_SMALL_END = 44 * MB;
constexpr size_t WS_W2T   = WS_SMALL_END;
constexpr size_t SZ_W2T   = (size_t)32 * 1024 * 1024 * 2;
constexpr size_t WS_W1T   = WS_W2T + SZ_W2T;
constexpr size_t SZ_W1T   = (size_t)32 * 2048 * 1024 * 2;
constexpr size_t WS_E     = WS_W1T + SZ_W1T;
constexpr size_t SZ_E     = (size_t)T * 1024 * 2;
constexpr size_t WS_A     = WS_E + SZ_E;
constexpr size_t SZ_A     = (size_t)NSLOT * 1024 * 2;
constexpr size_t WS_TAIL  = WS_A + SZ_A;
constexpr size_t WS_WINT  = WS_TAIL;
constexpr size_t WS_WIN8  = WS_WINT + (size_t)512 * 1024 * 2;
constexpr size_t WS_WGLUT = WS_WIN8 + (size_t)INP * 1024;
constexpr size_t WS_WSB8  = WS_WGLUT + 512 * 512 * 2;
constexpr size_t WS_WAB8  = WS_WSB8 + 1024 * 512;
constexpr size_t WS_WO8   = WS_WAB8 + 1024 * 512;
constexpr size_t WS_WPG8  = WS_WO8 + 1024 * 1024;
constexpr size_t WS_WPPT  = WS_WPG8 + 1024 * 1024;
constexpr size_t WS_END   = WS_WPPT + 1024 * 256 * 2;
static_assert(WS_END <= 604000000ull, "workspace map must fit sum(inputs) bytes");
constexpr size_t WS_U     = WS_A;
constexpr size_t SZ_U     = (size_t)32 * 512 * 1152 * 2;
constexpr size_t WS_Q     = WS_U + SZ_U;
constexpr size_t SZ_QKV   = (size_t)T * 512 * 2;
constexpr size_t WS_K     = WS_Q + SZ_QKV;
constexpr size_t WS_V     = WS_K + SZ_QKV;
constexpr size_t WS_QIDX  = WS_V + SZ_QKV;
constexpr size_t WS_MASK  = WS_QIDX + (size_t)T * 256 * 2;
constexpr size_t WS_TV    = WS_MASK + (size_t)8 * 128 * 4096 * 4;
constexpr size_t SZ_TV    = (size_t)32 * 1024 * 1152 * 2;
static_assert(WS_TV + SZ_TV <= WS_TAIL, "early temporaries fit the A region");
constexpr size_t WS_R2    = WS_A;
constexpr size_t WS_R2BF  = WS_A + (size_t)T * 1024 * 4;
constexpr size_t WS_PBF   = WS_R2BF + (size_t)T * 1024;
constexpr size_t WS_PROJ  = WS_PBF + (size_t)T * 256 * 2;
static_assert(WS_PROJ + (size_t)T * 1024 * 2 <= WS_TAIL, "late users fit the A region");
constexpr size_t WS_H8    = WS_W2T + (size_t)32 * 1024 * 1024;
constexpr size_t WS_YA8   = WS_E + 40 * MB;
constexpr size_t WS_Y28   = WS_K;
constexpr size_t WS_MIX8  = WS_TV;
constexpr int CW_CNT = 64;
constexpr int CW_PCNT = 512;
constexpr int CW_QIDX = 192, CW_QATT = 256;
constexpr int CW_SSQ = 1024;
constexpr int CTL_WORDS = CW_SSQ + T;

__device__ __forceinline__ unsigned f2bf(float f) { unsigned u = __builtin_bit_cast(unsigned, f); return (u + 0x7fffu + ((u >> 16) & 1u)) >> 16; }
typedef float f32x2_t __attribute__((ext_vector_type(2))); typedef __bf16 bf16x2_t __attribute__((ext_vector_type(2)));
__device__ __forceinline__ unsigned pk2(float lo, float hi) { f32x2_t v = {lo, hi}; bf16x2_t b = __builtin_convertvector(v, bf16x2_t); return __builtin_bit_cast(unsigned, b); }
__device__ __forceinline__ float bf2f(unsigned short b) { return __builtin_bit_cast(float, (unsigned)b << 16); }
__device__ __forceinline__ float bflo(unsigned w) { return __builtin_bit_cast(float, w << 16); }
__device__ __forceinline__ float bfhi(unsigned w) { return __builtin_bit_cast(float, w & 0xffff0000u); }
__device__ __forceinline__ float wave_sum(float v) {
#pragma unroll
    for (int o = 1; o < 64; o <<= 1) v += __shfl_xor(v, o);
    return v;
}
__device__ __forceinline__ float sigmoidf_(float x) { return __builtin_amdgcn_rcpf(1.0f + __builtin_amdgcn_exp2f(-1.4426950408889634f * x)); }
__device__ __forceinline__ float gelu_tanh(float x) {
    const float u = 0.7978845608028654f * (x + 0.044715f * x * x * x);
    const float e = __expf(-2.0f * fabsf(u));
    float t = (1.0f - e) / (1.0f + e); t = u < 0.f ? -t : t;
    return 0.5f * x * (1.0f + t);
}


typedef int v8i_t __attribute__((ext_vector_type(8)));
typedef int v4i_t __attribute__((ext_vector_type(4)));
__device__ __forceinline__ unsigned pk4_fp8(float a, float b, float c, float d) { int w = __builtin_amdgcn_cvt_pk_fp8_f32(a, b, 0, false); w = __builtin_amdgcn_cvt_pk_fp8_f32(c, d, w, true); return (unsigned)w; }
#ifdef FP8_SELFTEST
__device__ __forceinline__ bool fp8_selftest(int lane) {
    const int rc = lane & 15, g = lane >> 4; v8i_t a, b;
#pragma unroll
    for (int w = 0; w < 8; ++w) { float av[4], bv[4];
#pragma unroll
        for (int q = 0; q < 4; ++q) { const int bb = w * 4 + q; const int k = bb < 16 ? 16 * g + bb : 64 + 16 * g + (bb - 16);
            av[q] = (float)((rc * 7 + k * 3) % 9 - 4) * 0.5f; bv[q] = (float)((k * 5 + rc * 11) % 7 - 3) * 0.25f; }
        a[w] = (int)pk4_fp8(av[0], av[1], av[2], av[3]); b[w] = (int)pk4_fp8(bv[0], bv[1], bv[2], bv[3]); }
    f32x4 c = {0.f, 0.f, 0.f, 0.f};
    c = __builtin_amdgcn_mfma_scale_f32_16x16x128_f8f6f4(a, b, c, 0, 0, 0, 0x7f7f7f7f, 0, 0x7f7f7f7f);
    bool ok = true;
#pragma unroll
    for (int r = 0; r < 4; ++r) { const int i = 4 * g + r, j = rc; float ref = 0.f;
        for (int k = 0; k < 128; ++k) ref += ((float)((i * 7 + k * 3) % 9 - 4) * 0.5f) * ((float)((k * 5 + j * 11) % 7 - 3) * 0.25f);
        ok = ok && (c[r] == ref); }
    return __all(ok);
}
#endif

__device__ __forceinline__ int perm16_row(int c) { const int t = c & ~255, w = c & 255; return t + ((w >> 3) & 1) * 128 + (w >> 6) * 32 + ((w >> 2) & 1) * 16 + ((w >> 4) & 3) * 4 + (w & 3); }

__device__ __forceinline__ f32x4 bf4(u32x2 w) { return (f32x4){bflo(w.x), bfhi(w.x), bflo(w.y), bfhi(w.y)}; }
__device__ __forceinline__ f32x4 f84(unsigned w) { const f32x2_t lo = __builtin_amdgcn_cvt_pk_f32_fp8((int)w, false), hi = __builtin_amdgcn_cvt_pk_f32_fp8((int)w, true); return (f32x4){lo[0], lo[1], hi[0], hi[1]}; }
__device__ __forceinline__ u32x2 pkbf4(f32x4 v) { u32x2 w; w.x = pk2(v.x, v.y); w.y = pk2(v.z, v.w); return w; }
__device__ __forceinline__ unsigned pkf84(f32x4 v) { return pk4_fp8(v.x, v.y, v.z, v.w); }
__device__ __forceinline__ f32x4 sig4(f32x4 v) { return (f32x4){sigmoidf_(v.x), sigmoidf_(v.y), sigmoidf_(v.z), sigmoidf_(v.w)}; }

namespace pg {
constexpr int BM = 256, BK = 64, HALF = 128, HTB = HALF * BK * 2, STAGE_BYTES = 8 * HTB;
__device__ __forceinline__ int lds_byte(int r, int c) { const int st = (r >> 4) * 2 + (c >> 5), rr = r & 15, cc = c & 31, ob = rr * 64 + cc * 2; return st * 1024 + (ob ^ (((ob >> 9) & 1) << 5)); }
__device__ __forceinline__ void stage_rc(int b, int& R, int& C) { const int st = b / 1024, sb = b % 1024, swz = sb ^ (((sb >> 9) & 1) << 5); R = (st >> 1) * 16 + swz / 64; C = (st & 1) * 32 + (swz % 64) / 2; }
struct Unit { int pm, pn, g, li; };

template <bool FP8 = false, class Prob, class Epi>
__device__ __forceinline__ void gemm_phase(LAS unsigned char* lds, const Prob& P, const Epi& E) {
    const int tid = threadIdx.x, wid = __builtin_amdgcn_readfirstlane(tid >> 6), lane = tid & 63, wr = wid >> 2, wc = wid & 3, fr = lane & 15, fq = lane >> 4;
    const int nt = P.nt;
    int R[2], C[2];
#pragma unroll
    for (int i = 0; i < 2; ++i) stage_rc(tid * 16 + i * 8192, R[i], C[i]);
    unsigned offB[2][2];
#pragma unroll
    for (int h = 0; h < 2; ++h)
#pragma unroll
        for (int i = 0; i < 2; ++i) offB[h][i] = (unsigned)(h * HALF + R[i]) * P.ldb_bytes + (unsigned)C[i] * 2u;
    const unsigned ldsw = (unsigned)wid * 1024u;
    const int aoff = lds_byte(wr * 64 + fr, fq * 8), boff = lds_byte(wc * 32 + fr, fq * 8);
#define PG_SA(b, h) (((b) * 2 + (h)) * HTB)
#define PG_SB(b, h) ((4 + (b) * 2 + (h)) * HTB)
#define PG_STAGE(bufoff, gbase, voff, kbytes) do { _Pragma("unroll") for (int _i = 0; _i < 2; ++_i) \
        __builtin_amdgcn_global_load_lds((const unsigned*)((const char*)(gbase) + (voff)[_i] + (kbytes)), (LAS unsigned*)(lds + (bufoff) + ldsw + _i * 8192), 16, 0, 0); } while (0)
#define PG_CAT8(x0, x1) __builtin_shufflevector(x0, x1, 0, 1, 2, 3, 4, 5, 6, 7)
#define PG_LDA(dst, b, h) do { if constexpr (FP8) { _Pragma("unroll") for (int m = 0; m < 4; ++m) dst##8[m] = PG_CAT8(*(const LAS v4i_t*)(lds + PG_SA(b, h) + aoff + m * 2048), *(const LAS v4i_t*)(lds + PG_SA(b, h) + aoff + m * 2048 + 1024)); } \
        else { _Pragma("unroll") for (int m = 0; m < 4; ++m) _Pragma("unroll") for (int k = 0; k < 2; ++k) dst[m][k] = *(const LAS bf16x8*)(lds + PG_SA(b, h) + aoff + m * 2048 + k * 1024); } } while (0)
#define PG_LDB(dst, b, h) do { if constexpr (FP8) { _Pragma("unroll") for (int n = 0; n < 2; ++n) dst##8[n] = PG_CAT8(*(const LAS v4i_t*)(lds + PG_SB(b, h) + boff + n * 2048), *(const LAS v4i_t*)(lds + PG_SB(b, h) + boff + n * 2048 + 1024)); } \
        else { _Pragma("unroll") for (int n = 0; n < 2; ++n) _Pragma("unroll") for (int k = 0; k < 2; ++k) dst[n][k] = *(const LAS bf16x8*)(lds + PG_SB(b, h) + boff + n * 2048 + k * 1024); } } while (0)
#define PG_MMA(ai, bj, At, Bt) do { __builtin_amdgcn_s_setprio(1); \
        if constexpr (FP8) { _Pragma("unroll") for (int m = 0; m < 4; ++m) _Pragma("unroll") for (int n = 0; n < 2; ++n) \
            asm volatile("v_mfma_scale_f32_16x16x128_f8f6f4 %0, %1, %2, %0, %3, %3 op_sel_hi:[0,0,0]" : "+v"(acc[ai][bj][m][n]) : "v"(Bt##8[n]), "v"(At##8[m]), "v"(sc1)); } \
        else { _Pragma("unroll") for (int m = 0; m < 4; ++m) _Pragma("unroll") for (int n = 0; n < 2; ++n) _Pragma("unroll") for (int k = 0; k < 2; ++k) \
            acc[ai][bj][m][n] = __builtin_amdgcn_mfma_f32_16x16x32_bf16(Bt[n][k], At[m][k], acc[ai][bj][m][n], 0, 0, 0); } \
        __builtin_amdgcn_s_setprio(0); } while (0)
#define PG_WAIT_V(n) asm volatile("s_waitcnt vmcnt(" #n ")" ::: "memory")
#define PG_WAIT_L(n) asm volatile("s_waitcnt lgkmcnt(" #n ")" ::: "memory")
#define PG_BAR __builtin_amdgcn_s_barrier()
#define PG_SCHED __builtin_amdgcn_sched_barrier(0)
    Unit cur, nxt; int ui = 0;
    if (!P.next(0, cur)) return;
    f32x4 acc[2][2][4][2];
#pragma unroll
    for (int a = 0; a < 2; ++a)
#pragma unroll
        for (int b = 0; b < 2; ++b)
#pragma unroll
            for (int m = 0; m < 4; ++m)
#pragma unroll
                for (int n = 0; n < 2; ++n) acc[a][b][m][n] = (f32x4){0.f, 0.f, 0.f, 0.f};
    bf16x8 At[4][2], B0[2][2], B1[2][2]; v8i_t At8[4], B08[2], B18[2]; int sc1 = 0x7f7f7f7f; asm volatile("" : "+v"(sc1));
    const char* cA = P.a_base(cur); const char* cB = P.b_base(cur);
    unsigned cOA[2][2], nOA[2][2];
#pragma unroll
    for (int h = 0; h < 2; ++h)
#pragma unroll
        for (int i = 0; i < 2; ++i) cOA[h][i] = P.a_off(cur, h * HALF + R[i], C[i]);
    PG_STAGE(PG_SB(0, 0), cB, offB[0], 0); PG_STAGE(PG_SB(0, 1), cB, offB[1], 0); PG_STAGE(PG_SA(0, 0), cA, cOA[0], 0); PG_STAGE(PG_SA(0, 1), cA, cOA[1], 0);
    if (wr == 1) PG_BAR;
    PG_WAIT_V(2); PG_BAR;
    PG_STAGE(PG_SB(1, 0), cB, offB[0], 128); PG_STAGE(PG_SA(1, 0), cA, cOA[0], 128); PG_STAGE(PG_SB(1, 1), cB, offB[1], 128);
    PG_WAIT_V(6); PG_BAR;
    for (;;) {
        const bool has_next = P.next(ui + 1, nxt);
        const char* nA = has_next ? P.a_base(nxt) : cA; const char* nB = has_next ? P.b_base(nxt) : cB;
#pragma unroll
        for (int h = 0; h < 2; ++h)
#pragma unroll
            for (int i = 0; i < 2; ++i) nOA[h][i] = has_next ? P.a_off(nxt, h * HALF + R[i], C[i]) : cOA[h][i];
        for (int t = 0; t < nt; t += 2) {
            const bool last = (t == nt - 2);
            const unsigned k1 = (unsigned)(t + 1) * 128u;
            const unsigned k2 = last ? 0u : (unsigned)(t + 2) * 128u, k3 = k2 + 128u;
            const char* a2 = last ? nA : cA; const char* b2 = last ? nB : cB;
            unsigned o2[2][2];
#pragma unroll
            for (int h = 0; h < 2; ++h)
#pragma unroll
                for (int i = 0; i < 2; ++i) o2[h][i] = last ? nOA[h][i] : cOA[h][i];
            PG_LDB(B0, 0, 0); PG_LDB(B1, 0, 1); PG_SCHED; PG_LDA(At, 0, 0); PG_STAGE(PG_SA(1, 1), cA, cOA[1], k1);
            PG_WAIT_V(8); PG_WAIT_L(0); PG_BAR; PG_MMA(0, 0, At, B0); PG_MMA(0, 1, At, B1); PG_BAR; PG_SCHED;
            PG_LDA(At, 0, 1); PG_STAGE(PG_SB(0, 0), b2, offB[0], k2); PG_STAGE(PG_SB(0, 1), b2, offB[1], k2); PG_STAGE(PG_SA(0, 0), a2, o2[0], k2);
            PG_WAIT_V(8); PG_WAIT_L(0); PG_BAR; PG_MMA(1, 0, At, B0); PG_MMA(1, 1, At, B1); PG_BAR; PG_SCHED;
            PG_LDB(B0, 1, 0); PG_LDB(B1, 1, 1); PG_SCHED; PG_LDA(At, 1, 0); PG_STAGE(PG_SA(0, 1), a2, o2[1], k2);
            PG_WAIT_V(8); PG_WAIT_L(0); PG_BAR; PG_MMA(0, 0, At, B0); PG_MMA(0, 1, At, B1); PG_BAR; PG_SCHED;
            PG_LDA(At, 1, 1); PG_STAGE(PG_SB(1, 0), b2, offB[0], k3); PG_STAGE(PG_SB(1, 1), b2, offB[1], k3); PG_STAGE(PG_SA(1, 0), a2, o2[0], k3);
            PG_WAIT_V(8); PG_WAIT_L(0); PG_BAR; PG_MMA(1, 0, At, B0); PG_MMA(1, 1, At, B1); PG_BAR; PG_SCHED;
        }
        if (wr == 0) PG_BAR;
        if constexpr (FP8) asm volatile("s_nop 15\n\ts_nop 15" ::: "memory");
        { int fr_ = fr, fq_ = fq; asm volatile("" : "+v"(fr_), "+v"(fq_));
          E(acc, cur, wr, wc, fr_, fq_);
#ifdef PROBE_EPI2
          asm volatile("" : "+v"(fr_), "+v"(fq_)); E(acc, cur, wr, wc, fr_, fq_);
#endif
        }
        if (!has_next) break;
#pragma unroll
        for (int a = 0; a < 2; ++a)
#pragma unroll
            for (int b = 0; b < 2; ++b)
#pragma unroll
                for (int m = 0; m < 4; ++m)
#pragma unroll
                    for (int n = 0; n < 2; ++n) acc[a][b][m][n] = (f32x4){0.f, 0.f, 0.f, 0.f};
        cur = nxt; cA = nA; cB = nB; ++ui;
#pragma unroll
        for (int h = 0; h < 2; ++h)
#pragma unroll
            for (int i = 0; i < 2; ++i) cOA[h][i] = nOA[h][i];
        if (wr == 1) PG_BAR;
    }
    PG_WAIT_V(0);
    PG_BAR;
#undef PG_SA
#undef PG_SB
#undef PG_STAGE
#undef PG_LDA
#undef PG_LDB
#undef PG_MMA
#undef PG_CAT8
#undef PG_WAIT_V
#undef PG_WAIT_L
#undef PG_BAR
#undef PG_SCHED
}

struct Order {
    int nM, nN, nwg, G, c;
    __device__ void init(int nM_, int nN_, int G_, int c_) { nM = nM_; nN = nN_; nwg = nM * nN; G = G_; c = c_; }
    __device__ bool get(int i, int& pm, int& pn) const {
        const long L = (long)i * G + c; if (L >= nwg) return false;
        int wgid = (int)L; { const int q = nwg / 8, r = nwg % 8, xcd = wgid % 8, off = wgid / 8; wgid = (xcd < r ? xcd * (q + 1) : r * (q + 1) + (xcd - r) * q) + off; }
        const int nig = 8 * nN, gid = wgid / nig, fm = gid * 8, gsz = (nM - fm) < 8 ? (nM - fm) : 8;
        pm = fm + ((wgid % nig) % gsz); pn = (wgid % nig) / gsz; return true;
    }
};
struct Dense {
    const char* A; const char* B; unsigned lda_bytes, ldb_bytes; int nt; Order ord; int pn_base = 0, pn_split = 1 << 30, pn_skip = 0, b_tile0 = 0;
    __device__ bool next(int i, Unit& u) const { u.g = 0; int pp; const bool ok = ord.get(i, u.pm, pp); u.pn = pn_base + pp + (pp >= pn_split ? pn_skip : 0); return ok; }
    __device__ const char* a_base(const Unit& u) const { return A + (size_t)u.pm * 256 * lda_bytes; }
    __device__ unsigned a_off(const Unit&, int row, int col) const { return (unsigned)row * lda_bytes + (unsigned)col * 2u; }
    __device__ const char* b_base(const Unit& u) const { return B + (size_t)(u.pn - b_tile0) * 256 * ldb_bytes; }
};
}

struct Frame {
    LAS unsigned char* lds;
    int tid, lane, wave, G, bid, dry;
    const float* in[30]; float* out; unsigned char* ws;
};
#define WSP(T_, off) ((T_*)(F.ws + (off)))
#define LDS_WAIT() asm volatile("s_waitcnt lgkmcnt(0)" ::: "memory")

template <class DstRow>
__device__ __forceinline__ void transpose_item(const float* W, int K, int N, bf16_t* WT, LAS float* scr, int item, int lane, const DstRow& dstrow) {
    const int nblk = (N + 63) / 64, kb = item / nblk, nb = item % nblk, k0 = 64 * kb, n0 = 64 * nb;
    const int kk = lane >> 4, n4 = (lane & 15) * 4;
    f32x4 v[16];
#pragma unroll
    for (int i = 0; i < 16; ++i) v[i] = *(const f32x4*)(W + (size_t)(k0 + 4 * i + kk) * N + n0 + n4);
#pragma unroll
    for (int i = 0; i < 16; ++i) { LAS float* d = scr + (4 * i + kk) * 65 + n4; d[0] = v[i].x; d[1] = v[i].y; d[2] = v[i].z; d[3] = v[i].w; }
    LDS_WAIT(); asm volatile("" ::: "memory");
    const int c = lane & 7;
#pragma unroll
    for (int j = 0; j < 8; ++j) { const int n = (lane >> 3) + 8 * j; const LAS float* p = scr + (8 * c) * 65 + n; const int dr = dstrow(n0 + n);
        if (dr >= 0) { u32x4 o; o.x = pk2(p[0], p[65]); o.y = pk2(p[130], p[195]); o.z = pk2(p[260], p[325]); o.w = pk2(p[390], p[455]);
            *(u32x4*)(WT + (size_t)dr * K + k0 + 8 * c) = o; } }
    LDS_WAIT(); asm volatile("" ::: "memory");
}
__device__ __forceinline__ void tr8_load(f32x4 (&v)[16], const float* W, int K, int N, int item, int lane) {
    const int nblk = (N + 63) / 64, kb = item / nblk, nb = item % nblk, k0 = 64 * kb, n0 = 64 * nb; const int kk = lane >> 4, n4 = (lane & 15) * 4;
#pragma unroll
    for (int i = 0; i < 16; ++i) v[i] = *(const f32x4*)(W + (size_t)(k0 + 4 * i + kk) * N + n0 + n4);
}
template <class DstRow>
__device__ __forceinline__ void tr8_process(const f32x4 (&v)[16], int K, int N, unsigned char* WT, LAS float* scr, int item, int lane, float scale, const DstRow& dstrow) {
    const int nblk = (N + 63) / 64, kb = item / nblk, nb = item % nblk, k0 = 64 * kb, n0 = 64 * nb; const int kk = lane >> 4, n4 = (lane & 15) * 4;
#pragma unroll
    for (int i = 0; i < 16; ++i) { LAS float* d = scr + (4 * i + kk) * 65 + n4; d[0] = v[i].x * scale; d[1] = v[i].y * scale; d[2] = v[i].z * scale; d[3] = v[i].w * scale; }
    LDS_WAIT(); asm volatile("" ::: "memory");
    const int c = lane & 3;
#pragma unroll
    for (int j = 0; j < 4; ++j) { const int n = (lane >> 2) + 16 * j; const LAS float* p = scr + (16 * c) * 65 + n; const int dr = dstrow(n0 + n);
        u32x4 o; o.x = pk4_fp8(p[0], p[65], p[130], p[195]); o.y = pk4_fp8(p[260], p[325], p[390], p[455]); o.z = pk4_fp8(p[520], p[585], p[650], p[715]); o.w = pk4_fp8(p[780], p[845], p[910], p[975]);
        *(u32x4*)(WT + (size_t)dr * K + k0 + 16 * c) = o; }
    LDS_WAIT(); asm volatile("" ::: "memory");
}
template <class DstRow>
__device__ __forceinline__ void transpose_item_fp8(const float* W, int K, int N, unsigned char* WT, LAS float* scr, int item, int lane, float scale, const DstRow& dstrow) {
    f32x4 v[16]; tr8_load(v, W, K, N, item, lane); tr8_process(v, K, N, WT, scr, item, lane, scale, dstrow);
}
__device__ __forceinline__ int win_dst_row(int c) {
    if (c < 512) return perm16_row(c);
    if (c < 1536) { const int isk = c >= 1024, cc = c - (isk ? 1024 : 512), t = cc >> 8, w = cc & 255; return ((isk ? 4 : 2) + t) * 256 + ((w >> 5) & 1) * 128 + (w >> 6) * 32 + ((w >> 2) & 1) * 16 + ((w >> 3) & 3) * 4 + (w & 3); }
    if (c < 2048) return 1536 + perm16_row(c - 1536);
    if (c < 2304) { const int w = c - 2048, head = w >> 5, bj = (w >> 4) & 1, dd = w & 15; return 2048 + bj * 128 + (head >> 1) * 32 + ((dd >> 2) & 1) * 16 + (2 * (head & 1) + (dd >> 3)) * 4 + (dd & 3); }
    if (c < 2336) { const int cc = c - 2304, half = cc >> 4, w = cc & 15; return 9 * 256 + half * 128 + w; }
    if (c < 2344) return 9 * 256 + 16 + (c - 2336);
    if (c < INC) return 2560 + perm16_row(c - 2344);
    return -1;
}
__device__ __forceinline__ void rms_row_to_bf16(const float* xrow, const float* gain, bf16_t* orow, unsigned char* orow8, int lane) {
    const f32x4* xr = (const f32x4*)xrow + lane; const f32x4* gr = (const f32x4*)gain + lane;
    f32x4 v[4]; float s = 0.f;
#pragma unroll
    for (int j = 0; j < 4; ++j) { v[j] = xr[64 * j]; s += (v[j].x * v[j].x + v[j].y * v[j].y) + (v[j].z * v[j].z + v[j].w * v[j].w); }
    const float rstd = 1.0f / sqrtf(wave_sum(s) * (1.f / 1024.f) + EPS);
    u32x2* o8 = (u32x2*)orow + lane;
#pragma unroll
    for (int j = 0; j < 4; ++j) { const f32x4 g = gr[64 * j]; const float a0 = v[j].x * rstd * g.x, a1 = v[j].y * rstd * g.y, a2 = v[j].z * rstd * g.z, a3 = v[j].w * rstd * g.w;
        u32x2 w; w.x = pk2(a0, a1); w.y = pk2(a2, a3); o8[64 * j] = w; ((unsigned*)orow8)[lane + 64 * j] = pk4_fp8(a0, a1, a2, a3); }
}

__device__ __forceinline__ void p0_prologue(Frame& F) {
    LAS float* scr = (LAS float*)(F.lds + F.wave * 16640);
    const int gw = F.bid * 8 + F.wave, NGW = F.G * 8;
    { unsigned* ctl = WSP(unsigned, WS_CTL); for (int i = F.bid * NTHR + F.tid; i < CTL_WORDS; i += F.G * NTHR) ctl[i] = 0u; }
    { float* c64 = WSP(float, WS_COS64); float* s64 = WSP(float, WS_SIN64); float* c32 = WSP(float, WS_COS32); float* s32 = WSP(float, WS_SIN32);
      for (int i = F.bid * NTHR + F.tid; i < 4096 * 48; i += F.G * NTHR) {
          if (i < 4096 * 32) { const int pos = i >> 5, k = i & 31; const float inv = powf(10000.0f, -(float)k * (2.0f / 64.0f)); const float a = (float)pos * inv; c64[i] = cosf(a); s64[i] = sinf(a); }
          else { const int j = i - 4096 * 32, pos = j >> 4, k = j & 15; const float inv = powf(10000.0f, -(float)k * (2.0f / 32.0f)); const float a = (float)pos * inv; c32[j] = cosf(a); s32[j] = sinf(a); } } }
    { bf16_t* WT = WSP(bf16_t, WS_WINT) + (size_t)256 * 1024; unsigned char* W8 = WSP(unsigned char, WS_WIN8) + (size_t)9 * 256 * 1024;
      for (int i = F.bid * NTHR + F.tid; i < 256 * 128; i += F.G * NTHR) { const int row = i >> 7, ch = i & 127; const int w = row & 127, half = row >> 7;
          const bool used = (w < 16) || (half == 0 && w < 24); if (!used) { *(u32x4*)(WT + (size_t)row * 1024 + ch * 8) = (u32x4){0u, 0u, 0u, 0u}; if (ch < 64) *(u32x4*)(W8 + (size_t)row * 1024 + ch * 16) = (u32x4){0u, 0u, 0u, 0u}; } } }
    constexpr int I_WIN = ((INC + 63) / 64) * (1024 / 64), I_GLU = (512 / 64) * (512 / 64), I_SB = (1024 / 64) * (512 / 64), I_AB = I_SB, I_O = (1024 / 64) * (1024 / 64), I_PG = I_O, I_PP = (1024 / 64) * (256 / 64);
    constexpr int I_E = (1024 / 64) * (1024 / 64);
    constexpr int NDENSE = I_WIN + I_GLU + I_SB + I_AB + I_O + I_PG + I_PP;
    auto p16 = [](int n) { return perm16_row(n); };
    for (int it = gw; it < NDENSE; it += NGW) {
        int r = it;
        if (r < I_WIN) {
            const int nblk = (INC + 63) / 64, nb = r % nblk;
            if (nb * 64 + 64 <= INC) { transpose_item_fp8(F.in[2], 1024, INC, WSP(unsigned char, WS_WIN8), scr, r, F.lane, 32.0f, [](int n) { return win_dst_row(n); });
                if (nb * 64 + 64 > 2048 && nb * 64 < 2344) transpose_item(F.in[2], 1024, INC, WSP(bf16_t, WS_WINT), scr, r, F.lane, [](int n) { const int d = win_dst_row(n); return (d >= 2048 && d < 2560) ? d - 2048 : -1; }); }
            else { const int kb = r / nblk, k0 = 64 * kb, n0 = 64 * nb; const int n = n0 + F.lane; const int dr = n < INC ? win_dst_row(n) : -1;
                if (dr >= 0) { unsigned char* o = WSP(unsigned char, WS_WIN8) + (size_t)dr * 1024 + k0;
                    for (int k = 0; k < 64; k += 4) *(unsigned*)(o + k) = pk4_fp8(32.0f * F.in[2][(size_t)(k0 + k) * INC + n], 32.0f * F.in[2][(size_t)(k0 + k + 1) * INC + n], 32.0f * F.in[2][(size_t)(k0 + k + 2) * INC + n], 32.0f * F.in[2][(size_t)(k0 + k + 3) * INC + n]); } }
            continue; } r -= I_WIN;
        if (r < I_GLU) { transpose_item(F.in[12], 512, 512, WSP(bf16_t, WS_WGLUT), scr, r, F.lane, p16); continue; } r -= I_GLU;
        if (r < I_SB) { transpose_item_fp8(F.in[14], 512, 1024, WSP(unsigned char, WS_WSB8), scr, r, F.lane, 32.0f, p16); continue; } r -= I_SB;
        if (r < I_AB) { transpose_item_fp8(F.in[15], 512, 1024, WSP(unsigned char, WS_WAB8), scr, r, F.lane, 32.0f, p16); continue; } r -= I_AB;
        if (r < I_O) { transpose_item_fp8(F.in[16], 1024, 1024, WSP(unsigned char, WS_WO8), scr, r, F.lane, 32.0f, p16); continue; } r -= I_O;
        if (r < I_PG) { transpose_item_fp8(F.in[27], 1024, 1024, WSP(unsigned char, WS_WPG8), scr, r, F.lane, 32.0f, p16); continue; } r -= I_PG;
        transpose_item(F.in[28], 256, 1024, WSP(bf16_t, WS_WPPT), scr, r, F.lane, p16);
    }
    for (int m = gw; m < T; m += NGW) rms_row_to_bf16(F.in[0] + (size_t)m * 1024, F.in[17], WSP(bf16_t, WS_E) + (size_t)m * 1024, WSP(unsigned char, WS_H8) + (size_t)m * 1024, F.lane);
}

__device__ __forceinline__ void p0_s5_tables(Frame& F) {
    LAS float* zr = (LAS float*)F.lds; LAS float* zi = zr + 64; LAS float* bbr = zi + 64; LAS float* bbi = bbr + 1024; LAS float* Lr = bbi + 1024; LAS float* Li = Lr + 512;
    const float* lam_re = F.in[4]; const float* lam_im = F.in[5]; const float* log_dt = F.in[6]; const float* b_re = F.in[7]; const float* b_im = F.in[8];
    const float* c_re = F.in[9]; const float* c_im = F.in[10]; const float* d_skip = F.in[11];
    float* Kg = WSP(float, WS_KG); float* L64 = WSP(float, WS_L64); bf16_t* Wg = WSP(bf16_t, WS_WG); bf16_t* TV = WSP(bf16_t, WS_TV);
    for (int it = F.bid; it < 256; it += F.G) {
        const int g = it >> 3, sub = it & 7, tid = F.tid;
        __syncthreads();
        const float dt = expf(log_dt[g]);
        if (tid < 64) { zr[tid] = lam_re[g * 64 + tid] * dt; zi[tid] = lam_im[g * 64 + tid] * dt; }
        __syncthreads();
        for (int idx = tid; idx < 1024; idx += NTHR) { const int p = idx >> 4, hp = idx & 15;
            const float lr = lam_re[g * 64 + p], li = lam_im[g * 64 + p];
            const float er = expf(zr[p]), cr = er * cosf(zi[p]), ci = er * sinf(zi[p]);
            const float nr = cr - 1.0f, ni = ci, den = lr * lr + li * li;
            const float fr_ = (nr * lr + ni * li) / den, fi_ = (ni * lr - nr * li) / den;
            const float br = b_re[(g * 64 + p) * 16 + hp], bi = b_im[(g * 64 + p) * 16 + hp];
            bbr[idx] = fr_ * br - fi_ * bi; bbi[idx] = fr_ * bi + fi_ * br; }
        { const int lagl = tid >> 6, p = tid & 63; const float n = (float)(8 * sub + lagl); const float mag = expf(n * zr[p]), a = n * zi[p]; Lr[tid] = mag * cosf(a); Li[tid] = mag * sinf(a); }
        __syncthreads();
#pragma unroll 1
        for (int j = 0; j < 4; ++j) { const int o = tid + 512 * j, lagl = o >> 8, h = (o >> 4) & 15, hp = o & 15; float s = 0.f;
            for (int p = 0; p < 64; ++p) { const float cr = c_re[(g * 16 + h) * 64 + p], ci = c_im[(g * 16 + h) * 64 + p], lr = Lr[lagl * 64 + p], li = Li[lagl * 64 + p];
                const float tr = cr * lr - ci * li, ti = cr * li + ci * lr; s += tr * bbr[p * 16 + hp] - ti * bbi[p * 16 + hp]; }
            const int lag = 8 * sub + lagl; if (lag == 0 && h == hp) s += d_skip[g * 16 + h];
            Kg[((g * 64 + lag) * 16 + h) * 16 + hp] = s; }
        { const int pl = tid >> 6, j = tid & 63, p = 8 * sub + pl;
          { const float n = (float)(63 - j); const float mag = expf(n * zr[p]), a = n * zi[p]; const float er = mag * cosf(a), ei = mag * sinf(a);
            unsigned wre[8], wim[8];
#pragma unroll
            for (int q = 0; q < 8; ++q) { const float b0r = bbr[p * 16 + 2 * q], b0i = bbi[p * 16 + 2 * q], b1r = bbr[p * 16 + 2 * q + 1], b1i = bbi[p * 16 + 2 * q + 1];
                wre[q] = pk2(er * b0r - ei * b0i, er * b1r - ei * b1i); wim[q] = pk2(er * b0i + ei * b0r, er * b1i + ei * b1r); }
            u32x4* dre = (u32x4*)(Wg + (size_t)(g * 128 + p) * 1024 + j * 16); u32x4* dim = (u32x4*)(Wg + (size_t)(g * 128 + 64 + p) * 1024 + j * 16);
            dre[0] = (u32x4){wre[0], wre[1], wre[2], wre[3]}; dre[1] = (u32x4){wre[4], wre[5], wre[6], wre[7]};
            dim[0] = (u32x4){wim[0], wim[1], wim[2], wim[3]}; dim[1] = (u32x4){wim[4], wim[5], wim[6], wim[7]}; }
          { const int t = j; const float n = (float)(t + 1); const float mag = expf(n * zr[p]), a = n * zi[p]; const float er = mag * cosf(a), ei = mag * sinf(a);
#pragma unroll 4
            for (int h = 0; h < 16; ++h) { const float cr = c_re[(g * 16 + h) * 64 + p], ci = c_im[(g * 16 + h) * 64 + p];
                bf16_t* d = TV + (size_t)(g * 1024 + t * 16 + h) * 1152 + 1024 + p;
                d[0] = (bf16_t)f2bf(cr * er - ci * ei); d[64] = (bf16_t)f2bf(-(cr * ei + ci * er)); } }
          if (sub == 0 && tid < 64) { const float mag = expf(64.0f * zr[tid]), a = 64.0f * zi[tid]; L64[(g * 64 + tid) * 2] = mag * cosf(a); L64[(g * 64 + tid) * 2 + 1] = mag * sinf(a); }
        }
    }
    __syncthreads();
}
__device__ __forceinline__ void fill_tv_item(unsigned char* wsb, int tid, int item) {
    const float* Kg = (const float*)(wsb + WS_KG); bf16_t* TV = (bf16_t*)(wsb + WS_TV);
#pragma unroll 4
    for (int it = 0; it < 16; ++it) { const int ci = (item * 16 + it) * NTHR + tid;
        const int g = ci >> 17, row = (ci >> 7) & 1023, ch = ci & 127, t = row >> 4, h = row & 15, j = ch >> 1, h0 = (ch & 1) * 8, lag = t - j;
        u32x4 o = (u32x4){0u, 0u, 0u, 0u};
        if (lag >= 0) { const f32x4* sp = (const f32x4*)(Kg + ((g * 64 + lag) * 16 + h) * 16 + h0); const f32x4 a = sp[0], b = sp[1];
            o.x = pk2(a.x, a.y); o.y = pk2(a.z, a.w); o.z = pk2(b.x, b.y); o.w = pk2(b.z, b.w); }
        *(u32x4*)(TV + (size_t)(g * 1024 + row) * 1152 + ch * 8) = o; }
}

struct EpiInProj {
    bf16_t *U, *Q, *K, *V, *QI, *KI, *GS, *GA; float* WI; const float *bg, *c64, *s64, *c32, *s32; float ascale;
    __device__ __forceinline__ void operator()(f32x4 (&acc)[2][2][4][2], const pg::Unit& u, int wr, int wc, int fr, int fq) const {
        const int pn = u.pn, row0 = u.pm * 256 + wr * 64 + fr;
        if (ascale != 1.0f) {
#pragma unroll
            for (int a_ = 0; a_ < 2; ++a_)
#pragma unroll
                for (int b_ = 0; b_ < 2; ++b_)
#pragma unroll
                    for (int m_ = 0; m_ < 4; ++m_)
#pragma unroll
                        for (int n_ = 0; n_ < 2; ++n_) acc[a_][b_][m_][n_] *= ascale; }
        auto st32 = [](bf16_t* d, const f32x4& a, const f32x4& b) { const u32x2 x = pkbf4(a), y = pkbf4(b); *(u32x4*)d = (u32x4){x.x, x.y, y.x, y.y}; };
        if (pn < 2 || pn == 6 || pn == 7) {
            const int c0 = (pn & 1) * 256 + wc * 64 + fq * 16;
#pragma unroll
            for (int ai = 0; ai < 2; ++ai)
#pragma unroll
                for (int m = 0; m < 4; ++m) { const int r = row0 + ai * 128 + m * 16;
                    bf16_t* d = pn < 2 ? U + ((size_t)((c0 >> 4) * 512 + (r >> 6)) * 1152 + (r & 63) * 16) : V + (size_t)r * 512 + c0;
                    st32(d, acc[ai][0][m][0], acc[ai][0][m][1]); st32(d + 8, acc[ai][1][m][0], acc[ai][1][m][1]); }
        } else if (pn < 6) {
            bf16_t* O = pn < 4 ? Q : K; const float sc = pn < 4 ? C2 : 1.0f; const int head = (pn & 1) * 4 + wc, dd = fq * 8;
#pragma unroll
            for (int ai = 0; ai < 2; ++ai)
#pragma unroll
                for (int m = 0; m < 4; ++m) { const int r = row0 + ai * 128 + m * 16, l = r & 4095; bf16_t* d = O + (size_t)r * 512 + head * 64 + dd; f32x4 o1[2], o2[2];
#pragma unroll
                    for (int n = 0; n < 2; ++n) { const f32x4 cs = *(const f32x4*)(c64 + l * 32 + dd + 4 * n), sn = *(const f32x4*)(s64 + l * 32 + dd + 4 * n); const f32x4 x1 = acc[ai][0][m][n], x2 = acc[ai][1][m][n];
                        o1[n] = (x1 * cs - x2 * sn) * sc; o2[n] = (x2 * cs + x1 * sn) * sc; }
                    st32(d, o1[0], o1[1]); st32(d + 32, o2[0], o2[1]); }
        } else if (pn == 8) {
            const int head = 2 * wc + (fq >> 1), dd = (fq & 1) * 8;
#pragma unroll
            for (int ai = 0; ai < 2; ++ai)
#pragma unroll
                for (int m = 0; m < 4; ++m) { const int r = row0 + ai * 128 + m * 16, l = r & 4095; bf16_t* d = QI + (size_t)r * 256 + head * 32 + dd; f32x4 o1[2], o2[2];
#pragma unroll
                    for (int n = 0; n < 2; ++n) { const f32x4 cs = *(const f32x4*)(c32 + l * 16 + dd + 4 * n), sn = *(const f32x4*)(s32 + l * 16 + dd + 4 * n); const f32x4 x1 = acc[ai][0][m][n], x2 = acc[ai][1][m][n];
                        o1[n] = x1 * cs - x2 * sn; o2[n] = x2 * cs + x1 * sn; }
                    st32(d, o1[0], o1[1]); st32(d + 16, o2[0], o2[1]); }
        } else if (pn == 9) {
            if (wc == 0) {
#pragma unroll
                for (int ai = 0; ai < 2; ++ai)
#pragma unroll
                    for (int m = 0; m < 4; ++m) { const int r = row0 + ai * 128 + m * 16, l = r & 4095;
                        const f32x4 cs = *(const f32x4*)(c32 + l * 16 + fq * 4), sn = *(const f32x4*)(s32 + l * 16 + fq * 4);
                        const f32x4 x1 = acc[ai][0][m][0], x2 = acc[ai][1][m][0]; const f32x4 o1 = x1 * cs - x2 * sn, o2 = x2 * cs + x1 * sn;
                        bf16_t* d = KI + (size_t)r * 32 + fq * 4; *(u32x2*)d = pkbf4(o1); *(u32x2*)(d + 16) = pkbf4(o2);
                        if (fq < 2) *(f32x4*)(WI + (size_t)r * 8 + fq * 4) = acc[ai][0][m][1]; } }
        } else {
            const int gc = (pn - 10) * 256 + wc * 64 + fq * 16; f32x4 b[4];
#pragma unroll
            for (int q = 0; q < 4; ++q) b[q] = *(const f32x4*)(bg + gc + 4 * q);
            unsigned char* O = (unsigned char*)GS + (gc < 1024 ? (size_t)gc : (size_t)T * 1024 + (gc - 1024));
#pragma unroll
            for (int ai = 0; ai < 2; ++ai)
#pragma unroll
                for (int m = 0; m < 4; ++m) { const int r = row0 + ai * 128 + m * 16;
                    *(u32x4*)(O + (size_t)r * 1024) = (u32x4){pkf84(sig4(acc[ai][0][m][0] + b[0])), pkf84(sig4(acc[ai][0][m][1] + b[1])), pkf84(sig4(acc[ai][1][m][0] + b[2])), pkf84(sig4(acc[ai][1][m][1] + b[3]))}; }
        }
    }
};

__device__ __forceinline__ void idx_score_tile(bf16x8 k0, bf16x8 k1, const bf16x8 (&qp)[2], const bf16x8 (&qf)[8][2], const float (&w)[8], float (&sc)[16]) {
    const f32x16 z = (f32x16){0.f, 0.f, 0.f, 0.f, 0.f, 0.f, 0.f, 0.f, 0.f, 0.f, 0.f, 0.f, 0.f, 0.f, 0.f, 0.f};
    f32x16 lin = __builtin_amdgcn_mfma_f32_32x32x16_bf16(k0, qp[0], z, 0, 0, 0); lin = __builtin_amdgcn_mfma_f32_32x32x16_bf16(k1, qp[1], lin, 0, 0, 0);
    f32x16 dA = __builtin_amdgcn_mfma_f32_32x32x16_bf16(k0, qf[0][0], z, 0, 0, 0); dA = __builtin_amdgcn_mfma_f32_32x32x16_bf16(k1, qf[0][1], dA, 0, 0, 0);
#pragma unroll
    for (int r = 0; r < 16; ++r) sc[r] = lin[r];
#pragma unroll
    for (int h = 0; h < 8; ++h) {
        f32x16 dB = z;
        if (h < 7) { dB = __builtin_amdgcn_mfma_f32_32x32x16_bf16(k0, qf[h + 1][0], z, 0, 0, 0); dB = __builtin_amdgcn_mfma_f32_32x32x16_bf16(k1, qf[h + 1][1], dB, 0, 0, 0); }
#pragma unroll
        for (int r = 0; r < 16; ++r) sc[r] = __builtin_fmaf(w[h], __builtin_fabsf(dA[r]), sc[r]);
        asm volatile("" : "+v"(sc[0]), "+v"(sc[1]), "+v"(sc[2]), "+v"(sc[3]), "+v"(sc[4]), "+v"(sc[5]), "+v"(sc[6]), "+v"(sc[7]), "+v"(k0));
        asm volatile("" : "+v"(sc[8]), "+v"(sc[9]), "+v"(sc[10]), "+v"(sc[11]), "+v"(sc[12]), "+v"(sc[13]), "+v"(sc[14]), "+v"(sc[15]), "+v"(k1));
        dA = dB;
    }
}
__device__ __forceinline__ unsigned h16_of(float s) { const _Float16 hf = (_Float16)s; return (unsigned)__builtin_bit_cast(unsigned short, hf); }
__device__ __forceinline__ void idx_scan(const LAS unsigned* hq, unsigned need, int mode, unsigned& fb, unsigned& frem) {
    unsigned cum = 0; fb = 0; frem = 1; bool found = false;
    for (int k = 0; k < 256; ++k) { const int bin = mode == 0 ? (k < 128 ? 127 - k : k) : mode == 1 ? 255 - k : k; const unsigned c = hq[bin * 32];
        if (!found && cum + c >= need) { fb = (unsigned)bin; frem = need - cum; found = true; } cum += c; }
}
__device__ __forceinline__ void idx_phase(Frame& F) {
    LAS unsigned* hist = (LAS unsigned*)F.lds;
    LAS unsigned* b1s = hist + 16384; LAS unsigned* r1s = b1s + 64; LAS unsigned* ths = r1s + 64;
    const bf16_t* QI = WSP(bf16_t, WS_QIDX); const bf16_t* KI = WSP(bf16_t, WS_KIDX); const float* WI = WSP(float, WS_WIDX); unsigned* MASK = WSP(unsigned, WS_MASK);
    const int lane = F.lane, r32 = lane & 31, hi = lane >> 5, gq = F.wave & 1, ks = F.wave >> 1;
    LAS int* qslot = (LAS int*)(F.lds + 68 * 1024);
    unsigned* qhead = WSP(unsigned, WS_CTL) + CW_QIDX + (F.dry ? 16 : 0);
    for (;;) {
            __syncthreads();
            if (F.tid == 0) *qslot = (int)__hip_atomic_fetch_add(qhead, 1u, __ATOMIC_RELAXED, __HIP_MEMORY_SCOPE_AGENT);
            __syncthreads();
            const int qpos = *qslot; if (qpos >= 1024) break;
            if (qpos & 1) { if (!F.dry) fill_tv_item(F.ws, F.tid, qpos >> 1); continue; }
            const int un = qpos >> 1;
            const int qb = 63 - (un >> 3), b = un & 7;
            const int q0 = qb * 64 + gq * 32, tok = b * 4096 + q0 + r32, ntile = (qb + 1) * 2;
            bf16x8 qf[8][2], qp[2]; float w[8];
#pragma unroll
            for (int h = 0; h < 8; ++h)
#pragma unroll
                for (int k = 0; k < 2; ++k) qf[h][k] = *(const bf16x8*)(QI + (size_t)tok * 256 + h * 32 + k * 16 + hi * 8);
            { const f32x4 wa = *(const f32x4*)(WI + (size_t)tok * 8), wb = *(const f32x4*)(WI + (size_t)tok * 8 + 4); w[0] = wa.x; w[1] = wa.y; w[2] = wa.z; w[3] = wa.w; w[4] = wb.x; w[5] = wb.y; w[6] = wb.z; w[7] = wb.w; }
#pragma unroll
            for (int k = 0; k < 2; ++k) { float a[8];
#pragma unroll
                for (int j = 0; j < 8; ++j) a[j] = 0.f;
#pragma unroll
                for (int h = 0; h < 8; ++h)
#pragma unroll
                    for (int j = 0; j < 8; ++j) a[j] = __builtin_fmaf(w[h], bf2f((unsigned short)qf[h][k][j]), a[j]);
                u32x4 pkd; pkd.x = pk2(a[0], a[1]); pkd.y = pk2(a[2], a[3]); pkd.z = pk2(a[4], a[5]); pkd.w = pk2(a[6], a[7]); qp[k] = __builtin_bit_cast(bf16x8, pkd); }
            const bf16_t* kbase = KI + (size_t)(b * 4096 + r32) * 32 + hi * 8;
            LAS unsigned* hq = hist + gq * 8192 + r32;
            _Float16 theta = (_Float16)(-INFINITY); float sc[16]; bf16x8 kn0, kn1;
#define IDX_TILES(BODY) do { kn0 = *(const bf16x8*)(kbase + (size_t)ks * 1024); kn1 = *(const bf16x8*)(kbase + (size_t)ks * 1024 + 16); \
            for (int kt = ks; kt < ntile; kt += 4) { const bf16x8 kc0 = kn0, kc1 = kn1; \
                if (kt + 4 < ntile) { kn0 = *(const bf16x8*)(kbase + (size_t)(kt + 4) * 1024); kn1 = *(const bf16x8*)(kbase + (size_t)(kt + 4) * 1024 + 16); } \
                idx_score_tile(kc0, kc1, qp, qf, w, sc); BODY } } while (0)
            if (qb >= 4) {
                for (int i = F.tid; i < 16384; i += NTHR) hist[i] = 0u;
                __syncthreads();
                IDX_TILES({
                    _Pragma("unroll") for (int r = 0; r < 16; ++r) __hip_atomic_fetch_add(hq + (h16_of(sc[r]) >> 8) * 32, 1u, __ATOMIC_RELAXED, __HIP_MEMORY_SCOPE_WORKGROUP); });
                __syncthreads();
                if (ks == 0 && hi == 0) { unsigned fb, fr_; idx_scan(hq, 256u, 0, fb, fr_); b1s[gq * 32 + r32] = fb; r1s[gq * 32 + r32] = fr_; }
                __syncthreads();
                for (int i = F.tid; i < 16384; i += NTHR) hist[i] = 0u;
                __syncthreads();
                const unsigned b1 = b1s[gq * 32 + r32];
                IDX_TILES({
                    _Pragma("unroll") for (int r = 0; r < 16; ++r) { const unsigned hv = h16_of(sc[r]); if ((hv >> 8) == b1) __hip_atomic_fetch_add(hq + (hv & 255u) * 32, 1u, __ATOMIC_RELAXED, __HIP_MEMORY_SCOPE_WORKGROUP); } });
                __syncthreads();
                if (ks == 0 && hi == 0) { unsigned fb, fr_; const unsigned bb = b1s[gq * 32 + r32]; idx_scan(hq, r1s[gq * 32 + r32], bb < 128u ? 1 : 2, fb, fr_); ths[gq * 32 + r32] = (bb << 8) | fb; }
                __syncthreads();
                theta = __builtin_bit_cast(_Float16, (unsigned short)ths[gq * 32 + r32]);
            }
            IDX_TILES({
                unsigned bits = 0u;
                _Pragma("unroll") for (int r = 0; r < 16; ++r) bits |= ((_Float16)sc[r] >= theta ? 1u : 0u) << ((r & 3) + 8 * (r >> 2));
                bits <<= 4 * hi;
                bits |= (unsigned)__shfl_xor((int)bits, 32);
                if (hi == 0) MASK[(size_t)(b * 128 + kt) * 4096 + q0 + r32] = bits; });
#undef IDX_TILES
    }
}

constexpr int CV_IE = (1024 / 64) * (1024 / 64), CV_NITEMS = 3 * 32 * CV_IE, CV_NBLK = CV_NITEMS / 8;
__device__ __forceinline__ void expert_conv_item(LAS unsigned char* lds, unsigned char* ws, int wave, int lane, const float* wg_, const float* wu_, const float* wd_, int bitem) {
    LAS float* scr = (LAS float*)(lds + wave * 16640);
    const int r = bitem * 8 + wave, which = r / (32 * CV_IE), e = (r % (32 * CV_IE)) / CV_IE, item = r % CV_IE;
    auto w1row = [](int c) { const int pn = c >> 7, w = c & 127; return pn * 256 + (w & 96) + ((w >> 2) & 1) * 16 + ((w >> 3) & 3) * 4 + (w & 3); };
    const float* src = (which == 0 ? wg_ : which == 1 ? wu_ : wd_) + (size_t)e * 1024 * 1024;
    if (which == 0) transpose_item_fp8(src, 1024, 1024, ws + WS_W1T + (size_t)e * 2048 * 1024, scr, item, lane, 32.0f, w1row);
    else if (which == 1) transpose_item_fp8(src, 1024, 1024, ws + WS_W1T + (size_t)e * 2048 * 1024, scr, item, lane, 32.0f, [=](int c) { return w1row(c) + 128; });
    else transpose_item_fp8(src, 1024, 1024, ws + WS_W2T + (size_t)e * 1024 * 1024, scr, item, lane, 32.0f, [](int n) { return perm16_row(n); });
}
__device__ __forceinline__ s16x4 vtr(const LAS char* p) { typedef short v4i16_t __attribute__((ext_vector_type(4))); return __builtin_bit_cast(s16x4, __builtin_amdgcn_ds_read_tr16_b64_v4i16((LAS v4i16_t*)p)); }
__device__ __forceinline__ void glds16(const void* gsrc, unsigned lds_dst) {
    unsigned keep; asm volatile("s_mov_b32 %0, m0\n\ts_mov_b32 m0, %2\n\ts_nop 0\n\tglobal_load_lds_dwordx4 %1, off\n\ts_mov_b32 m0, %0" : "=&s"(keep) : "v"(gsrc), "s"(lds_dst) : "memory"); }
__device__ __forceinline__ void attn_phase(Frame& F) {
    const bf16_t* Q = WSP(bf16_t, WS_Q); const bf16_t* K = WSP(bf16_t, WS_K); const bf16_t* V = WSP(bf16_t, WS_V); unsigned char* O = F.dry ? WSP(unsigned char, WS_E) : WSP(unsigned char, WS_YA8); const unsigned* MASK = WSP(unsigned, WS_MASK);
    const int lane = F.lane, r32 = lane & 31, hi = lane >> 5, wv = F.wave;
    const LAS char* ldsc = (const LAS char*)F.lds;
    const unsigned lds0 = (unsigned)(uintptr_t)F.lds;
    constexpr int KOFF = 0, VOFF = 32768, MOFF = 65536;
    const float* const wg_ = F.in[21]; const float* const wu_ = F.in[23]; const float* const wd_ = F.in[25];
    LAS int* qslot = (LAS int*)(F.lds + LDS_BYTES_C - 128);
    unsigned* qhead = WSP(unsigned, WS_CTL) + CW_QATT + (F.dry ? 16 : 0);
    for (;;) {
            __syncthreads();
            if (F.tid == 0) *qslot = (int)__hip_atomic_fetch_add(qhead, 1u, __ATOMIC_RELAXED, __HIP_MEMORY_SCOPE_AGENT);
            __syncthreads();
            const int qp = *qslot; if (qp >= 1024 + CV_NBLK) break;
            if ((qp & 3) != 0 || qp >= 4096) { const int ci = qp < 4096 ? qp - (qp >> 2) - 1 : qp - 1024; if (!F.dry) expert_conv_item(F.lds, F.ws, F.wave, F.lane, wg_, wu_, wd_, ci); continue; }
            const int un = qp >> 2;
            const int qb = 15 - (un >> 6), b = (un >> 3) & 7, h = un & 7;
            const int q0 = qb * 256, NT = 4 * qb + 4, ntw = 4 * qb + (wv >> 1) + 1;
            const size_t tokq = (size_t)b * 4096 + q0 + wv * 32 + r32;
            const bf16_t* ksrc = K + ((size_t)b * 4096 + lane) * 512 + h * 64 + wv * 8;
            const bf16_t* vsrc = V + ((size_t)b * 4096 + 16 * (wv & 3) + (lane >> 2)) * 512 + h * 64 + (wv >> 2) * 32 + (lane & 3) * 8;
            const unsigned* msrc = MASK + ((size_t)b * 128 + (wv & 1)) * 4096 + q0 + lane * 4;
            const unsigned kdst = lds0 + KOFF + wv * 1024, vdst = lds0 + VOFF + wv * 1024, mdst = lds0 + MOFF + (wv & 1) * 1024;
#define ATT_DMA(t_) do { const int tt_ = (t_) < NT ? (t_) : NT - 1; const unsigned sl_ = (unsigned)((t_) & 3); \
        glds16(ksrc + (size_t)tt_ * 64 * 512, (unsigned)__builtin_amdgcn_readfirstlane(kdst + sl_ * 8192u)); \
        glds16(vsrc + (size_t)tt_ * 64 * 512, (unsigned)__builtin_amdgcn_readfirstlane(vdst + sl_ * 8192u)); \
        glds16(msrc + (size_t)tt_ * 2 * 4096, (unsigned)__builtin_amdgcn_readfirstlane(mdst + sl_ * 2048u)); } while (0)
            ATT_DMA(0); ATT_DMA(1); ATT_DMA(2);
            bf16x8 qr[4];
#pragma unroll
            for (int d0 = 0; d0 < 4; ++d0) qr[d0] = *(const bf16x8*)(Q + tokq * 512 + h * 64 + d0 * 16 + hi * 8);
            asm volatile("" : "+v"(qr[0]), "+v"(qr[1]), "+v"(qr[2]), "+v"(qr[3]));
            float m = 0.f; f32x16 o[2], o2, negm;
#pragma unroll
            for (int r = 0; r < 16; ++r) { o[0][r] = 0.f; o[1][r] = 0.f; o2[r] = 0.f; negm[r] = 0.f; }
            const unsigned onew = r32 == 0 ? 0x3f803f80u : 0u; const bf16x8 ones = __builtin_bit_cast(bf16x8, (u32x4){onew, onew, onew, onew});
            const int vlane = ((lane >> 4) & 1) * 32 + (lane & 3) * 8 + (4 * hi + ((lane & 15) >> 2)) * 64;
            for (int t = 0; t < NT; ++t) {
                asm volatile("s_waitcnt vmcnt(6)\n\ts_barrier" ::: "memory");
                ATT_DMA(t + 3);
                if (t < ntw) {
                    const int sl = t & 3;
                    const LAS char* Kb = ldsc + KOFF + sl * 8192; const LAS char* Vb = ldsc + VOFF + sl * 8192 + vlane; const LAS unsigned* Mb = (const LAS unsigned*)(ldsc + MOFF + sl * 2048) + wv * 32 + r32;
                    const int w0 = (int)(Mb[0] >> (4 * hi)), w1 = (int)(Mb[256] >> (4 * hi));
                    f32x16 p0, p1;
                    { const bf16x8 k0 = *(const LAS bf16x8*)(Kb + hi * 1024 + r32 * 16), k1 = *(const LAS bf16x8*)(Kb + hi * 1024 + r32 * 16 + 512);
                      p0 = __builtin_amdgcn_mfma_f32_32x32x16_bf16(k0, qr[0], negm, 0, 0, 0); p1 = __builtin_amdgcn_mfma_f32_32x32x16_bf16(k1, qr[0], negm, 0, 0, 0); }
#pragma unroll
                    for (int d0 = 1; d0 < 4; ++d0) { const bf16x8 k0 = *(const LAS bf16x8*)(Kb + d0 * 2048 + hi * 1024 + r32 * 16), k1 = *(const LAS bf16x8*)(Kb + d0 * 2048 + hi * 1024 + r32 * 16 + 512);
                        p0 = __builtin_amdgcn_mfma_f32_32x32x16_bf16(k0, qr[d0], p0, 0, 0, 0); p1 = __builtin_amdgcn_mfma_f32_32x32x16_bf16(k1, qr[d0], p1, 0, 0, 0); }
                    float rm = __builtin_fmaxf(p0[0], p1[0]);
#pragma unroll
                    for (int r = 1; r < 16; ++r) rm = __builtin_fmaxf(rm, __builtin_fmaxf(p0[r], p1[r]));
                    rm = __builtin_fmaxf(rm, __shfl_xor(rm, 32));
                    if (t == 0 || __any(rm > 0.f)) {
                        const float dl = t == 0 ? rm : __builtin_fmaxf(rm, 0.f), f = __builtin_amdgcn_exp2f(-dl);
                        m += dl;
#pragma unroll
                        for (int r = 0; r < 16; ++r) { negm[r] = -m; o[0][r] *= f; o[1][r] *= f; o2[r] *= f; p0[r] -= dl; p1[r] -= dl; }
                    }
#pragma unroll
                    for (int r = 0; r < 16; ++r) { const int bp = (r & 3) + 8 * (r >> 2);
                        p0[r] = __uint_as_float(__float_as_uint(__builtin_amdgcn_exp2f(p0[r])) & (unsigned)__builtin_amdgcn_sbfe(w0, bp, 1));
                        p1[r] = __uint_as_float(__float_as_uint(__builtin_amdgcn_exp2f(p1[r])) & (unsigned)__builtin_amdgcn_sbfe(w1, bp, 1)); }
                    u32x4 pw[4];
#pragma unroll
                    for (int q = 0; q < 4; ++q) { pw[0][q] = pk2(p0[2 * q], p0[2 * q + 1]); pw[1][q] = pk2(p0[8 + 2 * q], p0[8 + 2 * q + 1]); pw[2][q] = pk2(p1[2 * q], p1[2 * q + 1]); pw[3][q] = pk2(p1[8 + 2 * q], p1[8 + 2 * q + 1]); }
#pragma unroll
                    for (int d0 = 0; d0 < 2; ++d0)
#pragma unroll
                        for (int kk = 0; kk < 4; ++kk) { const s16x4 lo = vtr(Vb + d0 * 4096 + kk * 1024), hh = vtr(Vb + d0 * 4096 + kk * 1024 + 512);
                            const bf16x8 vf = (bf16x8){lo[0], lo[1], lo[2], lo[3], hh[0], hh[1], hh[2], hh[3]};
                            o[d0] = __builtin_amdgcn_mfma_f32_32x32x16_bf16(vf, __builtin_bit_cast(bf16x8, pw[kk]), o[d0], 0, 0, 0); }
#pragma unroll
                    for (int kk = 0; kk < 4; ++kk) o2 = __builtin_amdgcn_mfma_f32_32x32x16_bf16(ones, __builtin_bit_cast(bf16x8, pw[kk]), o2, 0, 0, 0);
                }
            }
            asm volatile("s_waitcnt vmcnt(0) lgkmcnt(0)\n\ts_barrier" ::: "memory");
#undef ATT_DMA
            const float lt = __shfl(o2[0], r32), inv = 1.0f / lt;
#pragma unroll
            for (int d0 = 0; d0 < 2; ++d0)
#pragma unroll
                for (int g4 = 0; g4 < 4; ++g4) { unsigned w = pk4_fp8(o[d0][4 * g4] * inv, o[d0][4 * g4 + 1] * inv, o[d0][4 * g4 + 2] * inv, o[d0][4 * g4 + 3] * inv);
#ifdef ABL_ATTN
                    w = 0u;
#endif
                    *(unsigned*)(O + tokq * 512 + h * 64 + d0 * 32 + g4 * 8 + hi * 4) = w; }
        }
}

struct ProbS5E {
    const char* U; const char* Wg; unsigned ldb_bytes; int nt, G, c;
    __device__ bool next(int i, pg::Unit& u) const { const int L = i * G + c; if (L >= 64) return false; u.g = L >> 1; u.pm = L & 1; u.pn = 0; return true; }
    __device__ const char* a_base(const pg::Unit& u) const { return U + ((size_t)u.g * 512 + u.pm * 256) * 2304; }
    __device__ unsigned a_off(const pg::Unit&, int row, int col) const { return (unsigned)row * 2304u + (unsigned)col * 2u; }
    __device__ const char* b_base(const pg::Unit& u) const { return Wg + (size_t)u.g * 128 * 2048; }
};
struct EpiS5E { float* E;
    __device__ __forceinline__ void operator()(f32x4 (&acc)[2][2][4][2], const pg::Unit& u, int wr, int wc, int fr, int fq) const {
#pragma unroll
        for (int ai = 0; ai < 2; ++ai)
#pragma unroll
            for (int m = 0; m < 4; ++m) { const int r = u.pm * 256 + ai * 128 + wr * 64 + m * 16 + fr;
#pragma unroll
                for (int n = 0; n < 2; ++n) *(f32x4*)(E + ((size_t)u.g * 512 + r) * 128 + wc * 32 + n * 16 + fq * 4) = acc[ai][0][m][n]; }
    }
};
__device__ __forceinline__ void s5_scan(Frame& F) {
    if (F.wave != 0) return;
    const float* E = WSP(float, WS_EF32); const float* L64 = WSP(float, WS_L64); bf16_t* U = WSP(bf16_t, WS_U);
    for (int gid = F.bid * 64 + F.lane; gid < 32 * 8 * 64; gid += F.G * 64) {
        const int p = gid & 63, b = (gid >> 6) & 7, g = gid >> 9;
        const float lr = L64[(g * 64 + p) * 2], li = L64[(g * 64 + p) * 2 + 1]; float sr = 0.f, si = 0.f;
        const size_t m0 = (size_t)g * 512 + b * 64;
#pragma unroll 1
        for (int c0 = 0; c0 < 64; c0 += 16) { float er[16], ei[16];
#pragma unroll
            for (int c = 0; c < 16; ++c) { er[c] = E[(m0 + c0 + c) * 128 + p]; ei[c] = E[(m0 + c0 + c) * 128 + 64 + p]; }
#pragma unroll
            for (int c = 0; c < 16; ++c) { const size_t m = m0 + c0 + c;
                U[m * 1152 + 1024 + p] = (bf16_t)f2bf(sr); U[m * 1152 + 1088 + p] = (bf16_t)f2bf(si);
                const float nr = lr * sr - li * si + er[c], ni = lr * si + li * sr + ei[c]; sr = nr; si = ni; } }
    }
}
struct ProbS5Y {
    const char* U; const char* TV; unsigned ldb_bytes; int nt, G, c;
    __device__ bool next(int i, pg::Unit& u) const { const int L = i * G + c; if (L >= 256) return false; u.g = L >> 3; u.pm = (L >> 2) & 1; u.pn = L & 3; return true; }
    __device__ const char* a_base(const pg::Unit& u) const { return U + ((size_t)u.g * 512 + u.pm * 256) * 2304; }
    __device__ unsigned a_off(const pg::Unit&, int row, int col) const { return (unsigned)row * 2304u + (unsigned)col * 2u; }
    __device__ const char* b_base(const pg::Unit& u) const { return TV + ((size_t)u.g * 1024 + u.pn * 256) * 2304; }
};
struct EpiS5Y { bf16_t* Y;
    __device__ __forceinline__ void operator()(f32x4 (&acc)[2][2][4][2], const pg::Unit& u, int wr, int wc, int fr, int fq) const {
#pragma unroll
        for (int ai = 0; ai < 2; ++ai)
#pragma unroll
            for (int m = 0; m < 4; ++m) { const int mm = u.pm * 256 + ai * 128 + wr * 64 + m * 16 + fr, b = mm >> 6, c = mm & 63;
#pragma unroll
                for (int bj = 0; bj < 2; ++bj)
#pragma unroll
                    for (int n = 0; n < 2; ++n) { const int nn = u.pn * 256 + bj * 128 + wc * 32 + n * 16 + fq * 4, t = nn >> 4, h = nn & 15; const f32x4 v = acc[ai][bj][m][n];
                        u32x2 w; w.x = pk2(gelu_tanh(v.x), gelu_tanh(v.y)); w.y = pk2(gelu_tanh(v.z), gelu_tanh(v.w));
#ifdef ABL_SSM
                        w.x = 0u; w.y = 0u;
#endif
                        *(u32x2*)(Y + ((size_t)b * 4096 + c * 64 + t) * 512 + u.g * 16 + h) = w; } }
    }
};

template <class Fn> __device__ __forceinline__ void epi_each(f32x4 (&acc)[2][2][4][2], const pg::Unit& u, int wr, int wc, int fr, int fq, const Fn& fn) {
#pragma unroll
    for (int ai = 0; ai < 2; ++ai)
#pragma unroll
        for (int m = 0; m < 4; ++m) { const int r = u.pm * 256 + ai * 128 + wr * 64 + m * 16 + fr;
#pragma unroll
            for (int bj = 0; bj < 2; ++bj)
#pragma unroll
                for (int n = 0; n < 2; ++n) fn(r, u.pn * 256 + bj * 128 + wc * 32 + n * 16 + fq * 4, acc[ai][bj][m][n]); }
}
template <class Fn> __device__ __forceinline__ void epi_each16(f32x4 (&acc)[2][2][4][2], const pg::Unit& u, int wr, int wc, int fr, int fq, const Fn& fn) {
#pragma unroll
    for (int ai = 0; ai < 2; ++ai)
#pragma unroll
        for (int m = 0; m < 4; ++m) fn(u.pm * 256 + ai * 128 + wr * 64 + m * 16 + fr, u.pn * 256 + wc * 64 + fq * 16, acc[ai][0][m][0], acc[ai][0][m][1], acc[ai][1][m][0], acc[ai][1][m][1]);
}
struct EpiGlu { const bf16_t* YS; unsigned char* Y2; const float* b;
    __device__ __forceinline__ void operator()(f32x4 (&acc)[2][2][4][2], const pg::Unit& u, int wr, int wc, int fr, int fq) const {
        epi_each16(acc, u, wr, wc, fr, fq, [&](int r, int c, const f32x4& v0, const f32x4& v1, const f32x4& v2, const f32x4& v3) {
            const f32x4* bp = (const f32x4*)(b + c); const u32x4 ya = *(const u32x4*)(YS + (size_t)r * 512 + c), yb = *(const u32x4*)(YS + (size_t)r * 512 + c + 8);
            u32x4 o; o.x = pkf84(bf4((u32x2){ya.x, ya.y}) * sig4(v0 + bp[0])); o.y = pkf84(bf4((u32x2){ya.z, ya.w}) * sig4(v1 + bp[1])); o.z = pkf84(bf4((u32x2){yb.x, yb.y}) * sig4(v2 + bp[2])); o.w = pkf84(bf4((u32x2){yb.z, yb.w}) * sig4(v3 + bp[3]));
            *(u32x4*)(Y2 + (size_t)r * 512 + c) = o; }); }
};
template <bool ADD> struct EpiMix { const unsigned char* Gt; bf16_t* MIX; unsigned char* MIX8;
    __device__ __forceinline__ void operator()(f32x4 (&acc)[2][2][4][2], const pg::Unit& u, int wr, int wc, int fr, int fq) const {
        epi_each16(acc, u, wr, wc, fr, fq, [&](int r, int c, const f32x4& v0, const f32x4& v1, const f32x4& v2, const f32x4& v3) {
            const u32x4 g = *(const u32x4*)(Gt + (size_t)r * 1024 + c);
            f32x4 o0 = f84(g.x) * v0 * 0.03125f, o1 = f84(g.y) * v1 * 0.03125f, o2 = f84(g.z) * v2 * 0.03125f, o3 = f84(g.w) * v3 * 0.03125f;
            if (ADD) { const u32x4 ma = *(const u32x4*)(MIX + (size_t)r * 1024 + c), mb = *(const u32x4*)(MIX + (size_t)r * 1024 + c + 8);
                o0 += bf4((u32x2){ma.x, ma.y}); o1 += bf4((u32x2){ma.z, ma.w}); o2 += bf4((u32x2){mb.x, mb.y}); o3 += bf4((u32x2){mb.z, mb.w});
                *(u32x4*)(MIX8 + (size_t)r * 1024 + c) = (u32x4){pkf84(o0), pkf84(o1), pkf84(o2), pkf84(o3)}; }
            else { const u32x2 a = pkbf4(o0), b_ = pkbf4(o1), c_ = pkbf4(o2), d = pkbf4(o3);
                *(u32x4*)(MIX + (size_t)r * 1024 + c) = (u32x4){a.x, a.y, b_.x, b_.y}; *(u32x4*)(MIX + (size_t)r * 1024 + c + 8) = (u32x4){c_.x, c_.y, d.x, d.y}; } }); }
};
struct EpiStoreBf { bf16_t* O; int ldo; float sc;
    __device__ __forceinline__ void operator()(f32x4 (&acc)[2][2][4][2], const pg::Unit& u, int wr, int wc, int fr, int fq) const {
        epi_each16(acc, u, wr, wc, fr, fq, [&](int r, int c, const f32x4& v0, const f32x4& v1, const f32x4& v2, const f32x4& v3) {
            const u32x2 a = pkbf4(v0 * sc), b_ = pkbf4(v1 * sc), c_ = pkbf4(v2 * sc), d = pkbf4(v3 * sc);
            *(u32x4*)(O + (size_t)r * ldo + c) = (u32x4){a.x, a.y, b_.x, b_.y}; *(u32x4*)(O + (size_t)r * ldo + c + 8) = (u32x4){c_.x, c_.y, d.x, d.y}; }); }
};
struct EpiPleNorm { const bf16_t* R2; const bf16_t* PROJ; float* OUT; const float* gain; float* xbuf; unsigned* pcnt; LAS float* Pl; LAS float* Sl;
    __device__ __forceinline__ void operator()(f32x4 (&acc)[2][2][4][2], const pg::Unit& u, int wr, int wc, int fr, int fq) const {
        const int tid = (wr * 4 + wc) * 64 + fq * 16 + fr;
        const int c0 = u.pn * 256 + wc * 64 + fq * 16;
#pragma unroll
        for (int ai = 0; ai < 2; ++ai)
#pragma unroll
            for (int m = 0; m < 4; ++m) { const size_t r = (size_t)u.pm * 256 + ai * 128 + wr * 64 + m * 16 + fr;
                const u32x4 ra = *(const u32x4*)(R2 + r * 1024 + c0), rb = *(const u32x4*)(R2 + r * 1024 + c0 + 8), pa = *(const u32x4*)(PROJ + r * 1024 + c0), pb = *(const u32x4*)(PROJ + r * 1024 + c0 + 8);
                acc[ai][0][m][0] = bf4((u32x2){ra.x, ra.y}) + sig4(acc[ai][0][m][0] * 0.03125f) * bf4((u32x2){pa.x, pa.y});
                acc[ai][0][m][1] = bf4((u32x2){ra.z, ra.w}) + sig4(acc[ai][0][m][1] * 0.03125f) * bf4((u32x2){pa.z, pa.w});
                acc[ai][1][m][0] = bf4((u32x2){rb.x, rb.y}) + sig4(acc[ai][1][m][0] * 0.03125f) * bf4((u32x2){pb.x, pb.y});
                acc[ai][1][m][1] = bf4((u32x2){rb.z, rb.w}) + sig4(acc[ai][1][m][1] * 0.03125f) * bf4((u32x2){pb.z, pb.w});
                asm volatile("" : "+v"(acc[ai][0][m][0]), "+v"(acc[ai][0][m][1]), "+v"(acc[ai][1][m][0]), "+v"(acc[ai][1][m][1]));
                if (m & 1) asm volatile("" ::: "memory"); }
#pragma unroll
        for (int ai = 0; ai < 2; ++ai)
#pragma unroll
            for (int m = 0; m < 4; ++m) { float q = 0.f;
#pragma unroll
                for (int bj = 0; bj < 2; ++bj)
#pragma unroll
                    for (int n = 0; n < 2; ++n) { const f32x4 x = acc[ai][bj][m][n]; q += (x[0] * x[0] + x[1] * x[1]) + (x[2] * x[2] + x[3] * x[3]); }
                q += __shfl_xor(q, 16); q += __shfl_xor(q, 32);
                if (fq == 0) Pl[(ai * 128 + wr * 64 + m * 16 + fr) * 4 + wc] = q; }
        asm volatile("s_waitcnt lgkmcnt(0)" ::: "memory"); __builtin_amdgcn_s_barrier(); asm volatile("" ::: "memory");
        if (tid < 256) { const float t = (Pl[tid * 4 + 0] + Pl[tid * 4 + 1]) + (Pl[tid * 4 + 2] + Pl[tid * 4 + 3]);
            __hip_atomic_store(xbuf + ((size_t)u.pm * 256 + tid) * 4 + u.pn, t, __ATOMIC_RELAXED, __HIP_MEMORY_SCOPE_AGENT); }
        asm volatile("s_waitcnt vmcnt(0) lgkmcnt(0)" ::: "memory"); __builtin_amdgcn_s_barrier(); asm volatile("" ::: "memory");
        if (tid == 0) { __hip_atomic_fetch_add(pcnt + u.pm, 1u, __ATOMIC_RELAXED, __HIP_MEMORY_SCOPE_AGENT);
            unsigned sp = 0; while (__hip_atomic_load(pcnt + u.pm, __ATOMIC_RELAXED, __HIP_MEMORY_SCOPE_AGENT) < 4u) { __builtin_amdgcn_s_sleep(2); if (++sp > (1u << 22)) break; }
            __builtin_amdgcn_fence(__ATOMIC_ACQUIRE, "agent"); }
        asm volatile("s_waitcnt vmcnt(0) lgkmcnt(0)" ::: "memory"); __builtin_amdgcn_s_barrier(); asm volatile("" ::: "memory");
        if (tid < 256) { const float* sl = xbuf + ((size_t)u.pm * 256 + tid) * 4;
            const float a0 = __hip_atomic_load(sl + 0, __ATOMIC_RELAXED, __HIP_MEMORY_SCOPE_AGENT), a1 = __hip_atomic_load(sl + 1, __ATOMIC_RELAXED, __HIP_MEMORY_SCOPE_AGENT), a2 = __hip_atomic_load(sl + 2, __ATOMIC_RELAXED, __HIP_MEMORY_SCOPE_AGENT), a3 = __hip_atomic_load(sl + 3, __ATOMIC_RELAXED, __HIP_MEMORY_SCOPE_AGENT);
            Sl[tid] = 1.0f / sqrtf(((a0 + a1) + (a2 + a3)) * (1.f / 1024.f) + EPS); }
        asm volatile("s_waitcnt vmcnt(0) lgkmcnt(0)" ::: "memory"); __builtin_amdgcn_s_barrier(); asm volatile("" ::: "memory");
        f32x4 gv[4];
#pragma unroll
        for (int q = 0; q < 4; ++q) gv[q] = *(const f32x4*)(gain + c0 + 4 * q);
#pragma unroll
        for (int ai = 0; ai < 2; ++ai)
#pragma unroll
            for (int m = 0; m < 4; ++m) { const int rl = ai * 128 + wr * 64 + m * 16 + fr; const float rs = Sl[rl]; f32x4* op = (f32x4*)(OUT + ((size_t)u.pm * 256 + rl) * 1024 + c0);
                op[0] = acc[ai][0][m][0] * rs * gv[0]; op[1] = acc[ai][0][m][1] * rs * gv[1]; op[2] = acc[ai][1][m][0] * rs * gv[2]; op[3] = acc[ai][1][m][1] * rs * gv[3]; }
        asm volatile("s_waitcnt lgkmcnt(0)" ::: "memory"); __builtin_amdgcn_s_barrier(); asm volatile("" ::: "memory");
    }
};

__device__ __forceinline__ void router_phase(Frame& F) {
    constexpr int WST = 1032;
    LAS bf16_t* whi = (LAS bf16_t*)F.lds; LAS bf16_t* wlo = whi + 32 * WST;
    LAS unsigned* lcnt = (LAS unsigned*)(F.lds + 2 * 32 * WST * 2);
    LAS unsigned* gbase = lcnt + 32;
    LAS unsigned* ent_e = gbase + 32;
    LAS float* ent_w = (LAS float*)(ent_e + 512);
    const float* Wr = F.in[19]; const float* br = F.in[20]; const float* gain = F.in[18]; const float* X = F.in[0];
    const bf16_t* D1 = (const bf16_t*)F.out + (size_t)T * 1024;
    unsigned char* H2 = F.dry ? WSP(unsigned char, WS_A) : (unsigned char*)F.out;
    unsigned* cnt = WSP(unsigned, WS_CTL) + CW_CNT + (F.dry ? 32 : 0); int* LTOK = F.dry ? (int*)(F.ws + WS_A + 70 * MB) : WSP(int, WS_LTOK); int* LSLOT = F.dry ? (int*)(F.ws + WS_A + 75 * MB) : WSP(int, WS_LSLOT); float* LWT = F.dry ? (float*)(F.ws + WS_A + 80 * MB) : WSP(float, WS_LWT);
    { f32x4 wv[16];
#pragma unroll
      for (int q = 0; q < 16; ++q) wv[q] = *((const f32x4*)Wr + F.tid + q * NTHR);
#pragma unroll
      for (int q = 0; q < 16; ++q) { const int i4 = F.tid + q * NTHR, k = i4 >> 3, e0 = (i4 & 7) * 4; const float g = gain[k];
#pragma unroll
          for (int c = 0; c < 4; ++c) { const float v = wv[q][c] * g; const unsigned h = f2bf(v); const float vh = __builtin_bit_cast(float, h << 16);
              whi[(e0 + c) * WST + k] = (bf16_t)h; wlo[(e0 + c) * WST + k] = (bf16_t)f2bf(v - vh); } } }
    const int lane = F.lane, tl = lane & 15, kq = lane >> 4;
    for (int tb = F.bid; tb < T / 128; tb += F.G) {
        if (F.tid < 32) lcnt[F.tid] = 0u;
        if (!F.dry) { const f32x4* ps = (const f32x4*)(F.in[1] + (size_t)tb * 128 * 256); u32x2* pd = (u32x2*)(WSP(bf16_t, WS_PBF) + (size_t)tb * 128 * 256);
#pragma unroll 4
            for (int q = 0; q < 16; ++q) { const f32x4 v = ps[F.tid + q * NTHR]; u32x2 w; w.x = pk2(v.x, v.y); w.y = pk2(v.z, v.w); pd[F.tid + q * NTHR] = w; } }
        __syncthreads();
        const int tok0 = tb * 128 + F.wave * 16, tok = tok0 + tl;
        const float* xrow = X + (size_t)tok * 1024 + 8 * kq; const bf16_t* drow = D1 + (size_t)tok * 1024 + 8 * kq;
        f32x4 acc[2]; acc[0] = (f32x4){0.f, 0.f, 0.f, 0.f}; acc[1] = acc[0]; float ss = 0.f;
#pragma unroll 16
        for (int st = 0; st < 32; ++st) {
            const f32x4 x0 = *(const f32x4*)(xrow + 32 * st), x1 = *(const f32x4*)(xrow + 32 * st + 4); const u32x4 dd = *(const u32x4*)(drow + 32 * st);
            const f32x4 g0 = *(const f32x4*)(gain + 32 * st + 8 * kq), g1 = *(const f32x4*)(gain + 32 * st + 8 * kq + 4);
            float r[8] = {x0.x + bflo(dd.x), x0.y + bfhi(dd.x), x0.z + bflo(dd.y), x0.w + bfhi(dd.y), x1.x + bflo(dd.z), x1.y + bfhi(dd.z), x1.z + bflo(dd.w), x1.w + bfhi(dd.w)};
            { u32x2 o; o.x = pk4_fp8(r[0] * g0.x, r[1] * g0.y, r[2] * g0.z, r[3] * g0.w); o.y = pk4_fp8(r[4] * g1.x, r[5] * g1.y, r[6] * g1.z, r[7] * g1.w); *(u32x2*)(H2 + (size_t)tok * 1024 + 32 * st + 8 * kq) = o; }
            u32x4 ah, al;
#pragma unroll
            for (int p = 0; p < 4; ++p) { ss = __builtin_fmaf(r[2 * p], r[2 * p], ss); ss = __builtin_fmaf(r[2 * p + 1], r[2 * p + 1], ss);
                const unsigned hw = pk2(r[2 * p], r[2 * p + 1]); ah[p] = hw; al[p] = pk2(r[2 * p] - bflo(hw), r[2 * p + 1] - bfhi(hw)); }
            const bf16x8 A_hi = __builtin_bit_cast(bf16x8, ah), A_lo = __builtin_bit_cast(bf16x8, al);
#pragma unroll
            for (int n = 0; n < 2; ++n) { const bf16x8 Bh = *(const LAS bf16x8*)(whi + (16 * n + tl) * WST + 32 * st + 8 * kq), Bl = *(const LAS bf16x8*)(wlo + (16 * n + tl) * WST + 32 * st + 8 * kq);
                acc[n] = __builtin_amdgcn_mfma_f32_16x16x32_bf16(A_hi, Bh, acc[n], 0, 0, 0); acc[n] = __builtin_amdgcn_mfma_f32_16x16x32_bf16(A_hi, Bl, acc[n], 0, 0, 0); acc[n] = __builtin_amdgcn_mfma_f32_16x16x32_bf16(A_lo, Bh, acc[n], 0, 0, 0); }
        }
        ss += __shfl_xor(ss, 16); ss += __shfl_xor(ss, 32);
        const float rstd = 1.0f / sqrtf(ss * (1.f / 1024.f) + EPS);
        if (kq == 0 && !F.dry) WSP(float, WS_CTL)[CW_SSQ + tok] = rstd;
        const float b0 = br[tl], b1 = br[16 + tl];
#pragma unroll
        for (int rg = 0; rg < 4; ++rg) { const float rs = __shfl(rstd, 4 * kq + rg);
            float v0 = acc[0][rg] * rs + b0, v1 = acc[1][rg] * rs + b1; float tv[4]; int te[4];
#pragma unroll
            for (int k = 0; k < 4; ++k) { float bv = v0; int bi = tl; if (v1 > v0) { bv = v1; bi = 16 + tl; }
#pragma unroll
                for (int o = 1; o < 16; o <<= 1) { const float ov = __shfl_xor(bv, o); const int oi = __shfl_xor(bi, o); if (ov > bv || (ov == bv && oi < bi)) { bv = ov; bi = oi; } }
                tv[k] = bv; te[k] = bi; if (bi == tl) v0 = -INFINITY; if (bi == 16 + tl) v1 = -INFINITY; }
            const float e1 = __expf(tv[1] - tv[0]), e2 = __expf(tv[2] - tv[0]), e3 = __expf(tv[3] - tv[0]), inv = 1.0f / (1.0f + e1 + e2 + e3);
            if (tl < 4) { const int e = tl == 0 ? te[0] : tl == 1 ? te[1] : tl == 2 ? te[2] : te[3]; const float w = (tl == 0 ? 1.0f : tl == 1 ? e1 : tl == 2 ? e2 : e3) * inv;
                const int tli = F.wave * 16 + 4 * kq + rg;
                const unsigned pos = __hip_atomic_fetch_add(lcnt + e, 1u, __ATOMIC_RELAXED, __HIP_MEMORY_SCOPE_WORKGROUP);
                ent_e[tli * 4 + tl] = (unsigned)e | (pos << 8); ent_w[tli * 4 + tl] = w; }
        }
        __syncthreads();
        if (F.tid < 32) gbase[F.tid] = __hip_atomic_fetch_add(cnt + F.tid, lcnt[F.tid], __ATOMIC_RELAXED, __HIP_MEMORY_SCOPE_AGENT);
        __syncthreads();
        { const unsigned ee = ent_e[F.tid]; const int e = ee & 255, pos = (int)(gbase[e] + (ee >> 8)); const int tok_ = tb * 128 + (F.tid >> 2);
          LTOK[(size_t)e * T + pos] = tok_; LSLOT[(size_t)e * T + pos] = tok_ * 4 + (F.tid & 3); LWT[(size_t)e * T + pos] = ent_w[F.tid]; }
        __syncthreads();
    }
}

struct MoeTab { LAS int* cnt; LAS int* ntile; LAS int* cumu; LAS int* offs; LAS unsigned short* rowl; };
template <int NPN> __device__ __forceinline__ bool moe_unit(const MoeTab& tab, int L, pg::Unit& u) {
    if (L >= tab.cumu[32]) return false; int e = 0;
#pragma unroll 1
    for (int k = 1; k < 32; ++k) if (tab.cumu[k] <= L) e = k;
    const int rem = L - tab.cumu[e]; u.g = e; u.pm = rem / NPN; u.pn = rem % NPN; return true;
}
__device__ __forceinline__ int moe_L(int i, int G, int c) { return i * G + ((G & 7) == 0 ? (c & 7) * (G >> 3) + (c >> 3) : c); }
template <int NPN> __device__ __forceinline__ MoeTab moe_tab_build(Frame& F, bool gather) {
    MoeTab t; t.cnt = (LAS int*)(F.lds + 131072); t.ntile = t.cnt + 32; t.cumu = t.ntile + 32; t.offs = t.cumu + 40; t.rowl = (LAS unsigned short*)(F.lds + 131072 + 1024);
    __syncthreads();
    if (F.tid < 32) t.cnt[F.tid] = (int)__hip_atomic_load(WSP(unsigned, WS_CTL) + CW_CNT + F.tid, __ATOMIC_RELAXED, __HIP_MEMORY_SCOPE_AGENT);
    __syncthreads();
    if (F.tid == 0) { int cu = 0, of = 0;
        for (int e = 0; e < 32; ++e) { const int n = t.cnt[e]; const int nt_ = (n + 255) >> 8; t.ntile[e] = nt_; t.cumu[e] = cu; t.offs[e] = of; cu += nt_ * NPN; of += n; }
        t.cumu[32] = cu; t.offs[32] = of; }
    __syncthreads();
    if (gather) {
        const int* ltok = WSP(int, WS_LTOK);
        for (int i = 0; i < 17; ++i) { pg::Unit u; if (!moe_unit<NPN>(t, moe_L(i, F.G, F.bid), u)) break;
            if (F.tid < 256) { int r = u.pm * 256 + F.tid; const int n = t.cnt[u.g]; r = r < n ? r : n - 1; t.rowl[i * 256 + F.tid] = (unsigned short)ltok[(size_t)u.g * T + r]; } }
        __syncthreads();
    }
    return t;
}
template <int NPN> struct ProbMoe {
    const char* A; const char* W; MoeTab tab; unsigned ldb_bytes; int nt, G, c; bool gather; int hot;
    __device__ bool next(int i, pg::Unit& u) const { u.li = i; const bool ok = moe_unit<NPN>(tab, moe_L(i, G, c), u); if (hot) { u.li = 0; u.g = 0; u.pn = 0; u.pm = 0; } return ok; }
    __device__ const char* a_base(const pg::Unit&) const { return A; }
    __device__ unsigned a_off(const pg::Unit& u, int row, int col) const {
        unsigned arow;
        if (gather) arow = (unsigned)tab.rowl[u.li * 256 + row];
        else { int r = u.pm * 256 + row; const int n = tab.cnt[u.g]; r = r < n ? r : n - 1; arow = (unsigned)(tab.offs[u.g] + r); }
        return arow * 1024u + (unsigned)col * 2u; }
    __device__ const char* b_base(const pg::Unit& u) const { return W + ((size_t)u.g * (NPN * 256) + u.pn * 256) * 1024; }
};
struct EpiMoe1 { unsigned char* Aout; const float* bgate; const float* bup; const float* rstd; MoeTab tab; int dry;
    __device__ __forceinline__ void operator()(f32x4 (&acc)[2][2][4][2], const pg::Unit& u, int wr, int wc, int fr, int fq) const {
        if (dry >= 3) return;
        const int e = u.g, n = tab.cnt[e], off = tab.offs[e];
        const int col = u.pn * 128 + wc * 32 + fq * 8;
        f32x4 bg[2], bu[2];
#pragma unroll
        for (int nn = 0; nn < 2; ++nn) { bg[nn] = *(const f32x4*)(bgate + e * 1024 + col + 4 * nn); bu[nn] = *(const f32x4*)(bup + e * 1024 + col + 4 * nn); }
        float rs_[8];
#pragma unroll
        for (int q = 0; q < 8; ++q) rs_[q] = 0.03125f * rstd[tab.rowl[u.li * 256 + (q >> 2) * 128 + wr * 64 + (q & 3) * 16 + fr]];
#pragma unroll
        for (int ai = 0; ai < 2; ++ai)
#pragma unroll
            for (int m = 0; m < 4; ++m) { const int r = u.pm * 256 + ai * 128 + wr * 64 + m * 16 + fr; float o[8];
#pragma unroll
                for (int nn = 0; nn < 2; ++nn) { const f32x4 g4 = acc[ai][0][m][nn] * rs_[ai * 4 + m] + bg[nn], u4 = acc[ai][1][m][nn] * rs_[ai * 4 + m] + bu[nn];
#pragma unroll
                    for (int j = 0; j < 4; ++j) { const float g = fminf(g4[j], 7.0f), uu = fminf(fmaxf(u4[j], -7.0f), 7.0f); o[4 * nn + j] = (uu + 1.0f) * (g * sigmoidf_(1.702f * g)); } }
                u32x2 w; w.x = pk4_fp8(o[0], o[1], o[2], o[3]); w.y = pk4_fp8(o[4], o[5], o[6], o[7]);
                if (r < n) { if (dry != 2) *(u32x2*)(Aout + (size_t)(off + r) * 1024 + col) = w; else asm volatile("" :: "v"(w.x), "v"(w.y)); } }
    }
};
struct EpiMoe2 { unsigned char* ws; unsigned char* outb; const float* bdown; const int* lslot; const float* lwt; MoeTab tab;
    __device__ __forceinline__ void operator()(f32x4 (&acc)[2][2][4][2], const pg::Unit& u, int wr, int wc, int fr, int fq) const {
        const int e = u.g, n = tab.cnt[e];
        int sl[8]; float wt[8];
#pragma unroll
        for (int q = 0; q < 8; ++q) { int r = u.pm * 256 + (q >> 2) * 128 + wr * 64 + (q & 3) * 16 + fr; r = r < n ? r : n - 1; sl[q] = lslot[(size_t)e * T + r]; wt[q] = lwt[(size_t)e * T + r]; }
        const int c0 = u.pn * 256 + wc * 64 + fq * 16;
        f32x4 bd[4];
#pragma unroll
        for (int q = 0; q < 4; ++q) bd[q] = *(const f32x4*)(bdown + e * 1024 + c0 + 4 * q);
#pragma unroll
        for (int ai = 0; ai < 2; ++ai)
#pragma unroll
            for (int m = 0; m < 4; ++m) { const int r = u.pm * 256 + ai * 128 + wr * 64 + m * 16 + fr; if (r < n) { const int s_ = sl[ai * 4 + m]; const float w_ = wt[ai * 4 + m] * 16.0f;
                    unsigned char* dst = ws + WS_W1T + (size_t)s_ * 1024;
                    u32x4 o; o.x = pkf84((acc[ai][0][m][0] * 0.03125f + bd[0]) * w_); o.y = pkf84((acc[ai][0][m][1] * 0.03125f + bd[1]) * w_); o.z = pkf84((acc[ai][1][m][0] * 0.03125f + bd[2]) * w_); o.w = pkf84((acc[ai][1][m][1] * 0.03125f + bd[3]) * w_);
                    *(u32x4*)(dst + c0) = o; } }
    }
};

__device__ __forceinline__ void combine_phase(Frame& F) {
    const int gw = F.bid * 8 + F.wave, NGW = F.G * 8, lane = F.lane;
    const bf16_t* D1 = (const bf16_t*)F.out + (size_t)T * 1024;
    auto slotp = [&](int sl) -> const unsigned* { return (const unsigned*)(F.ws + WS_W1T + (size_t)sl * 1024) + lane; };
    for (int tok = gw; tok < T; tok += NGW) {
        const f32x4* xr = (const f32x4*)(F.in[0] + (size_t)tok * 1024) + lane; const u32x2* dr = (const u32x2*)(D1 + (size_t)tok * 1024) + lane;
        f32x4 v[4]; u32x2 d1[4]; unsigned d[4][4];
#pragma unroll
        for (int j = 0; j < 4; ++j) { v[j] = xr[64 * j]; d1[j] = dr[64 * j]; }
#pragma unroll
        for (int k = 0; k < 4; ++k) { const unsigned* sr = slotp(tok * 4 + k);
#pragma unroll
            for (int j = 0; j < 4; ++j) d[k][j] = sr[64 * j]; }
#pragma unroll
        for (int j = 0; j < 4; ++j) { v[j].x += bflo(d1[j].x); v[j].y += bfhi(d1[j].x); v[j].z += bflo(d1[j].y); v[j].w += bfhi(d1[j].y); }
#pragma unroll
        for (int k = 0; k < 4; ++k)
#pragma unroll
            for (int j = 0; j < 4; ++j) { const f32x2_t lo = __builtin_amdgcn_cvt_pk_f32_fp8((int)d[k][j], false), hi2 = __builtin_amdgcn_cvt_pk_f32_fp8((int)d[k][j], true);
                v[j].x += lo[0] * 0.0625f; v[j].y += lo[1] * 0.0625f; v[j].z += hi2[0] * 0.0625f; v[j].w += hi2[1] * 0.0625f; }
        u32x2* r2 = (u32x2*)(WSP(bf16_t, WS_R2) + (size_t)tok * 1024) + lane; unsigned* rb = (unsigned*)(WSP(unsigned char, WS_R2BF) + (size_t)tok * 1024) + lane;
#pragma unroll
        for (int j = 0; j < 4; ++j) { u32x2 w; w.x = pk2(v[j].x, v[j].y); w.y = pk2(v[j].z, v[j].w); r2[64 * j] = w; rb[64 * j] = pk4_fp8(v[j].x, v[j].y, v[j].z, v[j].w); }
    }
}
__device__ __forceinline__ void final_norm_phase(Frame& F) {
    const int gw = F.bid * 8 + F.wave, NGW = F.G * 8, lane = F.lane; const f32x4* gr = (const f32x4*)F.in[29] + lane;
    for (int tok = gw; tok < T; tok += NGW) {
        const u32x2* xr = (const u32x2*)(WSP(bf16_t, WS_E) + (size_t)tok * 1024) + lane; f32x4 v[4]; float s = 0.f;
#pragma unroll
        for (int j = 0; j < 4; ++j) { const u32x2 d = xr[64 * j]; v[j] = (f32x4){bflo(d.x), bfhi(d.x), bflo(d.y), bfhi(d.y)}; s += (v[j].x * v[j].x + v[j].y * v[j].y) + (v[j].z * v[j].z + v[j].w * v[j].w); }
        const float rstd = 1.0f / sqrtf(wave_sum(s) * (1.f / 1024.f) + EPS);
        f32x4* xw = F.dry ? (f32x4*)(WSP(float, WS_A) + (size_t)tok * 1024) + lane : (f32x4*)(F.out + (size_t)tok * 1024) + lane;
#pragma unroll
        for (int j = 0; j < 4; ++j) { const f32x4 g = gr[64 * j]; xw[64 * j] = (f32x4){v[j].x * rstd * g.x, v[j].y * rstd * g.y, v[j].z * rstd * g.z, v[j].w * rstd * g.w}; }
    }
}
constexpr size_t WS_BAR = 512 * 1024;
#define XB_TMO      128
#define XB_XCNT(j)  (256  + 64 * (j))
#define XB_XSUB(j)  (1280 + 64 * (j))
#define XB_XGEN(j)  (2304 + 64 * (j))
#define XB_TOP      3328
#define XB_TOPGEN   3392
#define XCD_BAR_WORDS 3456
#define XB_SPIN_CAP (1u << 18)
__device__ __forceinline__ unsigned xb_ld(unsigned* p)              { return __hip_atomic_load(p, __ATOMIC_RELAXED, __HIP_MEMORY_SCOPE_AGENT); }
__device__ __forceinline__ unsigned xb_add(unsigned* p, unsigned v) { return __hip_atomic_fetch_add(p, v, __ATOMIC_RELAXED, __HIP_MEMORY_SCOPE_AGENT); }
__device__ __forceinline__ unsigned xb_xcc_id() { return (unsigned)__builtin_amdgcn_s_getreg((3 << 11) | 20) & 0xFu; }
#define XB_SPIN(cond, bar) do { unsigned _sp = 0; while (cond) { __builtin_amdgcn_s_sleep(1); \
    if ((++_sp & 255u) == 0u) { if (xb_ld(&(bar)[XB_TMO])) break; if (_sp > XB_SPIN_CAP) { atomicAdd(&(bar)[XB_TMO], 1u); break; } } } } while (0)
struct XcdBarrier { unsigned* bar; unsigned x; volatile LAS unsigned* st; };
__device__ __forceinline__ XcdBarrier xcd_barrier_post(unsigned* bar, volatile LAS unsigned* st) {
    XcdBarrier b; b.bar = bar; b.x = xb_xcc_id(); b.st = st;
    if (threadIdx.x == 0) (void)xb_add(&bar[XB_XCNT(b.x)], 1u);
    return b;
}
__device__ __forceinline__ void xcd_barrier_complete(unsigned* bar, unsigned x, unsigned& nloc, unsigned& nx) {
    const unsigned G = gridDim.x * gridDim.y * gridDim.z;
    unsigned sum, cnt, mine, sp = 0u;
    for (;;) {
        sum = 0u; cnt = 0u; mine = 0u;
#pragma unroll
        for (unsigned j = 0; j < 16; ++j) { const unsigned c = xb_ld(&bar[XB_XCNT(j)]); sum += c; cnt += (c > 0u) ? 1u : 0u; mine = (j == x) ? c : mine; }
        if (sum == G) break;
        __builtin_amdgcn_s_sleep(1);
        if ((++sp & 255u) == 0u) { if (xb_ld(&bar[XB_TMO])) break; if (sp > XB_SPIN_CAP) { atomicAdd(&bar[XB_TMO], 1u); break; } }
    }
    nloc = mine > 0u ? mine : 1u; nx = cnt > 0u ? cnt : 1u;
}
__device__ __forceinline__ void xcd_barrier(const XcdBarrier& b) {
    asm volatile("s_waitcnt vmcnt(0)" ::: "memory");
    __syncthreads();
    if (threadIdx.x == 0) {
        unsigned* bar = b.bar;
        __builtin_amdgcn_s_waitcnt(0);
        unsigned nloc = b.st[0], nx = b.st[1];
        if (nloc == 0u) { xcd_barrier_complete(bar, b.x, nloc, nx); b.st[0] = nloc; b.st[1] = nx; }
        const unsigned old = xb_add(&bar[XB_XSUB(b.x)], 1u);
        const unsigned gen = old / nloc;
        if (old + 1u == (gen + 1u) * nloc) {
            __builtin_amdgcn_fence(__ATOMIC_RELEASE, "agent");
            asm volatile("s_waitcnt vmcnt(0)" ::: "memory");
            const unsigned og = xb_add(&bar[XB_TOP], 1u);
            const unsigned tg = og / nx;
            if (og + 1u == (tg + 1u) * nx) xb_add(&bar[XB_TOPGEN], 1u);
            else XB_SPIN(xb_ld(&bar[XB_TOPGEN]) == tg, bar);
            __builtin_amdgcn_fence(__ATOMIC_ACQUIRE, "agent");
            xb_add(&bar[XB_XGEN(b.x)], 1u);
            asm volatile("s_waitcnt vmcnt(0)" ::: "memory");
        } else {
            XB_SPIN(xb_ld(&bar[XB_XGEN(b.x)]) == gen, bar);
            __builtin_amdgcn_fence(__ATOMIC_ACQUIRE, "agent");
            asm volatile("s_waitcnt vmcnt(0)" ::: "memory");
        }
    }
    __syncthreads();
}

constexpr int LDS_BYTES = 147456;
constexpr int NPHASE = 14;
#ifndef MK_MULTI
#define MK_MULTI 0
#endif
struct Args { const float* in[30]; float* out; unsigned char* ws; int ph_lo, ph_hi, dry, pad; };
static_assert(sizeof(Args) == 32 * 8 + 16, "no padding in Args");

__global__ void __launch_bounds__(NTHR, 2) fwd(Args a) {
    extern __shared__ __attribute__((aligned(16))) unsigned char lds_[];
    Frame F;
    F.lds = (LAS unsigned char*)lds_;
    F.tid = threadIdx.x; F.lane = F.tid & 63; F.wave = __builtin_amdgcn_readfirstlane(F.tid >> 6); F.G = gridDim.x; F.bid = blockIdx.x;
#pragma unroll
    for (int i = 0; i < 30; ++i) F.in[i] = a.in[i];
    F.out = a.out; F.ws = a.ws; F.dry = a.dry;
    const int lo = a.ph_lo, hi = a.ph_hi;
#ifndef PHMASK
#define PHMASK 0x3fff
#endif
#define IN(k) (((PHMASK >> (k)) & 1) && lo <= (k) && (k) < hi)
    volatile LAS unsigned* xst = (volatile LAS unsigned*)(F.lds + LDS_BYTES - 64);
    if (F.tid < 2) xst[F.tid] = 0u;
    __syncthreads();
    const XcdBarrier xbar = xcd_barrier_post((unsigned*)(F.ws + WS_BAR), xst);
#define SEAM(k) do { if (IN(k) && IN((k) + 1)) xcd_barrier(xbar); } while (0)
    bf16_t* GS = (bf16_t*)F.out; bf16_t* GA = GS + (size_t)T * 1024;

    if (IN(0)) { p0_prologue(F); __syncthreads(); p0_s5_tables(F); }
    SEAM(0);
    if (IN(1)) {
        EpiInProj E; E.U = WSP(bf16_t, WS_U); E.Q = WSP(bf16_t, WS_Q); E.K = WSP(bf16_t, WS_K); E.V = WSP(bf16_t, WS_V); E.QI = WSP(bf16_t, WS_QIDX); E.KI = WSP(bf16_t, WS_KIDX); E.GS = GS; E.GA = GA;
        E.WI = WSP(float, WS_WIDX); E.bg = F.in[3]; E.c64 = WSP(float, WS_COS64); E.s64 = WSP(float, WS_SIN64); E.c32 = WSP(float, WS_COS32); E.s32 = WSP(float, WS_SIN32);
        { pg::Dense P; P.A = (const char*)WSP(unsigned char, WS_H8); P.B = (const char*)WSP(unsigned char, WS_WIN8); P.lda_bytes = 1024; P.ldb_bytes = 1024; P.nt = 8; P.ord.init(T / 256, 16, F.G, F.bid); P.pn_split = 8; P.pn_skip = 2;
          E.ascale = 0.03125f; pg::gemm_phase<true>(F.lds, P, E); }
        { pg::Dense P; P.A = (const char*)WSP(bf16_t, WS_E); P.B = (const char*)WSP(bf16_t, WS_WINT); P.lda_bytes = 2048; P.ldb_bytes = 2048; P.nt = 16; P.ord.init(T / 256, 2, F.G, F.bid); P.pn_base = 8; P.b_tile0 = 8;
          E.ascale = 1.0f; pg::gemm_phase<false>(F.lds, P, E); }
    }
    SEAM(1);
    if (IN(2)) {
        { ProbS5E P; P.U = (const char*)WSP(bf16_t, WS_U); P.Wg = (const char*)WSP(bf16_t, WS_WG); P.ldb_bytes = 2048; P.nt = 16; P.G = F.G; P.c = F.bid; EpiS5E E; E.E = WSP(float, WS_EF32); pg::gemm_phase(F.lds, P, E); }
        __syncthreads();
        idx_phase(F);
    }
    SEAM(2);
    if (IN(3)) { s5_scan(F); __syncthreads(); attn_phase(F); }
    SEAM(3);
    if (IN(4)) { ProbS5Y P; P.U = (const char*)WSP(bf16_t, WS_U); P.TV = (const char*)WSP(bf16_t, WS_TV); P.ldb_bytes = 2304; P.nt = 18; P.G = F.G; P.c = F.bid; EpiS5Y E; E.Y = WSP(bf16_t, WS_E); pg::gemm_phase(F.lds, P, E); }
    SEAM(4);
    if (IN(5)) { pg::Dense P; P.A = (const char*)WSP(bf16_t, WS_E); P.B = (const char*)WSP(bf16_t, WS_WGLUT); P.lda_bytes = 1024; P.ldb_bytes = 1024; P.nt = 8; P.ord.init(T / 256, 2, F.G, F.bid);
        EpiGlu E; E.YS = WSP(bf16_t, WS_E); E.Y2 = WSP(unsigned char, WS_Y28); E.b = F.in[13]; pg::gemm_phase(F.lds, P, E); }
    SEAM(5);
    if (IN(6)) {
        { pg::Dense P; P.A = (const char*)WSP(unsigned char, WS_Y28); P.B = (const char*)WSP(unsigned char, WS_WSB8); P.lda_bytes = 512; P.ldb_bytes = 512; P.nt = 4; P.ord.init(T / 256, 4, F.G, F.bid);
          EpiMix<false> E; E.Gt = (const unsigned char*)GS; E.MIX = F.dry ? WSP(bf16_t, WS_U) : GA; E.MIX8 = nullptr; pg::gemm_phase<true>(F.lds, P, E); }
        { pg::Dense P; P.A = (const char*)WSP(unsigned char, WS_YA8); P.B = (const char*)WSP(unsigned char, WS_WAB8); P.lda_bytes = 512; P.ldb_bytes = 512; P.nt = 4; P.ord.init(T / 256, 4, F.G, F.bid);
          EpiMix<true> E; E.Gt = (const unsigned char*)GS + (size_t)T * 1024; E.MIX = F.dry ? WSP(bf16_t, WS_U) : GA; E.MIX8 = F.dry ? WSP(unsigned char, WS_V) : WSP(unsigned char, WS_MIX8); pg::gemm_phase<true>(F.lds, P, E); }
    }
    SEAM(6);
    if (IN(7)) { pg::Dense P; P.A = (const char*)WSP(unsigned char, WS_MIX8); P.B = (const char*)WSP(unsigned char, WS_WO8); P.lda_bytes = 1024; P.ldb_bytes = 1024; P.nt = 8; P.ord.init(T / 256, 4, F.G, F.bid);
        EpiStoreBf E; E.O = GA; E.ldo = 1024; E.sc = 0.03125f; pg::gemm_phase<true>(F.lds, P, E); }
    SEAM(7);
    if (IN(8)) router_phase(F);
    SEAM(8);
    if (IN(9)) { const MoeTab tab = moe_tab_build<8>(F, true);
        ProbMoe<8> P; P.A = (const char*)GS; P.W = (const char*)WSP(bf16_t, WS_W1T); P.tab = tab; P.ldb_bytes = 1024; P.nt = 8; P.G = F.G; P.c = F.bid; P.gather = true; P.hot = (F.dry == 4);
        EpiMoe1 E; E.Aout = WSP(unsigned char, WS_A); E.bgate = F.in[22]; E.bup = F.in[24]; E.rstd = WSP(float, WS_CTL) + CW_SSQ; E.tab = tab; E.dry = F.dry; pg::gemm_phase<true>(F.lds, P, E); }
    SEAM(9);
    if (IN(10)) { const MoeTab tab = moe_tab_build<4>(F, false);
        ProbMoe<4> P; P.A = (const char*)WSP(bf16_t, WS_A); P.W = (const char*)WSP(bf16_t, WS_W2T); P.tab = tab; P.ldb_bytes = 1024; P.nt = 8; P.G = F.G; P.c = F.bid; P.gather = false; P.hot = 0;
        EpiMoe2 E; E.ws = F.ws; E.outb = (unsigned char*)F.out; E.bdown = F.in[26]; E.lslot = WSP(int, WS_LSLOT); E.lwt = WSP(float, WS_LWT); E.tab = tab; pg::gemm_phase<true>(F.lds, P, E);
        { const int total = tab.cumu[32], rounds = (total + F.G - 1) / F.G, nfull = total - (rounds - 1) * F.G, nidle = F.G - nfull;
          const int pos = moe_L(0, F.G, F.bid);
          const int G2 = nidle > 0 ? nidle : F.G, c2 = nidle > 0 ? pos - nfull : pos;
          if (c2 >= 0) { pg::Dense P2; P2.A = (const char*)WSP(bf16_t, WS_PBF); P2.B = (const char*)WSP(bf16_t, WS_WPPT); P2.lda_bytes = 512; P2.ldb_bytes = 512; P2.nt = 4; P2.ord.init(T / 256, 4, G2, c2);
              EpiStoreBf E2; E2.O = WSP(bf16_t, WS_PROJ); E2.ldo = 1024; E2.sc = 1.0f; pg::gemm_phase(F.lds, P2, E2); } } }
    SEAM(10);
    if (IN(11)) combine_phase(F);
    SEAM(11);
    if (IN(12)) {
        { pg::Dense P; P.A = (const char*)WSP(unsigned char, WS_R2BF); P.B = (const char*)WSP(unsigned char, WS_WPG8); P.lda_bytes = 1024; P.ldb_bytes = 1024; P.nt = 8; P.ord.init(T / 256, 4, F.G, F.bid);
          EpiPleNorm E; E.R2 = WSP(bf16_t, WS_R2); E.PROJ = WSP(bf16_t, WS_PROJ); E.OUT = F.out; E.gain = F.in[29]; E.xbuf = (float*)(F.ws + WS_XBUF); E.pcnt = WSP(unsigned, WS_CTL) + CW_PCNT;
          E.Pl = (LAS float*)(F.lds + 131072); E.Sl = (LAS float*)(F.lds + 131072 + 4096); pg::gemm_phase<true>(F.lds, P, E); }
    }
#undef IN
#undef SEAM
}

extern "C" void kernel_launch(void* const* d_in, const int* in_sizes, int n_in, void* d_out, int out_size, void* d_ws, size_t ws_size, hipStream_t stream) {
    static int grid = 0;
    if (grid == 0) {
        if (n_in != 30 || out_size != T * 1024 || ws_size < WS_END) { fprintf(stderr, "kernel_launch: unexpected shapes (n_in %d, out %d, ws %zu < %zu)\n", n_in, out_size, ws_size, (size_t)WS_END); grid = -1; return; }
        int dev = 0, cus = 0, per_cu = 0;
        hipGetDevice(&dev); hipDeviceGetAttribute(&cus, hipDeviceAttributeMultiprocessorCount, dev);
        hipFuncSetAttribute((const void*)fwd, hipFuncAttributeMaxDynamicSharedMemorySize, LDS_BYTES);
        hipOccupancyMaxActiveBlocksPerMultiprocessor(&per_cu, (const void*)fwd, NTHR, LDS_BYTES);
        if (per_cu < 1) { fprintf(stderr, "kernel_launch: occupancy query says %d blocks per CU\n", per_cu); per_cu = 1; }
        (void)hipGetLastError();
        grid = cus;
    }
    if (grid < 0) return;
    Args a{};
    for (int i = 0; i < 30; ++i) a.in[i] = (const float*)d_in[i];
    a.out = (float*)d_out; a.ws = (unsigned char*)d_ws;
#if MK_MULTI
#ifndef DUP_MASK
#define DUP_MASK 0
#endif
    for (int ph = 0; ph < NPHASE; ++ph) { a.ph_lo = ph; a.ph_hi = ph + 1; const int reps = ((DUP_MASK >> ph) & 1) ? 2 : 1;
        for (int r = 0; r < reps; ++r) { a.dry = (r + 1 < reps && (ph == 3 || ph == 6 || ph == 8 || ph == 13)) ? 1 : 0;
#ifdef DRY9
            if (ph == 9 && r + 1 < reps) a.dry = DRY9;
#endif
 hipLaunchKernelGGL(fwd, dim3(grid), dim3(NTHR), LDS_BYTES, stream, a); } }
#else
    (void)hipMemsetAsync((char*)d_ws + WS_BAR, 0, XCD_BAR_WORDS * 4, stream);
    a.ph_lo = 0; a.ph_hi = NPHASE; void* args[] = {&a};
    hipError_t e = hipLaunchCooperativeKernel((const void*)fwd, dim3(grid), dim3(NTHR), args, LDS_BYTES, stream);
    if (e != hipSuccess) fprintf(stderr, "cooperative launch failed: %s (grid %d)\n", hipGetErrorString(e), grid);
#endif
}
```

```cpp
#include <hip/hip_runtime.h>
#include <hip/hip_cooperative_groups.h>
#include <cstdio>
#include <cstdint>
#include <cmath>
namespace cg = cooperative_groups;

#define LAS __attribute__((address_space(3)))
#define GAS __attribute__((address_space(1)))
typedef unsigned short bf16_t;
typedef short bf16x8 __attribute__((ext_vector_type(8)));
typedef short s16x4 __attribute__((ext_vector_type(4)));
typedef float f32x4 __attribute__((ext_vector_type(4)));
typedef float f32x16 __attribute__((ext_vector_type(16)));
typedef unsigned u32x4 __attribute__((ext_vector_type(4)));
typedef unsigned u32x2 __attribute__((ext_vector_type(2)));

constexpr int LDS_BYTES_C = 147456;
constexpr int NB = 8, SEQ = 4096, DM = 1024, T = NB * SEQ;
constexpr int PLE = 256, NE = 32, TOPK = 4, NSLOT = T * TOPK;
constexpr int INC = 4392, INP = 4608;
constexpr int NGRP = 32, SST = 64;
constexpr float EPS = 1e-6f;
constexpr float C2 = 0.125f * 1.4426950408889634f;
constexpr int NTHR = 512;

constexpr size_t MB = 1000000;
constexpr size_t WS_CTL   = 0;
constexpr size_t WS_COS64 = 1 * MB;
constexpr size_t WS_SIN64 = WS_COS64 + 4096 * 32 * 4;
constexpr size_t WS_COS32 = WS_SIN64 + 4096 * 32 * 4;
constexpr size_t WS_SIN32 = WS_COS32 + 4096 * 16 * 4;
constexpr size_t WS_KG    = 3 * MB;
constexpr size_t WS_L64   = WS_KG + 32 * 64 * 256 * 4;
constexpr size_t WS_XBUF  = 5200000;
constexpr size_t WS_KIDX  = 6 * MB;
constexpr size_t WS_WIDX  = 9 * MB;
constexpr size_t WS_EF32  = 11 * MB;
constexpr size_t WS_WG    = 20 * MB;
constexpr size_t WS_LTOK  = 29 * MB;
constexpr size_t WS_LSLOT = 34 * MB;
constexpr size_t WS_LWT   = 39 * MB;
constexpr size_t WS_SMALL_END = 44 * MB;
constexpr size_t WS_W2T   = WS_SMALL_END;
constexpr size_t SZ_W2T   = (size_t)32 * 1024 * 1024 * 2;
constexpr size_t WS_W1T   = WS_W2T + SZ_W2T;
constexpr size_t SZ_W1T   = (size_t)32 * 2048 * 1024 * 2;
constexpr size_t WS_E     = WS_W1T + SZ_W1T;
constexpr size_t SZ_E     = (size_t)T * 1024 * 2;
constexpr size_t WS_A     = WS_E + SZ_E;
constexpr size_t SZ_A     = (size_t)NSLOT * 1024 * 2;
constexpr size_t WS_TAIL  = WS_A + SZ_A;
constexpr size_t WS_WINT  = WS_TAIL;
constexpr size_t WS_WIN8  = WS_WINT + (size_t)512 * 1024 * 2;
constexpr size_t WS_WGLUT = WS_WIN8 + (size_t)INP * 1024;
constexpr size_t WS_WSB8  = WS_WGLUT + 512 * 512 * 2;
constexpr size_t WS_WAB8  = WS_WSB8 + 1024 * 512;
constexpr size_t WS_WO8   = WS_WAB8 + 1024 * 512;
constexpr size_t WS_WPG8  = WS_WO8 + 1024 * 1024;
constexpr size_t WS_WPPT  = WS_WPG8 + 1024 * 1024;
constexpr size_t WS_END   = WS_WPPT + 1024 * 256 * 2;
static_assert(WS_END <= 604000000ull, "workspace map must fit sum(inputs) bytes");
constexpr size_t WS_U     = WS_A;
constexpr size_t SZ_U     = (size_t)32 * 512 * 1152 * 2;
constexpr size_t WS_Q     = WS_U + SZ_U;
constexpr size_t SZ_QKV   = (size_t)T * 512 * 2;
constexpr size_t WS_K     = WS_Q + SZ_QKV;
constexpr size_t WS_V     = WS_K + SZ_QKV;
constexpr size_t WS_QIDX  = WS_V + SZ_QKV;
constexpr size_t WS_MASK  = WS_QIDX + (size_t)T * 256 * 2;
constexpr size_t WS_TV    = WS_MASK + (size_t)8 * 128 * 4096 * 4;
constexpr size_t SZ_TV    = (size_t)32 * 1024 * 1152 * 2;
static_assert(WS_TV + SZ_TV <= WS_TAIL, "early temporaries fit the A region");
constexpr size_t WS_R2    = WS_A;
constexpr size_t WS_R2BF  = WS_A + (size_t)T * 1024 * 4;
constexpr size_t WS_PBF   = WS_R2BF + (size_t)T * 1024;
constexpr size_t WS_PROJ  = WS_PBF + (size_t)T * 256 * 2;
static_assert(WS_PROJ + (size_t)T * 1024 * 2 <= WS_TAIL, "late users fit the A region");
constexpr size_t WS_H8    = WS_W2T + (size_t)32 * 1024 * 1024;
constexpr size_t WS_YA8   = WS_E + 40 * MB;
constexpr size_t WS_Y28   = WS_K;
constexpr size_t WS_MIX8  = WS_TV;
constexpr int CW_CNT = 64;
constexpr int CW_PCNT = 512;
constexpr int CW_QIDX = 192, CW_QATT = 256;
constexpr int CW_SSQ = 1024;
constexpr int CTL_WORDS = CW_SSQ + T;

__device__ __forceinline__ unsigned f2bf(float f) { unsigned u = __builtin_bit_cast(unsigned, f); return (u + 0x7fffu + ((u >> 16) & 1u)) >> 16; }
typedef float f32x2_t __attribute__((ext_vector_type(2))); typedef __bf16 bf16x2_t __attribute__((ext_vector_type(2)));
__device__ __forceinline__ unsigned pk2(float lo, float hi) { f32x2_t v = {lo, hi}; bf16x2_t b = __builtin_convertvector(v, bf16x2_t); return __builtin_bit_cast(unsigned, b); }
__device__ __forceinline__ float bf2f(unsigned short b) { return __builtin_bit_cast(float, (unsigned)b << 16); }
__device__ __forceinline__ float bflo(unsigned w) { return __builtin_bit_cast(float, w << 16); }
__device__ __forceinline__ float bfhi(unsigned w) { return __builtin_bit_cast(float, w & 0xffff0000u); }
__device__ __forceinline__ float wave_sum(float v) {
#pragma unroll
    for (int o = 1; o < 64; o <<= 1) v += __shfl_xor(v, o);
    return v;
}
__device__ __forceinline__ float sigmoidf_(float x) { return __builtin_amdgcn_rcpf(1.0f + __builtin_amdgcn_exp2f(-1.4426950408889634f * x)); }
__device__ __forceinline__ float gelu_tanh(float x) {
    const float u = 0.7978845608028654f * (x + 0.044715f * x * x * x);
    const float e = __expf(-2.0f * fabsf(u));
    float t = (1.0f - e) / (1.0f + e); t = u < 0.f ? -t : t;
    return 0.5f * x * (1.0f + t);
}


typedef int v8i_t __attribute__((ext_vector_type(8)));
typedef int v4i_t __attribute__((ext_vector_type(4)));
__device__ __forceinline__ unsigned pk4_fp8(float a, float b, float c, float d) { int w = __builtin_amdgcn_cvt_pk_fp8_f32(a, b, 0, false); w = __builtin_amdgcn_cvt_pk_fp8_f32(c, d, w, true); return (unsigned)w; }
#ifdef FP8_SELFTEST
__device__ __forceinline__ bool fp8_selftest(int lane) {
    const int rc = lane & 15, g = lane >> 4; v8i_t a, b;
#pragma unroll
    for (int w = 0; w < 8; ++w) { float av[4], bv[4];
#pragma unroll
        for (int q = 0; q < 4; ++q) { const int bb = w * 4 + q; const int k = bb < 16 ? 16 * g + bb : 64 + 16 * g + (bb - 16);
            av[q] = (float)((rc * 7 + k * 3) % 9 - 4) * 0.5f; bv[q] = (float)((k * 5 + rc * 11) % 7 - 3) * 0.25f; }
        a[w] = (int)pk4_fp8(av[0], av[1], av[2], av[3]); b[w] = (int)pk4_fp8(bv[0], bv[1], bv[2], bv[3]); }
    f32x4 c = {0.f, 0.f, 0.f, 0.f};
    c = __builtin_amdgcn_mfma_scale_f32_16x16x128_f8f6f4(a, b, c, 0, 0, 0, 0x7f7f7f7f, 0, 0x7f7f7f7f);
    bool ok = true;
#pragma unroll
    for (int r = 0; r < 4; ++r) { const int i = 4 * g + r, j = rc; float ref = 0.f;
        for (int k = 0; k < 128; ++k) ref += ((float)((i * 7 + k * 3) % 9 - 4) * 0.5f) * ((float)((k * 5 + j * 11) % 7 - 3) * 0.25f);
        ok = ok && (c[r] == ref); }
    return __all(ok);
}
#endif

__device__ __forceinline__ int perm16_row(int c) { const int t = c & ~255, w = c & 255; return t + ((w >> 3) & 1) * 128 + (w >> 6) * 32 + ((w >> 2) & 1) * 16 + ((w >> 4) & 3) * 4 + (w & 3); }

__device__ __forceinline__ f32x4 bf4(u32x2 w) { return (f32x4){bflo(w.x), bfhi(w.x), bflo(w.y), bfhi(w.y)}; }
__device__ __forceinline__ f32x4 f84(unsigned w) { const f32x2_t lo = __builtin_amdgcn_cvt_pk_f32_fp8((int)w, false), hi = __builtin_amdgcn_cvt_pk_f32_fp8((int)w, true); return (f32x4){lo[0], lo[1], hi[0], hi[1]}; }
__device__ __forceinline__ u32x2 pkbf4(f32x4 v) { u32x2 w; w.x = pk2(v.x, v.y); w.y = pk2(v.z, v.w); return w; }
__device__ __forceinline__ unsigned pkf84(f32x4 v) { return pk4_fp8(v.x, v.y, v.z, v.w); }
__device__ __forceinline__ f32x4 sig4(f32x4 v) { return (f32x4){sigmoidf_(v.x), sigmoidf_(v.y), sigmoidf_(v.z), sigmoidf_(v.w)}; }

namespace pg {
constexpr int BM = 256, BK = 64, HALF = 128, HTB = HALF * BK * 2, STAGE_BYTES = 8 * HTB;
__device__ __forceinline__ int lds_byte(int r, int c) { const int st = (r >> 4) * 2 + (c >> 5), rr = r & 15, cc = c & 31, ob = rr * 64 + cc * 2; return st * 1024 + (ob ^ (((ob >> 9) & 1) << 5)); }
__device__ __forceinline__ void stage_rc(int b, int& R, int& C) { const int st = b / 1024, sb = b % 1024, swz = sb ^ (((sb >> 9) & 1) << 5); R = (st >> 1) * 16 + swz / 64; C = (st & 1) * 32 + (swz % 64) / 2; }
struct Unit { int pm, pn, g, li; };

template <bool FP8 = false, class Prob, class Epi>
__device__ __forceinline__ void gemm_phase(LAS unsigned char* lds, const Prob& P, const Epi& E) {
    const int tid = threadIdx.x, wid = __builtin_amdgcn_readfirstlane(tid >> 6), lane = tid & 63, wr = wid >> 2, wc = wid & 3, fr = lane & 15, fq = lane >> 4;
    const int nt = P.nt;
    int R[2], C[2];
#pragma unroll
    for (int i = 0; i < 2; ++i) stage_rc(tid * 16 + i * 8192, R[i], C[i]);
    unsigned offB[2][2];
#pragma unroll
    for (int h = 0; h < 2; ++h)
#pragma unroll
        for (int i = 0; i < 2; ++i) offB[h][i] = (unsigned)(h * HALF + R[i]) * P.ldb_bytes + (unsigned)C[i] * 2u;
    const unsigned ldsw = (unsigned)wid * 1024u;
    const int aoff = lds_byte(wr * 64 + fr, fq * 8), boff = lds_byte(wc * 32 + fr, fq * 8);
#define PG_SA(b, h) (((b) * 2 + (h)) * HTB)
#define PG_SB(b, h) ((4 + (b) * 2 + (h)) * HTB)
#define PG_STAGE(bufoff, gbase, voff, kbytes) do { _Pragma("unroll") for (int _i = 0; _i < 2; ++_i) \
        __builtin_amdgcn_global_load_lds((const unsigned*)((const char*)(gbase) + (voff)[_i] + (kbytes)), (LAS unsigned*)(lds + (bufoff) + ldsw + _i * 8192), 16, 0, 0); } while (0)
#define PG_CAT8(x0, x1) __builtin_shufflevector(x0, x1, 0, 1, 2, 3, 4, 5, 6, 7)
#define PG_LDA(dst, b, h) do { if constexpr (FP8) { _Pragma("unroll") for (int m = 0; m < 4; ++m) dst##8[m] = PG_CAT8(*(const LAS v4i_t*)(lds + PG_SA(b, h) + aoff + m * 2048), *(const LAS v4i_t*)(lds + PG_SA(b, h) + aoff + m * 2048 + 1024)); } \
        else { _Pragma("unroll") for (int m = 0; m < 4; ++m) _Pragma("unroll") for (int k = 0; k < 2; ++k) dst[m][k] = *(const LAS bf16x8*)(lds + PG_SA(b, h) + aoff + m * 2048 + k * 1024); } } while (0)
#define PG_LDB(dst, b, h) do { if constexpr (FP8) { _Pragma("unroll") for (int n = 0; n < 2; ++n) dst##8[n] = PG_CAT8(*(const LAS v4i_t*)(lds + PG_SB(b, h) + boff + n * 2048), *(const LAS v4i_t*)(lds + PG_SB(b, h) + boff + n * 2048 + 1024)); } \
        else { _Pragma("unroll") for (int n = 0; n < 2; ++n) _Pragma("unroll") for (int k = 0; k < 2; ++k) dst[n][k] = *(const LAS bf16x8*)(lds + PG_SB(b, h) + boff + n * 2048 + k * 1024); } } while (0)
#define PG_MMA(ai, bj, At, Bt) do { __builtin_amdgcn_s_setprio(1); \
        if constexpr (FP8) { _Pragma("unroll") for (int m = 0; m < 4; ++m) _Pragma("unroll") for (int n = 0; n < 2; ++n) \
            asm volatile("v_mfma_scale_f32_16x16x128_f8f6f4 %0, %1, %2, %0, %3, %3 op_sel_hi:[0,0,0]" : "+v"(acc[ai][bj][m][n]) : "v"(Bt##8[n]), "v"(At##8[m]), "v"(sc1)); } \
        else { _Pragma("unroll") for (int m = 0; m < 4; ++m) _Pragma("unroll") for (int n = 0; n < 2; ++n) _Pragma("unroll") for (int k = 0; k < 2; ++k) \
            acc[ai][bj][m][n] = __builtin_amdgcn_mfma_f32_16x16x32_bf16(Bt[n][k], At[m][k], acc[ai][bj][m][n], 0, 0, 0); } \
        __builtin_amdgcn_s_setprio(0); } while (0)
#define PG_WAIT_V(n) asm volatile("s_waitcnt vmcnt(" #n ")" ::: "memory")
#define PG_WAIT_L(n) asm volatile("s_waitcnt lgkmcnt(" #n ")" ::: "memory")
#define PG_BAR __builtin_amdgcn_s_barrier()
#define PG_SCHED __builtin_amdgcn_sched_barrier(0)
    Unit cur, nxt; int ui = 0;
    if (!P.next(0, cur)) return;
    f32x4 acc[2][2][4][2];
#pragma unroll
    for (int a = 0; a < 2; ++a)
#pragma unroll
        for (int b = 0; b < 2; ++b)
#pragma unroll
            for (int m = 0; m < 4; ++m)
#pragma unroll
                for (int n = 0; n < 2; ++n) acc[a][b][m][n] = (f32x4){0.f, 0.f, 0.f, 0.f};
    bf16x8 At[4][2], B0[2][2], B1[2][2]; v8i_t At8[4], B08[2], B18[2]; int sc1 = 0x7f7f7f7f; asm volatile("" : "+v"(sc1));
    const char* cA = P.a_base(cur); const char* cB = P.b_base(cur);
    unsigned cOA[2][2], nOA[2][2];
#pragma unroll
    for (int h = 0; h < 2; ++h)
#pragma unroll
        for (int i = 0; i < 2; ++i) cOA[h][i] = P.a_off(cur, h * HALF + R[i], C[i]);
    PG_STAGE(PG_SB(0, 0), cB, offB[0], 0); PG_STAGE(PG_SB(0, 1), cB, offB[1], 0); PG_STAGE(PG_SA(0, 0), cA, cOA[0], 0); PG_STAGE(PG_SA(0, 1), cA, cOA[1], 0);
    if (wr == 1) PG_BAR;
    PG_WAIT_V(2); PG_BAR;
    PG_STAGE(PG_SB(1, 0), cB, offB[0], 128); PG_STAGE(PG_SA(1, 0), cA, cOA[0], 128); PG_STAGE(PG_SB(1, 1), cB, offB[1], 128);
    PG_WAIT_V(6); PG_BAR;
    for (;;) {
        const bool has_next = P.next(ui + 1, nxt);
        const char* nA = has_next ? P.a_base(nxt) : cA; const char* nB = has_next ? P.b_base(nxt) : cB;
#pragma unroll
        for (int h = 0; h < 2; ++h)
#pragma unroll
            for (int i = 0; i < 2; ++i) nOA[h][i] = has_next ? P.a_off(nxt, h * HALF + R[i], C[i]) : cOA[h][i];
        for (int t = 0; t < nt; t += 2) {
            const bool last = (t == nt - 2);
            const unsigned k1 = (unsigned)(t + 1) * 128u;
            const unsigned k2 = last ? 0u : (unsigned)(t + 2) * 128u, k3 = k2 + 128u;
            const char* a2 = last ? nA : cA; const char* b2 = last ? nB : cB;
            unsigned o2[2][2];
#pragma unroll
            for (int h = 0; h < 2; ++h)
#pragma unroll
                for (int i = 0; i < 2; ++i) o2[h][i] = last ? nOA[h][i] : cOA[h][i];
            PG_LDB(B0, 0, 0); PG_LDB(B1, 0, 1); PG_SCHED; PG_LDA(At, 0, 0); PG_STAGE(PG_SA(1, 1), cA, cOA[1], k1);
            PG_WAIT_V(8); PG_WAIT_L(0); PG_BAR; PG_MMA(0, 0, At, B0); PG_MMA(0, 1, At, B1); PG_BAR; PG_SCHED;
            PG_LDA(At, 0, 1); PG_STAGE(PG_SB(0, 0), b2, offB[0], k2); PG_STAGE(PG_SB(0, 1), b2, offB[1], k2); PG_STAGE(PG_SA(0, 0), a2, o2[0], k2);
            PG_WAIT_V(8); PG_WAIT_L(0); PG_BAR; PG_MMA(1, 0, At, B0); PG_MMA(1, 1, At, B1); PG_BAR; PG_SCHED;
            PG_LDB(B0, 1, 0); PG_LDB(B1, 1, 1); PG_SCHED; PG_LDA(At, 1, 0); PG_STAGE(PG_SA(0, 1), a2, o2[1], k2);
            PG_WAIT_V(8); PG_WAIT_L(0); PG_BAR; PG_MMA(0, 0, At, B0); PG_MMA(0, 1, At, B1); PG_BAR; PG_SCHED;
            PG_LDA(At, 1, 1); PG_STAGE(PG_SB(1, 0), b2, offB[0], k3); PG_STAGE(PG_SB(1, 1), b2, offB[1], k3); PG_STAGE(PG_SA(1, 0), a2, o2[0], k3);
            PG_WAIT_V(8); PG_WAIT_L(0); PG_BAR; PG_MMA(1, 0, At, B0); PG_MMA(1, 1, At, B1); PG_BAR; PG_SCHED;
        }
        if (wr == 0) PG_BAR;
        if constexpr (FP8) asm volatile("s_nop 15\n\ts_nop 15" ::: "memory");
        { int fr_ = fr, fq_ = fq; asm volatile("" : "+v"(fr_), "+v"(fq_));
          E(acc, cur, wr, wc, fr_, fq_);
#ifdef PROBE_EPI2
          asm volatile("" : "+v"(fr_), "+v"(fq_)); E(acc, cur, wr, wc, fr_, fq_);
#endif
        }
        if (!has_next) break;
#pragma unroll
        for (int a = 0; a < 2; ++a)
#pragma unroll
            for (int b = 0; b < 2; ++b)
#pragma unroll
                for (int m = 0; m < 4; ++m)
#pragma unroll
                    for (int n = 0; n < 2; ++n) acc[a][b][m][n] = (f32x4){0.f, 0.f, 0.f, 0.f};
        cur = nxt; cA = nA; cB = nB; ++ui;
#pragma unroll
        for (int h = 0; h < 2; ++h)
#pragma unroll
            for (int i = 0; i < 2; ++i) cOA[h][i] = nOA[h][i];
        if (wr == 1) PG_BAR;
    }
    PG_WAIT_V(0);
    PG_BAR;
#undef PG_SA
#undef PG_SB
#undef PG_STAGE
#undef PG_LDA
#undef PG_LDB
#undef PG_MMA
#undef PG_CAT8
#undef PG_WAIT_V
#undef PG_WAIT_L
#undef PG_BAR
#undef PG_SCHED
}

struct Order {
    int nM, nN, nwg, G, c;
    __device__ void init(int nM_, int nN_, int G_, int c_) { nM = nM_; nN = nN_; nwg = nM * nN; G = G_; c = c_; }
    __device__ bool get(int i, int& pm, int& pn) const {
        const long L = (long)i * G + c; if (L >= nwg) return false;
        int wgid = (int)L; { const int q = nwg / 8, r = nwg % 8, xcd = wgid % 8, off = wgid / 8; wgid = (xcd < r ? xcd * (q + 1) : r * (q + 1) + (xcd - r) * q) + off; }
        const int nig = 8 * nN, gid = wgid / nig, fm = gid * 8, gsz = (nM - fm) < 8 ? (nM - fm) : 8;
        pm = fm + ((wgid % nig) % gsz); pn = (wgid % nig) / gsz; return true;
    }
};
struct Dense {
    const char* A; const char* B; unsigned lda_bytes, ldb_bytes; int nt; Order ord; int pn_base = 0, pn_split = 1 << 30, pn_skip = 0, b_tile0 = 0;
    __device__ bool next(int i, Unit& u) const { u.g = 0; int pp; const bool ok = ord.get(i, u.pm, pp); u.pn = pn_base + pp + (pp >= pn_split ? pn_skip : 0); return ok; }
    __device__ const char* a_base(const Unit& u) const { return A + (size_t)u.pm * 256 * lda_bytes; }
    __device__ unsigned a_off(const Unit&, int row, int col) const { return (unsigned)row * lda_bytes + (unsigned)col * 2u; }
    __device__ const char* b_base(const Unit& u) const { return B + (size_t)(u.pn - b_tile0) * 256 * ldb_bytes; }
};
}

struct Frame {
    LAS unsigned char* lds;
    int tid, lane, wave, G, bid, dry;
    const float* in[30]; float* out; unsigned char* ws;
};
#define WSP(T_, off) ((T_*)(F.ws + (off)))
#define LDS_WAIT() asm volatile("s_waitcnt lgkmcnt(0)" ::: "memory")

template <class DstRow>
__device__ __forceinline__ void transpose_item(const float* W, int K, int N, bf16_t* WT, LAS float* scr, int item, int lane, const DstRow& dstrow) {
    const int nblk = (N + 63) / 64, kb = item / nblk, nb = item % nblk, k0 = 64 * kb, n0 = 64 * nb;
    const int kk = lane >> 4, n4 = (lane & 15) * 4;
    f32x4 v[16];
#pragma unroll
    for (int i = 0; i < 16; ++i) v[i] = __builtin_nontemporal_load((const f32x4*)(W + (size_t)(k0 + 4 * i + kk) * N + n0 + n4));
#pragma unroll
    for (int i = 0; i < 16; ++i) { LAS float* d = scr + (4 * i + kk) * 65 + n4; d[0] = v[i].x; d[1] = v[i].y; d[2] = v[i].z; d[3] = v[i].w; }
    LDS_WAIT(); asm volatile("" ::: "memory");
    const int c = lane & 7;
#pragma unroll
    for (int j = 0; j < 8; ++j) { const int n = (lane >> 3) + 8 * j; const LAS float* p = scr + (8 * c) * 65 + n; const int dr = dstrow(n0 + n);
        if (dr >= 0) { u32x4 o; o.x = pk2(p[0], p[65]); o.y = pk2(p[130], p[195]); o.z = pk2(p[260], p[325]); o.w = pk2(p[390], p[455]);
            *(u32x4*)(WT + (size_t)dr * K + k0 + 8 * c) = o; } }
    LDS_WAIT(); asm volatile("" ::: "memory");
}
__device__ __forceinline__ void tr8_load(f32x4 (&v)[16], const float* W, int K, int N, int item, int lane) {
    const int nblk = (N + 63) / 64, kb = item / nblk, nb = item % nblk, k0 = 64 * kb, n0 = 64 * nb; const int kk = lane >> 4, n4 = (lane & 15) * 4;
#pragma unroll
    for (int i = 0; i < 16; ++i) v[i] = __builtin_nontemporal_load((const f32x4*)(W + (size_t)(k0 + 4 * i + kk) * N + n0 + n4));
}
template <class DstRow>
__device__ __forceinline__ void tr8_process(const f32x4 (&v)[16], int K, int N, unsigned char* WT, LAS float* scr, int item, int lane, float scale, const DstRow& dstrow) {
    const int nblk = (N + 63) / 64, kb = item / nblk, nb = item % nblk, k0 = 64 * kb, n0 = 64 * nb; const int kk = lane >> 4, n4 = (lane & 15) * 4;
#pragma unroll
    for (int i = 0; i < 16; ++i) { LAS float* d = scr + (4 * i + kk) * 65 + n4; d[0] = v[i].x * scale; d[1] = v[i].y * scale; d[2] = v[i].z * scale; d[3] = v[i].w * scale; }
    LDS_WAIT(); asm volatile("" ::: "memory");
    const int c = lane & 3;
#pragma unroll
    for (int j = 0; j < 4; ++j) { const int n = (lane >> 2) + 16 * j; const LAS float* p = scr + (16 * c) * 65 + n; const int dr = dstrow(n0 + n);
        u32x4 o; o.x = pk4_fp8(p[0], p[65], p[130], p[195]); o.y = pk4_fp8(p[260], p[325], p[390], p[455]); o.z = pk4_fp8(p[520], p[585], p[650], p[715]); o.w = pk4_fp8(p[780], p[845], p[910], p[975]);
        *(u32x4*)(WT + (size_t)dr * K + k0 + 16 * c) = o; }
    LDS_WAIT(); asm volatile("" ::: "memory");
}
template <class DstRow>
__device__ __forceinline__ void transpose_item_fp8(const float* W, int K, int N, unsigned char* WT, LAS float* scr, int item, int lane, float scale, const DstRow& dstrow) {
    f32x4 v[16]; tr8_load(v, W, K, N, item, lane); tr8_process(v, K, N, WT, scr, item, lane, scale, dstrow);
}
__device__ __forceinline__ int win_dst_row(int c) {
    if (c < 512) return perm16_row(c);
    if (c < 1536) { const int isk = c >= 1024, cc = c - (isk ? 1024 : 512), t = cc >> 8, w = cc & 255; return ((isk ? 4 : 2) + t) * 256 + ((w >> 5) & 1) * 128 + (w >> 6) * 32 + ((w >> 2) & 1) * 16 + ((w >> 3) & 3) * 4 + (w & 3); }
    if (c < 2048) return 1536 + perm16_row(c - 1536);
    if (c < 2304) { const int w = c - 2048, head = w >> 5, bj = (w >> 4) & 1, dd = w & 15; return 2048 + bj * 128 + (head >> 1) * 32 + ((dd >> 2) & 1) * 16 + (2 * (head & 1) + (dd >> 3)) * 4 + (dd & 3); }
    if (c < 2336) { const int cc = c - 2304, half = cc >> 4, w = cc & 15; return 9 * 256 + half * 128 + w; }
    if (c < 2344) return 9 * 256 + 16 + (c - 2336);
    if (c < INC) return 2560 + perm16_row(c - 2344);
    return -1;
}
__device__ __forceinline__ void rms_row_to_bf16(const float* xrow, const float* gain, bf16_t* orow, unsigned char* orow8, int lane) {
    const f32x4* xr = (const f32x4*)xrow + lane; const f32x4* gr = (const f32x4*)gain + lane;
    f32x4 v[4]; float s = 0.f;
#pragma unroll
    for (int j = 0; j < 4; ++j) { v[j] = __builtin_nontemporal_load(xr + 64 * j); s += (v[j].x * v[j].x + v[j].y * v[j].y) + (v[j].z * v[j].z + v[j].w * v[j].w); }
    const float rstd = 1.0f / sqrtf(wave_sum(s) * (1.f / 1024.f) + EPS);
    u32x2* o8 = (u32x2*)orow + lane;
#pragma unroll
    for (int j = 0; j < 4; ++j) { const f32x4 g = gr[64 * j]; const float a0 = v[j].x * rstd * g.x, a1 = v[j].y * rstd * g.y, a2 = v[j].z * rstd * g.z, a3 = v[j].w * rstd * g.w;
        u32x2 w; w.x = pk2(a0, a1); w.y = pk2(a2, a3); o8[64 * j] = w; ((unsigned*)orow8)[lane + 64 * j] = pk4_fp8(a0, a1, a2, a3); }
}

__device__ __forceinline__ void p0_prologue(Frame& F) {
    LAS float* scr = (LAS float*)(F.lds + F.wave * 16640);
    const int gw = F.bid * 8 + F.wave, NGW = F.G * 8;
    { unsigned* ctl = WSP(unsigned, WS_CTL); for (int i = F.bid * NTHR + F.tid; i < CTL_WORDS; i += F.G * NTHR) ctl[i] = 0u; }
    { float* c64 = WSP(float, WS_COS64); float* s64 = WSP(float, WS_SIN64); float* c32 = WSP(float, WS_COS32); float* s32 = WSP(float, WS_SIN32);
      for (int i = F.bid * NTHR + F.tid; i < 4096 * 48; i += F.G * NTHR) {
          if (i < 4096 * 32) { const int pos = i >> 5, k = i & 31; const float inv = powf(10000.0f, -(float)k * (2.0f / 64.0f)); const float a = (float)pos * inv; c64[i] = cosf(a); s64[i] = sinf(a); }
          else { const int j = i - 4096 * 32, pos = j >> 4, k = j & 15; const float inv = powf(10000.0f, -(float)k * (2.0f / 32.0f)); const float a = (float)pos * inv; c32[j] = cosf(a); s32[j] = sinf(a); } } }
    { bf16_t* WT = WSP(bf16_t, WS_WINT) + (size_t)256 * 1024; unsigned char* W8 = WSP(unsigned char, WS_WIN8) + (size_t)9 * 256 * 1024;
      for (int i = F.bid * NTHR + F.tid; i < 256 * 128; i += F.G * NTHR) { const int row = i >> 7, ch = i & 127; const int w = row & 127, half = row >> 7;
          const bool used = (w < 16) || (half == 0 && w < 24); if (!used) { *(u32x4*)(WT + (size_t)row * 1024 + ch * 8) = (u32x4){0u, 0u, 0u, 0u}; if (ch < 64) *(u32x4*)(W8 + (size_t)row * 1024 + ch * 16) = (u32x4){0u, 0u, 0u, 0u}; } } }
    constexpr int I_WIN = ((INC + 63) / 64) * (1024 / 64), I_GLU = (512 / 64) * (512 / 64), I_SB = (1024 / 64) * (512 / 64), I_AB = I_SB, I_O = (1024 / 64) * (1024 / 64), I_PG = I_O, I_PP = (1024 / 64) * (256 / 64);
    constexpr int I_E = (1024 / 64) * (1024 / 64);
    constexpr int NDENSE = I_WIN + I_GLU + I_SB + I_AB + I_O + I_PG + I_PP;
    auto p16 = [](int n) { return perm16_row(n); };
    for (int it = gw; it < NDENSE; it += NGW) {
        int r = it;
        if (r < I_WIN) {
            const int nblk = (INC + 63) / 64, nb = r % nblk;
            if (nb * 64 + 64 <= INC) { transpose_item_fp8(F.in[2], 1024, INC, WSP(unsigned char, WS_WIN8), scr, r, F.lane, 32.0f, [](int n) { return win_dst_row(n); });
                if (nb * 64 + 64 > 2048 && nb * 64 < 2344) transpose_item(F.in[2], 1024, INC, WSP(bf16_t, WS_WINT), scr, r, F.lane, [](int n) { const int d = win_dst_row(n); return (d >= 2048 && d < 2560) ? d - 2048 : -1; }); }
            else { const int kb = r / nblk, k0 = 64 * kb, n0 = 64 * nb; const int n = n0 + F.lane; const int dr = n < INC ? win_dst_row(n) : -1;
                if (dr >= 0) { unsigned char* o = WSP(unsigned char, WS_WIN8) + (size_t)dr * 1024 + k0;
                    for (int k = 0; k < 64; k += 4) *(unsigned*)(o + k) = pk4_fp8(32.0f * F.in[2][(size_t)(k0 + k) * INC + n], 32.0f * F.in[2][(size_t)(k0 + k + 1) * INC + n], 32.0f * F.in[2][(size_t)(k0 + k + 2) * INC + n], 32.0f * F.in[2][(size_t)(k0 + k + 3) * INC + n]); } }
            continue; } r -= I_WIN;
        if (r < I_GLU) { transpose_item(F.in[12], 512, 512, WSP(bf16_t, WS_WGLUT), scr, r, F.lane, p16); continue; } r -= I_GLU;
        if (r < I_SB) { transpose_item_fp8(F.in[14], 512, 1024, WSP(unsigned char, WS_WSB8), scr, r, F.lane, 32.0f, p16); continue; } r -= I_SB;
        if (r < I_AB) { transpose_item_fp8(F.in[15], 512, 1024, WSP(unsigned char, WS_WAB8), scr, r, F.lane, 32.0f, p16); continue; } r -= I_AB;
        if (r < I_O) { transpose_item_fp8(F.in[16], 1024, 1024, WSP(unsigned char, WS_WO8), scr, r, F.lane, 32.0f, p16); continue; } r -= I_O;
        if (r < I_PG) { transpose_item_fp8(F.in[27], 1024, 1024, WSP(unsigned char, WS_WPG8), scr, r, F.lane, 32.0f, p16); continue; } r -= I_PG;
        transpose_item(F.in[28], 256, 1024, WSP(bf16_t, WS_WPPT), scr, r, F.lane, p16);
    }
    for (int m = gw; m < T; m += NGW) rms_row_to_bf16(F.in[0] + (size_t)m * 1024, F.in[17], WSP(bf16_t, WS_E) + (size_t)m * 1024, WSP(unsigned char, WS_H8) + (size_t)m * 1024, F.lane);
}

__device__ __forceinline__ void p0_s5_tables(Frame& F) {
    LAS float* zr = (LAS float*)F.lds; LAS float* zi = zr + 64; LAS float* bbr = zi + 64; LAS float* bbi = bbr + 1024; LAS float* Lr = bbi + 1024; LAS float* Li = Lr + 512;
    const float* lam_re = F.in[4]; const float* lam_im = F.in[5]; const float* log_dt = F.in[6]; const float* b_re = F.in[7]; const float* b_im = F.in[8];
    const float* c_re = F.in[9]; const float* c_im = F.in[10]; const float* d_skip = F.in[11];
    float* Kg = WSP(float, WS_KG); float* L64 = WSP(float, WS_L64); bf16_t* Wg = WSP(bf16_t, WS_WG); bf16_t* TV = WSP(bf16_t, WS_TV);
    for (int it = F.bid; it < 256; it += F.G) {
        const int g = it >> 3, sub = it & 7, tid = F.tid;
        __syncthreads();
        const float dt = expf(log_dt[g]);
        if (tid < 64) { zr[tid] = lam_re[g * 64 + tid] * dt; zi[tid] = lam_im[g * 64 + tid] * dt; }
        __syncthreads();
        for (int idx = tid; idx < 1024; idx += NTHR) { const int p = idx >> 4, hp = idx & 15;
            const float lr = lam_re[g * 64 + p], li = lam_im[g * 64 + p];
            const float er = expf(zr[p]), cr = er * cosf(zi[p]), ci = er * sinf(zi[p]);
            const float nr = cr - 1.0f, ni = ci, den = lr * lr + li * li;
            const float fr_ = (nr * lr + ni * li) / den, fi_ = (ni * lr - nr * li) / den;
            const float br = b_re[(g * 64 + p) * 16 + hp], bi = b_im[(g * 64 + p) * 16 + hp];
            bbr[idx] = fr_ * br - fi_ * bi; bbi[idx] = fr_ * bi + fi_ * br; }
        { const int lagl = tid >> 6, p = tid & 63; const float n = (float)(8 * sub + lagl); const float mag = expf(n * zr[p]), a = n * zi[p]; Lr[tid] = mag * cosf(a); Li[tid] = mag * sinf(a); }
        __syncthreads();
#pragma unroll 1
        for (int j = 0; j < 4; ++j) { const int o = tid + 512 * j, lagl = o >> 8, h = (o >> 4) & 15, hp = o & 15; float s = 0.f;
            for (int p = 0; p < 64; ++p) { const float cr = c_re[(g * 16 + h) * 64 + p], ci = c_im[(g * 16 + h) * 64 + p], lr = Lr[lagl * 64 + p], li = Li[lagl * 64 + p];
                const float tr = cr * lr - ci * li, ti = cr * li + ci * lr; s += tr * bbr[p * 16 + hp] - ti * bbi[p * 16 + hp]; }
            const int lag = 8 * sub + lagl; if (lag == 0 && h == hp) s += d_skip[g * 16 + h];
            Kg[((g * 64 + lag) * 16 + h) * 16 + hp] = s; }
        { const int pl = tid >> 6, j = tid & 63, p = 8 * sub + pl;
          { const float n = (float)(63 - j); const float mag = expf(n * zr[p]), a = n * zi[p]; const float er = mag * cosf(a), ei = mag * sinf(a);
            unsigned wre[8], wim[8];
#pragma unroll
            for (int q = 0; q < 8; ++q) { const float b0r = bbr[p * 16 + 2 * q], b0i = bbi[p * 16 + 2 * q], b1r = bbr[p * 16 + 2 * q + 1], b1i = bbi[p * 16 + 2 * q + 1];
                wre[q] = pk2(er * b0r - ei * b0i, er * b1r - ei * b1i); wim[q] = pk2(er * b0i + ei * b0r, er * b1i + ei * b1r); }
            u32x4* dre = (u32x4*)(Wg + (size_t)(g * 128 + p) * 1024 + j * 16); u32x4* dim = (u32x4*)(Wg + (size_t)(g * 128 + 64 + p) * 1024 + j * 16);
            dre[0] = (u32x4){wre[0], wre[1], wre[2], wre[3]}; dre[1] = (u32x4){wre[4], wre[5], wre[6], wre[7]};
            dim[0] = (u32x4){wim[0], wim[1], wim[2], wim[3]}; dim[1] = (u32x4){wim[4], wim[5], wim[6], wim[7]}; }
          { const int t = j; const float n = (float)(t + 1); const float mag = expf(n * zr[p]), a = n * zi[p]; const float er = mag * cosf(a), ei = mag * sinf(a);
#pragma unroll 4
            for (int h = 0; h < 16; ++h) { const float cr = c_re[(g * 16 + h) * 64 + p], ci = c_im[(g * 16 + h) * 64 + p];
                bf16_t* d = TV + (size_t)(g * 1024 + t * 16 + h) * 1152 + 1024 + p;
                d[0] = (bf16_t)f2bf(cr * er - ci * ei); d[64] = (bf16_t)f2bf(-(cr * ei + ci * er)); } }
          if (sub == 0 && tid < 64) { const float mag = expf(64.0f * zr[tid]), a = 64.0f * zi[tid]; L64[(g * 64 + tid) * 2] = mag * cosf(a); L64[(g * 64 + tid) * 2 + 1] = mag * sinf(a); }
        }
    }
    __syncthreads();
}
__device__ __forceinline__ void fill_tv_item(unsigned char* wsb, int tid, int item) {
    const float* Kg = (const float*)(wsb + WS_KG); bf16_t* TV = (bf16_t*)(wsb + WS_TV);
#pragma unroll 4
    for (int it = 0; it < 16; ++it) { const int ci = (item * 16 + it) * NTHR + tid;
        const int g = ci >> 17, row = (ci >> 7) & 1023, ch = ci & 127, t = row >> 4, h = row & 15, j = ch >> 1, h0 = (ch & 1) * 8, lag = t - j;
        u32x4 o = (u32x4){0u, 0u, 0u, 0u};
        if (lag >= 0) { const f32x4* sp = (const f32x4*)(Kg + ((g * 64 + lag) * 16 + h) * 16 + h0); const f32x4 a = sp[0], b = sp[1];
            o.x = pk2(a.x, a.y); o.y = pk2(a.z, a.w); o.z = pk2(b.x, b.y); o.w = pk2(b.z, b.w); }
        *(u32x4*)(TV + (size_t)(g * 1024 + row) * 1152 + ch * 8) = o; }
}

struct EpiInProj {
    bf16_t *U, *Q, *K, *V, *QI, *KI, *GS, *GA; float* WI; const float *bg, *c64, *s64, *c32, *s32; float ascale;
    __device__ __forceinline__ void operator()(f32x4 (&acc)[2][2][4][2], const pg::Unit& u, int wr, int wc, int fr, int fq) const {
        const int pn = u.pn, row0 = u.pm * 256 + wr * 64 + fr;
        if (ascale != 1.0f) {
#pragma unroll
            for (int a_ = 0; a_ < 2; ++a_)
#pragma unroll
                for (int b_ = 0; b_ < 2; ++b_)
#pragma unroll
                    for (int m_ = 0; m_ < 4; ++m_)
#pragma unroll
                        for (int n_ = 0; n_ < 2; ++n_) acc[a_][b_][m_][n_] *= ascale; }
        auto st32 = [](bf16_t* d, const f32x4& a, const f32x4& b) { const u32x2 x = pkbf4(a), y = pkbf4(b); *(u32x4*)d = (u32x4){x.x, x.y, y.x, y.y}; };
        if (pn < 2 || pn == 6 || pn == 7) {
            const int c0 = (pn & 1) * 256 + wc * 64 + fq * 16;
#pragma unroll
            for (int ai = 0; ai < 2; ++ai)
#pragma unroll
                for (int m = 0; m < 4; ++m) { const int r = row0 + ai * 128 + m * 16;
                    bf16_t* d = pn < 2 ? U + ((size_t)((c0 >> 4) * 512 + (r >> 6)) * 1152 + (r & 63) * 16) : V + (size_t)r * 512 + c0;
                    st32(d, acc[ai][0][m][0], acc[ai][0][m][1]); st32(d + 8, acc[ai][1][m][0], acc[ai][1][m][1]); }
        } else if (pn < 6) {
            bf16_t* O = pn < 4 ? Q : K; const float sc = pn < 4 ? C2 : 1.0f; const int head = (pn & 1) * 4 + wc, dd = fq * 8;
#pragma unroll
            for (int ai = 0; ai < 2; ++ai)
#pragma unroll
                for (int m = 0; m < 4; ++m) { const int r = row0 + ai * 128 + m * 16, l = r & 4095; bf16_t* d = O + (size_t)r * 512 + head * 64 + dd; f32x4 o1[2], o2[2];
#pragma unroll
                    for (int n = 0; n < 2; ++n) { const f32x4 cs = *(const f32x4*)(c64 + l * 32 + dd + 4 * n), sn = *(const f32x4*)(s64 + l * 32 + dd + 4 * n); const f32x4 x1 = acc[ai][0][m][n], x2 = acc[ai][1][m][n];
                        o1[n] = (x1 * cs - x2 * sn) * sc; o2[n] = (x2 * cs + x1 * sn) * sc; }
                    st32(d, o1[0], o1[1]); st32(d + 32, o2[0], o2[1]); }
        } else if (pn == 8) {
            const int head = 2 * wc + (fq >> 1), dd = (fq & 1) * 8;
#pragma unroll
            for (int ai = 0; ai < 2; ++ai)
#pragma unroll
                for (int m = 0; m < 4; ++m) { const int r = row0 + ai * 128 + m * 16, l = r & 4095; bf16_t* d = QI + (size_t)r * 256 + head * 32 + dd; f32x4 o1[2], o2[2];
#pragma unroll
                    for (int n = 0; n < 2; ++n) { const f32x4 cs = *(const f32x4*)(c32 + l * 16 + dd + 4 * n), sn = *(const f32x4*)(s32 + l * 16 + dd + 4 * n); const f32x4 x1 = acc[ai][0][m][n], x2 = acc[ai][1][m][n];
                        o1[n] = x1 * cs - x2 * sn; o2[n] = x2 * cs + x1 * sn; }
                    st32(d, o1[0], o1[1]); st32(d + 16, o2[0], o2[1]); }
        } else if (pn == 9) {
            if (wc == 0) {
#pragma unroll
                for (int ai = 0; ai < 2; ++ai)
#pragma unroll
                    for (int m = 0; m < 4; ++m) { const int r = row0 + ai * 128 + m * 16, l = r & 4095;
                        const f32x4 cs = *(const f32x4*)(c32 + l * 16 + fq * 4), sn = *(const f32x4*)(s32 + l * 16 + fq * 4);
                        const f32x4 x1 = acc[ai][0][m][0], x2 = acc[ai][1][m][0]; const f32x4 o1 = x1 * cs - x2 * sn, o2 = x2 * cs + x1 * sn;
                        bf16_t* d = KI + (size_t)r * 32 + fq * 4; *(u32x2*)d = pkbf4(o1); *(u32x2*)(d + 16) = pkbf4(o2);
                        if (fq < 2) *(f32x4*)(WI + (size_t)r * 8 + fq * 4) = acc[ai][0][m][1]; } }
        } else {
            const int gc = (pn - 10) * 256 + wc * 64 + fq * 16; f32x4 b[4];
#pragma unroll
            for (int q = 0; q < 4; ++q) b[q] = *(const f32x4*)(bg + gc + 4 * q);
            unsigned char* O = (unsigned char*)GS + (gc < 1024 ? (size_t)gc : (size_t)T * 1024 + (gc - 1024));
#pragma unroll
            for (int ai = 0; ai < 2; ++ai)
#pragma unroll
                for (int m = 0; m < 4; ++m) { const int r = row0 + ai * 128 + m * 16;
                    *(u32x4*)(O + (size_t)r * 1024) = (u32x4){pkf84(sig4(acc[ai][0][m][0] + b[0])), pkf84(sig4(acc[ai][0][m][1] + b[1])), pkf84(sig4(acc[ai][1][m][0] + b[2])), pkf84(sig4(acc[ai][1][m][1] + b[3]))}; }
        }
    }
};

__device__ __forceinline__ void idx_score_tile(bf16x8 k0, bf16x8 k1, const bf16x8 (&qp)[2], const bf16x8 (&qf)[8][2], const float (&w)[8], float (&sc)[16]) {
    const f32x16 z = (f32x16){0.f, 0.f, 0.f, 0.f, 0.f, 0.f, 0.f, 0.f, 0.f, 0.f, 0.f, 0.f, 0.f, 0.f, 0.f, 0.f};
    f32x16 lin = __builtin_amdgcn_mfma_f32_32x32x16_bf16(k0, qp[0], z, 0, 0, 0); lin = __builtin_amdgcn_mfma_f32_32x32x16_bf16(k1, qp[1], lin, 0, 0, 0);
    f32x16 dA = __builtin_amdgcn_mfma_f32_32x32x16_bf16(k0, qf[0][0], z, 0, 0, 0); dA = __builtin_amdgcn_mfma_f32_32x32x16_bf16(k1, qf[0][1], dA, 0, 0, 0);
#pragma unroll
    for (int r = 0; r < 16; ++r) sc[r] = lin[r];
#pragma unroll
    for (int h = 0; h < 8; ++h) {
        f32x16 dB = z;
        if (h < 7) { dB = __builtin_amdgcn_mfma_f32_32x32x16_bf16(k0, qf[h + 1][0], z, 0, 0, 0); dB = __builtin_amdgcn_mfma_f32_32x32x16_bf16(k1, qf[h + 1][1], dB, 0, 0, 0); }
#pragma unroll
        for (int r = 0; r < 16; ++r) sc[r] = __builtin_fmaf(w[h], __builtin_fabsf(dA[r]), sc[r]);
        asm volatile("" : "+v"(sc[0]), "+v"(sc[1]), "+v"(sc[2]), "+v"(sc[3]), "+v"(sc[4]), "+v"(sc[5]), "+v"(sc[6]), "+v"(sc[7]), "+v"(k0));
        asm volatile("" : "+v"(sc[8]), "+v"(sc[9]), "+v"(sc[10]), "+v"(sc[11]), "+v"(sc[12]), "+v"(sc[13]), "+v"(sc[14]), "+v"(sc[15]), "+v"(k1));
        dA = dB;
    }
}
__device__ __forceinline__ unsigned h16_of(float s) { const _Float16 hf = (_Float16)s; return (unsigned)__builtin_bit_cast(unsigned short, hf); }
__device__ __forceinline__ void idx_scan(const LAS unsigned* hq, unsigned need, int mode, unsigned& fb, unsigned& frem) {
    unsigned cum = 0; fb = 0; frem = 1; bool found = false;
    for (int k = 0; k < 256; ++k) { const int bin = mode == 0 ? (k < 128 ? 127 - k : k) : mode == 1 ? 255 - k : k; const unsigned c = hq[bin * 32];
        if (!found && cum + c >= need) { fb = (unsigned)bin; frem = need - cum; found = true; } cum += c; }
}
__device__ __forceinline__ void idx_phase(Frame& F) {
    LAS unsigned* hist = (LAS unsigned*)F.lds;
    LAS unsigned* b1s = hist + 16384; LAS unsigned* r1s = b1s + 64; LAS unsigned* ths = r1s + 64;
    const bf16_t* QI = WSP(bf16_t, WS_QIDX); const bf16_t* KI = WSP(bf16_t, WS_KIDX); const float* WI = WSP(float, WS_WIDX); unsigned* MASK = WSP(unsigned, WS_MASK);
    const int lane = F.lane, r32 = lane & 31, hi = lane >> 5, gq = F.wave & 1, ks = F.wave >> 1;
    LAS int* qslot = (LAS int*)(F.lds + 68 * 1024);
    unsigned* qhead = WSP(unsigned, WS_CTL) + CW_QIDX + (F.dry ? 16 : 0);
    for (;;) {
            __syncthreads();
            if (F.tid == 0) *qslot = (int)__hip_atomic_fetch_add(qhead, 1u, __ATOMIC_RELAXED, __HIP_MEMORY_SCOPE_AGENT);
            __syncthreads();
            const int qpos = *qslot; if (qpos >= 1024) break;
            if (qpos & 1) { if (!F.dry) fill_tv_item(F.ws, F.tid, qpos >> 1); continue; }
            const int un = qpos >> 1;
            const int qb = 63 - (un >> 3), b = un & 7;
            const int q0 = qb * 64 + gq * 32, tok = b * 4096 + q0 + r32, ntile = (qb + 1) * 2;
            bf16x8 qf[8][2], qp[2]; float w[8];
#pragma unroll
            for (int h = 0; h < 8; ++h)
#pragma unroll
                for (int k = 0; k < 2; ++k) qf[h][k] = *(const bf16x8*)(QI + (size_t)tok * 256 + h * 32 + k * 16 + hi * 8);
            { const f32x4 wa = *(const f32x4*)(WI + (size_t)tok * 8), wb = *(const f32x4*)(WI + (size_t)tok * 8 + 4); w[0] = wa.x; w[1] = wa.y; w[2] = wa.z; w[3] = wa.w; w[4] = wb.x; w[5] = wb.y; w[6] = wb.z; w[7] = wb.w; }
#pragma unroll
            for (int k = 0; k < 2; ++k) { float a[8];
#pragma unroll
                for (int j = 0; j < 8; ++j) a[j] = 0.f;
#pragma unroll
                for (int h = 0; h < 8; ++h)
#pragma unroll
                    for (int j = 0; j < 8; ++j) a[j] = __builtin_fmaf(w[h], bf2f((unsigned short)qf[h][k][j]), a[j]);
                u32x4 pkd; pkd.x = pk2(a[0], a[1]); pkd.y = pk2(a[2], a[3]); pkd.z = pk2(a[4], a[5]); pkd.w = pk2(a[6], a[7]); qp[k] = __builtin_bit_cast(bf16x8, pkd); }
            const bf16_t* kbase = KI + (size_t)(b * 4096 + r32) * 32 + hi * 8;
            LAS unsigned* hq = hist + gq * 8192 + r32;
            _Float16 theta = (_Float16)(-INFINITY); float sc[16]; bf16x8 kn0, kn1;
#define IDX_TILES(BODY) do { kn0 = *(const bf16x8*)(kbase + (size_t)ks * 1024); kn1 = *(const bf16x8*)(kbase + (size_t)ks * 1024 + 16); \
            for (int kt = ks; kt < ntile; kt += 4) { const bf16x8 kc0 = kn0, kc1 = kn1; \
                if (kt + 4 < ntile) { kn0 = *(const bf16x8*)(kbase + (size_t)(kt + 4) * 1024); kn1 = *(const bf16x8*)(kbase + (size_t)(kt + 4) * 1024 + 16); } \
                idx_score_tile(kc0, kc1, qp, qf, w, sc); BODY } } while (0)
            if (qb >= 4) {
                for (int i = F.tid; i < 16384; i += NTHR) hist[i] = 0u;
                __syncthreads();
                IDX_TILES({
                    _Pragma("unroll") for (int r = 0; r < 16; ++r) __hip_atomic_fetch_add(hq + (h16_of(sc[r]) >> 8) * 32, 1u, __ATOMIC_RELAXED, __HIP_MEMORY_SCOPE_WORKGROUP); });
                __syncthreads();
                if (ks == 0 && hi == 0) { unsigned fb, fr_; idx_scan(hq, 256u, 0, fb, fr_); b1s[gq * 32 + r32] = fb; r1s[gq * 32 + r32] = fr_; }
                __syncthreads();
                for (int i = F.tid; i < 16384; i += NTHR) hist[i] = 0u;
                __syncthreads();
                const unsigned b1 = b1s[gq * 32 + r32];
                IDX_TILES({
                    _Pragma("unroll") for (int r = 0; r < 16; ++r) { const unsigned hv = h16_of(sc[r]); if ((hv >> 8) == b1) __hip_atomic_fetch_add(hq + (hv & 255u) * 32, 1u, __ATOMIC_RELAXED, __HIP_MEMORY_SCOPE_WORKGROUP); } });
                __syncthreads();
                if (ks == 0 && hi == 0) { unsigned fb, fr_; const unsigned bb = b1s[gq * 32 + r32]; idx_scan(hq, r1s[gq * 32 + r32], bb < 128u ? 1 : 2, fb, fr_); ths[gq * 32 + r32] = (bb << 8) | fb; }
                __syncthreads();
                theta = __builtin_bit_cast(_Float16, (unsigned short)ths[gq * 32 + r32]);
            }
            IDX_TILES({
                unsigned bits = 0u;
                _Pragma("unroll") for (int r = 0; r < 16; ++r) bits |= ((_Float16)sc[r] >= theta ? 1u : 0u) << ((r & 3) + 8 * (r >> 2));
                bits <<= 4 * hi;
                bits |= (unsigned)__shfl_xor((int)bits, 32);
                if (hi == 0) MASK[(size_t)(b * 128 + kt) * 4096 + q0 + r32] = bits; });
#undef IDX_TILES
    }
}

constexpr int CV_IE = (1024 / 64) * (1024 / 64), CV_NITEMS = 3 * 32 * CV_IE, CV_NBLK = CV_NITEMS / 8;
__device__ __forceinline__ void expert_conv_item(LAS unsigned char* lds, unsigned char* ws, int wave, int lane, const float* wg_, const float* wu_, const float* wd_, int bitem) {
    LAS float* scr = (LAS float*)(lds + wave * 16640);
    const int r = bitem * 8 + wave, which = r / (32 * CV_IE), e = (r % (32 * CV_IE)) / CV_IE, item = r % CV_IE;
    auto w1row = [](int c) { const int pn = c >> 7, w = c & 127; return pn * 256 + (w & 96) + ((w >> 2) & 1) * 16 + ((w >> 3) & 3) * 4 + (w & 3); };
    const float* src = (which == 0 ? wg_ : which == 1 ? wu_ : wd_) + (size_t)e * 1024 * 1024;
    if (which == 0) transpose_item_fp8(src, 1024, 1024, ws + WS_W1T + (size_t)e * 2048 * 1024, scr, item, lane, 32.0f, w1row);
    else if (which == 1) transpose_item_fp8(src, 1024, 1024, ws + WS_W1T + (size_t)e * 2048 * 1024, scr, item, lane, 32.0f, [=](int c) { return w1row(c) + 128; });
    else transpose_item_fp8(src, 1024, 1024, ws + WS_W2T + (size_t)e * 1024 * 1024, scr, item, lane, 32.0f, [](int n) { return perm16_row(n); });
}
__device__ __forceinline__ s16x4 vtr(const LAS char* p) { typedef short v4i16_t __attribute__((ext_vector_type(4))); return __builtin_bit_cast(s16x4, __builtin_amdgcn_ds_read_tr16_b64_v4i16((LAS v4i16_t*)p)); }
__device__ __forceinline__ unsigned bfe_mask(int w, int bp) { int r; asm("v_bfe_i32 %0, %1, %2, 1" : "=v"(r) : "v"(w), "v"(bp)); return (unsigned)r; }
__device__ __forceinline__ float max3_(float a, float b, float c) { float r; asm("v_max3_f32 %0, %1, %2, %3" : "=v"(r) : "v"(a), "v"(b), "v"(c)); return r; }
__device__ __forceinline__ void glds16(const void* gsrc, unsigned lds_dst) {
    unsigned keep; asm volatile("s_mov_b32 %0, m0\n\ts_mov_b32 m0, %2\n\ts_nop 0\n\tglobal_load_lds_dwordx4 %1, off\n\ts_mov_b32 m0, %0" : "=&s"(keep) : "v"(gsrc), "s"(lds_dst) : "memory"); }
__device__ __forceinline__ void attn_phase(Frame& F) {
    const bf16_t* Q = WSP(bf16_t, WS_Q); const bf16_t* K = WSP(bf16_t, WS_K); const bf16_t* V = WSP(bf16_t, WS_V); unsigned char* O = F.dry ? WSP(unsigned char, WS_E) : WSP(unsigned char, WS_YA8); const unsigned* MASK = WSP(unsigned, WS_MASK);
    const int lane = F.lane, r32 = lane & 31, hi = lane >> 5, wv = F.wave;
    const LAS char* ldsc = (const LAS char*)F.lds;
    const unsigned lds0 = (unsigned)(uintptr_t)F.lds;
    constexpr int KOFF = 0, VOFF = 32768, MOFF = 65536;
    const float* const wg_ = F.in[21]; const float* const wu_ = F.in[23]; const float* const wd_ = F.in[25];
    LAS int* qslot = (LAS int*)(F.lds + LDS_BYTES_C - 128);
    unsigned* qhead = WSP(unsigned, WS_CTL) + CW_QATT + (F.dry ? 16 : 0);
    for (;;) {
            __syncthreads();
            if (F.tid == 0) *qslot = (int)__hip_atomic_fetch_add(qhead, 1u, __ATOMIC_RELAXED, __HIP_MEMORY_SCOPE_AGENT);
            __syncthreads();
            const int qp = *qslot; if (qp >= 1024 + CV_NBLK) break;
            if ((qp & 3) != 0 || qp >= 4096) { const int ci = qp < 4096 ? qp - (qp >> 2) - 1 : qp - 1024; if (!F.dry) expert_conv_item(F.lds, F.ws, F.wave, F.lane, wg_, wu_, wd_, ci); continue; }
            const int un = qp >> 2;
            const int qb = 15 - (un >> 6), b = (un >> 3) & 7, h = un & 7;
            const int q0 = qb * 256, NT = 4 * qb + 4, ntw = 4 * qb + (wv >> 1) + 1;
            const size_t tokq = (size_t)b * 4096 + q0 + wv * 32 + r32;
            const bf16_t* ksrc = K + ((size_t)b * 4096 + lane) * 512 + h * 64 + wv * 8;
            const bf16_t* vsrc = V + ((size_t)b * 4096 + 16 * (wv & 3) + (lane >> 2)) * 512 + h * 64 + (wv >> 2) * 32 + (lane & 3) * 8;
            const unsigned* msrc = MASK + ((size_t)b * 128 + (wv & 1)) * 4096 + q0 + lane * 4;
            const unsigned kdst = lds0 + KOFF + wv * 1024, vdst = lds0 + VOFF + wv * 1024, mdst = lds0 + MOFF + (wv & 1) * 1024;
#define ATT_DMA(t_) do { const int tt_ = (t_) < NT ? (t_) : NT - 1; const unsigned sl_ = (unsigned)((t_) & 3); \
        glds16(ksrc + (size_t)tt_ * 64 * 512, (unsigned)__builtin_amdgcn_readfirstlane(kdst + sl_ * 8192u)); \
        glds16(vsrc + (size_t)tt_ * 64 * 512, (unsigned)__builtin_amdgcn_readfirstlane(vdst + sl_ * 8192u)); \
        glds16(msrc + (size_t)tt_ * 2 * 4096, (unsigned)__builtin_amdgcn_readfirstlane(mdst + sl_ * 2048u)); } while (0)
            ATT_DMA(0); ATT_DMA(1); ATT_DMA(2);
            bf16x8 qr[4];
#pragma unroll
            for (int d0 = 0; d0 < 4; ++d0) qr[d0] = *(const bf16x8*)(Q + tokq * 512 + h * 64 + d0 * 16 + hi * 8);
            asm volatile("" : "+v"(qr[0]), "+v"(qr[1]), "+v"(qr[2]), "+v"(qr[3]));
            float m = 0.f; f32x16 o[2], o2, negm;
#pragma unroll
            for (int r = 0; r < 16; ++r) { o[0][r] = 0.f; o[1][r] = 0.f; o2[r] = 0.f; negm[r] = 0.f; }
            const unsigned onew = r32 == 0 ? 0x3f803f80u : 0u; const bf16x8 ones = __builtin_bit_cast(bf16x8, (u32x4){onew, onew, onew, onew});
            const int vlane = ((lane >> 4) & 1) * 32 + (lane & 3) * 8 + (4 * hi + ((lane & 15) >> 2)) * 64;
            for (int t = 0; t < NT; ++t) {
                asm volatile("s_waitcnt vmcnt(6)\n\ts_barrier" ::: "memory");
                ATT_DMA(t + 3);
                if (t < ntw) {
                    const int sl = t & 3;
                    const LAS char* Kb = ldsc + KOFF + sl * 8192; const LAS char* Vb = ldsc + VOFF + sl * 8192 + vlane; const LAS unsigned* Mb = (const LAS unsigned*)(ldsc + MOFF + sl * 2048) + wv * 32 + r32;
                    const int w0 = (int)(Mb[0] >> (4 * hi)), w1 = (int)(Mb[256] >> (4 * hi));
                    f32x16 p0, p1;
                    { const bf16x8 k0 = *(const LAS bf16x8*)(Kb + hi * 1024 + r32 * 16), k1 = *(const LAS bf16x8*)(Kb + hi * 1024 + r32 * 16 + 512);
                      p0 = __builtin_amdgcn_mfma_f32_32x32x16_bf16(k0, qr[0], negm, 0, 0, 0); p1 = __builtin_amdgcn_mfma_f32_32x32x16_bf16(k1, qr[0], negm, 0, 0, 0); }
#pragma unroll
                    for (int d0 = 1; d0 < 4; ++d0) { const bf16x8 k0 = *(const LAS bf16x8*)(Kb + d0 * 2048 + hi * 1024 + r32 * 16), k1 = *(const LAS bf16x8*)(Kb + d0 * 2048 + hi * 1024 + r32 * 16 + 512);
                        p0 = __builtin_amdgcn_mfma_f32_32x32x16_bf16(k0, qr[d0], p0, 0, 0, 0); p1 = __builtin_amdgcn_mfma_f32_32x32x16_bf16(k1, qr[d0], p1, 0, 0, 0); }
                    asm volatile("s_nop 15\n\ts_nop 7" : "+v"(p0), "+v"(p1));
                    float rm = max3_(p0[0], p1[0], p0[1]), rm2 = max3_(p1[1], p0[2], p1[2]);
#pragma unroll
                    for (int r = 3; r < 15; r += 2) { rm = max3_(rm, p0[r], p1[r]); rm2 = max3_(rm2, p0[r + 1], p1[r + 1]); }
                    rm = max3_(rm, p0[15], p1[15]); rm = __builtin_fmaxf(rm, rm2);
                    rm = __builtin_fmaxf(rm, __shfl_xor(rm, 32));
                    if (t == 0 || __any(rm > 0.f)) {
                        const float dl = t == 0 ? rm : __builtin_fmaxf(rm, 0.f), f = __builtin_amdgcn_exp2f(-dl);
                        m += dl;
#pragma unroll
                        for (int r = 0; r < 16; ++r) { negm[r] = -m; o[0][r] *= f; o[1][r] *= f; o2[r] *= f; p0[r] -= dl; p1[r] -= dl; }
                    }
#pragma unroll
                    for (int r = 0; r < 16; ++r) { const int bp = (r & 3) + 8 * (r >> 2);
                        p0[r] = __uint_as_float(__float_as_uint(__builtin_amdgcn_exp2f(p0[r])) & bfe_mask(w0, bp));
                        p1[r] = __uint_as_float(__float_as_uint(__builtin_amdgcn_exp2f(p1[r])) & bfe_mask(w1, bp)); }
                    u32x4 pw[4];
#pragma unroll
                    for (int q = 0; q < 4; ++q) { pw[0][q] = pk2(p0[2 * q], p0[2 * q + 1]); pw[1][q] = pk2(p0[8 + 2 * q], p0[8 + 2 * q + 1]); pw[2][q] = pk2(p1[2 * q], p1[2 * q + 1]); pw[3][q] = pk2(p1[8 + 2 * q], p1[8 + 2 * q + 1]); }
#pragma unroll
                    for (int d0 = 0; d0 < 2; ++d0)
#pragma unroll
                        for (int kk = 0; kk < 4; ++kk) { const s16x4 lo = vtr(Vb + d0 * 4096 + kk * 1024), hh = vtr(Vb + d0 * 4096 + kk * 1024 + 512);
                            const bf16x8 vf = (bf16x8){lo[0], lo[1], lo[2], lo[3], hh[0], hh[1], hh[2], hh[3]};
                            o[d0] = __builtin_amdgcn_mfma_f32_32x32x16_bf16(vf, __builtin_bit_cast(bf16x8, pw[kk]), o[d0], 0, 0, 0); }
#pragma unroll
                    for (int kk = 0; kk < 4; ++kk) o2 = __builtin_amdgcn_mfma_f32_32x32x16_bf16(ones, __builtin_bit_cast(bf16x8, pw[kk]), o2, 0, 0, 0);
                }
            }
            asm volatile("s_waitcnt vmcnt(0) lgkmcnt(0)\n\ts_barrier" ::: "memory");
#undef ATT_DMA
            const float lt = __shfl(o2[0], r32), inv = 1.0f / lt;
#pragma unroll
            for (int d0 = 0; d0 < 2; ++d0)
#pragma unroll
                for (int g4 = 0; g4 < 4; ++g4) { unsigned w = pk4_fp8(o[d0][4 * g4] * inv, o[d0][4 * g4 + 1] * inv, o[d0][4 * g4 + 2] * inv, o[d0][4 * g4 + 3] * inv);
#ifdef ABL_ATTN
                    w = 0u;
#endif
                    *(unsigned*)(O + tokq * 512 + h * 64 + d0 * 32 + g4 * 8 + hi * 4) = w; }
        }
}

__device__ __forceinline__ int xcd_pos(int G, int c) { return (G & 7) == 0 ? (c & 7) * (G >> 3) + (c >> 3) : c; }
struct ProbS5E {
    const char* U; const char* Wg; unsigned ldb_bytes; int nt, G, c;
    __device__ bool next(int i, pg::Unit& u) const { const int L = i * G + xcd_pos(G, c); if (L >= 64) return false; u.g = L >> 1; u.pm = L & 1; u.pn = 0; return true; }
    __device__ const char* a_base(const pg::Unit& u) const { return U + ((size_t)u.g * 512 + u.pm * 256) * 2304; }
    __device__ unsigned a_off(const pg::Unit&, int row, int col) const { return (unsigned)row * 2304u + (unsigned)col * 2u; }
    __device__ const char* b_base(const pg::Unit& u) const { return Wg + (size_t)u.g * 128 * 2048; }
};
struct EpiS5E { float* E;
    __device__ __forceinline__ void operator()(f32x4 (&acc)[2][2][4][2], const pg::Unit& u, int wr, int wc, int fr, int fq) const {
#pragma unroll
        for (int ai = 0; ai < 2; ++ai)
#pragma unroll
            for (int m = 0; m < 4; ++m) { const int r = u.pm * 256 + ai * 128 + wr * 64 + m * 16 + fr;
#pragma unroll
                for (int n = 0; n < 2; ++n) *(f32x4*)(E + ((size_t)u.g * 512 + r) * 128 + wc * 32 + n * 16 + fq * 4) = acc[ai][0][m][n]; }
    }
};
__device__ __forceinline__ void s5_scan(Frame& F) {
    if (F.wave != 0) return;
    const float* E = WSP(float, WS_EF32); const float* L64 = WSP(float, WS_L64); bf16_t* U = WSP(bf16_t, WS_U);
    for (int gid = F.bid * 64 + F.lane; gid < 32 * 8 * 64; gid += F.G * 64) {
        const int p = gid & 63, b = (gid >> 6) & 7, g = gid >> 9;
        const float lr = L64[(g * 64 + p) * 2], li = L64[(g * 64 + p) * 2 + 1]; float sr = 0.f, si = 0.f;
        const size_t m0 = (size_t)g * 512 + b * 64;
#pragma unroll 1
        for (int c0 = 0; c0 < 64; c0 += 16) { float er[16], ei[16];
#pragma unroll
            for (int c = 0; c < 16; ++c) { er[c] = E[(m0 + c0 + c) * 128 + p]; ei[c] = E[(m0 + c0 + c) * 128 + 64 + p]; }
#pragma unroll
            for (int c = 0; c < 16; ++c) { const size_t m = m0 + c0 + c;
                U[m * 1152 + 1024 + p] = (bf16_t)f2bf(sr); U[m * 1152 + 1088 + p] = (bf16_t)f2bf(si);
                const float nr = lr * sr - li * si + er[c], ni = lr * si + li * sr + ei[c]; sr = nr; si = ni; } }
    }
}
struct ProbS5Y {
    const char* U; const char* TV; unsigned ldb_bytes; int nt, G, c;
    __device__ bool next(int i, pg::Unit& u) const { const int L = i * G + xcd_pos(G, c); if (L >= 256) return false; u.g = L >> 3; u.pm = (L >> 2) & 1; u.pn = L & 3; return true; }
    __device__ const char* a_base(const pg::Unit& u) const { return U + ((size_t)u.g * 512 + u.pm * 256) * 2304; }
    __device__ unsigned a_off(const pg::Unit&, int row, int col) const { return (unsigned)row * 2304u + (unsigned)col * 2u; }
    __device__ const char* b_base(const pg::Unit& u) const { return TV + ((size_t)u.g * 1024 + u.pn * 256) * 2304; }
};
struct EpiS5Y { bf16_t* Y;
    __device__ __forceinline__ void operator()(f32x4 (&acc)[2][2][4][2], const pg::Unit& u, int wr, int wc, int fr, int fq) const {
#pragma unroll
        for (int ai = 0; ai < 2; ++ai)
#pragma unroll
            for (int m = 0; m < 4; ++m) { const int mm = u.pm * 256 + ai * 128 + wr * 64 + m * 16 + fr, b = mm >> 6, c = mm & 63;
#pragma unroll
                for (int bj = 0; bj < 2; ++bj)
#pragma unroll
                    for (int n = 0; n < 2; ++n) { const int nn = u.pn * 256 + bj * 128 + wc * 32 + n * 16 + fq * 4, t = nn >> 4, h = nn & 15; const f32x4 v = acc[ai][bj][m][n];
                        u32x2 w; w.x = pk2(gelu_tanh(v.x), gelu_tanh(v.y)); w.y = pk2(gelu_tanh(v.z), gelu_tanh(v.w));
#ifdef ABL_SSM
                        w.x = 0u; w.y = 0u;
#endif
                        *(u32x2*)(Y + ((size_t)b * 4096 + c * 64 + t) * 512 + u.g * 16 + h) = w; } }
    }
};

template <class Fn> __device__ __forceinline__ void epi_each(f32x4 (&acc)[2][2][4][2], const pg::Unit& u, int wr, int wc, int fr, int fq, const Fn& fn) {
#pragma unroll
    for (int ai = 0; ai < 2; ++ai)
#pragma unroll
        for (int m = 0; m < 4; ++m) { const int r = u.pm * 256 + ai * 128 + wr * 64 + m * 16 + fr;
#pragma unroll
            for (int bj = 0; bj < 2; ++bj)
#pragma unroll
                for (int n = 0; n < 2; ++n) fn(r, u.pn * 256 + bj * 128 + wc * 32 + n * 16 + fq * 4, acc[ai][bj][m][n]); }
}
template <class Fn> __device__ __forceinline__ void epi_each16(f32x4 (&acc)[2][2][4][2], const pg::Unit& u, int wr, int wc, int fr, int fq, const Fn& fn) {
#pragma unroll
    for (int ai = 0; ai < 2; ++ai)
#pragma unroll
        for (int m = 0; m < 4; ++m) fn(u.pm * 256 + ai * 128 + wr * 64 + m * 16 + fr, u.pn * 256 + wc * 64 + fq * 16, acc[ai][0][m][0], acc[ai][0][m][1], acc[ai][1][m][0], acc[ai][1][m][1]);
}
struct EpiGlu { const bf16_t* YS; unsigned char* Y2; const float* b;
    __device__ __forceinline__ void operator()(f32x4 (&acc)[2][2][4][2], const pg::Unit& u, int wr, int wc, int fr, int fq) const {
        epi_each16(acc, u, wr, wc, fr, fq, [&](int r, int c, const f32x4& v0, const f32x4& v1, const f32x4& v2, const f32x4& v3) {
            const f32x4* bp = (const f32x4*)(b + c); const u32x4 ya = *(const u32x4*)(YS + (size_t)r * 512 + c), yb = *(const u32x4*)(YS + (size_t)r * 512 + c + 8);
            u32x4 o; o.x = pkf84(bf4((u32x2){ya.x, ya.y}) * sig4(v0 + bp[0])); o.y = pkf84(bf4((u32x2){ya.z, ya.w}) * sig4(v1 + bp[1])); o.z = pkf84(bf4((u32x2){yb.x, yb.y}) * sig4(v2 + bp[2])); o.w = pkf84(bf4((u32x2){yb.z, yb.w}) * sig4(v3 + bp[3]));
            *(u32x4*)(Y2 + (size_t)r * 512 + c) = o; }); }
};
template <bool ADD> struct EpiMix { const unsigned char* Gt; bf16_t* MIX; unsigned char* MIX8;
    __device__ __forceinline__ void operator()(f32x4 (&acc)[2][2][4][2], const pg::Unit& u, int wr, int wc, int fr, int fq) const {
        epi_each16(acc, u, wr, wc, fr, fq, [&](int r, int c, const f32x4& v0, const f32x4& v1, const f32x4& v2, const f32x4& v3) {
            const u32x4 g = *(const u32x4*)(Gt + (size_t)r * 1024 + c);
            f32x4 o0 = f84(g.x) * v0 * 0.03125f, o1 = f84(g.y) * v1 * 0.03125f, o2 = f84(g.z) * v2 * 0.03125f, o3 = f84(g.w) * v3 * 0.03125f;
            if (ADD) { const u32x4 ma = *(const u32x4*)(MIX + (size_t)r * 1024 + c), mb = *(const u32x4*)(MIX + (size_t)r * 1024 + c + 8);
                o0 += bf4((u32x2){ma.x, ma.y}); o1 += bf4((u32x2){ma.z, ma.w}); o2 += bf4((u32x2){mb.x, mb.y}); o3 += bf4((u32x2){mb.z, mb.w});
                *(u32x4*)(MIX8 + (size_t)r * 1024 + c) = (u32x4){pkf84(o0), pkf84(o1), pkf84(o2), pkf84(o3)}; }
            else { const u32x2 a = pkbf4(o0), b_ = pkbf4(o1), c_ = pkbf4(o2), d = pkbf4(o3);
                *(u32x4*)(MIX + (size_t)r * 1024 + c) = (u32x4){a.x, a.y, b_.x, b_.y}; *(u32x4*)(MIX + (size_t)r * 1024 + c + 8) = (u32x4){c_.x, c_.y, d.x, d.y}; } }); }
};
struct EpiStoreBf { bf16_t* O; int ldo; float sc;
    __device__ __forceinline__ void operator()(f32x4 (&acc)[2][2][4][2], const pg::Unit& u, int wr, int wc, int fr, int fq) const {
        epi_each16(acc, u, wr, wc, fr, fq, [&](int r, int c, const f32x4& v0, const f32x4& v1, const f32x4& v2, const f32x4& v3) {
            const u32x2 a = pkbf4(v0 * sc), b_ = pkbf4(v1 * sc), c_ = pkbf4(v2 * sc), d = pkbf4(v3 * sc);
            *(u32x4*)(O + (size_t)r * ldo + c) = (u32x4){a.x, a.y, b_.x, b_.y}; *(u32x4*)(O + (size_t)r * ldo + c + 8) = (u32x4){c_.x, c_.y, d.x, d.y}; }); }
};
struct EpiPleNorm { const bf16_t* R2; const bf16_t* PROJ; float* OUT; const float* gain; float* xbuf; unsigned* pcnt; LAS float* Pl; LAS float* Sl;
    __device__ __forceinline__ void operator()(f32x4 (&acc)[2][2][4][2], const pg::Unit& u, int wr, int wc, int fr, int fq) const {
        const int tid = (wr * 4 + wc) * 64 + fq * 16 + fr;
        const int c0 = u.pn * 256 + wc * 64 + fq * 16;
#pragma unroll
        for (int ai = 0; ai < 2; ++ai)
#pragma unroll
            for (int m = 0; m < 4; ++m) { const size_t r = (size_t)u.pm * 256 + ai * 128 + wr * 64 + m * 16 + fr;
                const u32x4 ra = *(const u32x4*)(R2 + r * 1024 + c0), rb = *(const u32x4*)(R2 + r * 1024 + c0 + 8), pa = *(const u32x4*)(PROJ + r * 1024 + c0), pb = *(const u32x4*)(PROJ + r * 1024 + c0 + 8);
                acc[ai][0][m][0] = bf4((u32x2){ra.x, ra.y}) + sig4(acc[ai][0][m][0] * 0.03125f) * bf4((u32x2){pa.x, pa.y});
                acc[ai][0][m][1] = bf4((u32x2){ra.z, ra.w}) + sig4(acc[ai][0][m][1] * 0.03125f) * bf4((u32x2){pa.z, pa.w});
                acc[ai][1][m][0] = bf4((u32x2){rb.x, rb.y}) + sig4(acc[ai][1][m][0] * 0.03125f) * bf4((u32x2){pb.x, pb.y});
                acc[ai][1][m][1] = bf4((u32x2){rb.z, rb.w}) + sig4(acc[ai][1][m][1] * 0.03125f) * bf4((u32x2){pb.z, pb.w});
                asm volatile("" : "+v"(acc[ai][0][m][0]), "+v"(acc[ai][0][m][1]), "+v"(acc[ai][1][m][0]), "+v"(acc[ai][1][m][1]));
                if (m & 1) asm volatile("" ::: "memory"); }
#pragma unroll
        for (int ai = 0; ai < 2; ++ai)
#pragma unroll
            for (int m = 0; m < 4; ++m) { float q = 0.f;
#pragma unroll
                for (int bj = 0; bj < 2; ++bj)
#pragma unroll
                    for (int n = 0; n < 2; ++n) { const f32x4 x = acc[ai][bj][m][n]; q += (x[0] * x[0] + x[1] * x[1]) + (x[2] * x[2] + x[3] * x[3]); }
                q += __shfl_xor(q, 16); q += __shfl_xor(q, 32);
                if (fq == 0) Pl[(ai * 128 + wr * 64 + m * 16 + fr) * 4 + wc] = q; }
        asm volatile("s_waitcnt lgkmcnt(0)" ::: "memory"); __builtin_amdgcn_s_barrier(); asm volatile("" ::: "memory");
        if (tid < 256) { const float t = (Pl[tid * 4 + 0] + Pl[tid * 4 + 1]) + (Pl[tid * 4 + 2] + Pl[tid * 4 + 3]);
            __hip_atomic_store(xbuf + ((size_t)u.pm * 256 + tid) * 4 + u.pn, t, __ATOMIC_RELAXED, __HIP_MEMORY_SCOPE_AGENT); }
        asm volatile("s_waitcnt vmcnt(0) lgkmcnt(0)" ::: "memory"); __builtin_amdgcn_s_barrier(); asm volatile("" ::: "memory");
        if (tid == 0) { __hip_atomic_fetch_add(pcnt + u.pm, 1u, __ATOMIC_RELAXED, __HIP_MEMORY_SCOPE_AGENT);
            unsigned sp = 0; while (__hip_atomic_load(pcnt + u.pm, __ATOMIC_RELAXED, __HIP_MEMORY_SCOPE_AGENT) < 4u) { __builtin_amdgcn_s_sleep(2); if (++sp > (1u << 22)) break; }
            __builtin_amdgcn_fence(__ATOMIC_ACQUIRE, "agent"); }
        asm volatile("s_waitcnt vmcnt(0) lgkmcnt(0)" ::: "memory"); __builtin_amdgcn_s_barrier(); asm volatile("" ::: "memory");
        if (tid < 256) { const float* sl = xbuf + ((size_t)u.pm * 256 + tid) * 4;
            const float a0 = __hip_atomic_load(sl + 0, __ATOMIC_RELAXED, __HIP_MEMORY_SCOPE_AGENT), a1 = __hip_atomic_load(sl + 1, __ATOMIC_RELAXED, __HIP_MEMORY_SCOPE_AGENT), a2 = __hip_atomic_load(sl + 2, __ATOMIC_RELAXED, __HIP_MEMORY_SCOPE_AGENT), a3 = __hip_atomic_load(sl + 3, __ATOMIC_RELAXED, __HIP_MEMORY_SCOPE_AGENT);
            Sl[tid] = 1.0f / sqrtf(((a0 + a1) + (a2 + a3)) * (1.f / 1024.f) + EPS); }
        asm volatile("s_waitcnt vmcnt(0) lgkmcnt(0)" ::: "memory"); __builtin_amdgcn_s_barrier(); asm volatile("" ::: "memory");
        f32x4 gv[4];
#pragma unroll
        for (int q = 0; q < 4; ++q) gv[q] = *(const f32x4*)(gain + c0 + 4 * q);
#pragma unroll
        for (int ai = 0; ai < 2; ++ai)
#pragma unroll
            for (int m = 0; m < 4; ++m) { const int rl = ai * 128 + wr * 64 + m * 16 + fr; const float rs = Sl[rl]; f32x4* op = (f32x4*)(OUT + ((size_t)u.pm * 256 + rl) * 1024 + c0);
                op[0] = acc[ai][0][m][0] * rs * gv[0]; op[1] = acc[ai][0][m][1] * rs * gv[1]; op[2] = acc[ai][1][m][0] * rs * gv[2]; op[3] = acc[ai][1][m][1] * rs * gv[3]; }
        asm volatile("s_waitcnt lgkmcnt(0)" ::: "memory"); __builtin_amdgcn_s_barrier(); asm volatile("" ::: "memory");
    }
};

__device__ __forceinline__ void router_phase(Frame& F) {
    constexpr int WST = 1032;
    LAS bf16_t* whi = (LAS bf16_t*)F.lds; LAS bf16_t* wlo = whi + 32 * WST;
    LAS unsigned* lcnt = (LAS unsigned*)(F.lds + 2 * 32 * WST * 2);
    LAS unsigned* gbase = lcnt + 32;
    LAS unsigned* ent_e = gbase + 32;
    LAS float* ent_w = (LAS float*)(ent_e + 512);
    const float* Wr = F.in[19]; const float* br = F.in[20]; const float* gain = F.in[18]; const float* X = F.in[0];
    const bf16_t* D1 = (const bf16_t*)F.out + (size_t)T * 1024;
    unsigned char* H2 = F.dry ? WSP(unsigned char, WS_A) : (unsigned char*)F.out;
    unsigned* cnt = WSP(unsigned, WS_CTL) + CW_CNT + (F.dry ? 32 : 0); int* LTOK = F.dry ? (int*)(F.ws + WS_A + 70 * MB) : WSP(int, WS_LTOK); int* LSLOT = F.dry ? (int*)(F.ws + WS_A + 75 * MB) : WSP(int, WS_LSLOT); float* LWT = F.dry ? (float*)(F.ws + WS_A + 80 * MB) : WSP(float, WS_LWT);
    { f32x4 wv[16];
#pragma unroll
      for (int q = 0; q < 16; ++q) wv[q] = *((const f32x4*)Wr + F.tid + q * NTHR);
#pragma unroll
      for (int q = 0; q < 16; ++q) { const int i4 = F.tid + q * NTHR, k = i4 >> 3, e0 = (i4 & 7) * 4; const float g = gain[k];
#pragma unroll
          for (int c = 0; c < 4; ++c) { const float v = wv[q][c] * g; const unsigned h = f2bf(v); const float vh = __builtin_bit_cast(float, h << 16);
              whi[(e0 + c) * WST + k] = (bf16_t)h; wlo[(e0 + c) * WST + k] = (bf16_t)f2bf(v - vh); } } }
    const int lane = F.lane, tl = lane & 15, kq = lane >> 4;
    for (int tb = F.bid; tb < T / 128; tb += F.G) {
        if (F.tid < 32) lcnt[F.tid] = 0u;
        if (!F.dry) { const f32x4* ps = (const f32x4*)(F.in[1] + (size_t)tb * 128 * 256); u32x2* pd = (u32x2*)(WSP(bf16_t, WS_PBF) + (size_t)tb * 128 * 256);
#pragma unroll 4
            for (int q = 0; q < 16; ++q) { const f32x4 v = ps[F.tid + q * NTHR]; u32x2 w; w.x = pk2(v.x, v.y); w.y = pk2(v.z, v.w); pd[F.tid + q * NTHR] = w; } }
        __syncthreads();
        const int tok0 = tb * 128 + F.wave * 16, tok = tok0 + tl;
        const float* xrow = X + (size_t)tok * 1024 + 8 * kq; const bf16_t* drow = D1 + (size_t)tok * 1024 + 8 * kq;
        f32x4 acc[2]; acc[0] = (f32x4){0.f, 0.f, 0.f, 0.f}; acc[1] = acc[0]; float ss = 0.f;
#pragma unroll 16
        for (int st = 0; st < 32; ++st) {
            const f32x4 x0 = *(const f32x4*)(xrow + 32 * st), x1 = *(const f32x4*)(xrow + 32 * st + 4); const u32x4 dd = *(const u32x4*)(drow + 32 * st);
            const f32x4 g0 = *(const f32x4*)(gain + 32 * st + 8 * kq), g1 = *(const f32x4*)(gain + 32 * st + 8 * kq + 4);
            float r[8] = {x0.x + bflo(dd.x), x0.y + bfhi(dd.x), x0.z + bflo(dd.y), x0.w + bfhi(dd.y), x1.x + bflo(dd.z), x1.y + bfhi(dd.z), x1.z + bflo(dd.w), x1.w + bfhi(dd.w)};
            { u32x2 o; o.x = pk4_fp8(r[0] * g0.x, r[1] * g0.y, r[2] * g0.z, r[3] * g0.w); o.y = pk4_fp8(r[4] * g1.x, r[5] * g1.y, r[6] * g1.z, r[7] * g1.w); *(u32x2*)(H2 + (size_t)tok * 1024 + 32 * st + 8 * kq) = o; }
            u32x4 ah, al;
#pragma unroll
            for (int p = 0; p < 4; ++p) { ss = __builtin_fmaf(r[2 * p], r[2 * p], ss); ss = __builtin_fmaf(r[2 * p + 1], r[2 * p + 1], ss);
                const unsigned hw = pk2(r[2 * p], r[2 * p + 1]); ah[p] = hw; al[p] = pk2(r[2 * p] - bflo(hw), r[2 * p + 1] - bfhi(hw)); }
            const bf16x8 A_hi = __builtin_bit_cast(bf16x8, ah), A_lo = __builtin_bit_cast(bf16x8, al);
#pragma unroll
            for (int n = 0; n < 2; ++n) { const bf16x8 Bh = *(const LAS bf16x8*)(whi + (16 * n + tl) * WST + 32 * st + 8 * kq), Bl = *(const LAS bf16x8*)(wlo + (16 * n + tl) * WST + 32 * st + 8 * kq);
                acc[n] = __builtin_amdgcn_mfma_f32_16x16x32_bf16(A_hi, Bh, acc[n], 0, 0, 0); acc[n] = __builtin_amdgcn_mfma_f32_16x16x32_bf16(A_hi, Bl, acc[n], 0, 0, 0); acc[n] = __builtin_amdgcn_mfma_f32_16x16x32_bf16(A_lo, Bh, acc[n], 0, 0, 0); }
        }
        ss += __shfl_xor(ss, 16); ss += __shfl_xor(ss, 32);
        const float rstd = 1.0f / sqrtf(ss * (1.f / 1024.f) + EPS);
        if (kq == 0 && !F.dry) WSP(float, WS_CTL)[CW_SSQ + tok] = rstd;
        const float b0 = br[tl], b1 = br[16 + tl];
#pragma unroll
        for (int rg = 0; rg < 4; ++rg) { const float rs = __shfl(rstd, 4 * kq + rg);
            float v0 = acc[0][rg] * rs + b0, v1 = acc[1][rg] * rs + b1; float tv[4]; int te[4];
#pragma unroll
            for (int k = 0; k < 4; ++k) { float bv = v0; int bi = tl; if (v1 > v0) { bv = v1; bi = 16 + tl; }
#pragma unroll
                for (int o = 1; o < 16; o <<= 1) { const float ov = __shfl_xor(bv, o); const int oi = __shfl_xor(bi, o); if (ov > bv || (ov == bv && oi < bi)) { bv = ov; bi = oi; } }
                tv[k] = bv; te[k] = bi; if (bi == tl) v0 = -INFINITY; if (bi == 16 + tl) v1 = -INFINITY; }
            const float e1 = __expf(tv[1] - tv[0]), e2 = __expf(tv[2] - tv[0]), e3 = __expf(tv[3] - tv[0]), inv = 1.0f / (1.0f + e1 + e2 + e3);
            if (tl < 4) { const int e = tl == 0 ? te[0] : tl == 1 ? te[1] : tl == 2 ? te[2] : te[3]; const float w = (tl == 0 ? 1.0f : tl == 1 ? e1 : tl == 2 ? e2 : e3) * inv;
                const int tli = F.wave * 16 + 4 * kq + rg;
                const unsigned pos = __hip_atomic_fetch_add(lcnt + e, 1u, __ATOMIC_RELAXED, __HIP_MEMORY_SCOPE_WORKGROUP);
                ent_e[tli * 4 + tl] = (unsigned)e | (pos << 8); ent_w[tli * 4 + tl] = w; }
        }
        __syncthreads();
        if (F.tid < 32) gbase[F.tid] = __hip_atomic_fetch_add(cnt + F.tid, lcnt[F.tid], __ATOMIC_RELAXED, __HIP_MEMORY_SCOPE_AGENT);
        __syncthreads();
        { const unsigned ee = ent_e[F.tid]; const int e = ee & 255, pos = (int)(gbase[e] + (ee >> 8)); const int tok_ = tb * 128 + (F.tid >> 2);
          LTOK[(size_t)e * T + pos] = tok_; LSLOT[(size_t)e * T + pos] = tok_ * 4 + (F.tid & 3); LWT[(size_t)e * T + pos] = ent_w[F.tid]; }
        __syncthreads();
    }
}

struct MoeTab { LAS int* cnt; LAS int* ntile; LAS int* cumu; LAS int* offs; LAS unsigned short* rowl; };
template <int NPN> __device__ __forceinline__ bool moe_unit(const MoeTab& tab, int L, pg::Unit& u) {
    if (L >= tab.cumu[32]) return false; int e = 0;
#pragma unroll 1
    for (int k = 1; k < 32; ++k) if (tab.cumu[k] <= L) e = k;
    const int rem = L - tab.cumu[e]; u.g = e; u.pm = rem / NPN; u.pn = rem % NPN; return true;
}
__device__ __forceinline__ int moe_L(int i, int G, int c) { return i * G + ((G & 7) == 0 ? (c & 7) * (G >> 3) + (c >> 3) : c); }
template <int NPN> __device__ __forceinline__ MoeTab moe_tab_build(Frame& F, bool gather) {
    MoeTab t; t.cnt = (LAS int*)(F.lds + 131072); t.ntile = t.cnt + 32; t.cumu = t.ntile + 32; t.offs = t.cumu + 40; t.rowl = (LAS unsigned short*)(F.lds + 131072 + 1024);
    __syncthreads();
    if (F.tid < 32) t.cnt[F.tid] = (int)__hip_atomic_load(WSP(unsigned, WS_CTL) + CW_CNT + F.tid, __ATOMIC_RELAXED, __HIP_MEMORY_SCOPE_AGENT);
    __syncthreads();
    if (F.tid == 0) { int cu = 0, of = 0;
        for (int e = 0; e < 32; ++e) { const int n = t.cnt[e]; const int nt_ = (n + 255) >> 8; t.ntile[e] = nt_; t.cumu[e] = cu; t.offs[e] = of; cu += nt_ * NPN; of += n; }
        t.cumu[32] = cu; t.offs[32] = of; }
    __syncthreads();
    if (gather) {
        const int* ltok = WSP(int, WS_LTOK);
        for (int i = 0; i < 17; ++i) { pg::Unit u; if (!moe_unit<NPN>(t, moe_L(i, F.G, F.bid), u)) break;
            if (F.tid < 256) { int r = u.pm * 256 + F.tid; const int n = t.cnt[u.g]; r = r < n ? r : n - 1; t.rowl[i * 256 + F.tid] = (unsigned short)ltok[(size_t)u.g * T + r]; } }
        __syncthreads();
    }
    return t;
}
template <int NPN> struct ProbMoe {
    const char* A; const char* W; MoeTab tab; unsigned ldb_bytes; int nt, G, c; bool gather; int hot;
    __device__ bool next(int i, pg::Unit& u) const { u.li = i; const bool ok = moe_unit<NPN>(tab, moe_L(i, G, c), u); if (hot) { u.li = 0; u.g = 0; u.pn = 0; u.pm = 0; } return ok; }
    __device__ const char* a_base(const pg::Unit&) const { return A; }
    __device__ unsigned a_off(const pg::Unit& u, int row, int col) const {
        unsigned arow;
        if (gather) arow = (unsigned)tab.rowl[u.li * 256 + row];
        else { int r = u.pm * 256 + row; const int n = tab.cnt[u.g]; r = r < n ? r : n - 1; arow = (unsigned)(tab.offs[u.g] + r); }
        return arow * 1024u + (unsigned)col * 2u; }
    __device__ const char* b_base(const pg::Unit& u) const { return W + ((size_t)u.g * (NPN * 256) + u.pn * 256) * 1024; }
};
struct EpiMoe1 { unsigned char* Aout; const float* bgate; const float* bup; const float* rstd; MoeTab tab; int dry;
    __device__ __forceinline__ void operator()(f32x4 (&acc)[2][2][4][2], const pg::Unit& u, int wr, int wc, int fr, int fq) const {
        if (dry >= 3) return;
        const int e = u.g, n = tab.cnt[e], off = tab.offs[e];
        const int col = u.pn * 128 + wc * 32 + fq * 8;
        f32x4 bg[2], bu[2];
#pragma unroll
        for (int nn = 0; nn < 2; ++nn) { bg[nn] = *(const f32x4*)(bgate + e * 1024 + col + 4 * nn); bu[nn] = *(const f32x4*)(bup + e * 1024 + col + 4 * nn); }
        float rs_[8];
#pragma unroll
        for (int q = 0; q < 8; ++q) rs_[q] = 0.03125f * rstd[tab.rowl[u.li * 256 + (q >> 2) * 128 + wr * 64 + (q & 3) * 16 + fr]];
#pragma unroll
        for (int ai = 0; ai < 2; ++ai)
#pragma unroll
            for (int m = 0; m < 4; ++m) { const int r = u.pm * 256 + ai * 128 + wr * 64 + m * 16 + fr; float o[8];
#pragma unroll
                for (int nn = 0; nn < 2; ++nn) { const f32x4 g4 = acc[ai][0][m][nn] * rs_[ai * 4 + m] + bg[nn], u4 = acc[ai][1][m][nn] * rs_[ai * 4 + m] + bu[nn];
#pragma unroll
                    for (int j = 0; j < 4; ++j) { const float g = fminf(g4[j], 7.0f), uu = fminf(fmaxf(u4[j], -7.0f), 7.0f); o[4 * nn + j] = (uu + 1.0f) * (g * sigmoidf_(1.702f * g)); } }
                u32x2 w; w.x = pk4_fp8(o[0], o[1], o[2], o[3]); w.y = pk4_fp8(o[4], o[5], o[6], o[7]);
                if (r < n) { if (dry != 2) *(u32x2*)(Aout + (size_t)(off + r) * 1024 + col) = w; else asm volatile("" :: "v"(w.x), "v"(w.y)); } }
    }
};
struct EpiMoe2 { unsigned char* ws; unsigned char* outb; const float* bdown; const int* lslot; const float* lwt; MoeTab tab;
    __device__ __forceinline__ void operator()(f32x4 (&acc)[2][2][4][2], const pg::Unit& u, int wr, int wc, int fr, int fq) const {
        const int e = u.g, n = tab.cnt[e];
        int sl[8]; float wt[8];
#pragma unroll
        for (int q = 0; q < 8; ++q) { int r = u.pm * 256 + (q >> 2) * 128 + wr * 64 + (q & 3) * 16 + fr; r = r < n ? r : n - 1; sl[q] = lslot[(size_t)e * T + r]; wt[q] = lwt[(size_t)e * T + r]; }
        const int c0 = u.pn * 256 + wc * 64 + fq * 16;
        f32x4 bd[4];
#pragma unroll
        for (int q = 0; q < 4; ++q) bd[q] = *(const f32x4*)(bdown + e * 1024 + c0 + 4 * q);
#pragma unroll
        for (int ai = 0; ai < 2; ++ai)
#pragma unroll
            for (int m = 0; m < 4; ++m) { const int r = u.pm * 256 + ai * 128 + wr * 64 + m * 16 + fr; if (r < n) { const int s_ = sl[ai * 4 + m]; const float w_ = wt[ai * 4 + m] * 16.0f;
                    unsigned char* dst = ws + WS_W1T + (size_t)s_ * 1024;
                    u32x4 o; o.x = pkf84((acc[ai][0][m][0] * 0.03125f + bd[0]) * w_); o.y = pkf84((acc[ai][0][m][1] * 0.03125f + bd[1]) * w_); o.z = pkf84((acc[ai][1][m][0] * 0.03125f + bd[2]) * w_); o.w = pkf84((acc[ai][1][m][1] * 0.03125f + bd[3]) * w_);
                    *(u32x4*)(dst + c0) = o; } }
    }
};

__device__ __forceinline__ void combine_phase(Frame& F) {
    const int gw = F.bid * 8 + F.wave, NGW = F.G * 8, lane = F.lane;
    const bf16_t* D1 = (const bf16_t*)F.out + (size_t)T * 1024;
    auto slotp = [&](int sl) -> const unsigned* { return (const unsigned*)(F.ws + WS_W1T + (size_t)sl * 1024) + lane; };
    for (int tok = gw; tok < T; tok += NGW) {
        const f32x4* xr = (const f32x4*)(F.in[0] + (size_t)tok * 1024) + lane; const u32x2* dr = (const u32x2*)(D1 + (size_t)tok * 1024) + lane;
        f32x4 v[4]; u32x2 d1[4]; unsigned d[4][4];
#pragma unroll
        for (int j = 0; j < 4; ++j) { v[j] = __builtin_nontemporal_load(xr + 64 * j); d1[j] = __builtin_nontemporal_load(dr + 64 * j); }
#pragma unroll
        for (int k = 0; k < 4; ++k) { const unsigned* sr = slotp(tok * 4 + k);
#pragma unroll
            for (int j = 0; j < 4; ++j) d[k][j] = __builtin_nontemporal_load(sr + 64 * j); }
#pragma unroll
        for (int j = 0; j < 4; ++j) { v[j].x += bflo(d1[j].x); v[j].y += bfhi(d1[j].x); v[j].z += bflo(d1[j].y); v[j].w += bfhi(d1[j].y); }
#pragma unroll
        for (int k = 0; k < 4; ++k)
#pragma unroll
            for (int j = 0; j < 4; ++j) { const f32x2_t lo = __builtin_amdgcn_cvt_pk_f32_fp8((int)d[k][j], false), hi2 = __builtin_amdgcn_cvt_pk_f32_fp8((int)d[k][j], true);
                v[j].x += lo[0] * 0.0625f; v[j].y += lo[1] * 0.0625f; v[j].z += hi2[0] * 0.0625f; v[j].w += hi2[1] * 0.0625f; }
        u32x2* r2 = (u32x2*)(WSP(bf16_t, WS_R2) + (size_t)tok * 1024) + lane; unsigned* rb = (unsigned*)(WSP(unsigned char, WS_R2BF) + (size_t)tok * 1024) + lane;
#pragma unroll
        for (int j = 0; j < 4; ++j) { u32x2 w; w.x = pk2(v[j].x, v[j].y); w.y = pk2(v[j].z, v[j].w); r2[64 * j] = w; rb[64 * j] = pk4_fp8(v[j].x, v[j].y, v[j].z, v[j].w); }
    }
}
__device__ __forceinline__ void final_norm_phase(Frame& F) {
    const int gw = F.bid * 8 + F.wave, NGW = F.G * 8, lane = F.lane; const f32x4* gr = (const f32x4*)F.in[29] + lane;
    for (int tok = gw; tok < T; tok += NGW) {
        const u32x2* xr = (const u32x2*)(WSP(bf16_t, WS_E) + (size_t)tok * 1024) + lane; f32x4 v[4]; float s = 0.f;
#pragma unroll
        for (int j = 0; j < 4; ++j) { const u32x2 d = xr[64 * j]; v[j] = (f32x4){bflo(d.x), bfhi(d.x), bflo(d.y), bfhi(d.y)}; s += (v[j].x * v[j].x + v[j].y * v[j].y) + (v[j].z * v[j].z + v[j].w * v[j].w); }
        const float rstd = 1.0f / sqrtf(wave_sum(s) * (1.f / 1024.f) + EPS);
        f32x4* xw = F.dry ? (f32x4*)(WSP(float, WS_A) + (size_t)tok * 1024) + lane : (f32x4*)(F.out + (size_t)tok * 1024) + lane;
#pragma unroll
        for (int j = 0; j < 4; ++j) { const f32x4 g = gr[64 * j]; xw[64 * j] = (f32x4){v[j].x * rstd * g.x, v[j].y * rstd * g.y, v[j].z * rstd * g.z, v[j].w * rstd * g.w}; }
    }
}
constexpr size_t WS_BAR = 512 * 1024;
#define XB_TMO      128
#define XB_XCNT(j)  (256  + 64 * (j))
#define XB_XSUB(j)  (1280 + 64 * (j))
#define XB_XGEN(j)  (2304 + 64 * (j))
#define XB_TOP      3328
#define XB_TOPGEN   3392
#define XCD_BAR_WORDS 3456
#define XB_SPIN_CAP (1u << 18)
__device__ __forceinline__ unsigned xb_ld(unsigned* p)              { return __hip_atomic_load(p, __ATOMIC_RELAXED, __HIP_MEMORY_SCOPE_AGENT); }
__device__ __forceinline__ unsigned xb_add(unsigned* p, unsigned v) { return __hip_atomic_fetch_add(p, v, __ATOMIC_RELAXED, __HIP_MEMORY_SCOPE_AGENT); }
__device__ __forceinline__ unsigned xb_xcc_id() { return (unsigned)__builtin_amdgcn_s_getreg((3 << 11) | 20) & 0xFu; }
#define XB_SPIN(cond, bar) do { unsigned _sp = 0; while (cond) { __builtin_amdgcn_s_sleep(1); \
    if ((++_sp & 255u) == 0u) { if (xb_ld(&(bar)[XB_TMO])) break; if (_sp > XB_SPIN_CAP) { atomicAdd(&(bar)[XB_TMO], 1u); break; } } } } while (0)
struct XcdBarrier { unsigned* bar; unsigned x; volatile LAS unsigned* st; };
__device__ __forceinline__ XcdBarrier xcd_barrier_post(unsigned* bar, volatile LAS unsigned* st) {
    XcdBarrier b; b.bar = bar; b.x = xb_xcc_id(); b.st = st;
    if (threadIdx.x == 0) (void)xb_add(&bar[XB_XCNT(b.x)], 1u);
    return b;
}
__device__ __forceinline__ void xcd_barrier_complete(unsigned* bar, unsigned x, unsigned& nloc, unsigned& nx) {
    const unsigned G = gridDim.x * gridDim.y * gridDim.z;
    unsigned sum, cnt, mine, sp = 0u;
    for (;;) {
        sum = 0u; cnt = 0u; mine = 0u;
#pragma unroll
        for (unsigned j = 0; j < 16; ++j) { const unsigned c = xb_ld(&bar[XB_XCNT(j)]); sum += c; cnt += (c > 0u) ? 1u : 0u; mine = (j == x) ? c : mine; }
        if (sum == G) break;
        __builtin_amdgcn_s_sleep(1);
        if ((++sp & 255u) == 0u) { if (xb_ld(&bar[XB_TMO])) break; if (sp > XB_SPIN_CAP) { atomicAdd(&bar[XB_TMO], 1u); break; } }
    }
    nloc = mine > 0u ? mine : 1u; nx = cnt > 0u ? cnt : 1u;
}
__device__ __forceinline__ void xcd_barrier(const XcdBarrier& b) {
    asm volatile("s_waitcnt vmcnt(0)" ::: "memory");
    __syncthreads();
    if (threadIdx.x == 0) {
        unsigned* bar = b.bar;
        __builtin_amdgcn_s_waitcnt(0);
        unsigned nloc = b.st[0], nx = b.st[1];
        if (nloc == 0u) { xcd_barrier_complete(bar, b.x, nloc, nx); b.st[0] = nloc; b.st[1] = nx; }
        const unsigned old = xb_add(&bar[XB_XSUB(b.x)], 1u);
        const unsigned gen = old / nloc;
        if (old + 1u == (gen + 1u) * nloc) {
            __builtin_amdgcn_fence(__ATOMIC_RELEASE, "agent");
            asm volatile("s_waitcnt vmcnt(0)" ::: "memory");
            const unsigned og = xb_add(&bar[XB_TOP], 1u);
            const unsigned tg = og / nx;
            if (og + 1u == (tg + 1u) * nx) xb_add(&bar[XB_TOPGEN], 1u);
            else XB_SPIN(xb_ld(&bar[XB_TOPGEN]) == tg, bar);
            __builtin_amdgcn_fence(__ATOMIC_ACQUIRE, "agent");
            xb_add(&bar[XB_XGEN(b.x)], 1u);
            asm volatile("s_waitcnt vmcnt(0)" ::: "memory");
        } else {
            XB_SPIN(xb_ld(&bar[XB_XGEN(b.x)]) == gen, bar);
            __builtin_amdgcn_fence(__ATOMIC_ACQUIRE, "agent");
            asm volatile("s_waitcnt vmcnt(0)" ::: "memory");
        }
    }
    __syncthreads();
}

constexpr int LDS_BYTES = 147456;
constexpr int NPHASE = 14;
#ifndef MK_MULTI
#define MK_MULTI 0
#endif
struct Args { const float* in[30]; float* out; unsigned char* ws; int ph_lo, ph_hi, dry, pad; };
static_assert(sizeof(Args) == 32 * 8 + 16, "no padding in Args");

__global__ void __launch_bounds__(NTHR, 2) fwd(Args a) {
    extern __shared__ __attribute__((aligned(16))) unsigned char lds_[];
    Frame F;
    F.lds = (LAS unsigned char*)lds_;
    F.tid = threadIdx.x; F.lane = F.tid & 63; F.wave = __builtin_amdgcn_readfirstlane(F.tid >> 6); F.G = gridDim.x; F.bid = blockIdx.x;
#pragma unroll
    for (int i = 0; i < 30; ++i) F.in[i] = a.in[i];
    F.out = a.out; F.ws = a.ws; F.dry = a.dry;
    const int lo = a.ph_lo, hi = a.ph_hi;
#ifndef PHMASK
#define PHMASK 0x3fff
#endif
#define IN(k) (((PHMASK >> (k)) & 1) && lo <= (k) && (k) < hi)
    volatile LAS unsigned* xst = (volatile LAS unsigned*)(F.lds + LDS_BYTES - 64);
    if (F.tid < 2) xst[F.tid] = 0u;
    __syncthreads();
    const XcdBarrier xbar = xcd_barrier_post((unsigned*)(F.ws + WS_BAR), xst);
#define SEAM(k) do { if (IN(k) && IN((k) + 1)) xcd_barrier(xbar); } while (0)
    bf16_t* GS = (bf16_t*)F.out; bf16_t* GA = GS + (size_t)T * 1024;

    if (IN(0)) { p0_prologue(F); __syncthreads(); p0_s5_tables(F); }
    SEAM(0);
    if (IN(1)) {
        EpiInProj E; E.U = WSP(bf16_t, WS_U); E.Q = WSP(bf16_t, WS_Q); E.K = WSP(bf16_t, WS_K); E.V = WSP(bf16_t, WS_V); E.QI = WSP(bf16_t, WS_QIDX); E.KI = WSP(bf16_t, WS_KIDX); E.GS = GS; E.GA = GA;
        E.WI = WSP(float, WS_WIDX); E.bg = F.in[3]; E.c64 = WSP(float, WS_COS64); E.s64 = WSP(float, WS_SIN64); E.c32 = WSP(float, WS_COS32); E.s32 = WSP(float, WS_SIN32);
        { pg::Dense P; P.A = (const char*)WSP(unsigned char, WS_H8); P.B = (const char*)WSP(unsigned char, WS_WIN8); P.lda_bytes = 1024; P.ldb_bytes = 1024; P.nt = 8; P.ord.init(T / 256, 16, F.G, F.bid); P.pn_split = 8; P.pn_skip = 2;
          E.ascale = 0.03125f; pg::gemm_phase<true>(F.lds, P, E); }
        { pg::Dense P; P.A = (const char*)WSP(bf16_t, WS_E); P.B = (const char*)WSP(bf16_t, WS_WINT); P.lda_bytes = 2048; P.ldb_bytes = 2048; P.nt = 16; P.ord.init(T / 256, 2, F.G, F.bid); P.pn_base = 8; P.b_tile0 = 8;
          E.ascale = 1.0f; pg::gemm_phase<false>(F.lds, P, E); }
    }
    SEAM(1);
    if (IN(2)) {
        { ProbS5E P; P.U = (const char*)WSP(bf16_t, WS_U); P.Wg = (const char*)WSP(bf16_t, WS_WG); P.ldb_bytes = 2048; P.nt = 16; P.G = F.G; P.c = F.bid; EpiS5E E; E.E = WSP(float, WS_EF32); pg::gemm_phase(F.lds, P, E); }
        __syncthreads();
        idx_phase(F);
    }
    SEAM(2);
    if (IN(3)) { s5_scan(F); __syncthreads(); attn_phase(F); }
    SEAM(3);
    if (IN(4)) { ProbS5Y P; P.U = (const char*)WSP(bf16_t, WS_U); P.TV = (const char*)WSP(bf16_t, WS_TV); P.ldb_bytes = 2304; P.nt = 18; P.G = F.G; P.c = F.bid; EpiS5Y E; E.Y = WSP(bf16_t, WS_E); pg::gemm_phase(F.lds, P, E); }
    SEAM(4);
    if (IN(5)) { pg::Dense P; P.A = (const char*)WSP(bf16_t, WS_E); P.B = (const char*)WSP(bf16_t, WS_WGLUT); P.lda_bytes = 1024; P.ldb_bytes = 1024; P.nt = 8; P.ord.init(T / 256, 2, F.G, F.bid);
        EpiGlu E; E.YS = WSP(bf16_t, WS_E); E.Y2 = WSP(unsigned char, WS_Y28); E.b = F.in[13]; pg::gemm_phase(F.lds, P, E); }
    SEAM(5);
    if (IN(6)) {
        { pg::Dense P; P.A = (const char*)WSP(unsigned char, WS_Y28); P.B = (const char*)WSP(unsigned char, WS_WSB8); P.lda_bytes = 512; P.ldb_bytes = 512; P.nt = 4; P.ord.init(T / 256, 4, F.G, F.bid);
          EpiMix<false> E; E.Gt = (const unsigned char*)GS; E.MIX = F.dry ? WSP(bf16_t, WS_U) : GA; E.MIX8 = nullptr; pg::gemm_phase<true>(F.lds, P, E); }
        { pg::Dense P; P.A = (const char*)WSP(unsigned char, WS_YA8); P.B = (const char*)WSP(unsigned char, WS_WAB8); P.lda_bytes = 512; P.ldb_bytes = 512; P.nt = 4; P.ord.init(T / 256, 4, F.G, F.bid);
          EpiMix<true> E; E.Gt = (const unsigned char*)GS + (size_t)T * 1024; E.MIX = F.dry ? WSP(bf16_t, WS_U) : GA; E.MIX8 = F.dry ? WSP(unsigned char, WS_V) : WSP(unsigned char, WS_MIX8); pg::gemm_phase<true>(F.lds, P, E); }
    }
    SEAM(6);
    if (IN(7)) { pg::Dense P; P.A = (const char*)WSP(unsigned char, WS_MIX8); P.B = (const char*)WSP(unsigned char, WS_WO8); P.lda_bytes = 1024; P.ldb_bytes = 1024; P.nt = 8; P.ord.init(T / 256, 4, F.G, F.bid);
        EpiStoreBf E; E.O = GA; E.ldo = 1024; E.sc = 0.03125f; pg::gemm_phase<true>(F.lds, P, E); }
    SEAM(7);
    if (IN(8)) router_phase(F);
    SEAM(8);
    if (IN(9)) { const MoeTab tab = moe_tab_build<8>(F, true);
        ProbMoe<8> P; P.A = (const char*)GS; P.W = (const char*)WSP(bf16_t, WS_W1T); P.tab = tab; P.ldb_bytes = 1024; P.nt = 8; P.G = F.G; P.c = F.bid; P.gather = true; P.hot = (F.dry == 4);
        EpiMoe1 E; E.Aout = WSP(unsigned char, WS_A); E.bgate = F.in[22]; E.bup = F.in[24]; E.rstd = WSP(float, WS_CTL) + CW_SSQ; E.tab = tab; E.dry = F.dry; pg::gemm_phase<true>(F.lds, P, E); }
    SEAM(9);
    if (IN(10)) { const MoeTab tab = moe_tab_build<4>(F, false);
        ProbMoe<4> P; P.A = (const char*)WSP(bf16_t, WS_A); P.W = (const char*)WSP(bf16_t, WS_W2T); P.tab = tab; P.ldb_bytes = 1024; P.nt = 8; P.G = F.G; P.c = F.bid; P.gather = false; P.hot = 0;
        EpiMoe2 E; E.ws = F.ws; E.outb = (unsigned char*)F.out; E.bdown = F.in[26]; E.lslot = WSP(int, WS_LSLOT); E.lwt = WSP(float, WS_LWT); E.tab = tab; pg::gemm_phase<true>(F.lds, P, E);
        { const int total = tab.cumu[32], rounds = (total + F.G - 1) / F.G, nfull = total - (rounds - 1) * F.G, nidle = F.G - nfull;
          const int pos = moe_L(0, F.G, F.bid);
          const int G2 = nidle > 0 ? nidle : F.G, c2 = nidle > 0 ? pos - nfull : pos;
          if (c2 >= 0) { pg::Dense P2; P2.A = (const char*)WSP(bf16_t, WS_PBF); P2.B = (const char*)WSP(bf16_t, WS_WPPT); P2.lda_bytes = 512; P2.ldb_bytes = 512; P2.nt = 4; P2.ord.init(T / 256, 4, G2, c2);
              EpiStoreBf E2; E2.O = WSP(bf16_t, WS_PROJ); E2.ldo = 1024; E2.sc = 1.0f; pg::gemm_phase(F.lds, P2, E2); } } }
    SEAM(10);
    if (IN(11)) combine_phase(F);
    SEAM(11);
    if (IN(12)) {
        { pg::Dense P; P.A = (const char*)WSP(unsigned char, WS_R2BF); P.B = (const char*)WSP(unsigned char, WS_WPG8); P.lda_bytes = 1024; P.ldb_bytes = 1024; P.nt = 8; P.ord.init(T / 256, 4, F.G, F.bid);
          EpiPleNorm E; E.R2 = WSP(bf16_t, WS_R2); E.PROJ = WSP(bf16_t, WS_PROJ); E.OUT = F.out; E.gain = F.in[29]; E.xbuf = (float*)(F.ws + WS_XBUF); E.pcnt = WSP(unsigned, WS_CTL) + CW_PCNT;
          E.Pl = (LAS float*)(F.lds + 131072); E.Sl = (LAS float*)(F.lds + 131072 + 4096); pg::gemm_phase<true>(F.lds, P, E); }
    }
#undef IN
#undef SEAM
}

extern "C" void kernel_launch(void* const* d_in, const int* in_sizes, int n_in, void* d_out, int out_size, void* d_ws, size_t ws_size, hipStream_t stream) {
    static int grid = 0;
    if (grid == 0) {
        if (n_in != 30 || out_size != T * 1024 || ws_size < WS_END) { fprintf(stderr, "kernel_launch: unexpected shapes (n_in %d, out %d, ws %zu < %zu)\n", n_in, out_size, ws_size, (size_t)WS_END); grid = -1; return; }
        int dev = 0, cus = 0, per_cu = 0;
        hipGetDevice(&dev); hipDeviceGetAttribute(&cus, hipDeviceAttributeMultiprocessorCount, dev);
        hipFuncSetAttribute((const void*)fwd, hipFuncAttributeMaxDynamicSharedMemorySize, LDS_BYTES);
        hipOccupancyMaxActiveBlocksPerMultiprocessor(&per_cu, (const void*)fwd, NTHR, LDS_BYTES);
        if (per_cu < 1) { fprintf(stderr, "kernel_launch: occupancy query says %d blocks per CU\n", per_cu); per_cu = 1; }
        (void)hipGetLastError();
        grid = cus;
    }
    if (grid < 0) return;
    Args a{};
    for (int i = 0; i < 30; ++i) a.in[i] = (const float*)d_in[i];
    a.out = (float*)d_out; a.ws = (unsigned char*)d_ws;
#if MK_MULTI
#ifndef DUP_MASK
#define DUP_MASK 0
#endif
    for (int ph = 0; ph < NPHASE; ++ph) { a.ph_lo = ph; a.ph_hi = ph + 1; const int reps = ((DUP_MASK >> ph) & 1) ? 2 : 1;
        for (int r = 0; r < reps; ++r) { a.dry = (r + 1 < reps && (ph == 3 || ph == 6 || ph == 8 || ph == 13)) ? 1 : 0;
#ifdef DRY9
            if (ph == 9 && r + 1 < reps) a.dry = DRY9;
#endif
 hipLaunchKernelGGL(fwd, dim3(grid), dim3(NTHR), LDS_BYTES, stream, a); } }
#else
    (void)hipMemsetAsync((char*)d_ws + WS_BAR, 0, XCD_BAR_WORDS * 4, stream);
    a.ph_lo = 0; a.ph_hi = NPHASE; void* args[] = {&a};
    hipError_t e = hipLaunchCooperativeKernel((const void*)fwd, dim3(grid), dim3(NTHR), args, LDS_BYTES, stream);
    if (e != hipSuccess) fprintf(stderr, "cooperative launch failed: %s (grid %d)\n", hipGetErrorString(e), grid);
#endif
}
```

```cpp
#include <hip/hip_runtime.h>
#include <hip/hip_cooperative_groups.h>
#include <cstdio>
#include <cstdint>
#include <cmath>
namespace cg = cooperative_groups;

#define LAS __attribute__((address_space(3)))
#define GAS __attribute__((address_space(1)))
typedef unsigned short bf16_t;
typedef short bf16x8 __attribute__((ext_vector_type(8)));
typedef short s16x4 __attribute__((ext_vector_type(4)));
typedef float f32x4 __attribute__((ext_vector_type(4)));
typedef float f32x16 __attribute__((ext_vector_type(16)));
typedef unsigned u32x4 __attribute__((ext_vector_type(4)));
typedef unsigned u32x2 __attribute__((ext_vector_type(2)));

constexpr int LDS_BYTES_C = 147456;
constexpr int NB = 8, SEQ = 4096, DM = 1024, T = NB * SEQ;
constexpr int PLE = 256, NE = 32, TOPK = 4, NSLOT = T * TOPK;
constexpr int INC = 4392, INP = 4608;
constexpr int NGRP = 32, SST = 64;
constexpr float EPS = 1e-6f;
constexpr float C2 = 0.125f * 1.4426950408889634f;
constexpr int NTHR = 512;

constexpr size_t MB = 1000000;
constexpr size_t WS_CTL   = 0;
constexpr size_t WS_COS64 = 1 * MB;
constexpr size_t WS_SIN64 = WS_COS64 + 4096 * 32 * 4;
constexpr size_t WS_COS32 = WS_SIN64 + 4096 * 32 * 4;
constexpr size_t WS_SIN32 = WS_COS32 + 4096 * 16 * 4;
constexpr size_t WS_KG    = 3 * MB;
constexpr size_t WS_L64   = WS_KG + 32 * 64 * 256 * 4;
constexpr size_t WS_XBUF  = 5200000;
constexpr size_t WS_KIDX  = 6 * MB;
constexpr size_t WS_WIDX  = 9 * MB;
constexpr size_t WS_EF32  = 11 * MB;
constexpr size_t WS_WG    = 20 * MB;
constexpr size_t WS_LTOK  = 29 * MB;
constexpr size_t WS_LSLOT = 34 * MB;
constexpr size_t WS_LWT   = 39 * MB;
constexpr size_t WS_INV   = WS_LWT + (size_t)32 * T * 4;
constexpr size_t WS_SMALL_END = 44 * MB;
static_assert(WS_INV + (size_t)T * 4 * 4 <= WS_SMALL_END, "inverse map fits the small region");
constexpr size_t WS_W2T   = WS_SMALL_END;
constexpr size_t SZ_W2T   = (size_t)32 * 1024 * 1024 * 2;
constexpr size_t WS_W1T   = WS_W2T + SZ_W2T;
constexpr size_t SZ_W1T   = (size_t)32 * 2048 * 1024 * 2;
constexpr size_t WS_E     = WS_W1T + SZ_W1T;
constexpr size_t SZ_E     = (size_t)T * 1024 * 2;
constexpr size_t WS_A     = WS_E + SZ_E;
constexpr size_t SZ_A     = (size_t)NSLOT * 1024 * 2;
constexpr size_t WS_TAIL  = WS_A + SZ_A;
constexpr size_t WS_WINT  = WS_TAIL;
constexpr size_t WS_WIN8  = WS_WINT + (size_t)512 * 1024 * 2;
constexpr size_t WS_WGLUT = WS_WIN8 + (size_t)INP * 1024;
constexpr size_t WS_WSB8  = WS_WGLUT + 512 * 512 * 2;
constexpr size_t WS_WAB8  = WS_WSB8 + 1024 * 512;
constexpr size_t WS_WO8   = WS_WAB8 + 1024 * 512;
constexpr size_t WS_WPG8  = WS_WO8 + 1024 * 1024;
constexpr size_t WS_WPPT  = WS_WPG8 + 1024 * 1024;
constexpr size_t WS_END   = WS_WPPT + 1024 * 256 * 2;
static_assert(WS_END <= 604000000ull, "workspace map must fit sum(inputs) bytes");
constexpr size_t WS_U     = WS_A;
constexpr size_t SZ_U     = (size_t)32 * 512 * 1152 * 2;
constexpr size_t WS_Q     = WS_U + SZ_U;
constexpr size_t SZ_QKV   = (size_t)T * 512 * 2;
constexpr size_t WS_K     = WS_Q + SZ_QKV;
constexpr size_t WS_V     = WS_K + SZ_QKV;
constexpr size_t WS_QIDX  = WS_V + SZ_QKV;
constexpr size_t WS_MASK  = WS_QIDX + (size_t)T * 256 * 2;
constexpr size_t WS_TV    = WS_MASK + (size_t)8 * 128 * 4096 * 8;
constexpr size_t SZ_TV    = (size_t)32 * 1024 * 1152 * 2;
static_assert(WS_TV + SZ_TV <= WS_TAIL, "early temporaries fit the A region");
constexpr size_t WS_R2    = WS_A;
constexpr size_t WS_R2BF  = WS_A + (size_t)T * 1024 * 4;
constexpr size_t WS_PBF   = WS_R2BF + (size_t)T * 1024;
constexpr size_t WS_PROJ  = WS_PBF + (size_t)T * 256 * 2;
static_assert(WS_PROJ + (size_t)T * 1024 * 2 <= WS_TAIL, "late users fit the A region");
constexpr size_t WS_H8    = WS_W2T + (size_t)32 * 1024 * 1024;
constexpr size_t WS_YA8   = WS_E + 40 * MB;
constexpr size_t WS_Y28   = WS_K;
constexpr size_t WS_MIX8  = WS_TV;
constexpr int CW_CNT = 64;
constexpr int CW_PCNT = 512;
constexpr int CW_QIDX = 192, CW_QATT = 256;
constexpr int CW_SSQ = 1024;
constexpr int CTL_WORDS = CW_SSQ + T;

__device__ __forceinline__ unsigned f2bf(float f) { unsigned u = __builtin_bit_cast(unsigned, f); return (u + 0x7fffu + ((u >> 16) & 1u)) >> 16; }
typedef float f32x2_t __attribute__((ext_vector_type(2))); typedef __bf16 bf16x2_t __attribute__((ext_vector_type(2)));
__device__ __forceinline__ unsigned pk2(float lo, float hi) { f32x2_t v = {lo, hi}; bf16x2_t b = __builtin_convertvector(v, bf16x2_t); return __builtin_bit_cast(unsigned, b); }
__device__ __forceinline__ float bf2f(unsigned short b) { return __builtin_bit_cast(float, (unsigned)b << 16); }
__device__ __forceinline__ float bflo(unsigned w) { return __builtin_bit_cast(float, w << 16); }
__device__ __forceinline__ float bfhi(unsigned w) { return __builtin_bit_cast(float, w & 0xffff0000u); }
__device__ __forceinline__ float wave_sum(float v) {
#pragma unroll
    for (int o = 1; o < 64; o <<= 1) v += __shfl_xor(v, o);
    return v;
}
__device__ __forceinline__ float sigmoidf_(float x) { return __builtin_amdgcn_rcpf(1.0f + __builtin_amdgcn_exp2f(-1.4426950408889634f * x)); }
__device__ __forceinline__ float gelu_tanh(float x) {
    const float u = 0.7978845608028654f * (x + 0.044715f * x * x * x);
    const float e = __expf(-2.0f * fabsf(u));
    float t = (1.0f - e) / (1.0f + e); t = u < 0.f ? -t : t;
    return 0.5f * x * (1.0f + t);
}


typedef int v8i_t __attribute__((ext_vector_type(8)));
typedef int v4i_t __attribute__((ext_vector_type(4)));
__device__ __forceinline__ unsigned pk4_fp8(float a, float b, float c, float d) { int w = __builtin_amdgcn_cvt_pk_fp8_f32(a, b, 0, false); w = __builtin_amdgcn_cvt_pk_fp8_f32(c, d, w, true); return (unsigned)w; }
#ifdef FP8_SELFTEST
__device__ __forceinline__ bool fp8_selftest(int lane) {
    const int rc = lane & 15, g = lane >> 4; v8i_t a, b;
#pragma unroll
    for (int w = 0; w < 8; ++w) { float av[4], bv[4];
#pragma unroll
        for (int q = 0; q < 4; ++q) { const int bb = w * 4 + q; const int k = bb < 16 ? 16 * g + bb : 64 + 16 * g + (bb - 16);
            av[q] = (float)((rc * 7 + k * 3) % 9 - 4) * 0.5f; bv[q] = (float)((k * 5 + rc * 11) % 7 - 3) * 0.25f; }
        a[w] = (int)pk4_fp8(av[0], av[1], av[2], av[3]); b[w] = (int)pk4_fp8(bv[0], bv[1], bv[2], bv[3]); }
    f32x4 c = {0.f, 0.f, 0.f, 0.f};
    c = __builtin_amdgcn_mfma_scale_f32_16x16x128_f8f6f4(a, b, c, 0, 0, 0, 0x7f7f7f7f, 0, 0x7f7f7f7f);
    bool ok = true;
#pragma unroll
    for (int r = 0; r < 4; ++r) { const int i = 4 * g + r, j = rc; float ref = 0.f;
        for (int k = 0; k < 128; ++k) ref += ((float)((i * 7 + k * 3) % 9 - 4) * 0.5f) * ((float)((k * 5 + j * 11) % 7 - 3) * 0.25f);
        ok = ok && (c[r] == ref); }
    return __all(ok);
}
#endif

__device__ __forceinline__ int perm16_row(int c) { const int t = c & ~255, w = c & 255; return t + ((w >> 3) & 1) * 128 + (w >> 6) * 32 + ((w >> 2) & 1) * 16 + ((w >> 4) & 3) * 4 + (w & 3); }

__device__ __forceinline__ f32x4 bf4(u32x2 w) { return (f32x4){bflo(w.x), bfhi(w.x), bflo(w.y), bfhi(w.y)}; }
__device__ __forceinline__ f32x4 f84(unsigned w) { const f32x2_t lo = __builtin_amdgcn_cvt_pk_f32_fp8((int)w, false), hi = __builtin_amdgcn_cvt_pk_f32_fp8((int)w, true); return (f32x4){lo[0], lo[1], hi[0], hi[1]}; }
__device__ __forceinline__ u32x2 pkbf4(f32x4 v) { u32x2 w; w.x = pk2(v.x, v.y); w.y = pk2(v.z, v.w); return w; }
__device__ __forceinline__ unsigned pkf84(f32x4 v) { return pk4_fp8(v.x, v.y, v.z, v.w); }
__device__ __forceinline__ f32x4 sig4(f32x4 v) { return (f32x4){sigmoidf_(v.x), sigmoidf_(v.y), sigmoidf_(v.z), sigmoidf_(v.w)}; }

namespace pg {
constexpr int BM = 256, BK = 64, HALF = 128, HTB = HALF * BK * 2, STAGE_BYTES = 8 * HTB;
__device__ __forceinline__ int lds_byte(int r, int c) { const int st = (r >> 4) * 2 + (c >> 5), rr = r & 15, cc = c & 31, ob = rr * 64 + cc * 2; return st * 1024 + (ob ^ (((ob >> 9) & 1) << 5)); }
__device__ __forceinline__ void stage_rc(int b, int& R, int& C) { const int st = b / 1024, sb = b % 1024, swz = sb ^ (((sb >> 9) & 1) << 5); R = (st >> 1) * 16 + swz / 64; C = (st & 1) * 32 + (swz % 64) / 2; }
struct Unit { int pm, pn, g, li; };
template <class P, class = void> struct KaOf { static constexpr unsigned value = 128u; };
template <class P> struct KaOf<P, decltype((void)P::KA_BYTES)> { static constexpr unsigned value = P::KA_BYTES; };
template <class E, class = void> struct HasPre { static constexpr bool value = false; };
template <class E> struct HasPre<E, decltype((void)&E::pre)> { static constexpr bool value = true; };

template <bool FP8 = false, class Prob, class Epi>
__device__ __forceinline__ void gemm_phase(LAS unsigned char* lds, const Prob& P, const Epi& E) {
    const int tid = threadIdx.x, wid = __builtin_amdgcn_readfirstlane(tid >> 6), lane = tid & 63, wr = wid >> 2, wc = wid & 3, fr = lane & 15, fq = lane >> 4;
    const int nt = P.nt; constexpr unsigned KA = KaOf<Prob>::value;
    int R[2], C[2];
#pragma unroll
    for (int i = 0; i < 2; ++i) stage_rc(tid * 16 + i * 8192, R[i], C[i]);
    unsigned offB[2][2];
#pragma unroll
    for (int h = 0; h < 2; ++h)
#pragma unroll
        for (int i = 0; i < 2; ++i) offB[h][i] = (unsigned)(h * HALF + R[i]) * P.ldb_bytes + (unsigned)C[i] * 2u;
    const unsigned ldsw = (unsigned)wid * 1024u;
    const int aoff = lds_byte(wr * 64 + fr, fq * 8), boff = lds_byte(wc * 32 + fr, fq * 8);
#define PG_SA(b, h) (((b) * 2 + (h)) * HTB)
#define PG_SB(b, h) ((4 + (b) * 2 + (h)) * HTB)
#define PG_STAGE(bufoff, gbase, voff, kbytes) do { _Pragma("unroll") for (int _i = 0; _i < 2; ++_i) \
        __builtin_amdgcn_global_load_lds((const unsigned*)((const char*)(gbase) + (voff)[_i] + (kbytes)), (LAS unsigned*)(lds + (bufoff) + ldsw + _i * 8192), 16, 0, 0); } while (0)
#define PG_CAT8(x0, x1) __builtin_shufflevector(x0, x1, 0, 1, 2, 3, 4, 5, 6, 7)
#define PG_LDA(dst, b, h) do { if constexpr (FP8) { _Pragma("unroll") for (int m = 0; m < 4; ++m) dst##8[m] = PG_CAT8(*(const LAS v4i_t*)(lds + PG_SA(b, h) + aoff + m * 2048), *(const LAS v4i_t*)(lds + PG_SA(b, h) + aoff + m * 2048 + 1024)); } \
        else { _Pragma("unroll") for (int m = 0; m < 4; ++m) _Pragma("unroll") for (int k = 0; k < 2; ++k) dst[m][k] = *(const LAS bf16x8*)(lds + PG_SA(b, h) + aoff + m * 2048 + k * 1024); } } while (0)
#define PG_LDB(dst, b, h) do { if constexpr (FP8) { _Pragma("unroll") for (int n = 0; n < 2; ++n) dst##8[n] = PG_CAT8(*(const LAS v4i_t*)(lds + PG_SB(b, h) + boff + n * 2048), *(const LAS v4i_t*)(lds + PG_SB(b, h) + boff + n * 2048 + 1024)); } \
        else { _Pragma("unroll") for (int n = 0; n < 2; ++n) _Pragma("unroll") for (int k = 0; k < 2; ++k) dst[n][k] = *(const LAS bf16x8*)(lds + PG_SB(b, h) + boff + n * 2048 + k * 1024); } } while (0)
#define PG_MMA(ai, bj, At, Bt) do { __builtin_amdgcn_s_setprio(1); \
        if constexpr (FP8) { _Pragma("unroll") for (int m = 0; m < 4; ++m) _Pragma("unroll") for (int n = 0; n < 2; ++n) \
            asm volatile("v_mfma_scale_f32_16x16x128_f8f6f4 %0, %1, %2, %0, %3, %3 op_sel_hi:[0,0,0]" : "+v"(acc[ai][bj][m][n]) : "v"(Bt##8[n]), "v"(At##8[m]), "v"(sc1)); } \
        else { _Pragma("unroll") for (int m = 0; m < 4; ++m) _Pragma("unroll") for (int n = 0; n < 2; ++n) _Pragma("unroll") for (int k = 0; k < 2; ++k) \
            acc[ai][bj][m][n] = __builtin_amdgcn_mfma_f32_16x16x32_bf16(Bt[n][k], At[m][k], acc[ai][bj][m][n], 0, 0, 0); } \
        __builtin_amdgcn_s_setprio(0); } while (0)
#define PG_WAIT_V(n) asm volatile("s_waitcnt vmcnt(" #n ")" ::: "memory")
#define PG_WAIT_L(n) asm volatile("s_waitcnt lgkmcnt(" #n ")" ::: "memory")
#define PG_BAR __builtin_amdgcn_s_barrier()
#define PG_SCHED __builtin_amdgcn_sched_barrier(0)
    Unit cur, nxt; int ui = 0;
    if (!P.next(0, cur)) return;
    f32x4 acc[2][2][4][2];
#pragma unroll
    for (int a = 0; a < 2; ++a)
#pragma unroll
        for (int b = 0; b < 2; ++b)
#pragma unroll
            for (int m = 0; m < 4; ++m)
#pragma unroll
                for (int n = 0; n < 2; ++n) acc[a][b][m][n] = (f32x4){0.f, 0.f, 0.f, 0.f};
    bf16x8 At[4][2], B0[2][2], B1[2][2]; v8i_t At8[4], B08[2], B18[2]; int sc1 = 0x7f7f7f7f; asm volatile("" : "+v"(sc1));
    const char* cA = P.a_base(cur); const char* cB = P.b_base(cur);
    unsigned cOA[2][2], nOA[2][2];
#pragma unroll
    for (int h = 0; h < 2; ++h)
#pragma unroll
        for (int i = 0; i < 2; ++i) cOA[h][i] = P.a_off(cur, h * HALF + R[i], C[i]);
    PG_STAGE(PG_SB(0, 0), cB, offB[0], 0); PG_STAGE(PG_SB(0, 1), cB, offB[1], 0); PG_STAGE(PG_SA(0, 0), cA, cOA[0], 0); PG_STAGE(PG_SA(0, 1), cA, cOA[1], 0);
    if (wr == 1) PG_BAR;
    PG_WAIT_V(2); PG_BAR;
    PG_STAGE(PG_SB(1, 0), cB, offB[0], 128); PG_STAGE(PG_SA(1, 0), cA, cOA[0], KA); PG_STAGE(PG_SB(1, 1), cB, offB[1], 128);
    PG_WAIT_V(6); PG_BAR;
    for (;;) {
        if constexpr (HasPre<Epi>::value) E.pre(cur, wid, lane);
        const bool has_next = P.next(ui + 1, nxt);
        const char* nA = has_next ? P.a_base(nxt) : cA; const char* nB = has_next ? P.b_base(nxt) : cB;
#pragma unroll
        for (int h = 0; h < 2; ++h)
#pragma unroll
            for (int i = 0; i < 2; ++i) nOA[h][i] = has_next ? P.a_off(nxt, h * HALF + R[i], C[i]) : cOA[h][i];
        for (int t = 0; t < nt; t += 2) {
            const bool last = (t == nt - 2);
            const unsigned k1 = (unsigned)(t + 1) * 128u;
            const unsigned k2 = last ? 0u : (unsigned)(t + 2) * 128u, k3 = k2 + 128u;
            const unsigned kA1 = (unsigned)(t + 1) * KA, kA2 = last ? 0u : (unsigned)(t + 2) * KA, kA3 = kA2 + KA;
            const char* a2 = last ? nA : cA; const char* b2 = last ? nB : cB;
            unsigned o2[2][2];
#pragma unroll
            for (int h = 0; h < 2; ++h)
#pragma unroll
                for (int i = 0; i < 2; ++i) o2[h][i] = last ? nOA[h][i] : cOA[h][i];
            PG_LDB(B0, 0, 0); PG_LDB(B1, 0, 1); PG_SCHED; PG_LDA(At, 0, 0); PG_STAGE(PG_SA(1, 1), cA, cOA[1], kA1);
            PG_WAIT_V(8); PG_WAIT_L(0); PG_BAR; PG_MMA(0, 0, At, B0); PG_MMA(0, 1, At, B1); PG_BAR; PG_SCHED;
            PG_LDA(At, 0, 1); PG_STAGE(PG_SB(0, 0), b2, offB[0], k2); PG_STAGE(PG_SB(0, 1), b2, offB[1], k2); PG_STAGE(PG_SA(0, 0), a2, o2[0], kA2);
            PG_WAIT_V(8); PG_WAIT_L(0); PG_BAR; PG_MMA(1, 0, At, B0); PG_MMA(1, 1, At, B1); PG_BAR; PG_SCHED;
            PG_LDB(B0, 1, 0); PG_LDB(B1, 1, 1); PG_SCHED; PG_LDA(At, 1, 0); PG_STAGE(PG_SA(0, 1), a2, o2[1], kA2);
            PG_WAIT_V(8); PG_WAIT_L(0); PG_BAR; PG_MMA(0, 0, At, B0); PG_MMA(0, 1, At, B1); PG_BAR; PG_SCHED;
            PG_LDA(At, 1, 1); PG_STAGE(PG_SB(1, 0), b2, offB[0], k3); PG_STAGE(PG_SB(1, 1), b2, offB[1], k3); PG_STAGE(PG_SA(1, 0), a2, o2[0], kA3);
            PG_WAIT_V(8); PG_WAIT_L(0); PG_BAR; PG_MMA(1, 0, At, B0); PG_MMA(1, 1, At, B1); PG_BAR; PG_SCHED;
        }
        if (wr == 0) PG_BAR;
        if constexpr (FP8) asm volatile("s_nop 15\n\ts_nop 15" ::: "memory");
        { int fr_ = fr, fq_ = fq; asm volatile("" : "+v"(fr_), "+v"(fq_));
          E(acc, cur, wr, wc, fr_, fq_);
#ifdef PROBE_EPI2
          asm volatile("" : "+v"(fr_), "+v"(fq_)); E(acc, cur, wr, wc, fr_, fq_);
#endif
        }
        if (!has_next) break;
#pragma unroll
        for (int a = 0; a < 2; ++a)
#pragma unroll
            for (int b = 0; b < 2; ++b)
#pragma unroll
                for (int m = 0; m < 4; ++m)
#pragma unroll
                    for (int n = 0; n < 2; ++n) acc[a][b][m][n] = (f32x4){0.f, 0.f, 0.f, 0.f};
        cur = nxt; cA = nA; cB = nB; ++ui;
#pragma unroll
        for (int h = 0; h < 2; ++h)
#pragma unroll
            for (int i = 0; i < 2; ++i) cOA[h][i] = nOA[h][i];
        if (wr == 1) PG_BAR;
    }
    PG_WAIT_V(0);
    PG_BAR;
#undef PG_SA
#undef PG_SB
#undef PG_STAGE
#undef PG_LDA
#undef PG_LDB
#undef PG_MMA
#undef PG_CAT8
#undef PG_WAIT_V
#undef PG_WAIT_L
#undef PG_BAR
#undef PG_SCHED
}

struct Order {
    int nM, nN, nwg, G, c;
    __device__ void init(int nM_, int nN_, int G_, int c_) { nM = nM_; nN = nN_; nwg = nM * nN; G = G_; c = c_; }
    __device__ bool get(int i, int& pm, int& pn) const {
        const long L = (long)i * G + c; if (L >= nwg) return false;
        int wgid = (int)L; { const int q = nwg / 8, r = nwg % 8, xcd = wgid % 8, off = wgid / 8; wgid = (xcd < r ? xcd * (q + 1) : r * (q + 1) + (xcd - r) * q) + off; }
        const int sh = 3 + __builtin_ctz((unsigned)nN), rem = wgid & ((1 << sh) - 1);
        pm = (wgid >> sh) * 8 + (rem & 7); pn = rem >> 3; return true;
    }
};
struct Dense {
    const char* A; const char* B; unsigned lda_bytes, ldb_bytes; int nt; Order ord; int pn_base = 0, pn_split = 1 << 30, pn_skip = 0, b_tile0 = 0;
    __device__ bool next(int i, Unit& u) const { u.g = 0; int pp; const bool ok = ord.get(i, u.pm, pp); u.pn = pn_base + pp + (pp >= pn_split ? pn_skip : 0); return ok; }
    __device__ const char* a_base(const Unit& u) const { return A + (size_t)u.pm * 256 * lda_bytes; }
    __device__ unsigned a_off(const Unit&, int row, int col) const { return (unsigned)row * lda_bytes + (unsigned)col * 2u; }
    __device__ const char* b_base(const Unit& u) const { return B + (size_t)(u.pn - b_tile0) * 256 * ldb_bytes; }
};
struct ProbGlu {
    static constexpr unsigned KA_BYTES = 4u * (unsigned)T * 32u;
    const char* A; const char* B; unsigned ldb_bytes; int nt; Order ord;
    __device__ bool next(int i, Unit& u) const { u.g = 0; return ord.get(i, u.pm, u.pn); }
    __device__ const char* a_base(const Unit& u) const { return A + (size_t)u.pm * 256 * 32; }
    __device__ unsigned a_off(const Unit&, int row, int col) const { return ((unsigned)(col >> 4) * (unsigned)T + (unsigned)row) * 32u + (unsigned)(col & 15) * 2u; }
    __device__ const char* b_base(const Unit& u) const { return B + (size_t)u.pn * 256 * ldb_bytes; }
};
}

struct Frame {
    LAS unsigned char* lds;
    int tid, lane, wave, G, bid, dry;
    const float* in[30]; float* out; unsigned char* ws;
};
#define WSP(T_, off) ((T_*)(F.ws + (off)))
#define LDS_WAIT() asm volatile("s_waitcnt lgkmcnt(0)" ::: "memory")

template <class DstRow>
__device__ __forceinline__ void transpose_item(const float* W, int K, int N, bf16_t* WT, LAS float* scr, int item, int lane, const DstRow& dstrow) {
    const int nblk = (N + 63) / 64, kb = item / nblk, nb = item % nblk, k0 = 64 * kb, n0 = 64 * nb;
    const int kk = lane >> 4, n4 = (lane & 15) * 4;
    f32x4 v[16];
#pragma unroll
    for (int i = 0; i < 16; ++i) v[i] = __builtin_nontemporal_load((const f32x4*)(W + (size_t)(k0 + 4 * i + kk) * N + n0 + n4));
#pragma unroll
    for (int i = 0; i < 16; ++i) { LAS float* d = scr + (4 * i + kk) * 65 + n4; d[0] = v[i].x; d[1] = v[i].y; d[2] = v[i].z; d[3] = v[i].w; }
    LDS_WAIT(); asm volatile("" ::: "memory");
    const int c = lane & 7;
#pragma unroll
    for (int j = 0; j < 8; ++j) { const int n = (lane >> 3) + 8 * j; const LAS float* p = scr + (8 * c) * 65 + n; const int dr = dstrow(n0 + n);
        if (dr >= 0) { u32x4 o; o.x = pk2(p[0], p[65]); o.y = pk2(p[130], p[195]); o.z = pk2(p[260], p[325]); o.w = pk2(p[390], p[455]);
            *(u32x4*)(WT + (size_t)dr * K + k0 + 8 * c) = o; } }
    LDS_WAIT(); asm volatile("" ::: "memory");
}
__device__ __forceinline__ void tr8_load(f32x4 (&v)[16], const float* W, int K, int N, int item, int lane) {
    const int nblk = (N + 63) / 64, kb = item / nblk, nb = item % nblk, k0 = 64 * kb, n0 = 64 * nb; const int kk = lane >> 4, n4 = (lane & 15) * 4;
#pragma unroll
    for (int i = 0; i < 16; ++i) v[i] = __builtin_nontemporal_load((const f32x4*)(W + (size_t)(k0 + 4 * i + kk) * N + n0 + n4));
}
template <class DstRow>
__device__ __forceinline__ void tr8_process(const f32x4 (&v)[16], int K, int N, unsigned char* WT, LAS float* scr, int item, int lane, float scale, const DstRow& dstrow) {
    const int nblk = (N + 63) / 64, kb = item / nblk, nb = item % nblk, k0 = 64 * kb, n0 = 64 * nb; const int kk = lane >> 4, n4 = (lane & 15) * 4;
#pragma unroll
    for (int i = 0; i < 16; ++i) { LAS float* d = scr + (4 * i + kk) * 65 + n4; d[0] = v[i].x * scale; d[1] = v[i].y * scale; d[2] = v[i].z * scale; d[3] = v[i].w * scale; }
    LDS_WAIT(); asm volatile("" ::: "memory");
    const int c = lane & 3;
#pragma unroll
    for (int j = 0; j < 4; ++j) { const int n = (lane >> 2) + 16 * j; const LAS float* p = scr + (16 * c) * 65 + n; const int dr = dstrow(n0 + n);
        u32x4 o; o.x = pk4_fp8(p[0], p[65], p[130], p[195]); o.y = pk4_fp8(p[260], p[325], p[390], p[455]); o.z = pk4_fp8(p[520], p[585], p[650], p[715]); o.w = pk4_fp8(p[780], p[845], p[910], p[975]);
        *(u32x4*)(WT + (size_t)dr * K + k0 + 16 * c) = o; }
    LDS_WAIT(); asm volatile("" ::: "memory");
}
template <class DstRow>
__device__ __forceinline__ void transpose_item_fp8(const float* W, int K, int N, unsigned char* WT, LAS float* scr, int item, int lane, float scale, const DstRow& dstrow) {
    f32x4 v[16]; tr8_load(v, W, K, N, item, lane); tr8_process(v, K, N, WT, scr, item, lane, scale, dstrow);
}
__device__ __forceinline__ int win_dst_row(int c) {
    if (c < 512) return perm16_row(c);
    if (c < 1536) { const int isk = c >= 1024, cc = c - (isk ? 1024 : 512), t = cc >> 8, w = cc & 255; return ((isk ? 4 : 2) + t) * 256 + ((w >> 5) & 1) * 128 + (w >> 6) * 32 + ((w >> 2) & 1) * 16 + ((w >> 3) & 3) * 4 + (w & 3); }
    if (c < 2048) return 1536 + perm16_row(c - 1536);
    if (c < 2304) { const int w = c - 2048, head = w >> 5, bj = (w >> 4) & 1, dd = w & 15; return 2048 + bj * 128 + (head >> 1) * 32 + ((dd >> 2) & 1) * 16 + (2 * (head & 1) + (dd >> 3)) * 4 + (dd & 3); }
    if (c < 2336) { const int cc = c - 2304, half = cc >> 4, w = cc & 15; return 9 * 256 + half * 128 + w; }
    if (c < 2344) return 9 * 256 + 16 + (c - 2336);
    if (c < INC) return 2560 + perm16_row(c - 2344);
    return -1;
}
__device__ __forceinline__ void rms_row_to_bf16(const float* xrow, const float* gain, bf16_t* orow, unsigned char* orow8, int lane) {
    const f32x4* xr = (const f32x4*)xrow + lane; const f32x4* gr = (const f32x4*)gain + lane;
    f32x4 v[4]; float s = 0.f;
#pragma unroll
    for (int j = 0; j < 4; ++j) { v[j] = __builtin_nontemporal_load(xr + 64 * j); s += (v[j].x * v[j].x + v[j].y * v[j].y) + (v[j].z * v[j].z + v[j].w * v[j].w); }
    const float rstd = 1.0f / sqrtf(wave_sum(s) * (1.f / 1024.f) + EPS);
    u32x2* o8 = (u32x2*)orow + lane;
#pragma unroll
    for (int j = 0; j < 4; ++j) { const f32x4 g = gr[64 * j]; const float a0 = v[j].x * rstd * g.x, a1 = v[j].y * rstd * g.y, a2 = v[j].z * rstd * g.z, a3 = v[j].w * rstd * g.w;
        u32x2 w; w.x = pk2(a0, a1); w.y = pk2(a2, a3); o8[64 * j] = w; ((unsigned*)orow8)[lane + 64 * j] = pk4_fp8(a0, a1, a2, a3); }
}

struct RmsJob { const float* X; f32x4 g[4]; bf16_t* H; unsigned char* H8; int gw, ngw, lane; };
__device__ __forceinline__ void rms_issue(const RmsJob& J, int k, f32x4 (&v)[4]) {
    const f32x4* xr = (const f32x4*)(J.X + (size_t)(J.gw + k * J.ngw) * 1024) + J.lane;
#pragma unroll
    for (int j = 0; j < 4; ++j) v[j] = __builtin_nontemporal_load(xr + 64 * j);
}
__device__ __forceinline__ void rms_finish(const RmsJob& J, int k, const f32x4 (&v)[4]) {
    const size_t m = (size_t)(J.gw + k * J.ngw); float s = 0.f;
#pragma unroll
    for (int j = 0; j < 4; ++j) s += (v[j].x * v[j].x + v[j].y * v[j].y) + (v[j].z * v[j].z + v[j].w * v[j].w);
    const float rstd = 1.0f / sqrtf(wave_sum(s) * (1.f / 1024.f) + EPS);
    unsigned* o8 = (unsigned*)(J.H8 + m * 1024) + J.lane;
#pragma unroll
    for (int j = 0; j < 4; ++j) { const f32x4 g = J.g[j]; const float a0 = v[j].x * rstd * g.x, a1 = v[j].y * rstd * g.y, a2 = v[j].z * rstd * g.z, a3 = v[j].w * rstd * g.w;
        o8[64 * j] = pk4_fp8(a0, a1, a2, a3); }
}
__device__ __forceinline__ void p0_prologue(Frame& F) {
    LAS float* scr = (LAS float*)(F.lds + F.wave * 16640);
    const int gw = F.bid * 8 + F.wave, NGW = F.G * 8;
    { unsigned* ctl = WSP(unsigned, WS_CTL); for (int i = F.bid * NTHR + F.tid; i < CTL_WORDS; i += F.G * NTHR) ctl[i] = 0u; }
    { float* c64 = WSP(float, WS_COS64); float* s64 = WSP(float, WS_SIN64); float* c32 = WSP(float, WS_COS32); float* s32 = WSP(float, WS_SIN32);
      for (int i = F.bid * NTHR + F.tid; i < 4096 * 48; i += F.G * NTHR) {
          if (i < 4096 * 32) { const int pos = i >> 5, k = i & 31; const float inv = powf(10000.0f, -(float)k * (2.0f / 64.0f)); const float a = (float)pos * inv; c64[i] = cosf(a); s64[i] = sinf(a); }
          else { const int j = i - 4096 * 32, pos = j >> 4, k = j & 15; const float inv = powf(10000.0f, -(float)k * (2.0f / 32.0f)); const float a = (float)pos * inv; c32[j] = cosf(a); s32[j] = sinf(a); } } }
    { unsigned char* W8 = WSP(unsigned char, WS_WIN8) + (size_t)9 * 256 * 1024;
      for (int i = F.bid * NTHR + F.tid; i < 256 * 128; i += F.G * NTHR) { const int row = i >> 7, ch = i & 127; const int w = row & 127, half = row >> 7;
          const bool used = (w < 16) || (half == 0 && w < 24); if (!used && ch < 64) *(u32x4*)(W8 + (size_t)row * 1024 + ch * 16) = (u32x4){0u, 0u, 0u, 0u}; } }
    constexpr int I_WIN = ((INC + 63) / 64) * (1024 / 64), I_GLU = (512 / 64) * (512 / 64), I_SB = (1024 / 64) * (512 / 64), I_AB = I_SB, I_O = (1024 / 64) * (1024 / 64), I_PG = I_O, I_PP = (1024 / 64) * (256 / 64);
    constexpr int I_E = (1024 / 64) * (1024 / 64);
    constexpr int NDENSE = I_WIN + I_GLU + I_SB + I_AB + I_O + I_PG + I_PP;
    auto p16 = [](int n) { return perm16_row(n); };
    for (int it = gw; it < NDENSE; it += NGW) {
        int r = it;
        if (r < I_WIN) {
            const int nblk = (INC + 63) / 64, nb = r % nblk;
            if (nb * 64 + 64 <= INC) { transpose_item_fp8(F.in[2], 1024, INC, WSP(unsigned char, WS_WIN8), scr, r, F.lane, 32.0f, [](int n) { return win_dst_row(n); });
                }
            else { const int kb = r / nblk, k0 = 64 * kb, n0 = 64 * nb; const int n = n0 + F.lane; const int dr = n < INC ? win_dst_row(n) : -1;
                if (dr >= 0) { unsigned char* o = WSP(unsigned char, WS_WIN8) + (size_t)dr * 1024 + k0; float v[64];
#pragma unroll
                    for (int k = 0; k < 64; ++k) v[k] = F.in[2][(size_t)(k0 + k) * INC + n];
#pragma unroll
                    for (int k = 0; k < 64; k += 4) *(unsigned*)(o + k) = pk4_fp8(32.0f * v[k], 32.0f * v[k + 1], 32.0f * v[k + 2], 32.0f * v[k + 3]); } }
            continue; } r -= I_WIN;
        if (r < I_GLU) { transpose_item(F.in[12], 512, 512, WSP(bf16_t, WS_WGLUT), scr, r, F.lane, p16); continue; } r -= I_GLU;
        if (r < I_SB) { transpose_item_fp8(F.in[14], 512, 1024, WSP(unsigned char, WS_WSB8), scr, r, F.lane, 32.0f, p16); continue; } r -= I_SB;
        if (r < I_AB) { transpose_item_fp8(F.in[15], 512, 1024, WSP(unsigned char, WS_WAB8), scr, r, F.lane, 32.0f, p16); continue; } r -= I_AB;
        if (r < I_O) { transpose_item_fp8(F.in[16], 1024, 1024, WSP(unsigned char, WS_WO8), scr, r, F.lane, 32.0f, p16); continue; } r -= I_O;
        if (r < I_PG) { transpose_item_fp8(F.in[27], 1024, 1024, WSP(unsigned char, WS_WPG8), scr, r, F.lane, 32.0f, p16); continue; } r -= I_PG;
        transpose_item(F.in[28], 256, 1024, WSP(bf16_t, WS_WPPT), scr, r, F.lane, p16);
    }
}

__device__ __forceinline__ void p0_s5_tables(Frame& F) {
    LAS float* zr = (LAS float*)F.lds; LAS float* zi = zr + 64; LAS float* bbr = zi + 64; LAS float* bbi = bbr + 1024; LAS float* Lr = bbi + 1024; LAS float* Li = Lr + 512;
    LAS float* cre = Li + 512; LAS float* cim = cre + 16 * 68;
    const float* lam_re = F.in[4]; const float* lam_im = F.in[5]; const float* log_dt = F.in[6]; const float* b_re = F.in[7]; const float* b_im = F.in[8];
    const float* c_re = F.in[9]; const float* c_im = F.in[10]; const float* d_skip = F.in[11];
    float* Kg = WSP(float, WS_KG); float* L64 = WSP(float, WS_L64); bf16_t* Wg = WSP(bf16_t, WS_WG); bf16_t* TV = WSP(bf16_t, WS_TV);
    RmsJob J; J.X = F.in[0]; { const f32x4* gr = (const f32x4*)F.in[17] + F.lane; J.g[0] = gr[0]; J.g[1] = gr[64]; J.g[2] = gr[128]; J.g[3] = gr[192]; } J.H = WSP(bf16_t, WS_E); J.H8 = WSP(unsigned char, WS_H8); J.gw = F.bid * 8 + F.wave; J.ngw = F.G * 8; J.lane = F.lane;
    const int NR = (T - J.gw + J.ngw - 1) / J.ngw; int rk = 0, r0 = -1, r1 = -1; f32x4 va[4], vb[4];
#define RMS_TICK() do { if (r0 >= 0) rms_finish(J, r0, va); if (r1 >= 0) rms_finish(J, r1, vb); \
        r0 = rk < NR ? rk++ : -1; if (r0 >= 0) rms_issue(J, r0, va); r1 = rk < NR ? rk++ : -1; if (r1 >= 0) rms_issue(J, r1, vb); } while (0)
#define TB_SYNC() do { asm volatile("s_waitcnt lgkmcnt(0)" ::: "memory"); __builtin_amdgcn_s_barrier(); asm volatile("" ::: "memory"); } while (0)
    for (int it = F.bid; it < 256; it += F.G) {
        const int g = it >> 3, sub = it & 7, tid = F.tid;
        TB_SYNC();
        RMS_TICK();
        const float dt = expf(log_dt[g]);
        if (tid < 64) { zr[tid] = lam_re[g * 64 + tid] * dt; zi[tid] = lam_im[g * 64 + tid] * dt; }
        for (int idx = tid; idx < 1024; idx += NTHR) { cre[(idx >> 6) * 68 + (idx & 63)] = c_re[g * 1024 + idx]; cim[(idx >> 6) * 68 + (idx & 63)] = c_im[g * 1024 + idx]; }
        TB_SYNC();
        for (int idx = tid; idx < 1024; idx += NTHR) { const int p = idx >> 4, hp = idx & 15;
            const float lr = lam_re[g * 64 + p], li = lam_im[g * 64 + p];
            const float er = expf(zr[p]), cr = er * cosf(zi[p]), ci = er * sinf(zi[p]);
            const float nr = cr - 1.0f, ni = ci, den = lr * lr + li * li;
            const float fr_ = (nr * lr + ni * li) / den, fi_ = (ni * lr - nr * li) / den;
            const float br = b_re[(g * 64 + p) * 16 + hp], bi = b_im[(g * 64 + p) * 16 + hp];
            bbr[idx] = fr_ * br - fi_ * bi; bbi[idx] = fr_ * bi + fi_ * br; }
        { const int lagl = tid >> 6, p = tid & 63; const float n = (float)(8 * sub + lagl); const float mag = expf(n * zr[p]), a = n * zi[p]; Lr[tid] = mag * cosf(a); Li[tid] = mag * sinf(a); }
        RMS_TICK();
        TB_SYNC();
#pragma unroll 1
        for (int j = 0; j < 4; ++j) { const int o = tid + 512 * j, lagl = o >> 8, h = (o >> 4) & 15, hp = o & 15; float s = 0.f;
            for (int p = 0; p < 64; ++p) { const float cr = cre[h * 68 + p], ci = cim[h * 68 + p], lr = Lr[lagl * 64 + p], li = Li[lagl * 64 + p];
                const float tr = cr * lr - ci * li, ti = cr * li + ci * lr; s += tr * bbr[p * 16 + hp] - ti * bbi[p * 16 + hp]; }
            const int lag = 8 * sub + lagl; if (lag == 0 && h == hp) s += d_skip[g * 16 + h];
            Kg[((g * 64 + lag) * 16 + h) * 16 + hp] = s;
            RMS_TICK(); }
        { const int pl = tid >> 6, j = tid & 63, p = 8 * sub + pl;
          { const float n = (float)(63 - j); const float mag = expf(n * zr[p]), a = n * zi[p]; const float er = mag * cosf(a), ei = mag * sinf(a);
            unsigned wre[8], wim[8];
#pragma unroll
            for (int q = 0; q < 8; ++q) { const float b0r = bbr[p * 16 + 2 * q], b0i = bbi[p * 16 + 2 * q], b1r = bbr[p * 16 + 2 * q + 1], b1i = bbi[p * 16 + 2 * q + 1];
                wre[q] = pk2(er * b0r - ei * b0i, er * b1r - ei * b1i); wim[q] = pk2(er * b0i + ei * b0r, er * b1i + ei * b1r); }
            u32x4* dre = (u32x4*)(Wg + (size_t)(g * 128 + p) * 1024 + j * 16); u32x4* dim = (u32x4*)(Wg + (size_t)(g * 128 + 64 + p) * 1024 + j * 16);
            dre[0] = (u32x4){wre[0], wre[1], wre[2], wre[3]}; dre[1] = (u32x4){wre[4], wre[5], wre[6], wre[7]};
            dim[0] = (u32x4){wim[0], wim[1], wim[2], wim[3]}; dim[1] = (u32x4){wim[4], wim[5], wim[6], wim[7]}; }
          RMS_TICK();
          { const int t = j; const float n = (float)(t + 1); const float mag = expf(n * zr[p]), a = n * zi[p]; const float er = mag * cosf(a), ei = mag * sinf(a);
#pragma unroll 4
            for (int h = 0; h < 16; ++h) { const float cr = cre[h * 68 + p], ci = cim[h * 68 + p];
                bf16_t* d = TV + (size_t)(g * 1024 + perm16_row(t * 16 + h)) * 1152 + 1024 + p;
                d[0] = (bf16_t)f2bf(cr * er - ci * ei); d[64] = (bf16_t)f2bf(-(cr * ei + ci * er)); } }
          RMS_TICK();
          if (sub == 0 && tid < 64) { const float mag = expf(64.0f * zr[tid]), a = 64.0f * zi[tid]; L64[(g * 64 + tid) * 2] = mag * cosf(a); L64[(g * 64 + tid) * 2 + 1] = mag * sinf(a); }
        }
    }
    while (r0 >= 0 || r1 >= 0 || rk < NR) RMS_TICK();
#undef RMS_TICK
#undef TB_SYNC
    __syncthreads();
}
__device__ __forceinline__ void fill_tv_item(unsigned char* wsb, int tid, int item) {
    const float* Kg = (const float*)(wsb + WS_KG); bf16_t* TV = (bf16_t*)(wsb + WS_TV);
#pragma unroll 4
    for (int it = 0; it < 16; ++it) { const int ci = (item * 16 + it) * NTHR + tid;
        const int g = ci >> 17, row = (ci >> 7) & 1023, ch = ci & 127, t = row >> 4, h = row & 15, j = ch >> 1, h0 = (ch & 1) * 8, lag = t - j;
        u32x4 o = (u32x4){0u, 0u, 0u, 0u};
        if (lag >= 0) { const f32x4* sp = (const f32x4*)(Kg + ((g * 64 + lag) * 16 + h) * 16 + h0); const f32x4 a = sp[0], b = sp[1];
            o.x = pk2(a.x, a.y); o.y = pk2(a.z, a.w); o.z = pk2(b.x, b.y); o.w = pk2(b.z, b.w); }
        *(u32x4*)(TV + (size_t)(g * 1024 + perm16_row(row)) * 1152 + ch * 8) = o; }
}

struct EpiInProj {
    bf16_t *U, *Q, *K, *V, *QI, *KI, *GS, *GA; float* WI; const float *bg, *c64, *s64, *c32, *s32; float ascale;
    __device__ __forceinline__ void operator()(f32x4 (&acc)[2][2][4][2], const pg::Unit& u, int wr, int wc, int fr, int fq) const {
        const int pn = u.pn, row0 = u.pm * 256 + wr * 64 + fr;
        if (ascale != 1.0f) {
#pragma unroll
            for (int a_ = 0; a_ < 2; ++a_)
#pragma unroll
                for (int b_ = 0; b_ < 2; ++b_)
#pragma unroll
                    for (int m_ = 0; m_ < 4; ++m_)
#pragma unroll
                        for (int n_ = 0; n_ < 2; ++n_) acc[a_][b_][m_][n_] *= ascale; }
        auto st32 = [](bf16_t* d, const f32x4& a, const f32x4& b) { const u32x2 x = pkbf4(a), y = pkbf4(b); *(u32x4*)d = (u32x4){x.x, x.y, y.x, y.y}; };
        if (pn < 2 || pn == 6 || pn == 7) {
            const int c0 = (pn & 1) * 256 + wc * 64 + fq * 16;
#pragma unroll
            for (int ai = 0; ai < 2; ++ai)
#pragma unroll
                for (int m = 0; m < 4; ++m) { const int r = row0 + ai * 128 + m * 16;
                    if (pn < 2) { bf16_t* d = U + ((size_t)((c0 >> 4) * 512 + (r >> 6)) * 1152 + (r & 63) * 16);
                        st32(d, acc[ai][0][m][0], acc[ai][0][m][1]); st32(d + 8, acc[ai][1][m][0], acc[ai][1][m][1]); }
                    else {
                        const int head = c0 >> 6, dim0 = c0 & 63, bb = r >> 12, l = r & 4095, t = l & 63, tq = t & 31, hh = (tq >> 2) & 1, ii = (t >> 5) * 16 + ((tq & 3) | ((tq >> 3) << 2));
                        unsigned char* d8 = (unsigned char*)V + ((size_t)((bb * 8 + head) * 64 + (l >> 6)) * 4096) + dim0 * 64 + hh * 32 + ii;
                        const unsigned w0 = pkf84(acc[ai][0][m][0]), w1 = pkf84(acc[ai][0][m][1]), w2 = pkf84(acc[ai][1][m][0]), w3 = pkf84(acc[ai][1][m][1]);
#pragma unroll
                        for (int j = 0; j < 4; ++j) { d8[j * 64] = (unsigned char)(w0 >> (8 * j)); d8[(4 + j) * 64] = (unsigned char)(w1 >> (8 * j)); d8[(8 + j) * 64] = (unsigned char)(w2 >> (8 * j)); d8[(12 + j) * 64] = (unsigned char)(w3 >> (8 * j)); } } }
        } else if (pn < 6) {
            bf16_t* O = pn < 4 ? Q : K; const float sc = pn < 4 ? C2 : 1.0f; const int head = (pn & 1) * 4 + wc, dd = fq * 8;
#pragma unroll
            for (int ai = 0; ai < 2; ++ai)
#pragma unroll
                for (int m = 0; m < 4; ++m) { const int r = row0 + ai * 128 + m * 16, l = r & 4095; bf16_t* d = O + (size_t)r * 512 + head * 64 + dd; f32x4 o1[2], o2[2];
#pragma unroll
                    for (int n = 0; n < 2; ++n) { const f32x4 cs = *(const f32x4*)(c64 + l * 32 + dd + 4 * n), sn = *(const f32x4*)(s64 + l * 32 + dd + 4 * n); const f32x4 x1 = acc[ai][0][m][n], x2 = acc[ai][1][m][n];
                        o1[n] = (x1 * cs - x2 * sn) * sc; o2[n] = (x2 * cs + x1 * sn) * sc; }
                    if (pn < 4) { st32(d, o1[0], o1[1]); st32(d + 32, o2[0], o2[1]); }
                    else { unsigned char* d8 = (unsigned char*)K + (size_t)r * 512 + head * 64 + dd;
                        *(u32x2*)d8 = (u32x2){pkf84(o1[0]), pkf84(o1[1])}; *(u32x2*)(d8 + 32) = (u32x2){pkf84(o2[0]), pkf84(o2[1])}; } }
        } else if (pn == 8) {
            const int head = 2 * wc + (fq >> 1), dd = (fq & 1) * 8;
#pragma unroll
            for (int ai = 0; ai < 2; ++ai)
#pragma unroll
                for (int m = 0; m < 4; ++m) { const int r = row0 + ai * 128 + m * 16, l = r & 4095; bf16_t* d = QI + (size_t)r * 256 + head * 32 + dd; f32x4 o1[2], o2[2];
#pragma unroll
                    for (int n = 0; n < 2; ++n) { const f32x4 cs = *(const f32x4*)(c32 + l * 16 + dd + 4 * n), sn = *(const f32x4*)(s32 + l * 16 + dd + 4 * n); const f32x4 x1 = acc[ai][0][m][n], x2 = acc[ai][1][m][n];
                        o1[n] = x1 * cs - x2 * sn; o2[n] = x2 * cs + x1 * sn; }
                    st32(d, o1[0], o1[1]); st32(d + 16, o2[0], o2[1]); }
        } else if (pn == 9) {
            if (wc == 0) {
#pragma unroll
                for (int ai = 0; ai < 2; ++ai)
#pragma unroll
                    for (int m = 0; m < 4; ++m) { const int r = row0 + ai * 128 + m * 16, l = r & 4095;
                        const f32x4 cs = *(const f32x4*)(c32 + l * 16 + fq * 4), sn = *(const f32x4*)(s32 + l * 16 + fq * 4);
                        const f32x4 x1 = acc[ai][0][m][0], x2 = acc[ai][1][m][0]; const f32x4 o1 = x1 * cs - x2 * sn, o2 = x2 * cs + x1 * sn;
                        bf16_t* d = KI + (size_t)r * 32 + fq * 4; *(u32x2*)d = pkbf4(o1); *(u32x2*)(d + 16) = pkbf4(o2);
                        if (fq < 2) *(f32x4*)(WI + (size_t)r * 8 + fq * 4) = acc[ai][0][m][1]; } }
        } else {
            const int gc = (pn - 10) * 256 + wc * 64 + fq * 16; f32x4 b[4];
#pragma unroll
            for (int q = 0; q < 4; ++q) b[q] = *(const f32x4*)(bg + gc + 4 * q);
            unsigned char* O = (unsigned char*)GS + (gc < 1024 ? (size_t)gc : (size_t)T * 1024 + (gc - 1024));
#pragma unroll
            for (int ai = 0; ai < 2; ++ai)
#pragma unroll
                for (int m = 0; m < 4; ++m) { const int r = row0 + ai * 128 + m * 16;
                    *(u32x4*)(O + (size_t)r * 1024) = (u32x4){pkf84(sig4(acc[ai][0][m][0] + b[0])), pkf84(sig4(acc[ai][0][m][1] + b[1])), pkf84(sig4(acc[ai][1][m][0] + b[2])), pkf84(sig4(acc[ai][1][m][1] + b[3]))}; }
        }
    }
};

__device__ __forceinline__ void idx_score_tile(bf16x8 k0, bf16x8 k1, const bf16x8 (&qp)[2], const bf16x8 (&qf)[8][2], const float (&w)[8], float (&sc)[16]) {
    const f32x16 z = (f32x16){0.f, 0.f, 0.f, 0.f, 0.f, 0.f, 0.f, 0.f, 0.f, 0.f, 0.f, 0.f, 0.f, 0.f, 0.f, 0.f};
    f32x16 lin = __builtin_amdgcn_mfma_f32_32x32x16_bf16(k0, qp[0], z, 0, 0, 0); lin = __builtin_amdgcn_mfma_f32_32x32x16_bf16(k1, qp[1], lin, 0, 0, 0);
    f32x16 dA = __builtin_amdgcn_mfma_f32_32x32x16_bf16(k0, qf[0][0], z, 0, 0, 0); dA = __builtin_amdgcn_mfma_f32_32x32x16_bf16(k1, qf[0][1], dA, 0, 0, 0);
#pragma unroll
    for (int r = 0; r < 16; ++r) sc[r] = lin[r];
#pragma unroll
    for (int h = 0; h < 8; ++h) {
        f32x16 dB = z;
        if (h < 7) { dB = __builtin_amdgcn_mfma_f32_32x32x16_bf16(k0, qf[h + 1][0], z, 0, 0, 0); dB = __builtin_amdgcn_mfma_f32_32x32x16_bf16(k1, qf[h + 1][1], dB, 0, 0, 0); }
#pragma unroll
        for (int r = 0; r < 16; ++r) sc[r] = __builtin_fmaf(w[h], __builtin_fabsf(dA[r]), sc[r]);
        asm volatile("" : "+v"(sc[0]), "+v"(sc[1]), "+v"(sc[2]), "+v"(sc[3]), "+v"(sc[4]), "+v"(sc[5]), "+v"(sc[6]), "+v"(sc[7]), "+v"(k0));
        asm volatile("" : "+v"(sc[8]), "+v"(sc[9]), "+v"(sc[10]), "+v"(sc[11]), "+v"(sc[12]), "+v"(sc[13]), "+v"(sc[14]), "+v"(sc[15]), "+v"(k1));
        dA = dB;
    }
}
__device__ __forceinline__ u32x4 mk4(unsigned a, unsigned b, unsigned c, unsigned d) { return (u32x4){a, b, c, d}; }
__device__ __forceinline__ unsigned pkh2(float a, float b) { typedef _Float16 h2_t __attribute__((ext_vector_type(2))); const h2_t v = {(_Float16)a, (_Float16)b}; return __builtin_bit_cast(unsigned, v); }
__device__ __forceinline__ unsigned h16_of(float s) { const _Float16 hf = (_Float16)s; return (unsigned)__builtin_bit_cast(unsigned short, hf); }
__device__ __forceinline__ void idx_scan(const LAS unsigned* hist, LAS unsigned* segs, int wave, int lane, unsigned need, int mode, bool& own, unsigned& fb, unsigned& frem) {
    const LAS unsigned* hq = hist + (lane >> 5) * 8192 + (lane & 31);
    unsigned c[32], sum = 0;
#pragma unroll
    for (int j = 0; j < 32; ++j) { const int k = wave * 32 + j, bin = mode == 0 ? (k < 128 ? 127 - k : k) : mode == 1 ? 255 - k : k; c[j] = hq[bin * 32]; }
#pragma unroll
    for (int j = 0; j < 32; ++j) sum += c[j];
    segs[wave * 64 + lane] = sum;
    __syncthreads();
    unsigned cum = 0;
    for (int s2 = 0; s2 < wave; ++s2) cum += segs[s2 * 64 + lane];
    own = cum < need && need <= cum + sum; fb = 0; frem = 1;
    if (own) { bool found = false;
#pragma unroll
        for (int j = 0; j < 32; ++j) { const int k = wave * 32 + j, bin = mode == 0 ? (k < 128 ? 127 - k : k) : mode == 1 ? 255 - k : k;
            if (!found && cum + c[j] >= need) { fb = (unsigned)bin; frem = need - cum; found = true; } cum += c[j]; } }
}
__device__ __forceinline__ void idx_phase(Frame& F) {
    LAS unsigned* hist = (LAS unsigned*)F.lds;
    LAS unsigned* b1s = hist + 16384; LAS unsigned* r1s = b1s + 64; LAS unsigned* ths = r1s + 64; LAS unsigned* segs = ths + 64;
    const bf16_t* QI = WSP(bf16_t, WS_QIDX); const bf16_t* KI = WSP(bf16_t, WS_KIDX); const float* WI = WSP(float, WS_WIDX); unsigned* MASK = WSP(unsigned, WS_MASK);
    const int lane = F.lane, r32 = lane & 31, hi = lane >> 5, gq = F.wave & 1, ks = F.wave >> 1;
    LAS int* qslot = (LAS int*)(F.lds + 68 * 1024);
    unsigned* qhead = WSP(unsigned, WS_CTL) + CW_QIDX + (F.dry ? 16 : 0);
    for (;;) {
            __syncthreads();
            if (F.tid == 0) *qslot = (int)__hip_atomic_fetch_add(qhead, 1u, __ATOMIC_RELAXED, __HIP_MEMORY_SCOPE_AGENT);
            __syncthreads();
            const int qpos = *qslot; if (qpos >= 1024) break;
            if (qpos & 1) { if (!F.dry) fill_tv_item(F.ws, F.tid, qpos >> 1); continue; }
            const int un = qpos >> 1;
            const int qb = 63 - (un >> 3), b = un & 7;
            const int q0 = qb * 64 + gq * 32, tok = b * 4096 + q0 + r32, ntile = (qb + 1) * 2;
            bf16x8 qf[8][2], qp[2]; float w[8];
#pragma unroll
            for (int h = 0; h < 8; ++h)
#pragma unroll
                for (int k = 0; k < 2; ++k) qf[h][k] = *(const bf16x8*)(QI + (size_t)tok * 256 + h * 32 + k * 16 + hi * 8);
            { const f32x4 wa = *(const f32x4*)(WI + (size_t)tok * 8), wb = *(const f32x4*)(WI + (size_t)tok * 8 + 4); w[0] = wa.x; w[1] = wa.y; w[2] = wa.z; w[3] = wa.w; w[4] = wb.x; w[5] = wb.y; w[6] = wb.z; w[7] = wb.w; }
#pragma unroll
            for (int k = 0; k < 2; ++k) { float a[8];
#pragma unroll
                for (int j = 0; j < 8; ++j) a[j] = 0.f;
#pragma unroll
                for (int h = 0; h < 8; ++h)
#pragma unroll
                    for (int j = 0; j < 8; ++j) a[j] = __builtin_fmaf(w[h], bf2f((unsigned short)qf[h][k][j]), a[j]);
                u32x4 pkd; pkd.x = pk2(a[0], a[1]); pkd.y = pk2(a[2], a[3]); pkd.z = pk2(a[4], a[5]); pkd.w = pk2(a[6], a[7]); qp[k] = __builtin_bit_cast(bf16x8, pkd); }
            const bf16_t* kbase = KI + (size_t)(b * 4096 + r32) * 32 + hi * 8;
            u32x4* slab = (u32x4*)(F.ws + WS_W2T + ((size_t)b * 2080 + (size_t)(qb * (qb + 1) / 2)) * 8192) + gq * 128 + lane * 2;
            LAS unsigned* hq = hist + gq * 8192 + r32;
            _Float16 theta = (_Float16)(-INFINITY); float sc[16]; bf16x8 kn0, kn1;
#define IDX_TILES(BODY) do { kn0 = *(const bf16x8*)(kbase + (size_t)ks * 1024); kn1 = *(const bf16x8*)(kbase + (size_t)ks * 1024 + 16); \
            for (int kt = ks; kt < ntile; kt += 4) { const bf16x8 kc0 = kn0, kc1 = kn1; \
                if (kt + 4 < ntile) { kn0 = *(const bf16x8*)(kbase + (size_t)(kt + 4) * 1024); kn1 = *(const bf16x8*)(kbase + (size_t)(kt + 4) * 1024 + 16); } \
                idx_score_tile(kc0, kc1, qp, qf, w, sc); BODY } } while (0)
            if (qb >= 4) {
                for (int i = F.tid; i < 16384; i += NTHR) hist[i] = 0u;
                __syncthreads();
                IDX_TILES({
                    _Pragma("unroll") for (int r = 0; r < 16; ++r) __hip_atomic_fetch_add(hq + (h16_of(sc[r]) >> 8) * 32, 1u, __ATOMIC_RELAXED, __HIP_MEMORY_SCOPE_WORKGROUP);
                    slab[kt * 256] = mk4(pkh2(sc[0], sc[1]), pkh2(sc[2], sc[3]), pkh2(sc[4], sc[5]), pkh2(sc[6], sc[7]));
                    slab[kt * 256 + 1] = mk4(pkh2(sc[8], sc[9]), pkh2(sc[10], sc[11]), pkh2(sc[12], sc[13]), pkh2(sc[14], sc[15])); });
                __syncthreads();
                { bool own; unsigned fb, fr_; idx_scan(hist, segs, F.wave, lane, 256u, 0, own, fb, fr_); if (own) { b1s[lane] = fb; r1s[lane] = fr_; } }
                __syncthreads();
                for (int i = F.tid; i < 16384; i += NTHR) hist[i] = 0u;
                __syncthreads();
                const unsigned b1 = b1s[gq * 32 + r32];
                { u32x4 n0 = slab[ks * 256], n1 = slab[ks * 256 + 1];
                  for (int kt = ks; kt < ntile; kt += 4) { const u32x4 c0 = n0, c1 = n1;
                      if (kt + 4 < ntile) { n0 = slab[(kt + 4) * 256]; n1 = slab[(kt + 4) * 256 + 1]; }
                      _Pragma("unroll") for (int r = 0; r < 16; ++r) { const unsigned wv = r < 8 ? c0[(r & 7) >> 1] : c1[(r & 7) >> 1]; const unsigned hv = (r & 1) ? wv >> 16 : wv & 0xffffu;
                          if ((hv >> 8) == b1) __hip_atomic_fetch_add(hq + (hv & 255u) * 32, 1u, __ATOMIC_RELAXED, __HIP_MEMORY_SCOPE_WORKGROUP); } } }
                __syncthreads();
                { bool own; unsigned fb, fr_; const unsigned bb = b1s[lane]; idx_scan(hist, segs, F.wave, lane, r1s[lane], bb < 128u ? 1 : 2, own, fb, fr_); if (own) ths[lane] = (bb << 8) | fb; }
                __syncthreads();
                theta = __builtin_bit_cast(_Float16, (unsigned short)ths[gq * 32 + r32]);
                u32x4 n0 = slab[ks * 256], n1 = slab[ks * 256 + 1];
                for (int kt = ks; kt < ntile; kt += 4) { const u32x4 c0 = n0, c1 = n1;
                    if (kt + 4 < ntile) { n0 = slab[(kt + 4) * 256]; n1 = slab[(kt + 4) * 256 + 1]; }
                    unsigned bits = 0u;
                    _Pragma("unroll") for (int r = 0; r < 16; ++r) { const unsigned wv = r < 8 ? c0[(r & 7) >> 1] : c1[(r & 7) >> 1]; const unsigned short hv = (unsigned short)((r & 1) ? wv >> 16 : wv & 0xffffu);
                        bits |= (__builtin_bit_cast(_Float16, hv) >= theta ? 1u : 0u) << (8 * (r & 3) + (r >> 2)); }
                    MASK[((size_t)(b * 128 + kt) * 4096 + q0 + r32) * 2 + hi] = bits; }
                continue;
            }
            IDX_TILES({
                unsigned bits = 0u;
                _Pragma("unroll") for (int r = 0; r < 16; ++r) bits |= ((_Float16)sc[r] >= theta ? 1u : 0u) << (8 * (r & 3) + (r >> 2));
                MASK[((size_t)(b * 128 + kt) * 4096 + q0 + r32) * 2 + hi] = bits; });
#undef IDX_TILES
    }
}

constexpr int CV_R = 4, CV_IE = (1024 / 64) * (1024 / 64), CV_NITEMS = 3 * 32 * CV_IE, CV_NBLK = CV_NITEMS / (16 * CV_R);
__device__ __forceinline__ void expert_conv_item(LAS unsigned char* lds, unsigned char* ws, int wave, int lane, const float* wg_, const float* wu_, const float* wd_, int bitem) {
    asm volatile("" : "+v"(lane));
    LAS float* scr = (LAS float*)(lds + wave * 16640);
    auto w1row = [](int c) { const int pn = c >> 7, w = c & 127; return pn * 256 + (w & 96) + ((w >> 2) & 1) * 16 + ((w >> 3) & 3) * 4 + (w & 3); };
    const int r0 = bitem * (16 * CV_R) + wave * (2 * CV_R);
    const int which = r0 / (32 * CV_IE), e = (r0 % (32 * CV_IE)) / CV_IE, item0 = r0 % CV_IE;
    const float* src = (which == 0 ? wg_ : which == 1 ? wu_ : wd_) + (size_t)e * 1024 * 1024;
    unsigned char* dstm = which == 2 ? ws + WS_W2T + (size_t)e * 1024 * 1024 : ws + WS_W1T + (size_t)e * 2048 * 1024;
    const int up = which == 1 ? 128 : 0;
    auto drow = [=](int c) { return which == 2 ? perm16_row(c) : w1row(c) + up; };
    f32x4 va[16], vb[16];
    tr8_load(va, src, 1024, 1024, item0, lane); tr8_load(vb, src, 1024, 1024, item0 + 1, lane);
#pragma unroll 1
    for (int r = 0; r < CV_R; ++r) { const int it = item0 + 2 * r;
        tr8_process(va, 1024, 1024, dstm, scr, it, lane, 32.0f, drow); if (r + 1 < CV_R) tr8_load(va, src, 1024, 1024, it + 2, lane);
        tr8_process(vb, 1024, 1024, dstm, scr, it + 1, lane, 32.0f, drow); if (r + 1 < CV_R) tr8_load(vb, src, 1024, 1024, it + 3, lane); }
}
__device__ __forceinline__ s16x4 vtr(const LAS char* p) { typedef short v4i16_t __attribute__((ext_vector_type(4))); return __builtin_bit_cast(s16x4, __builtin_amdgcn_ds_read_tr16_b64_v4i16((LAS v4i16_t*)p)); }
__device__ __forceinline__ unsigned bfe_mask(int w, int bp) { int r; asm("v_bfe_i32 %0, %1, %2, 1" : "=v"(r) : "v"(w), "v"(bp)); return (unsigned)r; }
__device__ __forceinline__ float max3_(float a, float b, float c) { float r; asm("v_max3_f32 %0, %1, %2, %3" : "=v"(r) : "v"(a), "v"(b), "v"(c)); return r; }
__device__ __forceinline__ void glds16(const void* gsrc, unsigned lds_dst) {
    unsigned keep; asm volatile("s_mov_b32 %0, m0\n\ts_mov_b32 m0, %2\n\ts_nop 0\n\tglobal_load_lds_dwordx4 %1, off\n\ts_mov_b32 m0, %0" : "=&s"(keep) : "v"(gsrc), "s"(lds_dst) : "memory"); }
__device__ __forceinline__ void attn_phase(Frame& F) {
    const bf16_t* Q = WSP(bf16_t, WS_Q); const bf16_t* K = WSP(bf16_t, WS_K); const bf16_t* V = WSP(bf16_t, WS_V); unsigned char* O = F.dry ? WSP(unsigned char, WS_E) : WSP(unsigned char, WS_YA8); const unsigned* MASK = WSP(unsigned, WS_MASK);
    const int lane = F.lane, r32 = lane & 31, hi = lane >> 5, wv = F.wave;
    const LAS char* ldsc = (const LAS char*)F.lds;
    const unsigned lds0 = (unsigned)(uintptr_t)F.lds;
    constexpr int KOFF = 0, VOFF = 32768, MOFF = 65536;
    const float* const wg_ = F.in[21]; const float* const wu_ = F.in[23]; const float* const wd_ = F.in[25];
    LAS int* qslot = (LAS int*)(F.lds + LDS_BYTES_C - 128);
    unsigned* qhead = WSP(unsigned, WS_CTL) + CW_QATT + (F.dry ? 16 : 0);
    __builtin_amdgcn_s_setreg(1 | (23 << 6) | (0 << 11), 1);
    for (;;) {
            __syncthreads();
            if (F.tid == 0) *qslot = (int)__hip_atomic_fetch_add(qhead, 1u, __ATOMIC_RELAXED, __HIP_MEMORY_SCOPE_AGENT);
            __syncthreads();
            const int qp = *qslot; if (qp >= 1024 + CV_NBLK) break;
            static_assert(CV_NBLK == 384, "queue pattern");
            const int q3 = qp / 3, m3 = qp - 3 * q3;
            if (qp < 3 * CV_NBLK && m3 == 1) { if (!F.dry) expert_conv_item(F.lds, F.ws, F.wave, F.lane, wg_, wu_, wd_, q3); continue; }
            const int un = qp < 3 * CV_NBLK ? q3 * 2 + (m3 >> 1) : qp - CV_NBLK;
            const int qb = 15 - (un >> 6), b = (un >> 3) & 7, h = un & 7;
            const int q0 = qb * 256, NT = 4 * qb + 4, ntw = 4 * qb + (wv >> 1) + 1;
            const size_t tokq = (size_t)b * 4096 + q0 + wv * 32 + r32;
            const unsigned char* ksrc = (const unsigned char*)K + ((size_t)b * 4096 + lane) * 512 + h * 64 + (wv & 3) * 16;
            const unsigned char* vsrc = (const unsigned char*)V + (size_t)((b * 8 + h) * 64) * 4096 + lane * 64 + (wv & 3) * 16;
            const unsigned* msrc = MASK + (((size_t)b * 128 + ((wv >> 1) & 1)) * 4096 + q0 + (wv & 1) * 128) * 2 + lane * 4;
            const unsigned mdst = lds0 + MOFF + (wv & 3) * 1024;
            const unsigned char* kvsrc = wv < 4 ? ksrc : vsrc; const size_t kvstep = wv < 4 ? (size_t)64 * 512 : (size_t)4096; const unsigned kvdst = lds0 + (wv < 4 ? KOFF : VOFF) + (wv & 3) * 1024;
#define ATT_DMA(t_) do { const int tt_ = (t_) < NT ? (t_) : NT - 1; const unsigned sl_ = (unsigned)((t_) & 3); \
        glds16(kvsrc + (size_t)tt_ * kvstep, (unsigned)__builtin_amdgcn_readfirstlane(kvdst + sl_ * 8192u)); \
        glds16(msrc + (size_t)tt_ * 2 * 4096 * 2, (unsigned)__builtin_amdgcn_readfirstlane(mdst + sl_ * 4096u)); } while (0)
            ATT_DMA(0); ATT_DMA(1); ATT_DMA(2);
            v8i_t q8;
            { u32x4 qb_[4];
#pragma unroll
              for (int j = 0; j < 4; ++j) qb_[j] = *(const u32x4*)(Q + tokq * 512 + h * 64 + hi * 32 + j * 8);
              asm volatile("" : "+v"(qb_[0]), "+v"(qb_[1]), "+v"(qb_[2]), "+v"(qb_[3]));
#pragma unroll
              for (int j = 0; j < 4; ++j) { q8[2 * j] = (int)pk4_fp8(16.f * bflo(qb_[j].x), 16.f * bfhi(qb_[j].x), 16.f * bflo(qb_[j].y), 16.f * bfhi(qb_[j].y));
                  q8[2 * j + 1] = (int)pk4_fp8(16.f * bflo(qb_[j].z), 16.f * bfhi(qb_[j].z), 16.f * bflo(qb_[j].w), 16.f * bfhi(qb_[j].w)); } }
            int scK = 0x7f7f7f7f, scQ = 0x7b7b7b7b;
            constexpr float PB = 5.0f;
            float m = 0.f; f32x16 o[2], o2, negm;
            const int onew = r32 == 0 ? 0x38383838 : 0; const v8i_t ones8 = (v8i_t){onew, onew, onew, onew, onew, onew, onew, onew};
#pragma unroll
            for (int r = 0; r < 16; ++r) { o[0][r] = 0.f; o[1][r] = 0.f; o2[r] = 0.f; negm[r] = PB; }
            const int vlane = hi * 2048 + r32 * 16;
            for (int t = 0; t < NT; ++t) {
                asm volatile("s_waitcnt vmcnt(4)\n\ts_barrier" ::: "memory");
                ATT_DMA(t + 3);
                if (t < ntw) {
                    const int sl = t & 3;
                    const LAS char* Kb = ldsc + KOFF + sl * 8192; const LAS char* Vb = ldsc + VOFF + sl * 8192 + vlane; const LAS unsigned* Mb = (const LAS unsigned*)(ldsc + MOFF + sl * 4096) + (wv * 32 + r32) * 2 + hi;
                    const unsigned w0 = Mb[0], w1 = Mb[512];
                    f32x16 p0, p1;
                    { const LAS v4i_t* kp = (const LAS v4i_t*)(Kb + hi * 2048 + r32 * 16);
                      const v8i_t ka = __builtin_shufflevector(kp[0], kp[64], 0, 1, 2, 3, 4, 5, 6, 7), kb2 = __builtin_shufflevector(kp[32], kp[96], 0, 1, 2, 3, 4, 5, 6, 7);
                      p0 = __builtin_amdgcn_mfma_scale_f32_32x32x64_f8f6f4(ka, q8, negm, 0, 0, 0, scK, 0, scQ);
                      p1 = __builtin_amdgcn_mfma_scale_f32_32x32x64_f8f6f4(kb2, q8, negm, 0, 0, 0, scK, 0, scQ); }
                    v8i_t va[2];
#pragma unroll
                    for (int d0 = 0; d0 < 2; ++d0) { const LAS v4i_t* vp = (const LAS v4i_t*)(Vb + d0 * 512); va[d0] = __builtin_shufflevector(vp[0], vp[64], 0, 1, 2, 3, 4, 5, 6, 7); }
                    __builtin_amdgcn_sched_barrier(0);
                    if ((t & 3) == 0) {
                    asm volatile("s_nop 15\n\ts_nop 7" : "+v"(p0), "+v"(p1));
                    float rm = max3_(p0[0], p1[0], p0[1]), rm2 = max3_(p1[1], p0[2], p1[2]);
#pragma unroll
                    for (int r = 3; r < 15; r += 2) { rm = max3_(rm, p0[r], p1[r]); rm2 = max3_(rm2, p0[r + 1], p1[r + 1]); }
                    rm = max3_(rm, p0[15], p1[15]); rm = __builtin_fmaxf(rm, rm2);
                    rm = __builtin_fmaxf(rm, __shfl_xor(rm, 32));
                    rm -= PB;
                    if (t == 0 || __any(rm > 0.f)) {
                        const float dl = t == 0 ? rm : __builtin_fmaxf(rm, 0.f), f = __builtin_amdgcn_exp2f(-dl);
                        m += dl;
                        o2[0] *= f;
#pragma unroll
                        for (int r = 0; r < 16; ++r) { negm[r] = PB - m; o[0][r] *= f; o[1][r] *= f; p0[r] -= dl; p1[r] -= dl; }
                    }
                    }
#pragma unroll
                    for (int r = 0; r < 16; ++r) { p0[r] = __builtin_amdgcn_exp2f(p0[r]); p1[r] = __builtin_amdgcn_exp2f(p1[r]); }
                    v8i_t pb;
#pragma unroll
                    for (int q = 0; q < 4; ++q) { pb[q] = (int)pk4_fp8(p0[4 * q], p0[4 * q + 1], p0[4 * q + 2], p0[4 * q + 3]); pb[4 + q] = (int)pk4_fp8(p1[4 * q], p1[4 * q + 1], p1[4 * q + 2], p1[4 * q + 3]); }
#pragma unroll
                    for (int q = 0; q < 4; ++q) { pb[q] &= (int)__builtin_amdgcn_perm(0x0000ff00u, 0x0000ff00u, (w0 >> q) & 0x01010101u); pb[4 + q] &= (int)__builtin_amdgcn_perm(0x0000ff00u, 0x0000ff00u, (w1 >> q) & 0x01010101u); }
                    o2 = __builtin_amdgcn_mfma_scale_f32_32x32x64_f8f6f4(ones8, pb, o2, 0, 0, 0, scK, 0, scK);
#pragma unroll
                    for (int d0 = 0; d0 < 2; ++d0) o[d0] = __builtin_amdgcn_mfma_scale_f32_32x32x64_f8f6f4(va[d0], pb, o[d0], 0, 0, 0, scK, 0, scK);
                }
            }
            asm volatile("s_waitcnt vmcnt(0) lgkmcnt(0)\n\ts_barrier" ::: "memory");
#undef ATT_DMA
            const float lt = __shfl(o2[0], r32), inv = 1.0f / lt;
#pragma unroll
            for (int d0 = 0; d0 < 2; ++d0)
#pragma unroll
                for (int g4 = 0; g4 < 4; ++g4) { unsigned w = pk4_fp8(o[d0][4 * g4] * inv, o[d0][4 * g4 + 1] * inv, o[d0][4 * g4 + 2] * inv, o[d0][4 * g4 + 3] * inv);
#ifdef ABL_ATTN
                    w = 0u;
#endif
                    *(unsigned*)(O + tokq * 512 + h * 64 + d0 * 32 + g4 * 8 + hi * 4) = w; }
        }
    __builtin_amdgcn_s_setreg(1 | (23 << 6) | (0 << 11), 0);
}

__device__ __forceinline__ int xcd_pos(int G, int c) { return (G & 7) == 0 ? (c & 7) * (G >> 3) + (c >> 3) : c; }
struct ProbS5E {
    const char* U; const char* Wg; unsigned ldb_bytes; int nt, G, c;
    __device__ bool next(int i, pg::Unit& u) const { const int L = i * G + xcd_pos(G, c); if (L >= 64) return false; u.g = L >> 1; u.pm = L & 1; u.pn = 0; return true; }
    __device__ const char* a_base(const pg::Unit& u) const { return U + ((size_t)u.g * 512 + u.pm * 256) * 2304; }
    __device__ unsigned a_off(const pg::Unit&, int row, int col) const { return (unsigned)row * 2304u + (unsigned)col * 2u; }
    __device__ const char* b_base(const pg::Unit& u) const { return Wg + (size_t)u.g * 128 * 2048; }
};
struct EpiS5E { float* E;
    __device__ __forceinline__ void operator()(f32x4 (&acc)[2][2][4][2], const pg::Unit& u, int wr, int wc, int fr, int fq) const {
#pragma unroll
        for (int ai = 0; ai < 2; ++ai)
#pragma unroll
            for (int m = 0; m < 4; ++m) { const int r = u.pm * 256 + ai * 128 + wr * 64 + m * 16 + fr;
#pragma unroll
                for (int n = 0; n < 2; ++n) *(f32x4*)(E + ((size_t)u.g * 512 + r) * 128 + wc * 32 + n * 16 + fq * 4) = acc[ai][0][m][n]; }
    }
};
__device__ __forceinline__ void s5_scan(Frame& F) {
    if (F.wave != 0) return;
    const float* E = WSP(float, WS_EF32); const float* L64 = WSP(float, WS_L64); bf16_t* U = WSP(bf16_t, WS_U);
    for (int gid = F.bid * 64 + F.lane; gid < 32 * 8 * 64; gid += F.G * 64) {
        const int p = gid & 63, b = (gid >> 6) & 7, g = gid >> 9;
        const float lr = L64[(g * 64 + p) * 2], li = L64[(g * 64 + p) * 2 + 1]; float sr = 0.f, si = 0.f;
        const size_t m0 = (size_t)g * 512 + b * 64;
#pragma unroll 1
        for (int c0 = 0; c0 < 64; c0 += 16) { float er[16], ei[16];
#pragma unroll
            for (int c = 0; c < 16; ++c) { er[c] = E[(m0 + c0 + c) * 128 + p]; ei[c] = E[(m0 + c0 + c) * 128 + 64 + p]; }
#pragma unroll
            for (int c = 0; c < 16; ++c) { const size_t m = m0 + c0 + c;
                U[m * 1152 + 1024 + p] = (bf16_t)f2bf(sr); U[m * 1152 + 1088 + p] = (bf16_t)f2bf(si);
                const float nr = lr * sr - li * si + er[c], ni = lr * si + li * sr + ei[c]; sr = nr; si = ni; } }
    }
}
struct ProbS5Y {
    const char* U; const char* TV; unsigned ldb_bytes; int nt, G, c;
    __device__ bool next(int i, pg::Unit& u) const { const int L = i * G + xcd_pos(G, c); if (L >= 256) return false; u.g = L >> 3; u.pm = (L >> 2) & 1; u.pn = L & 3; return true; }
    __device__ const char* a_base(const pg::Unit& u) const { return U + ((size_t)u.g * 512 + u.pm * 256) * 2304; }
    __device__ unsigned a_off(const pg::Unit&, int row, int col) const { return (unsigned)row * 2304u + (unsigned)col * 2u; }
    __device__ const char* b_base(const pg::Unit& u) const { return TV + ((size_t)u.g * 1024 + u.pn * 256) * 2304; }
};
struct EpiS5Y { bf16_t* Y;
    __device__ __forceinline__ void operator()(f32x4 (&acc)[2][2][4][2], const pg::Unit& u, int wr, int wc, int fr, int fq) const {
        const int t = u.pn * 16 + wc * 4 + fq;
#pragma unroll
        for (int ai = 0; ai < 2; ++ai)
#pragma unroll
            for (int m = 0; m < 4; ++m) { const int mm = u.pm * 256 + ai * 128 + wr * 64 + m * 16 + fr, b = mm >> 6, c = mm & 63;
                u32x4 w0, w1;
                { const f32x4 v = acc[ai][0][m][0]; w0.x = pk2(gelu_tanh(v.x), gelu_tanh(v.y)); w0.y = pk2(gelu_tanh(v.z), gelu_tanh(v.w)); }
                { const f32x4 v = acc[ai][0][m][1]; w0.z = pk2(gelu_tanh(v.x), gelu_tanh(v.y)); w0.w = pk2(gelu_tanh(v.z), gelu_tanh(v.w)); }
                { const f32x4 v = acc[ai][1][m][0]; w1.x = pk2(gelu_tanh(v.x), gelu_tanh(v.y)); w1.y = pk2(gelu_tanh(v.z), gelu_tanh(v.w)); }
                { const f32x4 v = acc[ai][1][m][1]; w1.z = pk2(gelu_tanh(v.x), gelu_tanh(v.y)); w1.w = pk2(gelu_tanh(v.z), gelu_tanh(v.w)); }
#ifdef ABL_SSM
                w0 = (u32x4){0u, 0u, 0u, 0u}; w1 = w0;
#endif
                u32x4* d = (u32x4*)(Y + ((size_t)u.g * T + (size_t)b * 4096 + c * 64 + t) * 16); d[0] = w0; d[1] = w1; }
    }
};

template <class Fn> __device__ __forceinline__ void epi_each(f32x4 (&acc)[2][2][4][2], const pg::Unit& u, int wr, int wc, int fr, int fq, const Fn& fn) {
#pragma unroll
    for (int ai = 0; ai < 2; ++ai)
#pragma unroll
        for (int m = 0; m < 4; ++m) { const int r = u.pm * 256 + ai * 128 + wr * 64 + m * 16 + fr;
#pragma unroll
            for (int bj = 0; bj < 2; ++bj)
#pragma unroll
                for (int n = 0; n < 2; ++n) fn(r, u.pn * 256 + bj * 128 + wc * 32 + n * 16 + fq * 4, acc[ai][bj][m][n]); }
}
template <class Fn> __device__ __forceinline__ void epi_each16(f32x4 (&acc)[2][2][4][2], const pg::Unit& u, int wr, int wc, int fr, int fq, const Fn& fn) {
#pragma unroll
    for (int ai = 0; ai < 2; ++ai)
#pragma unroll
        for (int m = 0; m < 4; ++m) fn(u.pm * 256 + ai * 128 + wr * 64 + m * 16 + fr, u.pn * 256 + wc * 64 + fq * 16, acc[ai][0][m][0], acc[ai][0][m][1], acc[ai][1][m][0], acc[ai][1][m][1]);
}
struct EpiGlu { const bf16_t* YS; unsigned char* Y2; const float* b;
    __device__ __forceinline__ void operator()(f32x4 (&acc)[2][2][4][2], const pg::Unit& u, int wr, int wc, int fr, int fq) const {
        const int c = u.pn * 256 + wc * 64 + fq * 16, r0 = u.pm * 256 + wr * 64 + fr; const f32x4* bp = (const f32x4*)(b + c);
#pragma unroll
        for (int ai = 0; ai < 2; ++ai) { u32x4 ya[4], yb[4];
#pragma unroll
            for (int m = 0; m < 4; ++m) { const size_t r = (size_t)(r0 + ai * 128 + m * 16); const bf16_t* yp = YS + ((size_t)(c >> 4) * T + r) * 16; ya[m] = *(const u32x4*)yp; yb[m] = *(const u32x4*)(yp + 8); }
            asm volatile("" : "+v"(ya[0]), "+v"(ya[1]), "+v"(ya[2]), "+v"(ya[3]), "+v"(yb[0]), "+v"(yb[1]), "+v"(yb[2]), "+v"(yb[3]));
#pragma unroll
            for (int m = 0; m < 4; ++m) { const size_t r = (size_t)(r0 + ai * 128 + m * 16);
                u32x4 o; o.x = pkf84(bf4((u32x2){ya[m].x, ya[m].y}) * sig4(acc[ai][0][m][0] + bp[0])); o.y = pkf84(bf4((u32x2){ya[m].z, ya[m].w}) * sig4(acc[ai][0][m][1] + bp[1]));
                o.z = pkf84(bf4((u32x2){yb[m].x, yb[m].y}) * sig4(acc[ai][1][m][0] + bp[2])); o.w = pkf84(bf4((u32x2){yb[m].z, yb[m].w}) * sig4(acc[ai][1][m][1] + bp[3]));
                *(u32x4*)(Y2 + r * 512 + c) = o; } } }
};
template <bool ADD> struct EpiMix { const unsigned char* Gt; bf16_t* MIX; unsigned char* MIX8;
    __device__ __forceinline__ void operator()(f32x4 (&acc)[2][2][4][2], const pg::Unit& u, int wr, int wc, int fr, int fq) const {
        const int c = u.pn * 256 + wc * 64 + fq * 16, r0 = u.pm * 256 + wr * 64 + fr; unsigned char* MB = (unsigned char*)MIX;
        u32x4 g[8];
#pragma unroll
        for (int q = 0; q < 8; ++q) g[q] = *(const u32x4*)(Gt + (size_t)(r0 + (q >> 2) * 128 + (q & 3) * 16) * 1024 + c);
        u32x4 ma[8];
        if (ADD) {
#pragma unroll
            for (int q = 0; q < 8; ++q) ma[q] = *(const u32x4*)(MB + (size_t)(r0 + (q >> 2) * 128 + (q & 3) * 16) * 1024 + c); }
        asm volatile("" : "+v"(g[0]), "+v"(g[1]), "+v"(g[2]), "+v"(g[3]), "+v"(g[4]), "+v"(g[5]), "+v"(g[6]), "+v"(g[7]));
        if (ADD) asm volatile("" : "+v"(ma[0]), "+v"(ma[1]), "+v"(ma[2]), "+v"(ma[3]), "+v"(ma[4]), "+v"(ma[5]), "+v"(ma[6]), "+v"(ma[7]));
#pragma unroll
        for (int ai = 0; ai < 2; ++ai)
#pragma unroll
            for (int m = 0; m < 4; ++m) { const size_t r = (size_t)(r0 + ai * 128 + m * 16); const u32x4 gg = g[ai * 4 + m];
                f32x4 o0 = f84(gg.x) * acc[ai][0][m][0] * 0.03125f, o1 = f84(gg.y) * acc[ai][0][m][1] * 0.03125f, o2 = f84(gg.z) * acc[ai][1][m][0] * 0.03125f, o3 = f84(gg.w) * acc[ai][1][m][1] * 0.03125f;
                if (ADD) { const u32x4 mm = ma[ai * 4 + m]; o0 += f84(mm.x); o1 += f84(mm.y); o2 += f84(mm.z); o3 += f84(mm.w);
                    *(u32x4*)(MIX8 + r * 1024 + c) = (u32x4){pkf84(o0), pkf84(o1), pkf84(o2), pkf84(o3)}; }
                else *(u32x4*)(MB + r * 1024 + c) = (u32x4){pkf84(o0), pkf84(o1), pkf84(o2), pkf84(o3)}; } }
};
struct EpiWo { bf16_t* R1; const float* X; float sc; unsigned char* H2; const float* gm;
    __device__ __forceinline__ void operator()(f32x4 (&acc)[2][2][4][2], const pg::Unit& u, int wr, int wc, int fr, int fq) const {
        const int c = u.pn * 256 + wc * 64 + fq * 16, r0 = u.pm * 256 + wr * 64 + fr; f32x4 gv[4];
#pragma unroll
        for (int q = 0; q < 4; ++q) gv[q] = *(const f32x4*)(gm + c + 4 * q);
#pragma unroll
        for (int ai = 0; ai < 2; ++ai) { f32x4 xv[4][4];
#pragma unroll
            for (int m = 0; m < 4; ++m)
#pragma unroll
                for (int q = 0; q < 4; ++q) xv[m][q] = __builtin_nontemporal_load((const f32x4*)(X + (size_t)(r0 + ai * 128 + m * 16) * 1024 + c) + q);
            asm volatile("" : "+v"(xv[0][0]), "+v"(xv[0][1]), "+v"(xv[0][2]), "+v"(xv[0][3]), "+v"(xv[1][0]), "+v"(xv[1][1]), "+v"(xv[1][2]), "+v"(xv[1][3]));
            asm volatile("" : "+v"(xv[2][0]), "+v"(xv[2][1]), "+v"(xv[2][2]), "+v"(xv[2][3]), "+v"(xv[3][0]), "+v"(xv[3][1]), "+v"(xv[3][2]), "+v"(xv[3][3]));
#pragma unroll
            for (int m = 0; m < 4; ++m) { bf16_t* d = R1 + (size_t)(r0 + ai * 128 + m * 16) * 1024 + c;
                const f32x4 s0 = acc[ai][0][m][0] * sc + xv[m][0], s1 = acc[ai][0][m][1] * sc + xv[m][1], s2 = acc[ai][1][m][0] * sc + xv[m][2], s3 = acc[ai][1][m][1] * sc + xv[m][3];
                const u32x2 a = pkbf4(s0), b_ = pkbf4(s1), c_ = pkbf4(s2), dd = pkbf4(s3);
                *(u32x4*)d = (u32x4){a.x, a.y, b_.x, b_.y}; *(u32x4*)(d + 8) = (u32x4){c_.x, c_.y, dd.x, dd.y};
                *(u32x4*)(H2 + (size_t)(r0 + ai * 128 + m * 16) * 1024 + c) = (u32x4){pkf84(bf4(a) * gv[0]), pkf84(bf4(b_) * gv[1]), pkf84(bf4(c_) * gv[2]), pkf84(bf4(dd) * gv[3])}; } } }
};
struct EpiStoreBf { bf16_t* O; int ldo; float sc;
    __device__ __forceinline__ void operator()(f32x4 (&acc)[2][2][4][2], const pg::Unit& u, int wr, int wc, int fr, int fq) const {
        epi_each16(acc, u, wr, wc, fr, fq, [&](int r, int c, const f32x4& v0, const f32x4& v1, const f32x4& v2, const f32x4& v3) {
            const u32x2 a = pkbf4(v0 * sc), b_ = pkbf4(v1 * sc), c_ = pkbf4(v2 * sc), d = pkbf4(v3 * sc);
            *(u32x4*)(O + (size_t)r * ldo + c) = (u32x4){a.x, a.y, b_.x, b_.y}; *(u32x4*)(O + (size_t)r * ldo + c + 8) = (u32x4){c_.x, c_.y, d.x, d.y}; }); }
};
struct EpiPleNorm { const bf16_t* R2; const bf16_t* PROJ; float* OUT; const float* gain; float* xbuf; unsigned* pcnt; LAS float* Pl; LAS float* Sl;
    __device__ __forceinline__ void operator()(f32x4 (&acc)[2][2][4][2], const pg::Unit& u, int wr, int wc, int fr, int fq) const {
        const int tid = (wr * 4 + wc) * 64 + fq * 16 + fr;
        const int c0 = u.pn * 256 + wc * 64 + fq * 16;
#pragma unroll
        for (int ai = 0; ai < 2; ++ai)
#pragma unroll
            for (int m = 0; m < 4; ++m) { const size_t r = (size_t)u.pm * 256 + ai * 128 + wr * 64 + m * 16 + fr;
                const u32x4 ra = *(const u32x4*)(R2 + r * 1024 + c0), rb = *(const u32x4*)(R2 + r * 1024 + c0 + 8), pa = *(const u32x4*)(PROJ + r * 1024 + c0), pb = *(const u32x4*)(PROJ + r * 1024 + c0 + 8);
                acc[ai][0][m][0] = bf4((u32x2){ra.x, ra.y}) + sig4(acc[ai][0][m][0] * 0.03125f) * bf4((u32x2){pa.x, pa.y});
                acc[ai][0][m][1] = bf4((u32x2){ra.z, ra.w}) + sig4(acc[ai][0][m][1] * 0.03125f) * bf4((u32x2){pa.z, pa.w});
                acc[ai][1][m][0] = bf4((u32x2){rb.x, rb.y}) + sig4(acc[ai][1][m][0] * 0.03125f) * bf4((u32x2){pb.x, pb.y});
                acc[ai][1][m][1] = bf4((u32x2){rb.z, rb.w}) + sig4(acc[ai][1][m][1] * 0.03125f) * bf4((u32x2){pb.z, pb.w});
                asm volatile("" : "+v"(acc[ai][0][m][0]), "+v"(acc[ai][0][m][1]), "+v"(acc[ai][1][m][0]), "+v"(acc[ai][1][m][1]));
                if (m & 1) asm volatile("" ::: "memory"); }
#pragma unroll
        for (int ai = 0; ai < 2; ++ai)
#pragma unroll
            for (int m = 0; m < 4; ++m) { float q = 0.f;
#pragma unroll
                for (int bj = 0; bj < 2; ++bj)
#pragma unroll
                    for (int n = 0; n < 2; ++n) { const f32x4 x = acc[ai][bj][m][n]; q += (x[0] * x[0] + x[1] * x[1]) + (x[2] * x[2] + x[3] * x[3]); }
                q += __shfl_xor(q, 16); q += __shfl_xor(q, 32);
                if (fq == 0) Pl[(ai * 128 + wr * 64 + m * 16 + fr) * 4 + wc] = q; }
        asm volatile("s_waitcnt lgkmcnt(0)" ::: "memory"); __builtin_amdgcn_s_barrier(); asm volatile("" ::: "memory");
        if (tid < 256) { const float t = (Pl[tid * 4 + 0] + Pl[tid * 4 + 1]) + (Pl[tid * 4 + 2] + Pl[tid * 4 + 3]);
            __hip_atomic_store(xbuf + ((size_t)u.pm * 256 + tid) * 4 + u.pn, t, __ATOMIC_RELAXED, __HIP_MEMORY_SCOPE_AGENT); }
        asm volatile("s_waitcnt vmcnt(0) lgkmcnt(0)" ::: "memory"); __builtin_amdgcn_s_barrier(); asm volatile("" ::: "memory");
        if (tid == 0) { __hip_atomic_fetch_add(pcnt + u.pm, 1u, __ATOMIC_RELAXED, __HIP_MEMORY_SCOPE_AGENT);
            unsigned sp = 0; while (__hip_atomic_load(pcnt + u.pm, __ATOMIC_RELAXED, __HIP_MEMORY_SCOPE_AGENT) < 4u) { __builtin_amdgcn_s_sleep(2); if (++sp > (1u << 22)) break; }
            __builtin_amdgcn_fence(__ATOMIC_ACQUIRE, "agent"); }
        asm volatile("s_waitcnt vmcnt(0) lgkmcnt(0)" ::: "memory"); __builtin_amdgcn_s_barrier(); asm volatile("" ::: "memory");
        if (tid < 256) { const float* sl = xbuf + ((size_t)u.pm * 256 + tid) * 4;
            const float a0 = __hip_atomic_load(sl + 0, __ATOMIC_RELAXED, __HIP_MEMORY_SCOPE_AGENT), a1 = __hip_atomic_load(sl + 1, __ATOMIC_RELAXED, __HIP_MEMORY_SCOPE_AGENT), a2 = __hip_atomic_load(sl + 2, __ATOMIC_RELAXED, __HIP_MEMORY_SCOPE_AGENT), a3 = __hip_atomic_load(sl + 3, __ATOMIC_RELAXED, __HIP_MEMORY_SCOPE_AGENT);
            Sl[tid] = 1.0f / sqrtf(((a0 + a1) + (a2 + a3)) * (1.f / 1024.f) + EPS); }
        asm volatile("s_waitcnt vmcnt(0) lgkmcnt(0)" ::: "memory"); __builtin_amdgcn_s_barrier(); asm volatile("" ::: "memory");
        f32x4 gv[4];
#pragma unroll
        for (int q = 0; q < 4; ++q) gv[q] = *(const f32x4*)(gain + c0 + 4 * q);
#pragma unroll
        for (int ai = 0; ai < 2; ++ai)
#pragma unroll
            for (int m = 0; m < 4; ++m) { const int rl = ai * 128 + wr * 64 + m * 16 + fr; const float rs = Sl[rl]; f32x4* op = (f32x4*)(OUT + ((size_t)u.pm * 256 + rl) * 1024 + c0);
                op[0] = acc[ai][0][m][0] * rs * gv[0]; op[1] = acc[ai][0][m][1] * rs * gv[1]; op[2] = acc[ai][1][m][0] * rs * gv[2]; op[3] = acc[ai][1][m][1] * rs * gv[3]; }
        asm volatile("s_waitcnt lgkmcnt(0)" ::: "memory"); __builtin_amdgcn_s_barrier(); asm volatile("" ::: "memory");
    }
};

__device__ __forceinline__ void router_phase(Frame& F) {
    constexpr int WST = 1032;
    LAS bf16_t* whi = (LAS bf16_t*)F.lds; LAS bf16_t* wlo = whi + 32 * WST;
    LAS unsigned* lcnt = (LAS unsigned*)(F.lds + 2 * 32 * WST * 2);
    LAS unsigned* gbase = lcnt + 32;
    LAS unsigned* ent_e = gbase + 32;
    LAS float* ent_w = (LAS float*)(ent_e + 512);
    const float* Wr = F.in[19]; const float* br = F.in[20]; const float* gain = F.in[18]; const float* X = F.in[0];
    const bf16_t* D1 = (const bf16_t*)F.out + (size_t)T * 1024;
    unsigned char* H2 = F.dry ? WSP(unsigned char, WS_A) : (unsigned char*)F.out;
    unsigned* cnt = WSP(unsigned, WS_CTL) + CW_CNT + (F.dry ? 32 : 0); int* LTOK = F.dry ? (int*)(F.ws + WS_A + 70 * MB) : WSP(int, WS_LTOK); int* LSLOT = F.dry ? (int*)(F.ws + WS_A + 75 * MB) : WSP(int, WS_LSLOT); float* LWT = F.dry ? (float*)(F.ws + WS_A + 80 * MB) : WSP(float, WS_LWT);
    { f32x4 wv[16];
#pragma unroll
      for (int q = 0; q < 16; ++q) wv[q] = *((const f32x4*)Wr + F.tid + q * NTHR);
#pragma unroll
      for (int q = 0; q < 16; ++q) { const int i4 = F.tid + q * NTHR, k = i4 >> 3, e0 = (i4 & 7) * 4; const float g = gain[k];
#pragma unroll
          for (int c = 0; c < 4; ++c) { const float v = wv[q][c] * g; const unsigned h = f2bf(v); const float vh = __builtin_bit_cast(float, h << 16);
              whi[(e0 + c) * WST + k] = (bf16_t)h; wlo[(e0 + c) * WST + k] = (bf16_t)f2bf(v - vh); } } }
    const int lane = F.lane, tl = lane & 15, kq = lane >> 4;
    for (int tb = F.bid; tb < T / 128; tb += F.G) {
        if (F.tid < 32) lcnt[F.tid] = 0u;
        if (!F.dry) { const f32x4* ps = (const f32x4*)(F.in[1] + (size_t)tb * 128 * 256); u32x2* pd = (u32x2*)(WSP(bf16_t, WS_PBF) + (size_t)tb * 128 * 256);
#pragma unroll 4
            for (int q = 0; q < 16; ++q) { const f32x4 v = ps[F.tid + q * NTHR]; u32x2 w; w.x = pk2(v.x, v.y); w.y = pk2(v.z, v.w); pd[F.tid + q * NTHR] = w; } }
        __syncthreads();
        const int tok0 = tb * 128 + F.wave * 16, tok = tok0 + tl;
        const bf16_t* r1row = WSP(bf16_t, WS_E) + (size_t)tok * 1024 + 8 * kq;
        f32x4 acc[2]; acc[0] = (f32x4){0.f, 0.f, 0.f, 0.f}; acc[1] = acc[0]; float ss = 0.f;
        u32x4 RR[3];
#define RT_LOAD(st_) do { const int b_ = (st_) % 3; RR[b_] = *(const u32x4*)(r1row + 32 * (st_)); } while (0)
        RT_LOAD(0); RT_LOAD(1);
#pragma unroll
        for (int st = 0; st < 32; ++st) {
            if (st + 2 < 32) RT_LOAD(st + 2);
            const u32x4 rr = RR[st % 3];
            float r[8] = {bflo(rr.x), bfhi(rr.x), bflo(rr.y), bfhi(rr.y), bflo(rr.z), bfhi(rr.z), bflo(rr.w), bfhi(rr.w)};
#pragma unroll
            for (int p = 0; p < 4; ++p) { ss = __builtin_fmaf(r[2 * p], r[2 * p], ss); ss = __builtin_fmaf(r[2 * p + 1], r[2 * p + 1], ss); }
            const bf16x8 A_hi = __builtin_bit_cast(bf16x8, rr);
#pragma unroll
            for (int n = 0; n < 2; ++n) { const bf16x8 Bh = *(const LAS bf16x8*)(whi + (16 * n + tl) * WST + 32 * st + 8 * kq), Bl = *(const LAS bf16x8*)(wlo + (16 * n + tl) * WST + 32 * st + 8 * kq);
                acc[n] = __builtin_amdgcn_mfma_f32_16x16x32_bf16(A_hi, Bh, acc[n], 0, 0, 0); acc[n] = __builtin_amdgcn_mfma_f32_16x16x32_bf16(A_hi, Bl, acc[n], 0, 0, 0); }
        }
        ss += __shfl_xor(ss, 16); ss += __shfl_xor(ss, 32);
        const float rstd = 1.0f / sqrtf(ss * (1.f / 1024.f) + EPS);
        if (kq == 0 && !F.dry) WSP(float, WS_CTL)[CW_SSQ + tok] = rstd;
        const float b0 = br[tl], b1 = br[16 + tl];
#pragma unroll
        for (int rg = 0; rg < 4; ++rg) { const float rs = __shfl(rstd, 4 * kq + rg);
            float v0 = acc[0][rg] * rs + b0, v1 = acc[1][rg] * rs + b1; float tv[4]; int te[4];
#pragma unroll
            for (int k = 0; k < 4; ++k) { float bv = v0; int bi = tl; if (v1 > v0) { bv = v1; bi = 16 + tl; }
#pragma unroll
                for (int o = 1; o < 16; o <<= 1) { const float ov = __shfl_xor(bv, o); const int oi = __shfl_xor(bi, o); if (ov > bv || (ov == bv && oi < bi)) { bv = ov; bi = oi; } }
                tv[k] = bv; te[k] = bi; if (bi == tl) v0 = -INFINITY; if (bi == 16 + tl) v1 = -INFINITY; }
            const float e1 = __expf(tv[1] - tv[0]), e2 = __expf(tv[2] - tv[0]), e3 = __expf(tv[3] - tv[0]), inv = 1.0f / (1.0f + e1 + e2 + e3);
            if (tl < 4) { const int e = tl == 0 ? te[0] : tl == 1 ? te[1] : tl == 2 ? te[2] : te[3]; const float w = (tl == 0 ? 1.0f : tl == 1 ? e1 : tl == 2 ? e2 : e3) * inv;
                const int tli = F.wave * 16 + 4 * kq + rg;
                const unsigned pos = __hip_atomic_fetch_add(lcnt + e, 1u, __ATOMIC_RELAXED, __HIP_MEMORY_SCOPE_WORKGROUP);
                ent_e[tli * 4 + tl] = (unsigned)e | (pos << 8); ent_w[tli * 4 + tl] = w; }
        }
        __syncthreads();
        if (F.tid < 32) gbase[F.tid] = __hip_atomic_fetch_add(cnt + F.tid, lcnt[F.tid], __ATOMIC_RELAXED, __HIP_MEMORY_SCOPE_AGENT);
        __syncthreads();
        { const unsigned ee = ent_e[F.tid]; const int e = ee & 255, pos = (int)(gbase[e] + (ee >> 8)); const int tok_ = tb * 128 + (F.tid >> 2);
          LTOK[(size_t)e * T + pos] = tok_; LSLOT[(size_t)e * T + pos] = tok_ * 4 + (F.tid & 3); LWT[(size_t)e * T + pos] = ent_w[F.tid];
          if (!F.dry) WSP(unsigned, WS_INV)[tok_ * 4 + (F.tid & 3)] = (unsigned)e | ((unsigned)pos << 8); }
        __syncthreads();
    }
}

struct MoeTab { LAS int* cnt; LAS int* ntile; LAS int* cumu; LAS int* offs; LAS unsigned short* rowl; };
template <int NPN> __device__ __forceinline__ bool moe_unit(const MoeTab& tab, int L, pg::Unit& u) {
    if (L >= tab.cumu[32]) return false;
    const int cv = tab.cumu[__lane_id() & 31];
    const int e = __builtin_amdgcn_readfirstlane(__popcll(__ballot(cv <= L) & 0xffffffffull) - 1);
    const int rem = L - tab.cumu[e]; u.g = e; u.pm = rem / NPN; u.pn = rem % NPN; return true;
}
__device__ __forceinline__ int moe_L(int i, int G, int c) { return i * G + ((G & 7) == 0 ? (c & 7) * (G >> 3) + (c >> 3) : c); }
template <int NPN> __device__ __forceinline__ MoeTab moe_tab_build(Frame& F, bool gather) {
    MoeTab t; t.cnt = (LAS int*)(F.lds + 131072); t.ntile = t.cnt + 32; t.cumu = t.ntile + 32; t.offs = t.cumu + 40; t.rowl = (LAS unsigned short*)(F.lds + 131072 + 1024);
    __syncthreads();
    if (F.wave == 0) {
        const int e = F.lane & 31, n = (int)__hip_atomic_load(WSP(unsigned, WS_CTL) + CW_CNT + e, __ATOMIC_RELAXED, __HIP_MEMORY_SCOPE_AGENT), nt_ = (n + 255) >> 8;
        int cu = nt_ * NPN, of = n;
#pragma unroll
        for (int o = 1; o < 32; o <<= 1) { const int a_ = __shfl_up(cu, o), b_ = __shfl_up(of, o); if (e >= o) { cu += a_; of += b_; } }
        if (F.lane < 32) { t.cnt[e] = n; t.ntile[e] = nt_; t.cumu[e] = cu - nt_ * NPN; t.offs[e] = of - n; if (e == 31) { t.cumu[32] = cu; t.offs[32] = of; } } }
    __syncthreads();
    if (gather) {
        const int* ltok = WSP(int, WS_LTOK); int tk[9];
        const int hsel = F.tid >> 8, rowi = F.tid & 255;
#pragma unroll
        for (int j = 0; j < 9; ++j) { const int i = 2 * j + hsel; pg::Unit u; const bool ok = i < 17 && moe_unit<NPN>(t, moe_L(i < 17 ? i : 16, F.G, F.bid), u); const int g_ = ok ? u.g : 0, pm_ = ok ? u.pm : 0;
            int r = pm_ * 256 + rowi; const int n = t.cnt[g_]; r = r < n ? r : n - 1; r = r < 0 ? 0 : r; tk[j] = ltok[(size_t)g_ * T + r]; }
#pragma unroll
        for (int j = 0; j < 9; ++j) { const int i = 2 * j + hsel; if (i < 17) t.rowl[i * 256 + rowi] = (unsigned short)tk[j]; }
        __syncthreads();
    }
    return t;
}
template <int NPN> struct ProbMoe {
    const char* A; const char* W; MoeTab tab; unsigned ldb_bytes; int nt, G, c; bool gather; int hot;
    __device__ bool next(int i, pg::Unit& u) const { u.li = i; const bool ok = moe_unit<NPN>(tab, moe_L(i, G, c), u); if (hot) { u.li = 0; u.g = 0; u.pn = 0; u.pm = 0; } return ok; }
    __device__ const char* a_base(const pg::Unit&) const { return A; }
    __device__ unsigned a_off(const pg::Unit& u, int row, int col) const {
        unsigned arow;
        if (gather) arow = (unsigned)tab.rowl[u.li * 256 + row];
        else { int r = u.pm * 256 + row; const int n = tab.cnt[u.g]; r = r < n ? r : n - 1; arow = (unsigned)(tab.offs[u.g] + r); }
        return arow * 1024u + (unsigned)col * 2u; }
    __device__ const char* b_base(const pg::Unit& u) const { return W + ((size_t)u.g * (NPN * 256) + u.pn * 256) * 1024; }
};
struct EpiMoe1 { unsigned char* Aout; const float* bgate; const float* bup; const float* rstd; MoeTab tab; int dry; LAS float* prel;
    __device__ __forceinline__ void pre(const pg::Unit& u, int wid, int lane) const {
        LAS float* slot = prel + (u.li & 1) * 512;
        const float* src;
        if (wid < 4) src = rstd + tab.rowl[u.li * 256 + wid * 64 + lane];
        else if (wid < 6) src = bgate + u.g * 1024 + u.pn * 128 + (wid - 4) * 64 + lane;
        else src = bup + u.g * 1024 + u.pn * 128 + (wid - 6) * 64 + lane;
        __builtin_amdgcn_global_load_lds((const unsigned*)src, (LAS unsigned*)(slot + wid * 64), 4, 0, 0);
    }
    __device__ __forceinline__ void operator()(f32x4 (&acc)[2][2][4][2], const pg::Unit& u, int wr, int wc, int fr, int fq) const {
        if (dry >= 3) return;
        const int e = u.g, n = tab.cnt[e], off = tab.offs[e];
        const int col = u.pn * 128 + wc * 32 + fq * 8;
        f32x4 bg[2], bu[2];
        const LAS float* slot = prel + (u.li & 1) * 512;
#pragma unroll
        for (int nn = 0; nn < 2; ++nn) { bg[nn] = *(const LAS f32x4*)(slot + 256 + wc * 32 + fq * 8 + 4 * nn); bu[nn] = *(const LAS f32x4*)(slot + 384 + wc * 32 + fq * 8 + 4 * nn); }
        float rs_[8];
#pragma unroll
        for (int q = 0; q < 8; ++q) rs_[q] = 0.03125f * slot[(q >> 2) * 128 + wr * 64 + (q & 3) * 16 + fr];
#pragma unroll
        for (int ai = 0; ai < 2; ++ai)
#pragma unroll
            for (int m = 0; m < 4; ++m) { const int r = u.pm * 256 + ai * 128 + wr * 64 + m * 16 + fr; float o[8];
#pragma unroll
                for (int nn = 0; nn < 2; ++nn) { f32x4 g4 = acc[ai][0][m][nn] * rs_[ai * 4 + m] + bg[nn], u4 = acc[ai][1][m][nn] * rs_[ai * 4 + m] + bu[nn];
#pragma unroll
                    for (int j = 0; j < 4; ++j) { g4[j] = fminf(g4[j], 7.0f); u4[j] = fminf(fmaxf(u4[j], -7.0f), 7.0f); }
                    f32x4 ex = g4 * (-1.702f * 1.4426950408889634f);
#pragma unroll
                    for (int j = 0; j < 4; ++j) ex[j] = __builtin_amdgcn_exp2f(ex[j]);
                    f32x4 dn = ex + 1.0f;
#pragma unroll
                    for (int j = 0; j < 4; ++j) dn[j] = __builtin_amdgcn_rcpf(dn[j]);
                    const f32x4 res = (u4 * g4 + g4) * dn;
#pragma unroll
                    for (int j = 0; j < 4; ++j) o[4 * nn + j] = res[j]; }
                u32x2 w; w.x = pk4_fp8(o[0], o[1], o[2], o[3]); w.y = pk4_fp8(o[4], o[5], o[6], o[7]);
                if (r < n) { if (dry != 2) *(u32x2*)(Aout + (size_t)(off + r) * 1024 + col) = w; else asm volatile("" :: "v"(w.x), "v"(w.y)); } }
    }
};
struct EpiMoe2 { unsigned char* ws; unsigned char* outb; const float* bdown; const int* lslot; const float* lwt; MoeTab tab;
    __device__ __forceinline__ void operator()(f32x4 (&acc)[2][2][4][2], const pg::Unit& u, int wr, int wc, int fr, int fq) const {
        const int e = u.g, n = tab.cnt[e];
        int sl[8]; float wt[8];
#pragma unroll
        for (int q = 0; q < 8; ++q) { int r = u.pm * 256 + (q >> 2) * 128 + wr * 64 + (q & 3) * 16 + fr; r = r < n ? r : n - 1; sl[q] = tab.offs[e] + r; wt[q] = lwt[(size_t)e * T + r]; }
        const int c0 = u.pn * 256 + wc * 64 + fq * 16;
        f32x4 bd[4];
#pragma unroll
        for (int q = 0; q < 4; ++q) bd[q] = *(const f32x4*)(bdown + e * 1024 + c0 + 4 * q);
#pragma unroll
        for (int ai = 0; ai < 2; ++ai)
#pragma unroll
            for (int m = 0; m < 4; ++m) { const int r = u.pm * 256 + ai * 128 + wr * 64 + m * 16 + fr; if (r < n) { const int s_ = sl[ai * 4 + m]; const float w_ = wt[ai * 4 + m] * 16.0f;
                    unsigned char* dst = ws + WS_W1T + (size_t)s_ * 1024;
                    u32x4 o; o.x = pkf84((acc[ai][0][m][0] * 0.03125f + bd[0]) * w_); o.y = pkf84((acc[ai][0][m][1] * 0.03125f + bd[1]) * w_); o.z = pkf84((acc[ai][1][m][0] * 0.03125f + bd[2]) * w_); o.w = pkf84((acc[ai][1][m][1] * 0.03125f + bd[3]) * w_);
                    *(u32x4*)(dst + c0) = o; } }
    }
};

__device__ __forceinline__ void combine_phase(Frame& F) {
    const int gw = F.bid * 8 + F.wave, NGW = F.G * 8, lane = F.lane;
    const bf16_t* D1 = (const bf16_t*)F.out + (size_t)T * 1024;
    auto slotp = [&](int sl) -> const unsigned* { return (const unsigned*)(F.ws + WS_W1T + (size_t)sl * 1024) + lane; };
    int offl; { const int cn = (int)__hip_atomic_load(WSP(unsigned, WS_CTL) + CW_CNT + (lane & 31), __ATOMIC_RELAXED, __HIP_MEMORY_SCOPE_AGENT); int inc = cn;
#pragma unroll
        for (int o = 1; o < 32; o <<= 1) { const int up = __shfl_up(inc, o); if ((lane & 31) >= o) inc += up; }
        offl = inc - cn; }
    const unsigned* INV = WSP(unsigned, WS_INV);
    for (int tok = gw; tok < T; tok += NGW) {
        const u32x2* rr = (const u32x2*)(WSP(bf16_t, WS_E) + (size_t)tok * 1024) + lane;
        f32x4 v[4]; u32x2 d1[4]; unsigned d[4][4];
#pragma unroll
        for (int j = 0; j < 4; ++j) d1[j] = __builtin_nontemporal_load(rr + 64 * j);
        const unsigned invw = INV[tok * 4 + (lane & 3)];
#pragma unroll
        for (int k = 0; k < 4; ++k) { const unsigned iw = (unsigned)__builtin_amdgcn_readlane((int)invw, k); const int row = __builtin_amdgcn_readlane(offl, (int)(iw & 31u)) + (int)(iw >> 8); const unsigned* sr = slotp(row);
#pragma unroll
            for (int j = 0; j < 4; ++j) d[k][j] = __builtin_nontemporal_load(sr + 64 * j); }
#pragma unroll
        for (int j = 0; j < 4; ++j) v[j] = bf4(d1[j]);
#pragma unroll
        for (int k = 0; k < 4; ++k)
#pragma unroll
            for (int j = 0; j < 4; ++j) { const f32x2_t lo = __builtin_amdgcn_cvt_pk_f32_fp8((int)d[k][j], false), hi2 = __builtin_amdgcn_cvt_pk_f32_fp8((int)d[k][j], true);
                v[j].x += lo[0] * 0.0625f; v[j].y += lo[1] * 0.0625f; v[j].z += hi2[0] * 0.0625f; v[j].w += hi2[1] * 0.0625f; }
        u32x2* r2 = (u32x2*)(WSP(bf16_t, WS_R2) + (size_t)tok * 1024) + lane; unsigned* rb = (unsigned*)(WSP(unsigned char, WS_R2BF) + (size_t)tok * 1024) + lane;
#pragma unroll
        for (int j = 0; j < 4; ++j) { u32x2 w; w.x = pk2(v[j].x, v[j].y); w.y = pk2(v[j].z, v[j].w); r2[64 * j] = w; rb[64 * j] = pk4_fp8(v[j].x, v[j].y, v[j].z, v[j].w); }
    }
}
__device__ __forceinline__ void final_norm_phase(Frame& F) {
    const int gw = F.bid * 8 + F.wave, NGW = F.G * 8, lane = F.lane; const f32x4* gr = (const f32x4*)F.in[29] + lane;
    for (int tok = gw; tok < T; tok += NGW) {
        const u32x2* xr = (const u32x2*)(WSP(bf16_t, WS_E) + (size_t)tok * 1024) + lane; f32x4 v[4]; float s = 0.f;
#pragma unroll
        for (int j = 0; j < 4; ++j) { const u32x2 d = xr[64 * j]; v[j] = (f32x4){bflo(d.x), bfhi(d.x), bflo(d.y), bfhi(d.y)}; s += (v[j].x * v[j].x + v[j].y * v[j].y) + (v[j].z * v[j].z + v[j].w * v[j].w); }
        const float rstd = 1.0f / sqrtf(wave_sum(s) * (1.f / 1024.f) + EPS);
        f32x4* xw = F.dry ? (f32x4*)(WSP(float, WS_A) + (size_t)tok * 1024) + lane : (f32x4*)(F.out + (size_t)tok * 1024) + lane;
#pragma unroll
        for (int j = 0; j < 4; ++j) { const f32x4 g = gr[64 * j]; xw[64 * j] = (f32x4){v[j].x * rstd * g.x, v[j].y * rstd * g.y, v[j].z * rstd * g.z, v[j].w * rstd * g.w}; }
    }
}
constexpr size_t WS_BAR = 512 * 1024;
#define XB_TMO      128
#define XB_XCNT(j)  (256  + 64 * (j))
#define XB_XSUB(j)  (1280 + 64 * (j))
#define XB_XGEN(j)  (2304 + 64 * (j))
#define XB_TOP      3328
#define XB_TOPGEN   3392
#define XCD_BAR_WORDS 3456
#define XB_SPIN_CAP (1u << 18)
__device__ __forceinline__ unsigned xb_ld(unsigned* p)              { return __hip_atomic_load(p, __ATOMIC_RELAXED, __HIP_MEMORY_SCOPE_AGENT); }
__device__ __forceinline__ unsigned xb_add(unsigned* p, unsigned v) { return __hip_atomic_fetch_add(p, v, __ATOMIC_RELAXED, __HIP_MEMORY_SCOPE_AGENT); }
__device__ __forceinline__ unsigned xb_xcc_id() { return (unsigned)__builtin_amdgcn_s_getreg((3 << 11) | 20) & 0xFu; }
#define XB_SPIN(cond, bar) do { unsigned _sp = 0; while (cond) { __builtin_amdgcn_s_sleep(1); \
    if ((++_sp & 255u) == 0u) { if (xb_ld(&(bar)[XB_TMO])) break; if (_sp > XB_SPIN_CAP) { atomicAdd(&(bar)[XB_TMO], 1u); break; } } } } while (0)
struct XcdBarrier { unsigned* bar; unsigned x; volatile LAS unsigned* st; };
__device__ __forceinline__ XcdBarrier xcd_barrier_post(unsigned* bar, volatile LAS unsigned* st) {
    XcdBarrier b; b.bar = bar; b.x = xb_xcc_id(); b.st = st;
    if (threadIdx.x == 0) (void)xb_add(&bar[XB_XCNT(b.x)], 1u);
    return b;
}
__device__ __forceinline__ void xcd_barrier_complete(unsigned* bar, unsigned x, unsigned& nloc, unsigned& nx) {
    const unsigned G = gridDim.x * gridDim.y * gridDim.z;
    unsigned sum, cnt, mine, sp = 0u;
    for (;;) {
        sum = 0u; cnt = 0u; mine = 0u;
#pragma unroll
        for (unsigned j = 0; j < 16; ++j) { const unsigned c = xb_ld(&bar[XB_XCNT(j)]); sum += c; cnt += (c > 0u) ? 1u : 0u; mine = (j == x) ? c : mine; }
        if (sum == G) break;
        __builtin_amdgcn_s_sleep(1);
        if ((++sp & 255u) == 0u) { if (xb_ld(&bar[XB_TMO])) break; if (sp > XB_SPIN_CAP) { atomicAdd(&bar[XB_TMO], 1u); break; } }
    }
    nloc = mine > 0u ? mine : 1u; nx = cnt > 0u ? cnt : 1u;
}
__device__ __forceinline__ void xcd_barrier(const XcdBarrier& b) {
    asm volatile("s_waitcnt vmcnt(0)" ::: "memory");
    __syncthreads();
    if (threadIdx.x == 0) {
        unsigned* bar = b.bar;
        __builtin_amdgcn_s_waitcnt(0);
        unsigned nloc = b.st[0], nx = b.st[1];
        if (nloc == 0u) { xcd_barrier_complete(bar, b.x, nloc, nx); b.st[0] = nloc; b.st[1] = nx; }
        const unsigned old = xb_add(&bar[XB_XSUB(b.x)], 1u);
        const unsigned gen = old / nloc;
        if (old + 1u == (gen + 1u) * nloc) {
            __builtin_amdgcn_fence(__ATOMIC_RELEASE, "agent");
            asm volatile("s_waitcnt vmcnt(0)" ::: "memory");
            const unsigned og = xb_add(&bar[XB_TOP], 1u);
            const unsigned tg = og / nx;
            if (og + 1u == (tg + 1u) * nx) xb_add(&bar[XB_TOPGEN], 1u);
            else XB_SPIN(xb_ld(&bar[XB_TOPGEN]) == tg, bar);
            __builtin_amdgcn_fence(__ATOMIC_ACQUIRE, "agent");
            xb_add(&bar[XB_XGEN(b.x)], 1u);
            asm volatile("s_waitcnt vmcnt(0)" ::: "memory");
        } else {
            XB_SPIN(xb_ld(&bar[XB_XGEN(b.x)]) == gen, bar);
            __builtin_amdgcn_fence(__ATOMIC_ACQUIRE, "agent");
            asm volatile("s_waitcnt vmcnt(0)" ::: "memory");
        }
    }
    __syncthreads();
}

constexpr int LDS_BYTES = 147456;
constexpr int NPHASE = 14;
#ifndef MK_MULTI
#define MK_MULTI 0
#endif
struct Args { const float* in[30]; float* out; unsigned char* ws; int ph_lo, ph_hi, dry, pad; };
static_assert(sizeof(Args) == 32 * 8 + 16, "no padding in Args");

__global__ void __launch_bounds__(NTHR, 2) fwd(Args a) {
    extern __shared__ __attribute__((aligned(16))) unsigned char lds_[];
    Frame F;
    F.lds = (LAS unsigned char*)lds_;
    F.tid = threadIdx.x; F.lane = F.tid & 63; F.wave = __builtin_amdgcn_readfirstlane(F.tid >> 6); F.G = gridDim.x; F.bid = blockIdx.x;
#pragma unroll
    for (int i = 0; i < 30; ++i) F.in[i] = a.in[i];
    F.out = a.out; F.ws = a.ws; F.dry = a.dry;
    const int lo = a.ph_lo, hi = a.ph_hi;
#ifndef PHMASK
#define PHMASK 0x3fff
#endif
#define IN(k) (((PHMASK >> (k)) & 1) && lo <= (k) && (k) < hi)
    volatile LAS unsigned* xst = (volatile LAS unsigned*)(F.lds + LDS_BYTES - 64);
    if (F.tid < 2) xst[F.tid] = 0u;
    __syncthreads();
    const XcdBarrier xbar = xcd_barrier_post((unsigned*)(F.ws + WS_BAR), xst);
#define SEAM(k) do { if (IN(k) && IN((k) + 1)) xcd_barrier(xbar); } while (0)
    bf16_t* GS = (bf16_t*)F.out; bf16_t* GA = GS + (size_t)T * 1024;

    if (IN(0)) { p0_prologue(F); __syncthreads(); p0_s5_tables(F); }
    SEAM(0);
    if (IN(1)) {
        EpiInProj E; E.U = WSP(bf16_t, WS_U); E.Q = WSP(bf16_t, WS_Q); E.K = WSP(bf16_t, WS_K); E.V = WSP(bf16_t, WS_V); E.QI = WSP(bf16_t, WS_QIDX); E.KI = WSP(bf16_t, WS_KIDX); E.GS = GS; E.GA = GA;
        E.WI = WSP(float, WS_WIDX); E.bg = F.in[3]; E.c64 = WSP(float, WS_COS64); E.s64 = WSP(float, WS_SIN64); E.c32 = WSP(float, WS_COS32); E.s32 = WSP(float, WS_SIN32);
        { pg::Dense P; P.A = (const char*)WSP(unsigned char, WS_H8); P.B = (const char*)WSP(unsigned char, WS_WIN8); P.lda_bytes = 1024; P.ldb_bytes = 1024; P.nt = 8; P.ord.init(T / 256, 16, F.G, F.bid); P.pn_split = 8; P.pn_skip = 2;
          E.ascale = 0.03125f; pg::gemm_phase<true>(F.lds, P, E); }
        { pg::Dense P; P.A = (const char*)WSP(unsigned char, WS_H8); P.B = (const char*)WSP(unsigned char, WS_WIN8); P.lda_bytes = 1024; P.ldb_bytes = 1024; P.nt = 8; P.ord.init(T / 256, 2, F.G, F.bid); P.pn_base = 8;
          E.ascale = 0.03125f; pg::gemm_phase<true>(F.lds, P, E); }
    }
    SEAM(1);
    if (IN(2)) {
        { ProbS5E P; P.U = (const char*)WSP(bf16_t, WS_U); P.Wg = (const char*)WSP(bf16_t, WS_WG); P.ldb_bytes = 2048; P.nt = 16; P.G = F.G; P.c = F.bid; EpiS5E E; E.E = WSP(float, WS_EF32); pg::gemm_phase(F.lds, P, E); }
        __syncthreads();
        idx_phase(F);
    }
    SEAM(2);
    if (IN(3)) { s5_scan(F); __syncthreads(); attn_phase(F); }
    SEAM(3);
    if (IN(4)) { ProbS5Y P; P.U = (const char*)WSP(bf16_t, WS_U); P.TV = (const char*)WSP(bf16_t, WS_TV); P.ldb_bytes = 2304; P.nt = 18; P.G = F.G; P.c = F.bid; EpiS5Y E; E.Y = WSP(bf16_t, WS_E); pg::gemm_phase(F.lds, P, E); }
    SEAM(4);
    if (IN(5)) { pg::ProbGlu P; P.A = (const char*)WSP(bf16_t, WS_E); P.B = (const char*)WSP(bf16_t, WS_WGLUT); P.ldb_bytes = 1024; P.nt = 8; P.ord.init(T / 256, 2, F.G, F.bid);
        EpiGlu E; E.YS = WSP(bf16_t, WS_E); E.Y2 = WSP(unsigned char, WS_Y28); E.b = F.in[13]; pg::gemm_phase(F.lds, P, E); }
    SEAM(5);
    if (IN(6)) {
        { pg::Dense P; P.A = (const char*)WSP(unsigned char, WS_Y28); P.B = (const char*)WSP(unsigned char, WS_WSB8); P.lda_bytes = 512; P.ldb_bytes = 512; P.nt = 4; P.ord.init(T / 256, 4, F.G, F.bid);
          EpiMix<false> E; E.Gt = (const unsigned char*)GS; E.MIX = F.dry ? WSP(bf16_t, WS_U) : GA; E.MIX8 = nullptr; pg::gemm_phase<true>(F.lds, P, E); }
        { pg::Dense P; P.A = (const char*)WSP(unsigned char, WS_YA8); P.B = (const char*)WSP(unsigned char, WS_WAB8); P.lda_bytes = 512; P.ldb_bytes = 512; P.nt = 4; P.ord.init(T / 256, 4, F.G, F.bid);
          EpiMix<true> E; E.Gt = (const unsigned char*)GS + (size_t)T * 1024; E.MIX = F.dry ? WSP(bf16_t, WS_U) : GA; E.MIX8 = F.dry ? WSP(unsigned char, WS_V) : WSP(unsigned char, WS_MIX8); pg::gemm_phase<true>(F.lds, P, E); }
    }
    SEAM(6);
    if (IN(7)) { pg::Dense P; P.A = (const char*)WSP(unsigned char, WS_MIX8); P.B = (const char*)WSP(unsigned char, WS_WO8); P.lda_bytes = 1024; P.ldb_bytes = 1024; P.nt = 8; P.ord.init(T / 256, 4, F.G, F.bid);
        EpiWo E; E.R1 = WSP(bf16_t, WS_E); E.X = F.in[0]; E.sc = 0.03125f; E.H2 = (unsigned char*)F.out; E.gm = F.in[18]; pg::gemm_phase<true>(F.lds, P, E); }
    SEAM(7);
    if (IN(8)) router_phase(F);
    SEAM(8);
    if (IN(9)) { const MoeTab tab = moe_tab_build<8>(F, true);
        ProbMoe<8> P; P.A = (const char*)GS; P.W = (const char*)WSP(bf16_t, WS_W1T); P.tab = tab; P.ldb_bytes = 1024; P.nt = 8; P.G = F.G; P.c = F.bid; P.gather = true; P.hot = (F.dry == 4);
        EpiMoe1 E; E.Aout = WSP(unsigned char, WS_A); E.bgate = F.in[22]; E.bup = F.in[24]; E.rstd = WSP(float, WS_CTL) + CW_SSQ; E.tab = tab; E.dry = F.dry; E.prel = (LAS float*)(F.lds + 140800); pg::gemm_phase<true>(F.lds, P, E); }
    SEAM(9);
    if (IN(10)) { const MoeTab tab = moe_tab_build<4>(F, false);
        ProbMoe<4> P; P.A = (const char*)WSP(bf16_t, WS_A); P.W = (const char*)WSP(bf16_t, WS_W2T); P.tab = tab; P.ldb_bytes = 1024; P.nt = 8; P.G = F.G; P.c = F.bid; P.gather = false; P.hot = 0;
        EpiMoe2 E; E.ws = F.ws; E.outb = (unsigned char*)F.out; E.bdown = F.in[26]; E.lslot = WSP(int, WS_LSLOT); E.lwt = WSP(float, WS_LWT); E.tab = tab; pg::gemm_phase<true>(F.lds, P, E);
        { const int total = tab.cumu[32], rounds = (total + F.G - 1) / F.G, nfull = total - (rounds - 1) * F.G, nidle = F.G - nfull;
          const int pos = moe_L(0, F.G, F.bid);
          const int G2 = nidle > 0 ? nidle : F.G, c2 = nidle > 0 ? pos - nfull : pos;
          if (c2 >= 0) { pg::Dense P2; P2.A = (const char*)WSP(bf16_t, WS_PBF); P2.B = (const char*)WSP(bf16_t, WS_WPPT); P2.lda_bytes = 512; P2.ldb_bytes = 512; P2.nt = 4; P2.ord.init(T / 256, 4, G2, c2);
              EpiStoreBf E2; E2.O = WSP(bf16_t, WS_PROJ); E2.ldo = 1024; E2.sc = 1.0f; pg::gemm_phase(F.lds, P2, E2); } } }
    SEAM(10);
    if (IN(11)) combine_phase(F);
    SEAM(11);
    if (IN(12)) {
        { pg::Dense P; P.A = (const char*)WSP(unsigned char, WS_R2BF); P.B = (const char*)WSP(unsigned char, WS_WPG8); P.lda_bytes = 1024; P.ldb_bytes = 1024; P.nt = 8; P.ord.init(T / 256, 4, F.G, F.bid);
          EpiPleNorm E; E.R2 = WSP(bf16_t, WS_R2); E.PROJ = WSP(bf16_t, WS_PROJ); E.OUT = F.out; E.gain = F.in[29]; E.xbuf = (float*)(F.ws + WS_XBUF); E.pcnt = WSP(unsigned, WS_CTL) + CW_PCNT;
          E.Pl = (LAS float*)(F.lds + 131072); E.Sl = (LAS float*)(F.lds + 131072 + 4096); pg::gemm_phase<true>(F.lds, P, E); }
    }
#undef IN
#undef SEAM
}

extern "C" void kernel_launch(void* const* d_in, const int* in_sizes, int n_in, void* d_out, int out_size, void* d_ws, size_t ws_size, hipStream_t stream) {
    static int grid = 0;
    if (grid == 0) {
        if (n_in != 30 || out_size != T * 1024 || ws_size < WS_END) { fprintf(stderr, "kernel_launch: unexpected shapes (n_in %d, out %d, ws %zu < %zu)\n", n_in, out_size, ws_size, (size_t)WS_END); grid = -1; return; }
        int dev = 0, cus = 0, per_cu = 0;
        hipGetDevice(&dev); hipDeviceGetAttribute(&cus, hipDeviceAttributeMultiprocessorCount, dev);
        hipFuncSetAttribute((const void*)fwd, hipFuncAttributeMaxDynamicSharedMemorySize, LDS_BYTES);
        hipOccupancyMaxActiveBlocksPerMultiprocessor(&per_cu, (const void*)fwd, NTHR, LDS_BYTES);
        if (per_cu < 1) { fprintf(stderr, "kernel_launch: occupancy query says %d blocks per CU\n", per_cu); per_cu = 1; }
        (void)hipGetLastError();
        grid = cus;
    }
    if (grid < 0) return;
    Args a{};
    for (int i = 0; i < 30; ++i) a.in[i] = (const float*)d_in[i];
    a.out = (float*)d_out; a.ws = (unsigned char*)d_ws;
#if MK_MULTI
#ifndef DUP_MASK
#define DUP_MASK 0
#endif
    for (int ph = 0; ph < NPHASE; ++ph) { a.ph_lo = ph; a.ph_hi = ph + 1; const int reps = ((DUP_MASK >> ph) & 1) ? 2 : 1;
        for (int r = 0; r < reps; ++r) { a.dry = (r + 1 < reps && (ph == 3 || ph == 6 || ph == 8 || ph == 13)) ? 1 : 0;
#ifdef DRY9
            if (ph == 9 && r + 1 < reps) a.dry = DRY9;
#endif
 hipLaunchKernelGGL(fwd, dim3(grid), dim3(NTHR), LDS_BYTES, stream, a); } }
#else
    (void)hipMemsetAsync((char*)d_ws + WS_BAR, 0, XCD_BAR_WORDS * 4, stream);
    a.ph_lo = 0; a.ph_hi = NPHASE; void* args[] = {&a};
    hipError_t e = hipLaunchCooperativeKernel((const void*)fwd, dim3(grid), dim3(NTHR), args, LDS_BYTES, stream);
    if (e != hipSuccess) fprintf(stderr, "cooperative launch failed: %s (grid %d)\n", hipGetErrorString(e), grid);
#endif
}
```
